# Optimizing an MI355X kernel written in HIP

```python
import math
import jax, jax.numpy as jnp
from jax import lax
import numpy as np

D_MODEL = 1024
BATCH = 8
SEQ = 2048
DEPTH = 1
DEC_BATCH = 128
DEC_SEQ = 1
PAST_LEN = 16384
PAGE_SIZE = 128

D_SSD = D_MODEL
SSD_HEADDIM = 64
H_SSD = D_SSD // SSD_HEADDIM
SSD_GROUPS = 2
SSD_STATE = 128
CONV_K = 4
CONV_DIM = D_SSD + 2 * SSD_GROUPS * SSD_STATE
SSD_CHUNK = 128
D_RWKV = D_MODEL
HD_RWKV = 64
H_RWKV = D_RWKV // HD_RWKV
W_RANK = 64
A_RANK = 64
G_RANK = 128
RWKV_PROJ = 3 * D_RWKV + W_RANK + A_RANK + G_RANK
RWKV_LN_EPS = 64e-5
D_IN = D_SSD + CONV_DIM + H_SSD + RWKV_PROJ + 2 * D_MODEL
N_MEM = 256
MEM_HEADS = 4
MEM_HD = D_MODEL // MEM_HEADS
N_KEYS = 128
N_EXPERTS = N_KEYS * N_KEYS
PEER_HEADS = 8
PEER_DKEY = 256
PEER_HALF = PEER_DKEY // 2
PEER_TOPK = 16
PEER_BLOCK = 128
NORM_EPS = 1e-6

kernel_name = 'hybrid_ssd_rwkv7_peer_decode_step'


def _rmsnorm(x, w):
    xf = x.astype(jnp.float32)
    y = xf * lax.rsqrt(jnp.mean(xf * xf, axis=-1, keepdims=True) + NORM_EPS)
    return (y * w.astype(jnp.float32)).astype(x.dtype)


def _split(x, sizes):
    offs = []
    acc = 0
    for s in sizes[:-1]:
        acc += s
        offs.append(acc)
    return jnp.split(x, offs, axis=-1)


def _segsum(a):
    cs = jnp.cumsum(a, axis=-1)
    t = a.shape[-1]
    mask = jnp.tril(jnp.ones((t, t), dtype=bool))
    return jnp.where(mask, cs[..., :, None] - cs[..., None, :], -jnp.inf)


def _ssd(xh, dt, a_head, bm, cm, init_state):
    b, L = xh.shape[0], xh.shape[1]
    l = SSD_CHUNK if L % SSD_CHUNK == 0 else L
    c = L // l
    g, e = SSD_GROUPS, H_SSD // SSD_GROUPS
    xc = (xh * dt[..., None]).reshape(b, c, l, g, e, SSD_HEADDIM)
    ad = jnp.moveaxis((dt * a_head).reshape(b, c, l, g, e), (1, 2), (3, 4))
    bc = bm.reshape(b, c, l, g, SSD_STATE)
    cc = cm.reshape(b, c, l, g, SSD_STATE)
    a_cs = jnp.cumsum(ad, axis=-1)
    lmat = jnp.exp(_segsum(ad))
    cb = jnp.einsum('bclgn,bcsgn->bgcls', cc, bc)
    y_diag = jnp.einsum('bgcls,bgecls,bcsgep->bclgep', cb, lmat, xc)
    decay_states = jnp.exp(a_cs[..., -1:] - a_cs)
    states = jnp.einsum('bclgn,bgecl,bclgep->bcgepn', bc, decay_states, xc)
    init = init_state.reshape(b, 1, g, e, SSD_HEADDIM, SSD_STATE)
    states = jnp.concatenate([init, states], axis=1)
    chunk_a = jnp.pad(a_cs[..., -1], ((0, 0), (0, 0), (0, 0), (1, 0)))
    decay_chunk = jnp.exp(_segsum(chunk_a))
    new_states = jnp.einsum('bgezc,bcgepn->bzgepn', decay_chunk, states)
    y_off = jnp.einsum('bclgn,bcgepn,bgecl->bclgep', cc, new_states[:, :-1], jnp.exp(a_cs))
    y = (y_diag + y_off).reshape(b, L, H_SSD, SSD_HEADDIM)
    final = new_states[:, -1].reshape(b, H_SSD, SSD_HEADDIM, SSD_STATE)
    return y, final


def _rwkv7_scan(r, decay, k, v, kk_a, kk_b, s0):
    def step(s, inp):
        r_t, w_t, k_t, v_t, a_t, b_t = inp
        sa = jnp.einsum('bhvk,bhk->bhv', s, a_t)
        s = s * w_t[:, :, None, :] + sa[..., None] * b_t[:, :, None, :] + v_t[..., None] * k_t[:, :, None, :]
        return s, jnp.einsum('bhvk,bhk->bhv', s, r_t)
    xs = tuple(jnp.moveaxis(t, 1, 0) for t in (r, decay, k, v, kk_a, kk_b))
    s_final, ys = lax.scan(step, s0, xs)
    return jnp.moveaxis(ys, 0, 1), s_final


def _gated_mixer(h, conv_prev, ssm_prev, shift_prev, wkv_prev, p):
    f32 = jnp.float32
    b, L, _ = h.shape
    proj = h @ p['w_in']
    z, xbc, dt_raw, rw, gate_raw = _split(proj, (D_SSD, CONV_DIM, H_SSD, RWKV_PROJ, 2 * D_MODEL))

    xbc_all = jnp.concatenate([conv_prev.astype(xbc.dtype), xbc], axis=1)
    conv = p['conv_b'] + sum(xbc_all[:, i:i + L] * p['conv_w'][i] for i in range(CONV_K))
    conv_new = xbc_all[:, L:]
    xs, bm, cm = _split(jax.nn.silu(conv.astype(f32)), (D_SSD, SSD_GROUPS * SSD_STATE, SSD_GROUPS * SSD_STATE))
    xs = xs.reshape(b, L, H_SSD, SSD_HEADDIM)
    dt = jax.nn.softplus(dt_raw.astype(f32) + p['dt_bias'].astype(f32))
    a_head = -jnp.exp(p['a_log'].astype(f32))
    y, ssm_new = _ssd(xs, dt, a_head, bm.reshape(b, L, SSD_GROUPS, SSD_STATE),
                      cm.reshape(b, L, SSD_GROUPS, SSD_STATE), ssm_prev.astype(f32))
    y = (y + p['d_skip'].astype(f32)[:, None] * xs).reshape(b, L, D_SSD)
    y_ssd = _rmsnorm(y * jax.nn.silu(z.astype(f32)), p['ssd_norm_w'])

    rw_prev = jnp.concatenate([shift_prev[:, None].astype(rw.dtype), rw[:, :-1]], axis=1)
    rws = (rw + (rw_prev - rw) * p['rwkv_mu']).astype(f32)
    shift_new = rw[:, -1]
    r, k, v, wl, al, gl = _split(rws, (D_RWKV, D_RWKV, D_RWKV, W_RANK, A_RANK, G_RANK))
    wlog = -jax.nn.softplus(-(p['rwkv_w0'] + jnp.tanh(wl) @ p['rwkv_w2'])) - 0.5
    decay = jnp.exp(-jnp.exp(wlog))
    a = jax.nn.sigmoid(p['rwkv_a0'] + al @ p['rwkv_a2'])
    g = jax.nn.sigmoid(gl) @ p['rwkv_g2']
    heads = lambda t: t.reshape(b, L, H_RWKV, HD_RWKV)
    kk = heads(k * p['rwkv_k_k'])
    kk = kk * lax.rsqrt(jnp.maximum(jnp.sum(kk * kk, axis=-1, keepdims=True), 1e-24))
    kh = heads(k * (1.0 + (a - 1.0) * p['rwkv_k_a']))
    rh, vh, ah = heads(r), heads(v), heads(a)
    yr, wkv_new = _rwkv7_scan(rh, heads(decay), kh, vh, -kk, kk * ah, wkv_prev.astype(f32))
    mean = jnp.mean(yr, axis=-1, keepdims=True)
    var = jnp.mean(jnp.square(yr - mean), axis=-1, keepdims=True)
    yr = ((yr - mean) * lax.rsqrt(var + RWKV_LN_EPS)).reshape(b, L, D_RWKV) * p['rwkv_ln_w'] + p['rwkv_ln_b']
    bonus = jnp.sum(rh * kh * p['rwkv_r_k'], axis=-1, keepdims=True) * vh
    y_rwkv = (yr + bonus.reshape(b, L, D_RWKV)) * g

    gate_ssd, gate_rwkv = jnp.split(jax.nn.sigmoid(gate_raw.astype(f32)), 2, axis=-1)
    merged = gate_ssd * y_ssd + gate_rwkv * y_rwkv
    out = merged.astype(h.dtype) @ p['w_out']
    return (out, conv_new.astype(h.dtype), ssm_new.astype(h.dtype),
            shift_new.astype(h.dtype), wkv_new.astype(h.dtype))


def _memory_kv(mem, mem_norm_w, w_mk, w_mv):
    b, n, _ = mem.shape
    m = _rmsnorm(mem, mem_norm_w)
    return ((m @ w_mk).reshape(b, n, MEM_HEADS, MEM_HD), (m @ w_mv).reshape(b, n, MEM_HEADS, MEM_HD))


def _cross_attn(h, mem_k, mem_v, w_mq, w_mo):
    b, L, _ = h.shape
    q = (h @ w_mq).reshape(b, L, MEM_HEADS, MEM_HD)
    s = jnp.einsum('blhd,bmhd->bhlm', q.astype(jnp.float32), mem_k.astype(jnp.float32)) * (MEM_HD ** -0.5)
    prob = jax.nn.softmax(s, axis=-1).astype(h.dtype)
    o = jnp.einsum('bhlm,bmhd->blhd', prob, mem_v.astype(h.dtype)).reshape(b, L, D_MODEL)
    return o @ w_mo


def _peer(h, w_pq, sub_keys, expert_u, expert_v):
    b, L, d = h.shape
    t = b * L
    pad = (-t) % PEER_BLOCK
    xt = jnp.pad(h.reshape(t, d), ((0, pad), (0, 0))).reshape(-1, PEER_BLOCK, d)

    def one_block(xb):
        q = (xb @ w_pq).reshape(PEER_BLOCK, PEER_HEADS, 2, PEER_HALF).astype(jnp.float32)
        s = jnp.einsum('thcd,hckd->thck', q, sub_keys.astype(jnp.float32))
        s1, i1 = lax.top_k(s[:, :, 0], PEER_TOPK)
        s2, i2 = lax.top_k(s[:, :, 1], PEER_TOPK)
        cand_s = (s1[..., :, None] + s2[..., None, :]).reshape(PEER_BLOCK, PEER_HEADS, PEER_TOPK * PEER_TOPK)
        cand_i = (i1[..., :, None] * N_KEYS + i2[..., None, :]).reshape(PEER_BLOCK, PEER_HEADS, PEER_TOPK * PEER_TOPK)
        top_s, pos = lax.top_k(cand_s, PEER_TOPK)
        idx = jnp.take_along_axis(cand_i, pos, axis=-1)
        gate = jax.nn.softmax(top_s, axis=-1)
        act = jax.nn.gelu(jnp.einsum('td,thkd->thk', xb, expert_u[idx]).astype(jnp.float32), approximate=False)
        coef = (gate * act).astype(xb.dtype)
        return jnp.einsum('thk,thkd->td', coef, expert_v[idx])

    out = lax.map(one_block, xt)
    return out.reshape(-1, d)[:t].reshape(b, L, d)


def _block(x, mem_k, mem_v, conv_prev, ssm_prev, shift_prev, wkv_prev, p):
    mix, conv_new, ssm_new, shift_new, wkv_new = _gated_mixer(
        _rmsnorm(x, p['norm_mix_w']), conv_prev, ssm_prev, shift_prev, wkv_prev, p)
    x = x + mix
    x = x + _cross_attn(_rmsnorm(x, p['norm_mem_w']), mem_k, mem_v, p['w_mq'], p['w_mo'])
    x = x + _peer(_rmsnorm(x, p['norm_ffn_w']), p['w_pq'], p['sub_keys'], p['expert_u'], p['expert_v'])
    return x, conv_new, ssm_new, shift_new, wkv_new


def setup_inputs(seed: int = 0) -> dict:
    key = jax.random.key(seed)
    ks = iter(jax.random.split(key, 64))
    f32 = jnp.float32
    L = DEPTH

    def nrm(shape, scale):
        return jax.random.normal(next(ks), shape, f32) * scale

    def unif(shape, lo, hi):
        return jax.random.uniform(next(ks), shape, f32, lo, hi)

    def gain(shape):
        return 1.0 + nrm(shape, 0.02)

    dt0 = jnp.exp(unif((L, H_SSD), math.log(1e-3), math.log(1e-1)))
    return {
        'x_prompt': nrm((BATCH, SEQ, D_MODEL), 1.0),
        'x_sample': nrm((DEC_BATCH, DEC_SEQ, D_MODEL), 1.0),
        'mem_prompt': nrm((BATCH, N_MEM, D_MODEL), 1.0),
        'state_ssm': nrm((L, DEC_BATCH, H_SSD, SSD_HEADDIM, SSD_STATE), 0.3),
        'state_conv': nrm((L, DEC_BATCH, CONV_K - 1, CONV_DIM), 1.0),
        'state_wkv': nrm((L, DEC_BATCH, H_RWKV, HD_RWKV, HD_RWKV), 0.3),
        'state_shift': nrm((L, DEC_BATCH, RWKV_PROJ), 1.0),
        'cache_mem_k': nrm((L, DEC_BATCH, N_MEM, MEM_HEADS, MEM_HD), 1.0),
        'cache_mem_v': nrm((L, DEC_BATCH, N_MEM, MEM_HEADS, MEM_HD), 1.0),
        'norm_mix_w': gain((L, D_MODEL)),
        'w_in': nrm((L, D_MODEL, D_IN), D_MODEL ** -0.5),
        'conv_w': nrm((L, CONV_K, CONV_DIM), CONV_K ** -0.5),
        'conv_b': nrm((L, CONV_DIM), 0.02),
        'dt_bias': dt0 + jnp.log(-jnp.expm1(-dt0)),
        'a_log': jnp.log(unif((L, H_SSD), 1.0, 16.0)),
        'd_skip': gain((L, H_SSD)),
        'ssd_norm_w': gain((L, D_SSD)),
        'rwkv_mu': unif((L, RWKV_PROJ), 0.0, 1.0),
        'rwkv_w0': unif((L, D_RWKV), -4.0, 0.0),
        'rwkv_w2': nrm((L, W_RANK, D_RWKV), 0.1),
        'rwkv_a0': nrm((L, D_RWKV), 0.1),
        'rwkv_a2': nrm((L, A_RANK, D_RWKV), 0.1),
        'rwkv_g2': nrm((L, G_RANK, D_RWKV), G_RANK ** -0.5),
        'rwkv_k_k': 0.85 + nrm((L, D_RWKV), 0.02),
        'rwkv_k_a': gain((L, D_RWKV)),
        'rwkv_r_k': nrm((L, H_RWKV, HD_RWKV), 0.1),
        'rwkv_ln_w': gain((L, D_RWKV)),
        'rwkv_ln_b': nrm((L, D_RWKV), 0.02),
        'w_out': nrm((L, D_MODEL, D_MODEL), D_MODEL ** -0.5),
        'norm_mem_w': gain((L, D_MODEL)),
        'mem_norm_w': gain((L, D_MODEL)),
        'w_mk': nrm((L, D_MODEL, D_MODEL), D_MODEL ** -0.5),
        'w_mv': nrm((L, D_MODEL, D_MODEL), D_MODEL ** -0.5),
        'w_mq': nrm((L, D_MODEL, D_MODEL), D_MODEL ** -0.5),
        'w_mo': nrm((L, D_MODEL, D_MODEL), D_MODEL ** -0.5),
        'norm_ffn_w': gain((L, D_MODEL)),
        'w_pq': nrm((L, D_MODEL, PEER_HEADS * PEER_DKEY), D_MODEL ** -0.5),
        'sub_keys': nrm((L, PEER_HEADS, 2, N_KEYS, PEER_HALF), PEER_HALF ** -0.5),
        'expert_u': nrm((L, N_EXPERTS, D_MODEL), D_MODEL ** -0.5),
        'expert_v': nrm((L, N_EXPERTS, D_MODEL), 0.25),
        'norm_final_w': gain((D_MODEL,)),
    }


def reference(x_prompt, x_sample, mem_prompt, state_ssm, state_conv, state_wkv, state_shift,
              cache_mem_k, cache_mem_v, norm_mix_w, w_in, conv_w, conv_b, dt_bias, a_log, d_skip,
              ssd_norm_w, rwkv_mu, rwkv_w0, rwkv_w2, rwkv_a0, rwkv_a2, rwkv_g2, rwkv_k_k, rwkv_k_a,
              rwkv_r_k, rwkv_ln_w, rwkv_ln_b, w_out, norm_mem_w, mem_norm_w, w_mk, w_mv, w_mq, w_mo,
              norm_ffn_w, w_pq, sub_keys, expert_u, expert_v, norm_final_w):
    bp = x_prompt.shape[0]
    xp, xs = x_prompt, x_sample
    ssm_p, conv_p, wkv_p, shift_p, mk_p, mv_p = [], [], [], [], [], []
    ssm_s, conv_s, wkv_s, shift_s = [], [], [], []
    for l in range(DEPTH):
        p = {
            'norm_mix_w': norm_mix_w[l], 'w_in': w_in[l], 'conv_w': conv_w[l], 'conv_b': conv_b[l],
            'dt_bias': dt_bias[l], 'a_log': a_log[l], 'd_skip': d_skip[l], 'ssd_norm_w': ssd_norm_w[l],
            'rwkv_mu': rwkv_mu[l], 'rwkv_w0': rwkv_w0[l], 'rwkv_w2': rwkv_w2[l], 'rwkv_a0': rwkv_a0[l],
            'rwkv_a2': rwkv_a2[l], 'rwkv_g2': rwkv_g2[l], 'rwkv_k_k': rwkv_k_k[l], 'rwkv_k_a': rwkv_k_a[l],
            'rwkv_r_k': rwkv_r_k[l], 'rwkv_ln_w': rwkv_ln_w[l], 'rwkv_ln_b': rwkv_ln_b[l], 'w_out': w_out[l],
            'norm_mem_w': norm_mem_w[l], 'w_mq': w_mq[l], 'w_mo': w_mo[l], 'norm_ffn_w': norm_ffn_w[l],
            'w_pq': w_pq[l], 'sub_keys': sub_keys[l], 'expert_u': expert_u[l], 'expert_v': expert_v[l],
        }
        mem_k, mem_v = _memory_kv(mem_prompt, mem_norm_w[l], w_mk[l], w_mv[l])
        xp, c_new, s_new, sh_new, w_new = _block(
            xp, mem_k, mem_v,
            jnp.zeros((bp, CONV_K - 1, CONV_DIM), xp.dtype),
            jnp.zeros((bp, H_SSD, SSD_HEADDIM, SSD_STATE), jnp.float32),
            jnp.zeros((bp, RWKV_PROJ), xp.dtype),
            jnp.zeros((bp, H_RWKV, HD_RWKV, HD_RWKV), jnp.float32), p)
        ssm_p.append(s_new)
        conv_p.append(c_new)
        wkv_p.append(w_new)
        shift_p.append(sh_new)
        mk_p.append(mem_k)
        mv_p.append(mem_v)
        xs, c_new, s_new, sh_new, w_new = _block(
            xs, cache_mem_k[l], cache_mem_v[l], state_conv[l], state_ssm[l], state_shift[l], state_wkv[l], p)
        ssm_s.append(s_new)
        conv_s.append(c_new)
        wkv_s.append(w_new)
        shift_s.append(sh_new)
    y_prompt = _rmsnorm(xp, norm_final_w)
    y_sample = _rmsnorm(xs, norm_final_w)
    ssm_prompt = jnp.stack(ssm_p)
    conv_prompt = jnp.stack(conv_p)
    wkv_prompt = jnp.stack(wkv_p)
    shift_prompt = jnp.stack(shift_p)
    mem_k_prompt = jnp.stack(mk_p)
    mem_v_prompt = jnp.stack(mv_p)
    ssm_sample = jnp.stack(ssm_s)
    conv_sample = jnp.stack(conv_s)
    wkv_sample = jnp.stack(wkv_s)
    shift_sample = jnp.stack(shift_s)
    return (y_prompt, y_sample, ssm_prompt, conv_prompt, wkv_prompt, shift_prompt, mem_k_prompt, mem_v_prompt,
            ssm_sample, conv_sample, wkv_sample, shift_sample)
```

```cpp
#ifdef HOST_EMU
#include <cmath>
#include <cstring>
#include <cstdint>
#include <cstdio>
#include <cstddef>
typedef void* hipStream_t;
#define __global__
#define __device__
#define __host__
#define __forceinline__ inline
static thread_local size_t g_tid;
#define GTID g_tid
template <class F, class... A> static void launch(F f, size_t n, hipStream_t, A... a) {
#pragma omp parallel for schedule(static)
    for (long long i = 0; i < (long long)n; ++i) { g_tid = (size_t)i; f(a...); }
}
#else
#include <hip/hip_runtime.h>
#include <cstdint>
#include <cstdio>
#define GTID ((size_t)blockIdx.x * blockDim.x + threadIdx.x)
template <class F, class... A> static void launch(F f, size_t n, hipStream_t s, A... a) {
    if (n == 0) return;
    hipLaunchKernelGGL(f, dim3((unsigned)((n + 255) / 256)), dim3(256), 0, s, a...);
}
#endif

#ifndef D_MODEL
#define D_MODEL 1024
#define BATCH 8
#define SEQ 2048
#define DEC_BATCH 128
#define SSD_HEADDIM 64
#define SSD_GROUPS 2
#define SSD_STATE 128
#define HD_RWKV 64
#define W_RANK 64
#define A_RANK 64
#define G_RANK 128
#define N_MEM 256
#define MEM_HEADS 4
#define N_KEYS 128
#define PEER_HEADS 8
#define PEER_DKEY 256
#define PEER_TOPK 16
#endif
#define CONV_K 4
constexpr int D = D_MODEL;
constexpr int H_SSD = D / SSD_HEADDIM, P_SSD = SSD_HEADDIM, N_SSD = SSD_STATE, G_SSD = SSD_GROUPS;
constexpr int CONV_DIM = D + 2 * G_SSD * N_SSD;
constexpr int H_RWKV = D / HD_RWKV, HK = HD_RWKV;
constexpr int RWKV_PROJ = 3 * D + W_RANK + A_RANK + G_RANK;
constexpr int D_IN = D + CONV_DIM + H_SSD + RWKV_PROJ + 2 * D;
constexpr int MEM_HD = D / MEM_HEADS;
constexpr int N_EXPERTS = N_KEYS * N_KEYS, PEER_HALF = PEER_DKEY / 2, NPQ = PEER_HEADS * PEER_DKEY, NSEL = PEER_HEADS * PEER_TOPK;
constexpr int MP = BATCH * SEQ, MS = DEC_BATCH, MT = MP + MS, MPAD = (MT + 255) / 256 * 256, NMEMROWS = BATCH * N_MEM;
constexpr float NORM_EPS = 1e-6f, RWKV_LN_EPS = 64e-5f;
constexpr int NMAIN = D_IN - H_SSD;

typedef unsigned short bf16_t;
typedef _Float16 f16_t;
__host__ __device__ __forceinline__ float bf2f(bf16_t v) { unsigned u = (unsigned)v << 16; float f; memcpy(&f, &u, 4); return f; }
__host__ __device__ __forceinline__ bf16_t f2bf(float f) { unsigned u; memcpy(&u, &f, 4); u = (u + 0x7fffu + ((u >> 16) & 1u)) >> 16; return (bf16_t)u; }
__host__ __device__ __forceinline__ float siluf(float x) { return x / (1.f + expf(-x)); }
__host__ __device__ __forceinline__ float sigmoidf(float x) { return 1.f / (1.f + expf(-x)); }
__host__ __device__ __forceinline__ float softplusf(float x) { return x > 20.f ? x : log1pf(expf(x)); }
__host__ __device__ __forceinline__ float geluf(float x) { return 0.5f * x * (1.f + erff(x * 0.70710678118654752f)); }

struct RowInfo { int grp, b, t; };
__host__ __device__ __forceinline__ RowInfo rowinfo(int r) { RowInfo q; if (r < MP) { q.grp = 0; q.b = r / SEQ; q.t = r % SEQ; } else { q.grp = 1; q.b = r - MP; q.t = 0; } return q; }

__global__ void k_zero_u16(bf16_t* p, size_t n) { size_t i = GTID; if (i < n) p[i] = 0; }
__global__ void k_rmsnorm_bf16(const float* x, const float* w, bf16_t* out, int nrows) {
    size_t i = GTID; if (i >= (size_t)nrows) return;
    const float* xr = x + i * D; float ss = 0.f;
    for (int c = 0; c < D; ++c) ss += xr[c] * xr[c];
    const float rs = 1.f / sqrtf(ss / D + NORM_EPS);
    for (int c = 0; c < D; ++c) out[i * D + c] = f2bf(xr[c] * rs * w[c]);
}
__global__ void k_wt(const float* W, int K, int ldw, int ncol0, int skip_at, int skip, bf16_t* WT, int N) {
    size_t i = GTID; if (i >= (size_t)N * K) return;
    const int n = (int)(i / K), k = (int)(i % K); const int sc = ncol0 + n + (n >= skip_at ? skip : 0);
    WT[i] = f2bf(W[(size_t)k * ldw + sc]);
}
struct __attribute__((aligned(16))) V8 { bf16_t v[8]; };
__global__ void k_gemm(const bf16_t* A, int lda, const bf16_t* Bt, int K, int M, int N, int mode, bf16_t* ob, int ldob, float* of, int ldof, const float* base, int ldbase) {
    size_t i = GTID; if (i >= (size_t)M * N) return;
    const int m = (int)(i / N), n = (int)(i % N);
    const bf16_t* a = A + (size_t)m * lda; const bf16_t* b = Bt + (size_t)n * K; float acc = 0.f;
    for (int k = 0; k < K; k += 8) { V8 va, vb; memcpy(&va, a + k, 16); memcpy(&vb, b + k, 16);
        for (int j = 0; j < 8; ++j) acc += bf2f(va.v[j]) * bf2f(vb.v[j]); }
    if (mode == 0) ob[(size_t)m * ldob + n] = f2bf(acc);
    else if (mode == 1) { of[(size_t)m * ldof + n] = acc; if (ob) ob[(size_t)m * ldob + n] = f2bf(acc); }
    else of[(size_t)m * ldof + n] = base[(size_t)m * ldbase + n] + acc;
}
__global__ void k_conv(const bf16_t* PXBC, const float* state_conv, const float* conv_w, const float* conv_b, bf16_t* XC) {
    size_t i = GTID; if (i >= (size_t)MT * CONV_DIM) return;
    const int r = (int)(i / CONV_DIM), ch = (int)(i % CONV_DIM); const RowInfo q = rowinfo(r);
    float acc = conv_b[ch];
    for (int j = 0; j < CONV_K; ++j) { const int tp = q.t - (CONV_K - 1) + j; float v;
        if (tp >= 0) v = bf2f(PXBC[(size_t)(r - (q.t - tp)) * CONV_DIM + ch]);
        else v = q.grp ? state_conv[((size_t)q.b * (CONV_K - 1) + (CONV_K - 1 + tp)) * CONV_DIM + ch] : 0.f;
        acc += v * conv_w[j * CONV_DIM + ch]; }
    XC[i] = f2bf(siluf(acc));
}
__global__ void k_convstate(const bf16_t* PXBC, const float* state_conv, float* conv_p, float* conv_s) {
    size_t i = GTID; const size_t np = (size_t)BATCH * (CONV_K - 1) * CONV_DIM, ns = (size_t)DEC_BATCH * (CONV_K - 1) * CONV_DIM; if (i >= np + ns) return;
    if (i < np) { const int ch = (int)(i % CONV_DIM), j = (int)((i / CONV_DIM) % (CONV_K - 1)), b = (int)(i / ((CONV_K - 1) * CONV_DIM));
        const int t = SEQ - (CONV_K - 1) + j; conv_p[i] = t >= 0 ? bf2f(PXBC[((size_t)b * SEQ + t) * CONV_DIM + ch]) : 0.f; }
    else { const size_t k = i - np; const int ch = (int)(k % CONV_DIM), j = (int)((k / CONV_DIM) % (CONV_K - 1)), b = (int)(k / ((CONV_K - 1) * CONV_DIM));
        conv_s[k] = (j + 1 < CONV_K - 1) ? state_conv[((size_t)b * (CONV_K - 1) + j + 1) * CONV_DIM + ch] : bf2f(PXBC[((size_t)MP + b) * CONV_DIM + ch]); }
}
__global__ void k_copy_or_zero(const float* src, float* dst, size_t n) { size_t i = GTID; if (i < n) dst[i] = src ? src[i] : 0.f; }
__global__ void k_ssd(const bf16_t* XC, const float* DT, const float* dt_bias, const float* a_log, const float* d_skip, float* Sp, float* Ss, bf16_t* YS) {
    size_t i = GTID; const size_t np = (size_t)BATCH * H_SSD * P_SSD, ns = (size_t)DEC_BATCH * H_SSD * P_SSD; if (i >= np + ns) return;
    const int grp = i >= np; const size_t k = grp ? i - np : i; const int p = (int)(k % P_SSD), h = (int)((k / P_SSD) % H_SSD), b = (int)(k / (P_SSD * H_SSD));
    float* S = (grp ? Ss : Sp) + k * N_SSD; const int L = grp ? 1 : SEQ; const int g = h / (H_SSD / G_SSD);
    const float ah = -expf(a_log[h]), db = dt_bias[h], dsk = d_skip[h];
    for (int t = 0; t < L; ++t) { const size_t r = grp ? (size_t)MP + b : (size_t)b * SEQ + t;
        const float dt = softplusf(DT[r * H_SSD + h] + db), dA = expf(dt * ah), x = bf2f(XC[r * CONV_DIM + h * P_SSD + p]);
        const bf16_t* Bv = XC + r * CONV_DIM + D + g * N_SSD; const bf16_t* Cv = XC + r * CONV_DIM + D + G_SSD * N_SSD + g * N_SSD;
        float y = 0.f;
        for (int n = 0; n < N_SSD; ++n) { const float s = S[n] * dA + dt * x * bf2f(Bv[n]); S[n] = s; y += bf2f(Cv[n]) * s; }
        YS[r * D + h * P_SSD + p] = f2bf(y + dsk * x); }
}
__device__ __forceinline__ float rws_at(const bf16_t* PRW, const float* state_shift, const float* mu, int r, int c) {
    const RowInfo q = rowinfo(r); const float cur = bf2f(PRW[(size_t)r * RWKV_PROJ + c]);
    const float prev = q.t > 0 ? bf2f(PRW[(size_t)(r - 1) * RWKV_PROJ + c]) : (q.grp ? state_shift[(size_t)q.b * RWKV_PROJ + c] : 0.f);
    return cur + (prev - cur) * mu[c];
}
struct RwkvW { const float *mu, *w0, *w2, *a0, *a2, *g2, *k_k, *k_a; };
__global__ void k_rwkv_prep(const bf16_t* PRW, const float* state_shift, RwkvW W, f16_t* R16, f16_t* OMW16, f16_t* K16, f16_t* V16, f16_t* KK16, f16_t* B16, bf16_t* Gb) {
    size_t i = GTID; if (i >= (size_t)MT * D) return;
    const int r = (int)(i / D), ch = (int)(i % D), h0 = ch / HK * HK;
    float dw = 0.f, da = 0.f, dg = 0.f;
    for (int j = 0; j < W_RANK; ++j) dw += tanhf(rws_at(PRW, state_shift, W.mu, r, 3 * D + j)) * W.w2[j * D + ch];
    for (int j = 0; j < A_RANK; ++j) da += rws_at(PRW, state_shift, W.mu, r, 3 * D + W_RANK + j) * W.a2[j * D + ch];
    for (int j = 0; j < G_RANK; ++j) dg += sigmoidf(rws_at(PRW, state_shift, W.mu, r, 3 * D + W_RANK + A_RANK + j)) * W.g2[j * D + ch];
    const float wlog = -softplusf(-(W.w0[ch] + dw)) - 0.5f, e = expf(wlog), omw = -expm1f(-e);
    const float ag = sigmoidf(W.a0[ch] + da);
    const float kv = rws_at(PRW, state_shift, W.mu, r, D + ch);
    float ss = 0.f;
    for (int c = h0; c < h0 + HK; ++c) { const float q = rws_at(PRW, state_shift, W.mu, r, D + c) * W.k_k[c]; ss += q * q; }
    const float kk = kv * W.k_k[ch] / sqrtf(fmaxf(ss, 1e-24f));
    R16[i] = (f16_t)rws_at(PRW, state_shift, W.mu, r, ch); OMW16[i] = (f16_t)omw; K16[i] = (f16_t)(kv * (1.f + (ag - 1.f) * W.k_a[ch]));
    V16[i] = (f16_t)rws_at(PRW, state_shift, W.mu, r, 2 * D + ch); KK16[i] = (f16_t)kk; B16[i] = (f16_t)(kk * ag); Gb[i] = f2bf(dg);
}
__global__ void k_shiftstate(const bf16_t* PRW, float* sh_p, float* sh_s) {
    size_t i = GTID; const size_t np = (size_t)BATCH * RWKV_PROJ, ns = (size_t)DEC_BATCH * RWKV_PROJ; if (i >= np + ns) return;
    if (i < np) { const int c = (int)(i % RWKV_PROJ), b = (int)(i / RWKV_PROJ); sh_p[i] = bf2f(PRW[((size_t)b * SEQ + SEQ - 1) * RWKV_PROJ + c]); }
    else { const size_t k = i - np; const int c = (int)(k % RWKV_PROJ), b = (int)(k / RWKV_PROJ); sh_s[k] = bf2f(PRW[((size_t)MP + b) * RWKV_PROJ + c]); }
}
__global__ void k_rwkv_scan(const f16_t* R16, const f16_t* OMW16, const f16_t* K16, const f16_t* V16, const f16_t* KK16, const f16_t* B16, float* Sp, float* Ss, bf16_t* YR) {
    size_t i = GTID; const size_t np = (size_t)BATCH * H_RWKV * HK, ns = (size_t)DEC_BATCH * H_RWKV * HK; if (i >= np + ns) return;
    const int grp = i >= np; const size_t k0 = grp ? i - np : i; const int v = (int)(k0 % HK), h = (int)((k0 / HK) % H_RWKV), b = (int)(k0 / (HK * H_RWKV));
    float* S = (grp ? Ss : Sp) + k0 * HK; const int L = grp ? 1 : SEQ;
    for (int t = 0; t < L; ++t) { const size_t r = grp ? (size_t)MP + b : (size_t)b * SEQ + t; const size_t o = r * D + h * HK;
        float sa = 0.f; for (int k = 0; k < HK; ++k) sa += S[k] * (float)KK16[o + k];
        const float vv = (float)V16[o + v]; float y = 0.f;
        for (int k = 0; k < HK; ++k) { float s = S[k]; s = s - s * (float)OMW16[o + k]; s = s - sa * (float)B16[o + k]; s = s + vv * (float)K16[o + k]; S[k] = s; y += s * (float)R16[o + k]; }
        YR[o + v] = f2bf(y); }
}
struct MergeW { const float *ssd_norm_w, *r_k, *ln_w, *ln_b; };
__global__ void k_merge(const bf16_t* YS, const bf16_t* YR, const bf16_t* PZ, const bf16_t* PGATE, const bf16_t* Gb, const f16_t* R16, const f16_t* K16, const f16_t* V16, MergeW W, bf16_t* MERGED) {
    size_t i = GTID; if (i >= (size_t)MT) return; const size_t o = i * D;
    float ss = 0.f; for (int c = 0; c < D; ++c) { const float q = bf2f(YS[o + c]) * siluf(bf2f(PZ[o + c])); ss += q * q; }
    const float rs = 1.f / sqrtf(ss / D + NORM_EPS);
    for (int h = 0; h < H_RWKV; ++h) { float m = 0.f, bonus = 0.f;
        for (int k = 0; k < HK; ++k) { const int c = h * HK + k; m += bf2f(YR[o + c]); bonus += (float)R16[o + c] * (float)K16[o + c] * W.r_k[c]; }
        m /= HK; float var = 0.f; for (int k = 0; k < HK; ++k) { const float d = bf2f(YR[o + h * HK + k]) - m; var += d * d; } var /= HK;
        const float rstd = 1.f / sqrtf(var + RWKV_LN_EPS);
        for (int k = 0; k < HK; ++k) { const int c = h * HK + k;
            const float yssd = bf2f(YS[o + c]) * siluf(bf2f(PZ[o + c])) * rs * W.ssd_norm_w[c];
            const float yrn = (bf2f(YR[o + c]) - m) * rstd * W.ln_w[c] + W.ln_b[c];
            const float yrw = (yrn + bonus * (float)V16[o + c]) * bf2f(Gb[o + c]);
            MERGED[o + c] = f2bf(sigmoidf(bf2f(PGATE[i * 2 * D + c])) * yssd + sigmoidf(bf2f(PGATE[i * 2 * D + D + c])) * yrw); } }
}
__global__ void k_rmsnorm_f2b(const float* X, const float* w, bf16_t* out, int nrows) { size_t i = GTID; if (i >= (size_t)nrows) return;
    const float* xr = X + i * D; float ss = 0.f; for (int c = 0; c < D; ++c) ss += xr[c] * xr[c]; const float rs = 1.f / sqrtf(ss / D + NORM_EPS);
    for (int c = 0; c < D; ++c) out[i * D + c] = f2bf(xr[c] * rs * w[c]); }
__global__ void k_attn_scores(const bf16_t* Q, const float* kp, const float* kc, float* SC) {
    size_t i = GTID; if (i >= (size_t)MT * MEM_HEADS * N_MEM) return;
    const int m = (int)(i % N_MEM), h = (int)((i / N_MEM) % MEM_HEADS), r = (int)(i / (N_MEM * MEM_HEADS)); const RowInfo q = rowinfo(r);
    const float* kr = (q.grp ? kc : kp) + ((size_t)q.b * N_MEM + m) * D + h * MEM_HD; const bf16_t* qr = Q + (size_t)r * D + h * MEM_HD; float acc = 0.f;
    for (int d = 0; d < MEM_HD; ++d) acc += bf2f(qr[d]) * kr[d];
    SC[i] = acc / sqrtf((float)MEM_HD);
}
__global__ void k_attn_softmax(float* SC) { size_t i = GTID; if (i >= (size_t)MT * MEM_HEADS) return; float* s = SC + i * N_MEM;
    float mx = s[0]; for (int m = 1; m < N_MEM; ++m) mx = fmaxf(mx, s[m]); float sum = 0.f; for (int m = 0; m < N_MEM; ++m) { const float e = expf(s[m] - mx); s[m] = e; sum += e; }
    const float inv = 1.f / sum; for (int m = 0; m < N_MEM; ++m) s[m] *= inv; }
__global__ void k_attn_av(const float* SC, const float* vp, const float* vc, bf16_t* AO) {
    size_t i = GTID; if (i >= (size_t)MT * D) return; const int c = (int)(i % D), r = (int)(i / D), h = c / MEM_HD; const RowInfo q = rowinfo(r);
    const float* vb = (q.grp ? vc : vp) + (size_t)q.b * N_MEM * D + c; const float* s = SC + ((size_t)r * MEM_HEADS + h) * N_MEM; float acc = 0.f;
    for (int m = 0; m < N_MEM; ++m) acc += s[m] * vb[(size_t)m * D];
    AO[i] = f2bf(acc);
}
__global__ void k_peer_scores(const bf16_t* PQ, const float* sub_keys, float* SCP) {
    size_t i = GTID; if (i >= (size_t)MT * PEER_HEADS * 2 * N_KEYS) return;
    const int key = (int)(i % N_KEYS), c = (int)((i / N_KEYS) % 2), h = (int)((i / (2 * N_KEYS)) % PEER_HEADS), r = (int)(i / ((size_t)2 * N_KEYS * PEER_HEADS));
    const bf16_t* q = PQ + (size_t)r * NPQ + h * PEER_DKEY + c * PEER_HALF; const float* kk = sub_keys + (((size_t)h * 2 + c) * N_KEYS + key) * PEER_HALF; float acc = 0.f;
    for (int d = 0; d < PEER_HALF; ++d) acc += bf2f(q[d]) * kk[d];
    SCP[i] = acc;
}
__global__ void k_peer_topk(const float* SCP, float* TS, int* TI, int* IDX, float* GATE) {
    size_t i = GTID; if (i >= (size_t)MT * PEER_HEADS) return;
    float* ts = TS + i * 2 * PEER_TOPK; int* ti = TI + i * 2 * PEER_TOPK;
    for (int c = 0; c < 2; ++c) { const float* s = SCP + (i * 2 + c) * N_KEYS; float pv = INFINITY; int pi = -1;
        for (int j = 0; j < PEER_TOPK; ++j) { float bv = -INFINITY; int bi = -1;
            for (int k = 0; k < N_KEYS; ++k) { const float v = s[k]; const bool after = (v < pv) || (v == pv && k > pi); if (after && (v > bv)) { bv = v; bi = k; } }
            ts[c * PEER_TOPK + j] = bv; ti[c * PEER_TOPK + j] = bi; pv = bv; pi = bi; } }
    float pv = INFINITY; int pi = -1; float* g = GATE + i * PEER_TOPK; int* id = IDX + i * PEER_TOPK;
    for (int j = 0; j < PEER_TOPK; ++j) { float bv = -INFINITY; int bi = -1;
        for (int k = 0; k < PEER_TOPK * PEER_TOPK; ++k) { const float v = ts[k / PEER_TOPK] + ts[PEER_TOPK + k % PEER_TOPK]; const bool after = (v < pv) || (v == pv && k > pi); if (after && (v > bv)) { bv = v; bi = k; } }
        g[j] = bv; id[j] = ti[bi / PEER_TOPK] * N_KEYS + ti[PEER_TOPK + bi % PEER_TOPK]; pv = bv; pi = bi; }
    const float mx = g[0]; float sum = 0.f; for (int j = 0; j < PEER_TOPK; ++j) { const float e = expf(g[j] - mx); g[j] = e; sum += e; }
    for (int j = 0; j < PEER_TOPK; ++j) g[j] /= sum;
}
__global__ void k_peer_act(const bf16_t* H3, const float* eu, const int* IDX, const float* GATE, float* COEF) {
    size_t i = GTID; if (i >= (size_t)MT * NSEL) return; const int r = (int)(i / NSEL);
    const float* u = eu + (size_t)IDX[i] * D; const bf16_t* x = H3 + (size_t)r * D; float acc = 0.f;
    for (int d = 0; d < D; ++d) acc += bf2f(x[d]) * u[d];
    COEF[i] = GATE[i] * geluf(acc);
}
__global__ void k_peer_out(float* X2, const float* ev, const int* IDX, const float* COEF) {
    size_t i = GTID; if (i >= (size_t)MT * D) return; const int r = (int)(i / D), c = (int)(i % D); float acc = 0.f;
    for (int j = 0; j < NSEL; ++j) acc += COEF[(size_t)r * NSEL + j] * ev[(size_t)IDX[(size_t)r * NSEL + j] * D + c];
    X2[i] += acc;
}
__global__ void k_final(const float* X, const float* w, float* yp, float* ys) { size_t i = GTID; if (i >= (size_t)MT) return;
    const float* xr = X + i * D; float ss = 0.f; for (int c = 0; c < D; ++c) ss += xr[c] * xr[c]; const float rs = 1.f / sqrtf(ss / D + NORM_EPS);
    float* o = i < (size_t)MP ? yp + i * D : ys + (i - MP) * D; for (int c = 0; c < D; ++c) o[c] = xr[c] * rs * w[c]; }

struct WsMap { size_t off = 0; size_t take(size_t bytes) { size_t o = off; off += (bytes + 255) & ~(size_t)255; return o; } };

extern "C" void kernel_launch(void* const* d_in, const int* in_sizes, int n_in, void* d_out, int out_size, void* d_ws, size_t ws_size, hipStream_t stream) {
    const float* const* in = (const float* const*)d_in;
    const float *x_prompt = in[0], *x_sample = in[1], *mem_prompt = in[2], *state_ssm = in[3], *state_conv = in[4], *state_wkv = in[5], *state_shift = in[6], *cache_k = in[7], *cache_v = in[8];
    const float *norm_mix_w = in[9], *w_in = in[10], *conv_w = in[11], *conv_b = in[12], *dt_bias = in[13], *a_log = in[14], *d_skip = in[15], *ssd_norm_w = in[16];
    const float *rwkv_mu = in[17], *rwkv_w0 = in[18], *rwkv_w2 = in[19], *rwkv_a0 = in[20], *rwkv_a2 = in[21], *rwkv_g2 = in[22], *rwkv_k_k = in[23], *rwkv_k_a = in[24], *rwkv_r_k = in[25], *rwkv_ln_w = in[26], *rwkv_ln_b = in[27];
    const float *w_out = in[28], *norm_mem_w = in[29], *mem_norm_w = in[30], *w_mk = in[31], *w_mv = in[32], *w_mq = in[33], *w_mo = in[34], *norm_ffn_w = in[35], *w_pq = in[36], *sub_keys = in[37], *expert_u = in[38], *expert_v = in[39], *norm_final_w = in[40];
    float* o = (float*)d_out;
    float* y_prompt = o; o += (size_t)MP * D; float* y_sample = o; o += (size_t)MS * D;
    float* ssm_p = o; o += (size_t)BATCH * H_SSD * P_SSD * N_SSD; float* conv_p = o; o += (size_t)BATCH * (CONV_K - 1) * CONV_DIM;
    float* wkv_p = o; o += (size_t)BATCH * H_RWKV * HK * HK; float* shift_p = o; o += (size_t)BATCH * RWKV_PROJ;
    float* memk_p = o; o += (size_t)NMEMROWS * D; float* memv_p = o; o += (size_t)NMEMROWS * D;
    float* ssm_s = o; o += (size_t)DEC_BATCH * H_SSD * P_SSD * N_SSD; float* conv_s = o; o += (size_t)DEC_BATCH * (CONV_K - 1) * CONV_DIM;
    float* wkv_s = o; o += (size_t)DEC_BATCH * H_RWKV * HK * HK; float* shift_s = o; o += (size_t)DEC_BATCH * RWKV_PROJ;
    unsigned char* ws = (unsigned char*)d_ws; WsMap wm;
    bf16_t* WT_in = (bf16_t*)(ws + wm.take((size_t)NMAIN * D * 2)); bf16_t* WT_dt = (bf16_t*)(ws + wm.take((size_t)H_SSD * D * 2));
    bf16_t* WT_out = (bf16_t*)(ws + wm.take((size_t)D * D * 2)); bf16_t* WT_mk = (bf16_t*)(ws + wm.take((size_t)D * D * 2)); bf16_t* WT_mv = (bf16_t*)(ws + wm.take((size_t)D * D * 2));
    bf16_t* WT_mq = (bf16_t*)(ws + wm.take((size_t)D * D * 2)); bf16_t* WT_mo = (bf16_t*)(ws + wm.take((size_t)D * D * 2)); bf16_t* WT_pq = (bf16_t*)(ws + wm.take((size_t)NPQ * D * 2));
    const size_t o_Hb = wm.take((size_t)MPAD * D * 2); bf16_t* Hb = (bf16_t*)(ws + o_Hb);
    bf16_t* MN = (bf16_t*)(ws + wm.take((size_t)NMEMROWS * D * 2));
    const size_t o_PZ = wm.take((size_t)MPAD * D * 2); bf16_t* PZ = (bf16_t*)(ws + o_PZ);
    const size_t o_PXBC = wm.take((size_t)MPAD * CONV_DIM * 2); bf16_t* PXBC = (bf16_t*)(ws + o_PXBC);
    const size_t o_PRW = wm.take((size_t)MPAD * RWKV_PROJ * 2); bf16_t* PRW = (bf16_t*)(ws + o_PRW);
    const size_t o_PGATE = wm.take((size_t)MPAD * 2 * D * 2); bf16_t* PGATE = (bf16_t*)(ws + o_PGATE);
    float* DT = (float*)(ws + wm.take((size_t)MT * H_SSD * 4));
    const size_t o_XC = wm.take((size_t)MT * CONV_DIM * 2 > (size_t)MPAD * D * 2 ? (size_t)MT * CONV_DIM * 2 : (size_t)MPAD * D * 2); bf16_t* XC = (bf16_t*)(ws + o_XC);
    f16_t* R16 = (f16_t*)(ws + wm.take((size_t)MT * D * 2)); f16_t* OMW16 = (f16_t*)(ws + wm.take((size_t)MT * D * 2)); f16_t* K16 = (f16_t*)(ws + wm.take((size_t)MT * D * 2));
    f16_t* V16 = (f16_t*)(ws + wm.take((size_t)MT * D * 2)); f16_t* KK16 = (f16_t*)(ws + wm.take((size_t)MT * D * 2)); f16_t* B16 = (f16_t*)(ws + wm.take((size_t)MT * D * 2));
    bf16_t* YR = (bf16_t*)(ws + wm.take((size_t)MT * D * 2));
    const size_t o_END = wm.off;
    bf16_t* Gb = Hb;
    bf16_t* YS = PXBC;
    bf16_t* MERGED = XC;
    float* X1 = (float*)PGATE;
    if ((size_t)MT * D * 4 > (size_t)MPAD * 2 * D * 2) { fprintf(stderr, "X1 overlay too big\n"); return; }
    WsMap lm; lm.off = o_PRW;
    bf16_t* H2 = (bf16_t*)(ws + lm.take((size_t)MPAD * D * 2)); bf16_t* Qb = (bf16_t*)(ws + lm.take((size_t)MPAD * D * 2)); bf16_t* AO = (bf16_t*)(ws + lm.take((size_t)MPAD * D * 2));
    if (lm.off > o_PGATE) { fprintf(stderr, "late overlay 1 too big\n"); return; }
    WsMap mm; mm.off = o_XC;
    float* SC = (float*)(ws + mm.take((size_t)MT * MEM_HEADS * N_MEM * 4));
    float* X2 = (float*)(ws + mm.take((size_t)MT * D * 4)); bf16_t* H3 = (bf16_t*)(ws + mm.take((size_t)MPAD * D * 2)); bf16_t* PQ = (bf16_t*)(ws + mm.take((size_t)MPAD * NPQ * 2));
    int* IDX = (int*)(ws + mm.take((size_t)MT * NSEL * 4)); float* GATE = (float*)(ws + mm.take((size_t)MT * NSEL * 4)); float* COEF = (float*)(ws + mm.take((size_t)MT * NSEL * 4));
    if (mm.off > o_END) { fprintf(stderr, "late overlay 2 too big\n"); return; }
    WsMap tm; tm.off = o_Hb;
    float* TS = (float*)(ws + tm.take((size_t)MT * PEER_HEADS * 2 * PEER_TOPK * 4)); int* TI = (int*)(ws + tm.take((size_t)MT * PEER_HEADS * 2 * PEER_TOPK * 4));
    if (tm.off > o_PZ) { fprintf(stderr, "topk temp overlay too big\n"); return; }
    float* SCP = (float*)PZ;
    if ((size_t)MT * PEER_HEADS * 2 * N_KEYS * 4 > o_PGATE - o_PZ) { fprintf(stderr, "SCP overlay too big\n"); return; }
    if (o_END > ws_size) { fprintf(stderr, "workspace too small: need %zu have %zu\n", o_END, ws_size); return; }

    launch(k_wt, (size_t)NMAIN * D, stream, w_in, D, D_IN, 0, D + CONV_DIM, H_SSD, WT_in, NMAIN);
    launch(k_wt, (size_t)H_SSD * D, stream, w_in, D, D_IN, D + CONV_DIM, 1 << 30, 0, WT_dt, H_SSD);
    launch(k_wt, (size_t)D * D, stream, w_out, D, D, 0, 1 << 30, 0, WT_out, D);
    launch(k_wt, (size_t)D * D, stream, w_mk, D, D, 0, 1 << 30, 0, WT_mk, D);
    launch(k_wt, (size_t)D * D, stream, w_mv, D, D, 0, 1 << 30, 0, WT_mv, D);
    launch(k_wt, (size_t)D * D, stream, w_mq, D, D, 0, 1 << 30, 0, WT_mq, D);
    launch(k_wt, (size_t)D * D, stream, w_mo, D, D, 0, 1 << 30, 0, WT_mo, D);
    launch(k_wt, (size_t)NPQ * D, stream, w_pq, D, NPQ, 0, 1 << 30, 0, WT_pq, NPQ);
    launch(k_rmsnorm_bf16, (size_t)MP, stream, x_prompt, norm_mix_w, Hb, MP);
    launch(k_rmsnorm_bf16, (size_t)MS, stream, x_sample, norm_mix_w, Hb + (size_t)MP * D, MS);
    launch(k_rmsnorm_bf16, (size_t)NMEMROWS, stream, mem_prompt, mem_norm_w, MN, NMEMROWS);
    launch(k_gemm, (size_t)MT * D, stream, Hb, D, WT_in, D, MT, D, 0, PZ, D, (float*)nullptr, 0, (const float*)nullptr, 0);
    launch(k_gemm, (size_t)MT * CONV_DIM, stream, Hb, D, WT_in + (size_t)D * D, D, MT, CONV_DIM, 0, PXBC, CONV_DIM, (float*)nullptr, 0, (const float*)nullptr, 0);
    launch(k_gemm, (size_t)MT * RWKV_PROJ, stream, Hb, D, WT_in + (size_t)(D + CONV_DIM) * D, D, MT, RWKV_PROJ, 0, PRW, RWKV_PROJ, (float*)nullptr, 0, (const float*)nullptr, 0);
    launch(k_gemm, (size_t)MT * 2 * D, stream, Hb, D, WT_in + (size_t)(D + CONV_DIM + RWKV_PROJ) * D, D, MT, 2 * D, 0, PGATE, 2 * D, (float*)nullptr, 0, (const float*)nullptr, 0);
    launch(k_gemm, (size_t)MT * H_SSD, stream, Hb, D, WT_dt, D, MT, H_SSD, 1, (bf16_t*)nullptr, 0, DT, H_SSD, (const float*)nullptr, 0);
    launch(k_gemm, (size_t)NMEMROWS * D, stream, MN, D, WT_mk, D, NMEMROWS, D, 1, (bf16_t*)nullptr, 0, memk_p, D, (const float*)nullptr, 0);
    launch(k_gemm, (size_t)NMEMROWS * D, stream, MN, D, WT_mv, D, NMEMROWS, D, 1, (bf16_t*)nullptr, 0, memv_p, D, (const float*)nullptr, 0);
    launch(k_conv, (size_t)MT * CONV_DIM, stream, PXBC, state_conv, conv_w, conv_b, XC);
    launch(k_convstate, (size_t)(BATCH + DEC_BATCH) * (CONV_K - 1) * CONV_DIM, stream, PXBC, state_conv, conv_p, conv_s);
    RwkvW rw{rwkv_mu, rwkv_w0, rwkv_w2, rwkv_a0, rwkv_a2, rwkv_g2, rwkv_k_k, rwkv_k_a};
    launch(k_rwkv_prep, (size_t)MT * D, stream, PRW, state_shift, rw, R16, OMW16, K16, V16, KK16, B16, Gb);
    launch(k_shiftstate, (size_t)(BATCH + DEC_BATCH) * RWKV_PROJ, stream, PRW, shift_p, shift_s);
    launch(k_copy_or_zero, (size_t)BATCH * H_SSD * P_SSD * N_SSD, stream, (const float*)nullptr, ssm_p, (size_t)BATCH * H_SSD * P_SSD * N_SSD);
    launch(k_copy_or_zero, (size_t)DEC_BATCH * H_SSD * P_SSD * N_SSD, stream, state_ssm, ssm_s, (size_t)DEC_BATCH * H_SSD * P_SSD * N_SSD);
    launch(k_ssd, (size_t)(BATCH + DEC_BATCH) * H_SSD * P_SSD, stream, XC, DT, dt_bias, a_log, d_skip, ssm_p, ssm_s, YS);
    launch(k_copy_or_zero, (size_t)BATCH * H_RWKV * HK * HK, stream, (const float*)nullptr, wkv_p, (size_t)BATCH * H_RWKV * HK * HK);
    launch(k_copy_or_zero, (size_t)DEC_BATCH * H_RWKV * HK * HK, stream, state_wkv, wkv_s, (size_t)DEC_BATCH * H_RWKV * HK * HK);
    launch(k_rwkv_scan, (size_t)(BATCH + DEC_BATCH) * H_RWKV * HK, stream, R16, OMW16, K16, V16, KK16, B16, wkv_p, wkv_s, YR);
    MergeW mw{ssd_norm_w, rwkv_r_k, rwkv_ln_w, rwkv_ln_b};
    launch(k_merge, (size_t)MT, stream, YS, YR, PZ, PGATE, Gb, R16, K16, V16, mw, MERGED);
    launch(k_gemm, (size_t)MP * D, stream, MERGED, D, WT_out, D, MP, D, 2, (bf16_t*)nullptr, 0, X1, D, x_prompt, D);
    launch(k_gemm, (size_t)MS * D, stream, MERGED + (size_t)MP * D, D, WT_out, D, MS, D, 2, (bf16_t*)nullptr, 0, X1 + (size_t)MP * D, D, x_sample, D);
    launch(k_rmsnorm_f2b, (size_t)MT, stream, X1, norm_mem_w, H2, MT);
    launch(k_gemm, (size_t)MT * D, stream, H2, D, WT_mq, D, MT, D, 0, Qb, D, (float*)nullptr, 0, (const float*)nullptr, 0);
    launch(k_attn_scores, (size_t)MT * MEM_HEADS * N_MEM, stream, Qb, memk_p, cache_k, SC);
    launch(k_attn_softmax, (size_t)MT * MEM_HEADS, stream, SC);
    launch(k_attn_av, (size_t)MT * D, stream, SC, memv_p, cache_v, AO);
    launch(k_gemm, (size_t)MT * D, stream, AO, D, WT_mo, D, MT, D, 2, (bf16_t*)nullptr, 0, X2, D, X1, D);
    launch(k_rmsnorm_f2b, (size_t)MT, stream, X2, norm_ffn_w, H3, MT);
    launch(k_gemm, (size_t)MT * NPQ, stream, H3, D, WT_pq, D, MT, NPQ, 0, PQ, NPQ, (float*)nullptr, 0, (const float*)nullptr, 0);
    launch(k_peer_scores, (size_t)MT * PEER_HEADS * 2 * N_KEYS, stream, PQ, sub_keys, SCP);
    launch(k_peer_topk, (size_t)MT * PEER_HEADS, stream, SCP, TS, TI, IDX, GATE);
    launch(k_peer_act, (size_t)MT * NSEL, stream, H3, expert_u, IDX, GATE, COEF);
    launch(k_peer_out, (size_t)MT * D, stream, X2, expert_v, IDX, COEF);
    launch(k_final, (size_t)MT, stream, X2, norm_final_w, y_prompt, y_sample);
}
```

```cpp
#ifdef HOST_EMU
#include <cmath>
#include <cstring>
#include <cstdint>
#include <cstdio>
#include <cstddef>
typedef void* hipStream_t;
#define __global__
#define __device__
#define __host__
#define __forceinline__ inline
static thread_local size_t g_tid;
#define GTID g_tid
template <class F, class... A> static void launch(F f, size_t n, hipStream_t, A... a) {
#pragma omp parallel for schedule(static)
    for (long long i = 0; i < (long long)n; ++i) { g_tid = (size_t)i; f(a...); }
}
#else
#include <hip/hip_runtime.h>
#include <cstdint>
#include <cstdio>
#define GTID ((size_t)blockIdx.x * blockDim.x + threadIdx.x)
template <class F, class... A> static void launch(F f, size_t n, hipStream_t s, A... a) {
    if (n == 0) return;
    hipLaunchKernelGGL(f, dim3((unsigned)((n + 255) / 256)), dim3(256), 0, s, a...);
}
#endif

#ifndef D_MODEL
#define D_MODEL 1024
#define BATCH 8
#define SEQ 2048
#define DEC_BATCH 128
#define SSD_HEADDIM 64
#define SSD_GROUPS 2
#define SSD_STATE 128
#define HD_RWKV 64
#define W_RANK 64
#define A_RANK 64
#define G_RANK 128
#define N_MEM 256
#define MEM_HEADS 4
#define N_KEYS 128
#define PEER_HEADS 8
#define PEER_DKEY 256
#define PEER_TOPK 16
#endif
#define CONV_K 4
constexpr int D = D_MODEL;
constexpr int H_SSD = D / SSD_HEADDIM, P_SSD = SSD_HEADDIM, N_SSD = SSD_STATE, G_SSD = SSD_GROUPS;
constexpr int CONV_DIM = D + 2 * G_SSD * N_SSD;
constexpr int H_RWKV = D / HD_RWKV, HK = HD_RWKV;
constexpr int RWKV_PROJ = 3 * D + W_RANK + A_RANK + G_RANK;
constexpr int D_IN = D + CONV_DIM + H_SSD + RWKV_PROJ + 2 * D;
constexpr int MEM_HD = D / MEM_HEADS;
constexpr int N_EXPERTS = N_KEYS * N_KEYS, PEER_HALF = PEER_DKEY / 2, NPQ = PEER_HEADS * PEER_DKEY, NSEL = PEER_HEADS * PEER_TOPK;
constexpr int MP = BATCH * SEQ, MS = DEC_BATCH, MT = MP + MS, MPAD = (MT + 255) / 256 * 256, NMEMROWS = BATCH * N_MEM;
constexpr float NORM_EPS = 1e-6f, RWKV_LN_EPS = 64e-5f;
constexpr int NMAIN = D_IN - H_SSD;

typedef unsigned short bf16_t;
typedef _Float16 f16_t;
__host__ __device__ __forceinline__ float bf2f(bf16_t v) { unsigned u = (unsigned)v << 16; float f; memcpy(&f, &u, 4); return f; }
__host__ __device__ __forceinline__ bf16_t f2bf(float f) { unsigned u; memcpy(&u, &f, 4); u = (u + 0x7fffu + ((u >> 16) & 1u)) >> 16; return (bf16_t)u; }
__host__ __device__ __forceinline__ float siluf(float x) { return x / (1.f + expf(-x)); }
__host__ __device__ __forceinline__ float sigmoidf(float x) { return 1.f / (1.f + expf(-x)); }
__host__ __device__ __forceinline__ float softplusf(float x) { return x > 20.f ? x : log1pf(expf(x)); }
__host__ __device__ __forceinline__ float geluf(float x) { return 0.5f * x * (1.f + erff(x * 0.70710678118654752f)); }

struct RowInfo { int grp, b, t; };
__host__ __device__ __forceinline__ RowInfo rowinfo(int r) { RowInfo q; if (r < MP) { q.grp = 0; q.b = r / SEQ; q.t = r % SEQ; } else { q.grp = 1; q.b = r - MP; q.t = 0; } return q; }

__device__ __forceinline__ void b_zero_u16(size_t i, bf16_t* p, size_t n) {  if (i < n) p[i] = 0; }
__device__ __forceinline__ void b_rmsnorm_bf16(size_t i, const float* x, const float* w, bf16_t* out, int nrows) {
     if (i >= (size_t)nrows) return;
    const float* xr = x + i * D; float ss = 0.f;
    for (int c = 0; c < D; ++c) ss += xr[c] * xr[c];
    const float rs = 1.f / sqrtf(ss / D + NORM_EPS);
    for (int c = 0; c < D; ++c) out[i * D + c] = f2bf(xr[c] * rs * w[c]);
}
__device__ __forceinline__ void b_wt(size_t i, const float* W, int K, int ldw, int ncol0, int skip_at, int skip, bf16_t* WT, int N) {
     if (i >= (size_t)N * K) return;
    const int n = (int)(i / K), k = (int)(i % K); const int sc = ncol0 + n + (n >= skip_at ? skip : 0);
    WT[i] = f2bf(W[(size_t)k * ldw + sc]);
}
struct __attribute__((aligned(16))) V8 { bf16_t v[8]; };
__device__ __forceinline__ void b_gemm(size_t i, const bf16_t* A, int lda, const bf16_t* Bt, int K, int M, int N, int mode, bf16_t* ob, int ldob, float* of, int ldof, const float* base, int ldbase) {
     if (i >= (size_t)M * N) return;
    const int m = (int)(i / N), n = (int)(i % N);
    const bf16_t* a = A + (size_t)m * lda; const bf16_t* b = Bt + (size_t)n * K; float acc = 0.f;
    for (int k = 0; k < K; k += 8) { V8 va, vb; memcpy(&va, a + k, 16); memcpy(&vb, b + k, 16);
        for (int j = 0; j < 8; ++j) acc += bf2f(va.v[j]) * bf2f(vb.v[j]); }
    if (mode == 0) ob[(size_t)m * ldob + n] = f2bf(acc);
    else if (mode == 1) { of[(size_t)m * ldof + n] = acc; if (ob) ob[(size_t)m * ldob + n] = f2bf(acc); }
    else of[(size_t)m * ldof + n] = base[(size_t)m * ldbase + n] + acc;
}
__device__ __forceinline__ void b_conv(size_t i, const bf16_t* PXBC, const float* state_conv, const float* conv_w, const float* conv_b, bf16_t* XC) {
     if (i >= (size_t)MT * CONV_DIM) return;
    const int r = (int)(i / CONV_DIM), ch = (int)(i % CONV_DIM); const RowInfo q = rowinfo(r);
    float acc = conv_b[ch];
    for (int j = 0; j < CONV_K; ++j) { const int tp = q.t - (CONV_K - 1) + j; float v;
        if (tp >= 0) v = bf2f(PXBC[(size_t)(r - (q.t - tp)) * CONV_DIM + ch]);
        else v = q.grp ? state_conv[((size_t)q.b * (CONV_K - 1) + (CONV_K - 1 + tp)) * CONV_DIM + ch] : 0.f;
        acc += v * conv_w[j * CONV_DIM + ch]; }
    XC[i] = f2bf(siluf(acc));
}
__device__ __forceinline__ void b_convstate(size_t i, const bf16_t* PXBC, const float* state_conv, float* conv_p, float* conv_s) {
     const size_t np = (size_t)BATCH * (CONV_K - 1) * CONV_DIM, ns = (size_t)DEC_BATCH * (CONV_K - 1) * CONV_DIM; if (i >= np + ns) return;
    if (i < np) { const int ch = (int)(i % CONV_DIM), j = (int)((i / CONV_DIM) % (CONV_K - 1)), b = (int)(i / ((CONV_K - 1) * CONV_DIM));
        const int t = SEQ - (CONV_K - 1) + j; conv_p[i] = t >= 0 ? bf2f(PXBC[((size_t)b * SEQ + t) * CONV_DIM + ch]) : 0.f; }
    else { const size_t k = i - np; const int ch = (int)(k % CONV_DIM), j = (int)((k / CONV_DIM) % (CONV_K - 1)), b = (int)(k / ((CONV_K - 1) * CONV_DIM));
        conv_s[k] = (j + 1 < CONV_K - 1) ? state_conv[((size_t)b * (CONV_K - 1) + j + 1) * CONV_DIM + ch] : bf2f(PXBC[((size_t)MP + b) * CONV_DIM + ch]); }
}
__device__ __forceinline__ void b_copy_or_zero(size_t i, const float* src, float* dst, size_t n) {  if (i < n) dst[i] = src ? src[i] : 0.f; }
__device__ __forceinline__ void b_ssd(size_t i, const bf16_t* XC, const float* DT, const float* dt_bias, const float* a_log, const float* d_skip, float* Sp, float* Ss, bf16_t* YS) {
     const size_t np = (size_t)BATCH * H_SSD * P_SSD, ns = (size_t)DEC_BATCH * H_SSD * P_SSD; if (i >= np + ns) return;
    const int grp = i >= np; const size_t k = grp ? i - np : i; const int p = (int)(k % P_SSD), h = (int)((k / P_SSD) % H_SSD), b = (int)(k / (P_SSD * H_SSD));
    float* S = (grp ? Ss : Sp) + k * N_SSD; const int L = grp ? 1 : SEQ; const int g = h / (H_SSD / G_SSD);
    const float ah = -expf(a_log[h]), db = dt_bias[h], dsk = d_skip[h];
    for (int t = 0; t < L; ++t) { const size_t r = grp ? (size_t)MP + b : (size_t)b * SEQ + t;
        const float dt = softplusf(DT[r * H_SSD + h] + db), dA = expf(dt * ah), x = bf2f(XC[r * CONV_DIM + h * P_SSD + p]);
        const bf16_t* Bv = XC + r * CONV_DIM + D + g * N_SSD; const bf16_t* Cv = XC + r * CONV_DIM + D + G_SSD * N_SSD + g * N_SSD;
        float y = 0.f;
        for (int n = 0; n < N_SSD; ++n) { const float s = S[n] * dA + dt * x * bf2f(Bv[n]); S[n] = s; y += bf2f(Cv[n]) * s; }
        YS[r * D + h * P_SSD + p] = f2bf(y + dsk * x); }
}
__device__ __forceinline__ float rws_at(const bf16_t* PRW, const float* state_shift, const float* mu, int r, int c) {
    const RowInfo q = rowinfo(r); const float cur = bf2f(PRW[(size_t)r * RWKV_PROJ + c]);
    const float prev = q.t > 0 ? bf2f(PRW[(size_t)(r - 1) * RWKV_PROJ + c]) : (q.grp ? state_shift[(size_t)q.b * RWKV_PROJ + c] : 0.f);
    return cur + (prev - cur) * mu[c];
}
struct RwkvW { const float *mu, *w0, *w2, *a0, *a2, *g2, *k_k, *k_a; };
__device__ __forceinline__ void b_rwkv_prep(size_t i, const bf16_t* PRW, const float* state_shift, RwkvW W, f16_t* R16, f16_t* OMW16, f16_t* K16, f16_t* V16, f16_t* KK16, f16_t* B16, bf16_t* Gb) {
     if (i >= (size_t)MT * D) return;
    const int r = (int)(i / D), ch = (int)(i % D), h0 = ch / HK * HK;
    float dw = 0.f, da = 0.f, dg = 0.f;
    for (int j = 0; j < W_RANK; ++j) dw += tanhf(rws_at(PRW, state_shift, W.mu, r, 3 * D + j)) * W.w2[j * D + ch];
    for (int j = 0; j < A_RANK; ++j) da += rws_at(PRW, state_shift, W.mu, r, 3 * D + W_RANK + j) * W.a2[j * D + ch];
    for (int j = 0; j < G_RANK; ++j) dg += sigmoidf(rws_at(PRW, state_shift, W.mu, r, 3 * D + W_RANK + A_RANK + j)) * W.g2[j * D + ch];
    const float wlog = -softplusf(-(W.w0[ch] + dw)) - 0.5f, e = expf(wlog), omw = -expm1f(-e);
    const float ag = sigmoidf(W.a0[ch] + da);
    const float kv = rws_at(PRW, state_shift, W.mu, r, D + ch);
    float ss = 0.f;
    for (int c = h0; c < h0 + HK; ++c) { const float q = rws_at(PRW, state_shift, W.mu, r, D + c) * W.k_k[c]; ss += q * q; }
    const float kk = kv * W.k_k[ch] / sqrtf(fmaxf(ss, 1e-24f));
    R16[i] = (f16_t)rws_at(PRW, state_shift, W.mu, r, ch); OMW16[i] = (f16_t)omw; K16[i] = (f16_t)(kv * (1.f + (ag - 1.f) * W.k_a[ch]));
    V16[i] = (f16_t)rws_at(PRW, state_shift, W.mu, r, 2 * D + ch); KK16[i] = (f16_t)kk; B16[i] = (f16_t)(kk * ag); Gb[i] = f2bf(dg);
}
__device__ __forceinline__ void b_shiftstate(size_t i, const bf16_t* PRW, float* sh_p, float* sh_s) {
     const size_t np = (size_t)BATCH * RWKV_PROJ, ns = (size_t)DEC_BATCH * RWKV_PROJ; if (i >= np + ns) return;
    if (i < np) { const int c = (int)(i % RWKV_PROJ), b = (int)(i / RWKV_PROJ); sh_p[i] = bf2f(PRW[((size_t)b * SEQ + SEQ - 1) * RWKV_PROJ + c]); }
    else { const size_t k = i - np; const int c = (int)(k % RWKV_PROJ), b = (int)(k / RWKV_PROJ); sh_s[k] = bf2f(PRW[((size_t)MP + b) * RWKV_PROJ + c]); }
}
__device__ __forceinline__ void b_rwkv_scan(size_t i, const f16_t* R16, const f16_t* OMW16, const f16_t* K16, const f16_t* V16, const f16_t* KK16, const f16_t* B16, float* Sp, float* Ss, bf16_t* YR) {
     const size_t np = (size_t)BATCH * H_RWKV * HK, ns = (size_t)DEC_BATCH * H_RWKV * HK; if (i >= np + ns) return;
    const int grp = i >= np; const size_t k0 = grp ? i - np : i; const int v = (int)(k0 % HK), h = (int)((k0 / HK) % H_RWKV), b = (int)(k0 / (HK * H_RWKV));
    float* S = (grp ? Ss : Sp) + k0 * HK; const int L = grp ? 1 : SEQ;
    for (int t = 0; t < L; ++t) { const size_t r = grp ? (size_t)MP + b : (size_t)b * SEQ + t; const size_t o = r * D + h * HK;
        float sa = 0.f; for (int k = 0; k < HK; ++k) sa += S[k] * (float)KK16[o + k];
        const float vv = (float)V16[o + v]; float y = 0.f;
        for (int k = 0; k < HK; ++k) { float s = S[k]; s = s - s * (float)OMW16[o + k]; s = s - sa * (float)B16[o + k]; s = s + vv * (float)K16[o + k]; S[k] = s; y += s * (float)R16[o + k]; }
        YR[o + v] = f2bf(y); }
}
struct MergeW { const float *ssd_norm_w, *r_k, *ln_w, *ln_b; };
__device__ __forceinline__ void b_merge(size_t i, const bf16_t* YS, const bf16_t* YR, const bf16_t* PZ, const bf16_t* PGATE, const bf16_t* Gb, const f16_t* R16, const f16_t* K16, const f16_t* V16, MergeW W, bf16_t* MERGED) {
     if (i >= (size_t)MT) return; const size_t o = i * D;
    float ss = 0.f; for (int c = 0; c < D; ++c) { const float q = bf2f(YS[o + c]) * siluf(bf2f(PZ[o + c])); ss += q * q; }
    const float rs = 1.f / sqrtf(ss / D + NORM_EPS);
    for (int h = 0; h < H_RWKV; ++h) { float m = 0.f, bonus = 0.f;
        for (int k = 0; k < HK; ++k) { const int c = h * HK + k; m += bf2f(YR[o + c]); bonus += (float)R16[o + c] * (float)K16[o + c] * W.r_k[c]; }
        m /= HK; float var = 0.f; for (int k = 0; k < HK; ++k) { const float d = bf2f(YR[o + h * HK + k]) - m; var += d * d; } var /= HK;
        const float rstd = 1.f / sqrtf(var + RWKV_LN_EPS);
        for (int k = 0; k < HK; ++k) { const int c = h * HK + k;
            const float yssd = bf2f(YS[o + c]) * siluf(bf2f(PZ[o + c])) * rs * W.ssd_norm_w[c];
            const float yrn = (bf2f(YR[o + c]) - m) * rstd * W.ln_w[c] + W.ln_b[c];
            const float yrw = (yrn + bonus * (float)V16[o + c]) * bf2f(Gb[o + c]);
            MERGED[o + c] = f2bf(sigmoidf(bf2f(PGATE[i * 2 * D + c])) * yssd + sigmoidf(bf2f(PGATE[i * 2 * D + D + c])) * yrw); } }
}
__device__ __forceinline__ void b_rmsnorm_f2b(size_t i, const float* X, const float* w, bf16_t* out, int nrows) {  if (i >= (size_t)nrows) return;
    const float* xr = X + i * D; float ss = 0.f; for (int c = 0; c < D; ++c) ss += xr[c] * xr[c]; const float rs = 1.f / sqrtf(ss / D + NORM_EPS);
    for (int c = 0; c < D; ++c) out[i * D + c] = f2bf(xr[c] * rs * w[c]); }
__device__ __forceinline__ void b_attn_scores(size_t i, const bf16_t* Q, const float* kp, const float* kc, float* SC) {
     if (i >= (size_t)MT * MEM_HEADS * N_MEM) return;
    const int m = (int)(i % N_MEM), h = (int)((i / N_MEM) % MEM_HEADS), r = (int)(i / (N_MEM * MEM_HEADS)); const RowInfo q = rowinfo(r);
    const float* kr = (q.grp ? kc : kp) + ((size_t)q.b * N_MEM + m) * D + h * MEM_HD; const bf16_t* qr = Q + (size_t)r * D + h * MEM_HD; float acc = 0.f;
    for (int d = 0; d < MEM_HD; ++d) acc += bf2f(qr[d]) * kr[d];
    SC[i] = acc / sqrtf((float)MEM_HD);
}
__device__ __forceinline__ void b_attn_softmax(size_t i, float* SC) {  if (i >= (size_t)MT * MEM_HEADS) return; float* s = SC + i * N_MEM;
    float mx = s[0]; for (int m = 1; m < N_MEM; ++m) mx = fmaxf(mx, s[m]); float sum = 0.f; for (int m = 0; m < N_MEM; ++m) { const float e = expf(s[m] - mx); s[m] = e; sum += e; }
    const float inv = 1.f / sum; for (int m = 0; m < N_MEM; ++m) s[m] *= inv; }
__device__ __forceinline__ void b_attn_av(size_t i, const float* SC, const float* vp, const float* vc, bf16_t* AO) {
     if (i >= (size_t)MT * D) return; const int c = (int)(i % D), r = (int)(i / D), h = c / MEM_HD; const RowInfo q = rowinfo(r);
    const float* vb = (q.grp ? vc : vp) + (size_t)q.b * N_MEM * D + c; const float* s = SC + ((size_t)r * MEM_HEADS + h) * N_MEM; float acc = 0.f;
    for (int m = 0; m < N_MEM; ++m) acc += s[m] * vb[(size_t)m * D];
    AO[i] = f2bf(acc);
}
__device__ __forceinline__ void b_peer_scores(size_t i, const bf16_t* PQ, const float* sub_keys, float* SCP) {
     if (i >= (size_t)MT * PEER_HEADS * 2 * N_KEYS) return;
    const int key = (int)(i % N_KEYS), c = (int)((i / N_KEYS) % 2), h = (int)((i / (2 * N_KEYS)) % PEER_HEADS), r = (int)(i / ((size_t)2 * N_KEYS * PEER_HEADS));
    const bf16_t* q = PQ + (size_t)r * NPQ + h * PEER_DKEY + c * PEER_HALF; const float* kk = sub_keys + (((size_t)h * 2 + c) * N_KEYS + key) * PEER_HALF; float acc = 0.f;
    for (int d = 0; d < PEER_HALF; ++d) acc += bf2f(q[d]) * kk[d];
    SCP[i] = acc;
}
__device__ __forceinline__ void b_peer_topk(size_t i, const float* SCP, float* TS, int* TI, int* IDX, float* GATE) {
     if (i >= (size_t)MT * PEER_HEADS) return;
    float* ts = TS + i * 2 * PEER_TOPK; int* ti = TI + i * 2 * PEER_TOPK;
    for (int c = 0; c < 2; ++c) { const float* s = SCP + (i * 2 + c) * N_KEYS; float pv = INFINITY; int pi = -1;
        for (int j = 0; j < PEER_TOPK; ++j) { float bv = -INFINITY; int bi = -1;
            for (int k = 0; k < N_KEYS; ++k) { const float v = s[k]; const bool after = (v < pv) || (v == pv && k > pi); if (after && (v > bv)) { bv = v; bi = k; } }
            ts[c * PEER_TOPK + j] = bv; ti[c * PEER_TOPK + j] = bi; pv = bv; pi = bi; } }
    float pv = INFINITY; int pi = -1; float* g = GATE + i * PEER_TOPK; int* id = IDX + i * PEER_TOPK;
    for (int j = 0; j < PEER_TOPK; ++j) { float bv = -INFINITY; int bi = -1;
        for (int k = 0; k < PEER_TOPK * PEER_TOPK; ++k) { const float v = ts[k / PEER_TOPK] + ts[PEER_TOPK + k % PEER_TOPK]; const bool after = (v < pv) || (v == pv && k > pi); if (after && (v > bv)) { bv = v; bi = k; } }
        g[j] = bv; id[j] = ti[bi / PEER_TOPK] * N_KEYS + ti[PEER_TOPK + bi % PEER_TOPK]; pv = bv; pi = bi; }
    const float mx = g[0]; float sum = 0.f; for (int j = 0; j < PEER_TOPK; ++j) { const float e = expf(g[j] - mx); g[j] = e; sum += e; }
    for (int j = 0; j < PEER_TOPK; ++j) g[j] /= sum;
}
__device__ __forceinline__ void b_peer_act(size_t i, const bf16_t* H3, const float* eu, const int* IDX, const float* GATE, float* COEF) {
     if (i >= (size_t)MT * NSEL) return; const int r = (int)(i / NSEL);
    const float* u = eu + (size_t)IDX[i] * D; const bf16_t* x = H3 + (size_t)r * D; float acc = 0.f;
    for (int d = 0; d < D; ++d) acc += bf2f(x[d]) * u[d];
    COEF[i] = GATE[i] * geluf(acc);
}
__device__ __forceinline__ void b_peer_out(size_t i, float* X2, const float* ev, const int* IDX, const float* COEF) {
     if (i >= (size_t)MT * D) return; const int r = (int)(i / D), c = (int)(i % D); float acc = 0.f;
    for (int j = 0; j < NSEL; ++j) acc += COEF[(size_t)r * NSEL + j] * ev[(size_t)IDX[(size_t)r * NSEL + j] * D + c];
    X2[i] += acc;
}
__device__ __forceinline__ void b_final(size_t i, const float* X, const float* w, float* yp, float* ys) {  if (i >= (size_t)MT) return;
    const float* xr = X + i * D; float ss = 0.f; for (int c = 0; c < D; ++c) ss += xr[c] * xr[c]; const float rs = 1.f / sqrtf(ss / D + NORM_EPS);
    float* o = i < (size_t)MP ? yp + i * D : ys + (i - MP) * D; for (int c = 0; c < D; ++c) o[c] = xr[c] * rs * w[c]; }


__global__ void k_zero_u16(bf16_t* p, size_t n) { b_zero_u16(GTID, p, n); }
__global__ void k_rmsnorm_bf16(const float* x, const float* w, bf16_t* out, int nrows) { b_rmsnorm_bf16(GTID, x, w, out, nrows); }
__global__ void k_wt(const float* W, int K, int ldw, int ncol0, int skip_at, int skip, bf16_t* WT, int N) { b_wt(GTID, W, K, ldw, ncol0, skip_at, skip, WT, N); }
__global__ void k_gemm(const bf16_t* A, int lda, const bf16_t* Bt, int K, int M, int N, int mode, bf16_t* ob, int ldob, float* of, int ldof, const float* base, int ldbase) { b_gemm(GTID, A, lda, Bt, K, M, N, mode, ob, ldob, of, ldof, base, ldbase); }
__global__ void k_conv(const bf16_t* PXBC, const float* state_conv, const float* conv_w, const float* conv_b, bf16_t* XC) { b_conv(GTID, PXBC, state_conv, conv_w, conv_b, XC); }
__global__ void k_convstate(const bf16_t* PXBC, const float* state_conv, float* conv_p, float* conv_s) { b_convstate(GTID, PXBC, state_conv, conv_p, conv_s); }
__global__ void k_copy_or_zero(const float* src, float* dst, size_t n) { b_copy_or_zero(GTID, src, dst, n); }
__global__ void k_ssd(const bf16_t* XC, const float* DT, const float* dt_bias, const float* a_log, const float* d_skip, float* Sp, float* Ss, bf16_t* YS) { b_ssd(GTID, XC, DT, dt_bias, a_log, d_skip, Sp, Ss, YS); }
__global__ void k_rwkv_prep(const bf16_t* PRW, const float* state_shift, RwkvW W, f16_t* R16, f16_t* OMW16, f16_t* K16, f16_t* V16, f16_t* KK16, f16_t* B16, bf16_t* Gb) { b_rwkv_prep(GTID, PRW, state_shift, W, R16, OMW16, K16, V16, KK16, B16, Gb); }
__global__ void k_shiftstate(const bf16_t* PRW, float* sh_p, float* sh_s) { b_shiftstate(GTID, PRW, sh_p, sh_s); }
__global__ void k_rwkv_scan(const f16_t* R16, const f16_t* OMW16, const f16_t* K16, const f16_t* V16, const f16_t* KK16, const f16_t* B16, float* Sp, float* Ss, bf16_t* YR) { b_rwkv_scan(GTID, R16, OMW16, K16, V16, KK16, B16, Sp, Ss, YR); }
__global__ void k_merge(const bf16_t* YS, const bf16_t* YR, const bf16_t* PZ, const bf16_t* PGATE, const bf16_t* Gb, const f16_t* R16, const f16_t* K16, const f16_t* V16, MergeW W, bf16_t* MERGED) { b_merge(GTID, YS, YR, PZ, PGATE, Gb, R16, K16, V16, W, MERGED); }
__global__ void k_rmsnorm_f2b(const float* X, const float* w, bf16_t* out, int nrows) { b_rmsnorm_f2b(GTID, X, w, out, nrows); }
__global__ void k_attn_scores(const bf16_t* Q, const float* kp, const float* kc, float* SC) { b_attn_scores(GTID, Q, kp, kc, SC); }
__global__ void k_attn_softmax(float* SC) { b_attn_softmax(GTID, SC); }
__global__ void k_attn_av(const float* SC, const float* vp, const float* vc, bf16_t* AO) { b_attn_av(GTID, SC, vp, vc, AO); }
__global__ void k_peer_scores(const bf16_t* PQ, const float* sub_keys, float* SCP) { b_peer_scores(GTID, PQ, sub_keys, SCP); }
__global__ void k_peer_topk(const float* SCP, float* TS, int* TI, int* IDX, float* GATE) { b_peer_topk(GTID, SCP, TS, TI, IDX, GATE); }
__global__ void k_peer_act(const bf16_t* H3, const float* eu, const int* IDX, const float* GATE, float* COEF) { b_peer_act(GTID, H3, eu, IDX, GATE, COEF); }
__global__ void k_peer_out(float* X2, const float* ev, const int* IDX, const float* COEF) { b_peer_out(GTID, X2, ev, IDX, COEF); }
__global__ void k_final(const float* X, const float* w, float* yp, float* ys) { b_final(GTID, X, w, yp, ys); }
constexpr size_t al256(size_t x) { return (x + 255) & ~(size_t)255; }
constexpr size_t cmax(size_t a, size_t b) { return a > b ? a : b; }
constexpr size_t O_WT_IN = 0;
constexpr size_t O_WT_DT = O_WT_IN + al256((size_t)NMAIN * D * 2);
constexpr size_t O_WT_OUT = O_WT_DT + al256((size_t)H_SSD * D * 2);
constexpr size_t O_WT_MK = O_WT_OUT + al256((size_t)D * D * 2);
constexpr size_t O_WT_MV = O_WT_MK + al256((size_t)D * D * 2);
constexpr size_t O_WT_MQ = O_WT_MV + al256((size_t)D * D * 2);
constexpr size_t O_WT_MO = O_WT_MQ + al256((size_t)D * D * 2);
constexpr size_t O_WT_PQ = O_WT_MO + al256((size_t)D * D * 2);
constexpr size_t O_HB = O_WT_PQ + al256((size_t)NPQ * D * 2);
constexpr size_t O_MN = O_HB + al256((size_t)MPAD * D * 2);
constexpr size_t O_PZ = O_MN + al256((size_t)NMEMROWS * D * 2);
constexpr size_t O_PXBC = O_PZ + al256((size_t)MPAD * D * 2);
constexpr size_t O_PRW = O_PXBC + al256((size_t)MPAD * CONV_DIM * 2);
constexpr size_t O_PGATE = O_PRW + al256((size_t)MPAD * RWKV_PROJ * 2);
constexpr size_t O_DT = O_PGATE + al256((size_t)MPAD * 2 * D * 2);
constexpr size_t O_XC = O_DT + al256((size_t)MT * H_SSD * 4);
constexpr size_t O_R16 = O_XC + al256(cmax((size_t)MT * CONV_DIM * 2, (size_t)MPAD * D * 2));
constexpr size_t SZ16 = al256((size_t)MT * D * 2);
constexpr size_t O_OMW16 = O_R16 + SZ16, O_K16 = O_OMW16 + SZ16, O_V16 = O_K16 + SZ16, O_KK16 = O_V16 + SZ16, O_B16 = O_KK16 + SZ16;
constexpr size_t O_T1END = O_B16 + SZ16;
constexpr size_t O_CTL = O_T1END;
constexpr size_t CTL_BYTES = 1u << 20;
constexpr size_t O_EU8 = O_CTL + CTL_BYTES;
constexpr size_t O_EV8 = O_EU8 + al256((size_t)N_EXPERTS * D);
constexpr size_t O_ESC = O_EV8 + al256((size_t)N_EXPERTS * D);
constexpr size_t O_KVB = O_ESC + al256((size_t)2 * N_EXPERTS * 4);
constexpr size_t O_SKB = O_KVB + al256((size_t)NMEMROWS * 2 * D * 2);
constexpr size_t O_LW2 = O_SKB + al256((size_t)PEER_HEADS * 2 * N_KEYS * PEER_HALF * 2);
constexpr size_t O_LA2 = O_LW2 + al256((size_t)D * W_RANK * 2);
constexpr size_t O_LG2 = O_LA2 + al256((size_t)D * A_RANK * 2);
constexpr size_t O_END = O_LG2 + al256((size_t)D * G_RANK * 2);
constexpr size_t O_GB = O_HB, O_YS = O_PXBC, O_MERGED = O_XC, O_X1 = O_PGATE;
constexpr size_t O_H2 = O_PRW, O_QB = O_H2 + al256((size_t)MPAD * D * 2), O_AO = O_QB + al256((size_t)MPAD * D * 2);
static_assert(O_AO + al256((size_t)MPAD * D * 2) <= O_PGATE, "late overlay 1");
static_assert((size_t)MPAD * D * 4 <= (size_t)MPAD * 2 * D * 2, "X1 overlay");
constexpr size_t O_SC = O_XC, O_X2 = O_SC + al256((size_t)MT * MEM_HEADS * N_MEM * 4), O_H3 = O_X2 + al256((size_t)MPAD * D * 4), O_PQ = O_H3 + al256((size_t)MPAD * D * 2);
static_assert(O_PQ + al256((size_t)MPAD * NPQ * 2) <= O_T1END, "late overlay 2");
constexpr size_t O_TS = O_HB, O_TI = O_TS + al256((size_t)MT * PEER_HEADS * 2 * PEER_TOPK * 4);
static_assert(O_TI + al256((size_t)MT * PEER_HEADS * 2 * PEER_TOPK * 4) <= O_PZ, "topk temp overlay");
constexpr size_t O_SCP = O_PZ;
constexpr size_t O_IDX = O_SCP + al256((size_t)MT * PEER_HEADS * 2 * N_KEYS * 4), O_GATE = O_IDX + al256((size_t)MT * NSEL * 4), O_COEF = O_GATE + al256((size_t)MT * NSEL * 4);
static_assert(O_COEF + al256((size_t)MT * NSEL * 4) <= O_PGATE, "SCP/IDX/GATE/COEF overlay");

constexpr size_t OO_YP = 0, OO_YS = OO_YP + (size_t)MP * D, OO_SSMP = OO_YS + (size_t)MS * D, OO_CONVP = OO_SSMP + (size_t)BATCH * H_SSD * P_SSD * N_SSD,
    OO_WKVP = OO_CONVP + (size_t)BATCH * (CONV_K - 1) * CONV_DIM, OO_SHP = OO_WKVP + (size_t)BATCH * H_RWKV * HK * HK, OO_MKP = OO_SHP + (size_t)BATCH * RWKV_PROJ,
    OO_MVP = OO_MKP + (size_t)NMEMROWS * D, OO_SSMS = OO_MVP + (size_t)NMEMROWS * D, OO_CONVS = OO_SSMS + (size_t)DEC_BATCH * H_SSD * P_SSD * N_SSD,
    OO_WKVS = OO_CONVS + (size_t)DEC_BATCH * (CONV_K - 1) * CONV_DIM, OO_SHS = OO_WKVS + (size_t)DEC_BATCH * H_RWKV * HK * HK, OO_END = OO_SHS + (size_t)DEC_BATCH * RWKV_PROJ;
enum InIdx { I_XP = 0, I_XS, I_MEM, I_SSSM, I_SCONV, I_SWKV, I_SSHIFT, I_CK, I_CV, I_NORM_MIX, I_W_IN, I_CONV_W, I_CONV_B, I_DT_BIAS, I_A_LOG, I_D_SKIP, I_SSD_NORM, I_MU, I_W0, I_W2, I_A0, I_A2, I_G2,
    I_K_K, I_K_A, I_R_K, I_LN_W, I_LN_B, I_W_OUT, I_NORM_MEM, I_MEM_NORM, I_W_MK, I_W_MV, I_W_MQ, I_W_MO, I_NORM_FFN, I_W_PQ, I_SUBK, I_EU, I_EV, I_NORM_FINAL, N_INPUTS };

#ifndef HOST_EMU
namespace pg8 {
#define PG8_LAS __attribute__((address_space(3)))
typedef unsigned short bf16_t;
typedef short bf16x8 __attribute__((ext_vector_type(8)));
typedef float f32x4 __attribute__((ext_vector_type(4)));
typedef unsigned u32x4 __attribute__((ext_vector_type(4)));
constexpr int BM = 256, BK = 64, HALF = 128, HTB = HALF * BK * 2  , STAGE_BYTES = 8 * HTB, NXCD = 8, WGM = 8;

__host__ __device__ __forceinline__ int lds_byte(int r, int c) { const int st = (r >> 4) * 2 + (c >> 5), rr = r & 15, cc = c & 31, ob = rr * 64 + cc * 2; return st * 1024 + (ob ^ (((ob >> 9) & 1) << 5)); }
__host__ __device__ __forceinline__ void stage_rc(int b, int& R, int& C) { const int st = b / 1024, sb = b % 1024, swz = sb ^ (((sb >> 9) & 1) << 5); R = (st >> 1) * 16 + swz / 64; C = (st & 1) * 32 + (swz % 64) / 2; }
__host__ __device__ __forceinline__ int perm32(int rho) { const int n = rho >> 4, i = rho & 15; return 8 * (i >> 2) + 4 * n + (i & 3); }

struct Unit { int pm, pn; };
struct Gemm { const bf16_t* A; const bf16_t* Bt; int M, N, K; };

struct StaticOrder {
    int nM, nN, nwg, G, c;
    __host__ __device__ void init(int M, int N, int G_, int c_) { nM = M / BM; nN = N / BM; nwg = nM * nN; G = G_; c = c_; }
    __host__ __device__ bool next(int i, Unit& u) const {
        const long L = (long)i * G + c; if (L >= nwg) return false;
        int wgid = (int)L; { const int q = nwg / NXCD, r = nwg % NXCD, xcd = wgid % NXCD, off = wgid / NXCD; wgid = (xcd < r ? xcd * (q + 1) : r * (q + 1) + (xcd - r) * q) + off; }
        const int nig = WGM * nN, gid = wgid / nig, fm = gid * WGM, gsz = (nM - fm) < WGM ? (nM - fm) : WGM;
        u.pm = fm + ((wgid % nig) % gsz); u.pn = (wgid % nig) / gsz; return true;
    }
    __device__ __forceinline__ void a_ready(const Unit&) const {}
    __device__ __forceinline__ void done(const Unit&) const {}
};

__device__ __forceinline__ unsigned cvt_pk_bf16(float lo, float hi) { unsigned r; asm volatile("v_cvt_pk_bf16_f32 %0, %1, %2" : "=v"(r) : "v"(lo), "v"(hi)); return r; }
typedef float f32x2 __attribute__((ext_vector_type(2)));
template <class Epi, class Sched, bool ALIGN_EPI = false, bool SP2 = false>
__device__ __forceinline__ void gemm_phase(PG8_LAS unsigned char* lds, const Gemm g, const Sched& S, const Epi& E) {
    const int tid = threadIdx.x, wid = __builtin_amdgcn_readfirstlane(tid >> 6), lane = tid & 63, wr = wid >> 2, wc = wid & 3, fr = lane & 15, fq = lane >> 4;
    const int K = g.K, nt = K / BK;
    unsigned voffA[2], voffB[2];
#pragma unroll
    for (int i = 0; i < 2; ++i) { int R, C; stage_rc(tid * 16 + i * 8192, R, C); const int Rb = Epi::PERM ? ((R & ~31) + perm32(R & 31)) : R;
        voffA[i] = (unsigned)(R * K + C) * 2u; voffB[i] = (unsigned)(Rb * K + C) * 2u; }
    const size_t kstep = (size_t)(BK * 2);
    const size_t hstep = (size_t)HALF * K * 2;
    const size_t tstep = 2 * hstep;
    const unsigned ldsw = (unsigned)wid * 1024u;
    const int aoff = lds_byte(wr * 64 + fr, fq * 8), boff = lds_byte(wc * 32 + fr, fq * 8);
#define PG8_SA(b, h) (((b) * 2 + (h)) * HTB)
#define PG8_SB(b, h) ((4 + (b) * 2 + (h)) * HTB)
#define PG8_STAGE(bufoff, gbase, voff) do { _Pragma("unroll") for (int _i = 0; _i < 2; ++_i) \
        __builtin_amdgcn_global_load_lds((const unsigned*)((const char*)(gbase) + (voff)[_i]), (PG8_LAS unsigned*)(lds + (bufoff) + ldsw + _i * 8192), 16, 0, 0); } while (0)
#define PG8_LDA(dst, b, h) do { _Pragma("unroll") for (int m = 0; m < 4; ++m) _Pragma("unroll") for (int k = 0; k < 2; ++k) dst[m][k] = *(const PG8_LAS bf16x8*)(lds + PG8_SA(b, h) + aoff + m * 2048 + k * 1024); } while (0)
#define PG8_LDB(dst, b, h) do { _Pragma("unroll") for (int n = 0; n < 2; ++n) _Pragma("unroll") for (int k = 0; k < 2; ++k) dst[n][k] = *(const PG8_LAS bf16x8*)(lds + PG8_SB(b, h) + boff + n * 2048 + k * 1024); } while (0)
#define PG8_MMA(ai, bj, At, Bt) do { __builtin_amdgcn_s_setprio(1); _Pragma("unroll") for (int m = 0; m < 4; ++m) _Pragma("unroll") for (int n = 0; n < 2; ++n) _Pragma("unroll") for (int k = 0; k < 2; ++k) \
        acc[ai][bj][m][n] = __builtin_amdgcn_mfma_f32_16x16x32_bf16(Bt[n][k], At[m][k], acc[ai][bj][m][n], 0, 0, 0); __builtin_amdgcn_s_setprio(0); } while (0)
#define PG8_WAIT_V(n) asm volatile("s_waitcnt vmcnt(" #n ")" ::: "memory")
#define PG8_WAIT_L(n) asm volatile("s_waitcnt lgkmcnt(" #n ")" ::: "memory")
#define PG8_BAR __builtin_amdgcn_s_barrier()
#define PG8_SCHED __builtin_amdgcn_sched_barrier(0)
    Unit cur, nxt; int ui = 0;
    if (!S.next(0, cur)) return;
    f32x4 acc[2][2][4][2];
#pragma unroll
    for (int a = 0; a < 2; ++a)
#pragma unroll
        for (int b = 0; b < 2; ++b)
#pragma unroll
            for (int m = 0; m < 4; ++m)
#pragma unroll
                for (int n = 0; n < 2; ++n) acc[a][b][m][n] = (f32x4){0.f, 0.f, 0.f, 0.f};
    bf16x8 At[4][2], B0[2][2], B1[2][2];
    const char* cA = (const char*)g.A + (size_t)cur.pm * tstep; const char* cB = (const char*)g.Bt + (size_t)cur.pn * tstep;
    S.a_ready(cur);
    if constexpr (SP2) {
        PG8_STAGE(PG8_SB(0, 0), cB, voffB); PG8_STAGE(PG8_SB(0, 1), cB + hstep, voffB); PG8_STAGE(PG8_SA(0, 0), cA, voffA); PG8_STAGE(PG8_SA(0, 1), cA + hstep, voffA);
        if (wr == 1) PG8_BAR;
        PG8_WAIT_V(2); PG8_BAR;
        PG8_STAGE(PG8_SB(1, 0), cB + kstep, voffB); PG8_STAGE(PG8_SA(1, 0), cA + kstep, voffA); PG8_STAGE(PG8_SB(1, 1), cB + hstep + kstep, voffB);
        PG8_WAIT_V(6); PG8_BAR;
    } else {
        PG8_STAGE(PG8_SB(0, 0), cB, voffB); PG8_STAGE(PG8_SA(0, 0), cA, voffA); PG8_STAGE(PG8_SB(0, 1), cB + hstep, voffB); PG8_STAGE(PG8_SA(0, 1), cA + hstep, voffA);
        if (wr == 1) PG8_BAR;
        PG8_WAIT_V(4); PG8_BAR;
        PG8_STAGE(PG8_SB(1, 0), cB + kstep, voffB); PG8_STAGE(PG8_SA(1, 0), cA + kstep, voffA); PG8_STAGE(PG8_SB(1, 1), cB + hstep + kstep, voffB);
        PG8_WAIT_V(6); PG8_BAR;
    }
    for (;;) {
        const bool has_next = S.next(ui + 1, nxt);
        const char* nA = has_next ? (const char*)g.A + (size_t)nxt.pm * tstep : cA; const char* nB = has_next ? (const char*)g.Bt + (size_t)nxt.pn * tstep : cB;
        for (int t = 0; t < nt; t += 2) {
            const bool last = (t == nt - 2);
            const char* a1 = cA + (size_t)(t + 1) * kstep;
            const char* a2 = last ? nA : cA + (size_t)(t + 2) * kstep; const char* b2 = last ? nB : cB + (size_t)(t + 2) * kstep;
            const char* a3 = a2 + kstep; const char* b3 = b2 + kstep;
            if (last && has_next) S.a_ready(nxt);
            if constexpr (SP2) {
            PG8_LDB(B0, 0, 0); PG8_LDB(B1, 0, 1); PG8_SCHED; PG8_LDA(At, 0, 0); PG8_STAGE(PG8_SA(1, 1), a1 + hstep, voffA);
            PG8_WAIT_V(8); PG8_WAIT_L(0); PG8_BAR; PG8_MMA(0, 0, At, B0); PG8_MMA(0, 1, At, B1); PG8_BAR; PG8_SCHED;
            PG8_LDA(At, 0, 1); PG8_STAGE(PG8_SB(0, 0), b2, voffB); PG8_STAGE(PG8_SB(0, 1), b2 + hstep, voffB); PG8_STAGE(PG8_SA(0, 0), a2, voffA);
            PG8_WAIT_V(8); PG8_WAIT_L(0); PG8_BAR; PG8_MMA(1, 0, At, B0); PG8_MMA(1, 1, At, B1); PG8_BAR; PG8_SCHED;
            PG8_LDB(B0, 1, 0); PG8_LDB(B1, 1, 1); PG8_SCHED; PG8_LDA(At, 1, 0); PG8_STAGE(PG8_SA(0, 1), a2 + hstep, voffA);
            PG8_WAIT_V(8); PG8_WAIT_L(0); PG8_BAR; PG8_MMA(0, 0, At, B0); PG8_MMA(0, 1, At, B1); PG8_BAR; PG8_SCHED;
            PG8_LDA(At, 1, 1); PG8_STAGE(PG8_SB(1, 0), b3, voffB); PG8_STAGE(PG8_SB(1, 1), b3 + hstep, voffB); PG8_STAGE(PG8_SA(1, 0), a3, voffA);
            PG8_WAIT_V(8); PG8_WAIT_L(0); PG8_BAR; PG8_MMA(1, 0, At, B0); PG8_MMA(1, 1, At, B1); PG8_BAR; PG8_SCHED;
            } else {
            PG8_LDB(B0, 0, 0); PG8_SCHED; PG8_LDA(At, 0, 0); PG8_STAGE(PG8_SA(1, 1), a1 + hstep, voffA);
            PG8_WAIT_L(8); PG8_BAR; PG8_WAIT_L(0); PG8_MMA(0, 0, At, B0); PG8_BAR; PG8_SCHED;
            PG8_LDB(B1, 0, 1); PG8_STAGE(PG8_SB(0, 0), b2, voffB);
            PG8_BAR; PG8_WAIT_L(0); PG8_MMA(0, 1, At, B1); PG8_BAR;
            PG8_LDA(At, 0, 1); PG8_STAGE(PG8_SA(0, 0), a2, voffA);
            PG8_BAR; PG8_WAIT_L(0); PG8_MMA(1, 0, At, B0); PG8_BAR; PG8_SCHED;
            PG8_STAGE(PG8_SB(0, 1), b2 + hstep, voffB);
            PG8_WAIT_V(6); PG8_BAR; PG8_MMA(1, 1, At, B1); PG8_BAR;
            PG8_LDB(B0, 1, 0); PG8_SCHED; PG8_LDA(At, 1, 0); PG8_STAGE(PG8_SA(0, 1), a2 + hstep, voffA);
            PG8_WAIT_L(8); PG8_BAR; PG8_WAIT_L(0); PG8_MMA(0, 0, At, B0); PG8_BAR; PG8_SCHED;
            PG8_LDB(B1, 1, 1); PG8_STAGE(PG8_SB(1, 0), b3, voffB);
            PG8_BAR; PG8_WAIT_L(0); PG8_MMA(0, 1, At, B1); PG8_BAR;
            PG8_LDA(At, 1, 1); PG8_STAGE(PG8_SA(1, 0), a3, voffA);
            PG8_BAR; PG8_WAIT_L(0); PG8_MMA(1, 0, At, B0); PG8_BAR; PG8_SCHED;
            PG8_STAGE(PG8_SB(1, 1), b3 + hstep, voffB);
            PG8_WAIT_V(6); PG8_BAR; PG8_MMA(1, 1, At, B1); PG8_BAR;
            }
        }
        if constexpr (ALIGN_EPI) { if (wr == 0) PG8_BAR; }
        if constexpr (!Epi::AFTER_DRAIN) { E(acc, cur, wr, wc, fr, fq); S.done(cur); }
        if (!has_next) break;
#pragma unroll
        for (int a = 0; a < 2; ++a)
#pragma unroll
            for (int b = 0; b < 2; ++b)
#pragma unroll
                for (int m = 0; m < 4; ++m)
#pragma unroll
                    for (int n = 0; n < 2; ++n) acc[a][b][m][n] = (f32x4){0.f, 0.f, 0.f, 0.f};
        cur = nxt; cA = nA; cB = nB; ++ui;
        if constexpr (ALIGN_EPI) { if (wr == 1) PG8_BAR; }
    }
    PG8_WAIT_V(0);
    if constexpr (!ALIGN_EPI) { if (wr == 0) PG8_BAR; }
    PG8_BAR;
    if constexpr (Epi::AFTER_DRAIN) { E.fused(acc, cur, wr, wc, fr, fq, lds, wid, lane); S.done(cur); }
#undef PG8_SA
#undef PG8_SB
#undef PG8_STAGE
#undef PG8_LDA
#undef PG8_LDB
#undef PG8_MMA
#undef PG8_WAIT_V
#undef PG8_WAIT_L
#undef PG8_BAR
#undef PG8_SCHED
}
}

namespace pg8 {
struct EpiProj {
    static constexpr bool PERM = true, AFTER_DRAIN = false;
    bf16_t *PZ, *PXBC, *PRW, *PGATE;
    __device__ __forceinline__ void operator()(const f32x4 (&acc)[2][2][4][2], const Unit& u, int wr, int wc, int fr, int fq) const {
        constexpr int T0 = D / 256, T1 = T0 + CONV_DIM / 256, T2 = T1 + RWKV_PROJ / 256;
        bf16_t* base; int ldc, colt;
        if (u.pn < T0) { base = PZ; ldc = D; colt = u.pn * BM; }
        else if (u.pn < T1) { base = PXBC; ldc = CONV_DIM; colt = (u.pn - T0) * BM; }
        else if (u.pn < T2) { base = PRW; ldc = RWKV_PROJ; colt = (u.pn - T1) * BM; }
        else { base = PGATE; ldc = 2 * D; colt = (u.pn - T2) * BM; }
        const int row0 = u.pm * BM + wr * 64 + fr, col0 = colt + wc * 32 + 8 * fq;
#pragma unroll
        for (int ai = 0; ai < 2; ++ai)
#pragma unroll
            for (int m = 0; m < 4; ++m) { bf16_t* rowp = base + (size_t)(row0 + ai * HALF + m * 16) * ldc + col0;
#pragma unroll
                for (int bj = 0; bj < 2; ++bj) { const f32x4 v0 = acc[ai][bj][m][0], v1 = acc[ai][bj][m][1];
                    u32x4 w; w.x = cvt_pk_bf16(v0[0], v0[1]); w.y = cvt_pk_bf16(v0[2], v0[3]); w.z = cvt_pk_bf16(v1[0], v1[1]); w.w = cvt_pk_bf16(v1[2], v1[3]);
                    *(u32x4*)(rowp + bj * HALF) = w; } }
    }
};
struct EpiB16 {
    static constexpr bool PERM = true, AFTER_DRAIN = false;
    bf16_t* O; int ldc;
    __device__ __forceinline__ void operator()(const f32x4 (&acc)[2][2][4][2], const Unit& u, int wr, int wc, int fr, int fq) const {
        const int row0 = u.pm * BM + wr * 64 + fr, col0 = u.pn * BM + wc * 32 + 8 * fq;
#pragma unroll
        for (int ai = 0; ai < 2; ++ai)
#pragma unroll
            for (int m = 0; m < 4; ++m) { bf16_t* rowp = O + (size_t)(row0 + ai * HALF + m * 16) * ldc + col0;
#pragma unroll
                for (int bj = 0; bj < 2; ++bj) { const f32x4 v0 = acc[ai][bj][m][0], v1 = acc[ai][bj][m][1];
                    u32x4 w; w.x = cvt_pk_bf16(v0[0], v0[1]); w.y = cvt_pk_bf16(v0[2], v0[3]); w.z = cvt_pk_bf16(v1[0], v1[1]); w.w = cvt_pk_bf16(v1[2], v1[3]);
                    *(u32x4*)(rowp + bj * HALF) = w; } }
    }
};
struct EpiKV {
    static constexpr bool PERM = false, AFTER_DRAIN = false;
    float *mk, *mv; bf16_t* kvb;
    __device__ __forceinline__ void operator()(const f32x4 (&acc)[2][2][4][2], const Unit& u, int wr, int wc, int fr, int fq) const {
        const int row0 = u.pm * BM + wr * 64 + fr, col0 = u.pn * BM + wc * 32 + 4 * fq;
        float* ob = col0 < D ? mk : mv; const int colo = col0 < D ? col0 : col0 - D;
#pragma unroll
        for (int ai = 0; ai < 2; ++ai)
#pragma unroll
            for (int m = 0; m < 4; ++m) { const size_t r = (size_t)(row0 + ai * HALF + m * 16);
#pragma unroll
                for (int bj = 0; bj < 2; ++bj)
#pragma unroll
                    for (int n = 0; n < 2; ++n) { const f32x4 v = acc[ai][bj][m][n];
                        *(f32x4*)(ob + r * D + colo + bj * HALF + n * 16) = v;
                        typedef unsigned u32x2 __attribute__((ext_vector_type(2))); u32x2 w; w.x = cvt_pk_bf16(v[0], v[1]); w.y = cvt_pk_bf16(v[2], v[3]);
                        *(u32x2*)(kvb + r * 2 * D + col0 + bj * HALF + n * 16) = w; } }
    }
};
struct EpiRes {
    static constexpr bool PERM = false, AFTER_DRAIN = false;
    const float* base0; const float* base1; int split; float* out; int nrows;
    __device__ __forceinline__ void operator()(const f32x4 (&acc)[2][2][4][2], const Unit& u, int wr, int wc, int fr, int fq) const {
        const int row0 = u.pm * BM + wr * 64 + fr, col0 = u.pn * BM + wc * 32 + 4 * fq;
#pragma unroll
        for (int ai = 0; ai < 2; ++ai)
#pragma unroll
            for (int m = 0; m < 4; ++m) { const int r = row0 + ai * HALF + m * 16; if (r < nrows) {
                const float* bp = r < split ? base0 + (size_t)r * D : base1 + (size_t)(r - split) * D;
#pragma unroll
                for (int bj = 0; bj < 2; ++bj)
#pragma unroll
                    for (int n = 0; n < 2; ++n) { const int c = col0 + bj * HALF + n * 16; *(f32x4*)(out + (size_t)r * D + c) = *(const f32x4*)(bp + c) + acc[ai][bj][m][n]; } } }
    }
};
}

#define GAS __attribute__((address_space(1)))
#define LAS __attribute__((address_space(3)))
typedef unsigned v4u __attribute__((ext_vector_type(4)));
typedef float f32x4 __attribute__((ext_vector_type(4)));
typedef GAS unsigned gu32;
#define RLX_AGENT __ATOMIC_RELAXED, __HIP_MEMORY_SCOPE_AGENT
#define LDS_WAIT() asm volatile("s_waitcnt lgkmcnt(0)" ::: "memory")
#define VM_WAIT() asm volatile("s_waitcnt vmcnt(0)" ::: "memory")
#define XB_TMO      128
#define XB_XCNT(j)  (256  + 64 * (j))
#define XB_XSUB(j)  (1280 + 64 * (j))
#define XB_XGEN(j)  (2304 + 64 * (j))
#define XB_TOP      3328
#define XB_TOPGEN   3392
#define XCD_BAR_WORDS 3456
#define XB_SPIN_CAP (1u << 30)

__device__ __forceinline__ unsigned xb_ld(unsigned* p)              { return __hip_atomic_load(p, __ATOMIC_RELAXED, __HIP_MEMORY_SCOPE_AGENT); }
__device__ __forceinline__ unsigned xb_add(unsigned* p, unsigned v) { return __hip_atomic_fetch_add(p, v, __ATOMIC_RELAXED, __HIP_MEMORY_SCOPE_AGENT); }
__device__ __forceinline__ unsigned xb_xcc_id() { return (unsigned)__builtin_amdgcn_s_getreg((3 << 11) | 20) & 0xFu; }
#define XB_SPIN(cond, bar) do { unsigned _sp = 0; while (cond) { __builtin_amdgcn_s_sleep(1); \
    if ((++_sp & 255u) == 0u) { if (xb_ld(&(bar)[XB_TMO])) break; if (_sp > XB_SPIN_CAP) { atomicAdd(&(bar)[XB_TMO], 1u); break; } } } } while (0)

struct XcdBarrier {
    unsigned* bar; unsigned x;
    volatile LAS unsigned* st;
};

__device__ __forceinline__ XcdBarrier xcd_barrier_post(unsigned* bar, volatile LAS unsigned* st) {
    XcdBarrier b; b.bar = bar; b.x = xb_xcc_id(); b.st = st;
    if (threadIdx.x == 0) (void)xb_add(&bar[XB_XCNT(b.x)], 1u);
    return b;
}
__device__ __forceinline__ void xcd_barrier_complete(unsigned* bar, unsigned x, unsigned& nloc, unsigned& nx) {
    const unsigned G = gridDim.x * gridDim.y * gridDim.z;
    unsigned sum, cnt, mine, sp = 0u;
    for (;;) {
        sum = 0u; cnt = 0u; mine = 0u;
#pragma unroll
        for (unsigned j = 0; j < 16; ++j) { const unsigned c = xb_ld(&bar[XB_XCNT(j)]); sum += c; cnt += (c > 0u) ? 1u : 0u; mine = (j == x) ? c : mine; }
        if (sum == G) break;
        __builtin_amdgcn_s_sleep(1);
        if ((++sp & 255u) == 0u) { if (xb_ld(&bar[XB_TMO])) break; if (sp > XB_SPIN_CAP) { atomicAdd(&bar[XB_TMO], 1u); break; } }
    }
    nloc = mine > 0u ? mine : 1u; nx = cnt > 0u ? cnt : 1u;
}

__device__ __forceinline__ void xcd_barrier(const XcdBarrier& b) {
    asm volatile("s_waitcnt vmcnt(0)" ::: "memory");
    __syncthreads();
    if (threadIdx.x == 0) {
        unsigned* bar = b.bar;
        __builtin_amdgcn_s_waitcnt(0);
        unsigned nloc = b.st[0], nx = b.st[1];
        if (nloc == 0u) { xcd_barrier_complete(bar, b.x, nloc, nx); b.st[0] = nloc; b.st[1] = nx; }
        const unsigned old = xb_add(&bar[XB_XSUB(b.x)], 1u);
        const unsigned gen = old / nloc;
        if (old + 1u == (gen + 1u) * nloc) {
            __builtin_amdgcn_fence(__ATOMIC_RELEASE, "agent");
            asm volatile("s_waitcnt vmcnt(0)" ::: "memory");
            const unsigned og = xb_add(&bar[XB_TOP], 1u);
            const unsigned tg = og / nx;
            if (og + 1u == (tg + 1u) * nx) xb_add(&bar[XB_TOPGEN], 1u);
            else XB_SPIN(xb_ld(&bar[XB_TOPGEN]) == tg, bar);
            __builtin_amdgcn_fence(__ATOMIC_ACQUIRE, "agent");
            xb_add(&bar[XB_XGEN(b.x)], 1u);
            asm volatile("s_waitcnt vmcnt(0)" ::: "memory");
        } else {
            XB_SPIN(xb_ld(&bar[XB_XGEN(b.x)]) == gen, bar);
            __builtin_amdgcn_fence(__ATOMIC_ACQUIRE, "agent");
            asm volatile("s_waitcnt vmcnt(0)" ::: "memory");
        }
    }
    __syncthreads();
}


constexpr int NWAVES = 8, NTHREADS = NWAVES * 64;
constexpr int LDS_BYTES = 163840, LDSCTL_OFF = LDS_BYTES - 1024;
constexpr int CW_BAR = 4096;

enum Phase { PH_PREP = 0, PH_INPROJ, PH_MIXA, PH_SCAN, PH_MERGE, PH_OUT, PH_NORM2, PH_Q, PH_ATT1, PH_ATT2, PH_ATT3, PH_O, PH_NORM3, PH_PQ, PH_PK1, PH_PK2, PH_PE1, PH_PE2, PH_PE3, N_PHASES };
constexpr int MAX_LAUNCHES = 16;
#define GS_LOOP(n, call) do { for (size_t i_ = (size_t)bx * NTHREADS + tid; i_ < (size_t)(n); i_ += (size_t)G * NTHREADS) { call; } } while (0)

__device__ __forceinline__ unsigned pk2(float lo, float hi) { return (unsigned)f2bf(lo) | ((unsigned)f2bf(hi) << 16); }
__device__ __forceinline__ float wave_sum(float v) {
#pragma unroll
    for (int o = 1; o < 64; o <<= 1) v += __shfl_xor(v, o);
    return v;
}
__device__ __forceinline__ float wave_max(float v) {
#pragma unroll
    for (int o = 1; o < 64; o <<= 1) v = fmaxf(v, __shfl_xor(v, o));
    return v;
}

struct MkArgs { const float* in[N_INPUTS]; float* out; unsigned char* ws; int ph_lo, ph_hi, bar_idx, pad; };
static_assert((CW_BAR + MAX_LAUNCHES * XCD_BAR_WORDS) * 4 <= (int)CTL_BYTES, "ctl");

__device__ __forceinline__ void p0_transpose_item(const float* W, int K, int ldw, int srccol0, bf16_t* WT, int row0, LAS float* scr, int kb, int lane) {
    const int k0 = 64 * kb;
#pragma unroll 8
    for (int i = 0; i < 32; ++i) { const int kk = 2 * i + (lane >> 5); scr[kk * 33 + (lane & 31)] = W[(size_t)(k0 + kk) * ldw + srccol0 + (lane & 31)]; }
    LDS_WAIT(); asm volatile("" ::: "memory");
    const int c = lane & 7;
#pragma unroll
    for (int j = 0; j < 4; ++j) { const int n = (lane >> 3) + 8 * j; const LAS float* s = scr + (8 * c) * 33 + n;
        v4u o; o.x = pk2(s[0 * 33], s[1 * 33]); o.y = pk2(s[2 * 33], s[3 * 33]); o.z = pk2(s[4 * 33], s[5 * 33]); o.w = pk2(s[6 * 33], s[7 * 33]);
        *(v4u*)(WT + (size_t)(row0 + n) * K + k0 + 8 * c) = o; }
    LDS_WAIT(); asm volatile("" ::: "memory");
}
template <bool WITH_DT>
__device__ __forceinline__ void norm_row(const float* xrow, const float* w, bf16_t* orow, const float* w_in, float* dtrow, int lane) {
    static_assert(D == 1024, "norm_row is written for D = 1024");
    const f32x4* xr = (const f32x4*)xrow + lane; const f32x4* wr4 = (const f32x4*)w + lane;
    f32x4 v[4]; float s = 0.f;
#pragma unroll
    for (int j = 0; j < 4; ++j) { v[j] = xr[64 * j]; s += (v[j].x * v[j].x + v[j].y * v[j].y) + (v[j].z * v[j].z + v[j].w * v[j].w); }
    const float rs = 1.f / sqrtf(wave_sum(s) * (1.f / D) + NORM_EPS);
    unsigned long long* o8 = (unsigned long long*)orow + lane;
#pragma unroll
    for (int j = 0; j < 4; ++j) { v[j] = v[j] * rs * wr4[64 * j]; o8[64 * j] = (unsigned long long)pk2(v[j].x, v[j].y) | ((unsigned long long)pk2(v[j].z, v[j].w) << 32); }
    if constexpr (WITH_DT) {
        static_assert(H_SSD == 16, "dt path is written for 16 heads");
        f32x4 acc[4] = {{0.f, 0.f, 0.f, 0.f}, {0.f, 0.f, 0.f, 0.f}, {0.f, 0.f, 0.f, 0.f}, {0.f, 0.f, 0.f, 0.f}};
#pragma unroll
        for (int j = 0; j < 4; ++j)
#pragma unroll
            for (int i = 0; i < 4; ++i) { const int k = 4 * (64 * j + lane) + i; const f32x4* wp = (const f32x4*)(w_in + (size_t)k * D_IN + D + CONV_DIM); const float h = v[j][i];
#pragma unroll
                for (int q = 0; q < 4; ++q) acc[q] += wp[q] * h; }
        float mine = 0.f;
#pragma unroll
        for (int q = 0; q < 4; ++q)
#pragma unroll
            for (int e = 0; e < 4; ++e) { const float t = wave_sum(acc[q][e]); if (lane == 4 * q + e) mine = t; }
        if (lane < 16) dtrow[lane] = mine;
    }
}
__device__ __forceinline__ void fp8_row(const float* src, unsigned char* dst, float* inv, int lane) {
    static_assert(D == 1024, "fp8_row is written for D = 1024");
    const f32x4* s4 = (const f32x4*)src + 4 * lane; f32x4 v[4]; float am = 0.f;
#pragma unroll
    for (int j = 0; j < 4; ++j) { v[j] = s4[j]; am = fmaxf(am, fmaxf(fmaxf(fabsf(v[j].x), fabsf(v[j].y)), fmaxf(fabsf(v[j].z), fabsf(v[j].w)))); }
    am = wave_max(am); const float sc = am > 0.f ? 224.f / am : 1.f;
    v4u o;
#pragma unroll
    for (int j = 0; j < 4; ++j) { int p = __builtin_amdgcn_cvt_pk_fp8_f32(v[j].x * sc, v[j].y * sc, 0, false); p = __builtin_amdgcn_cvt_pk_fp8_f32(v[j].z * sc, v[j].w * sc, p, true); o[j] = (unsigned)p; }
    *((v4u*)dst + lane) = o;
    if (lane == 0) *inv = am > 0.f ? am / 224.f : 1.f;
}

__global__ void __launch_bounds__(NTHREADS, 2) mk_fwd(MkArgs args) {
    extern __shared__ __attribute__((aligned(16))) unsigned char lds_raw[];
    LAS unsigned char* lds = (LAS unsigned char*)lds_raw;
    volatile LAS unsigned* MISC = (volatile LAS unsigned*)(lds + LDSCTL_OFF);
    const int tid = threadIdx.x, lane = tid & 63, wave = __builtin_amdgcn_readfirstlane(tid >> 6);
    const int G = gridDim.x, bx = blockIdx.x, vcu = (G % 8 == 0) ? (bx % 8) * (G / 8) + bx / 8 : bx;
    unsigned char* ws = args.ws; float* out = args.out;
    for (int u = tid; u < (LDS_BYTES - LDSCTL_OFF) / 4; u += NTHREADS) ((LAS unsigned*)(lds + LDSCTL_OFF))[u] = 0u;
    __syncthreads();
    XcdBarrier bar = xcd_barrier_post((unsigned*)(ws + O_CTL) + CW_BAR + args.bar_idx * XCD_BAR_WORDS, MISC + 8);
    const int lo = args.ph_lo, hi = args.ph_hi;
#define IN_PH(k) (lo <= (k) && (k) < hi)
#define SEAM(k) do { if (IN_PH(k) && IN_PH((k) + 1)) xcd_barrier(bar); } while (0)
    bf16_t* WT_in = (bf16_t*)(ws + O_WT_IN); bf16_t* Hb = (bf16_t*)(ws + O_HB); bf16_t* MN = (bf16_t*)(ws + O_MN);
    const int gw = vcu * NWAVES + wave, NGW = G * NWAVES;

    if (IN_PH(PH_PREP)) {
        LAS float* scr = (LAS float*)(lds + wave * 16384);
        constexpr int KB = D / 64;
        constexpr int I_IN = (NMAIN / 32) * KB, I_SQ = (D / 32) * KB, I_PQ = (NPQ / 32) * KB, I_L64 = D / 32, I_L128 = (D / 32) * 2;
        constexpr int NITEMS = I_IN + 5 * I_SQ + I_PQ + 2 * I_L64 + I_L128;
        static_assert(W_RANK == 64 && A_RANK == 64 && G_RANK == 128 && (D + CONV_DIM) % 32 == 0, "P0 item shapes");
        for (int it = gw; it < NITEMS; it += NGW) {
            int r = it;
            if (r < I_IN) { const int kb = r / (NMAIN / 32), nb = r % (NMAIN / 32), n0 = 32 * nb; p0_transpose_item(args.in[I_W_IN], D, D_IN, n0 + (n0 >= D + CONV_DIM ? H_SSD : 0), WT_in, n0, scr, kb, lane); continue; } r -= I_IN;
            if (r < 5 * I_SQ) { const int wsel = r / I_SQ; r %= I_SQ; const int kb = r / (D / 32), nb = r % (D / 32);
                const float* W = args.in[wsel == 0 ? I_W_OUT : wsel == 1 ? I_W_MK : wsel == 2 ? I_W_MV : wsel == 3 ? I_W_MQ : I_W_MO];
                bf16_t* WT = (bf16_t*)(ws + (wsel == 0 ? O_WT_OUT : wsel == 1 ? O_WT_MK : wsel == 2 ? O_WT_MV : wsel == 3 ? O_WT_MQ : O_WT_MO));
                p0_transpose_item(W, D, D, 32 * nb, WT, 32 * nb, scr, kb, lane); continue; } r -= 5 * I_SQ;
            if (r < I_PQ) { const int kb = r / (NPQ / 32), nb = r % (NPQ / 32); p0_transpose_item(args.in[I_W_PQ], D, NPQ, 32 * nb, (bf16_t*)(ws + O_WT_PQ), 32 * nb, scr, kb, lane); continue; } r -= I_PQ;
            if (r < I_L64) { p0_transpose_item(args.in[I_W2], W_RANK, D, 32 * r, (bf16_t*)(ws + O_LW2), 32 * r, scr, 0, lane); continue; } r -= I_L64;
            if (r < I_L64) { p0_transpose_item(args.in[I_A2], A_RANK, D, 32 * r, (bf16_t*)(ws + O_LA2), 32 * r, scr, 0, lane); continue; } r -= I_L64;
            { const int kb = r / (D / 32), nb = r % (D / 32); p0_transpose_item(args.in[I_G2], G_RANK, D, 32 * nb, (bf16_t*)(ws + O_LG2), 32 * nb, scr, kb, lane); }
        }
        float* DT = (float*)(ws + O_DT);
        for (int m = gw; m < MPAD; m += NGW) {
            if (m < MT) norm_row<true>(m < MP ? args.in[I_XP] + (size_t)m * D : args.in[I_XS] + (size_t)(m - MP) * D, args.in[I_NORM_MIX], Hb + (size_t)m * D, args.in[I_W_IN], DT + (size_t)m * H_SSD, lane);
            else { v4u z = {0u, 0u, 0u, 0u}; v4u* o = (v4u*)(Hb + (size_t)m * D) + lane; o[0] = z; o[64] = z; }
        }
        for (int m = gw; m < NMEMROWS; m += NGW) norm_row<false>(args.in[I_MEM] + (size_t)m * D, args.in[I_MEM_NORM], MN + (size_t)m * D, nullptr, nullptr, lane);
        float* esc = (float*)(ws + O_ESC);
        for (int e = gw; e < 2 * N_EXPERTS; e += NGW) { const int t = e >= N_EXPERTS, r = e - t * N_EXPERTS;
            fp8_row(args.in[t ? I_EV : I_EU] + (size_t)r * D, ws + (t ? O_EV8 : O_EU8) + (size_t)r * D, esc + e, lane); }
        { const float* sk = args.in[I_SUBK]; bf16_t* skb = (bf16_t*)(ws + O_SKB); constexpr int NSK = PEER_HEADS * 2 * N_KEYS * PEER_HALF;
          for (int i = (vcu * NTHREADS + tid) * 4; i < NSK; i += G * NTHREADS * 4) { const f32x4 v = *(const f32x4*)(sk + i); typedef unsigned u32x2 __attribute__((ext_vector_type(2))); u32x2 w; w.x = pk2(v.x, v.y); w.y = pk2(v.z, v.w); *(u32x2*)(skb + i) = w; } }
    }
    SEAM(PH_PREP);
    if (IN_PH(PH_INPROJ)) {
        { pg8::Gemm g{Hb, WT_in, MPAD, NMAIN, D}; pg8::StaticOrder S; S.init(MPAD, NMAIN, G, bx);
          pg8::EpiProj E{(bf16_t*)(ws + O_PZ), (bf16_t*)(ws + O_PXBC), (bf16_t*)(ws + O_PRW), (bf16_t*)(ws + O_PGATE)};
          pg8::gemm_phase<pg8::EpiProj, pg8::StaticOrder, true, true>(lds, g, S, E); }
        { pg8::Gemm g{MN, (const bf16_t*)(ws + O_WT_MK), NMEMROWS, 2 * D, D}; pg8::StaticOrder S; S.init(NMEMROWS, 2 * D, G, G - 1 - bx);
          pg8::EpiKV E{out + OO_MKP, out + OO_MVP, (bf16_t*)(ws + O_KVB)};
          pg8::gemm_phase<pg8::EpiKV, pg8::StaticOrder, true, true>(lds, g, S, E); }
    }
    SEAM(PH_INPROJ);
    float* o_ = out;
    if (IN_PH(PH_MIXA)) {
        const bf16_t* PXBC = (const bf16_t*)(ws + O_PXBC); const bf16_t* PRW = (const bf16_t*)(ws + O_PRW);
        GS_LOOP((size_t)MT * CONV_DIM, b_conv(i_, PXBC, args.in[I_SCONV], args.in[I_CONV_W], args.in[I_CONV_B], (bf16_t*)(ws + O_XC)));
        GS_LOOP((size_t)(BATCH + DEC_BATCH) * (CONV_K - 1) * CONV_DIM, b_convstate(i_, PXBC, args.in[I_SCONV], o_ + OO_CONVP, o_ + OO_CONVS));
        RwkvW rw{args.in[I_MU], args.in[I_W0], args.in[I_W2], args.in[I_A0], args.in[I_A2], args.in[I_G2], args.in[I_K_K], args.in[I_K_A]};
        GS_LOOP((size_t)MT * D, b_rwkv_prep(i_, PRW, args.in[I_SSHIFT], rw, (f16_t*)(ws + O_R16), (f16_t*)(ws + O_OMW16), (f16_t*)(ws + O_K16), (f16_t*)(ws + O_V16), (f16_t*)(ws + O_KK16), (f16_t*)(ws + O_B16), (bf16_t*)(ws + O_GB)));
        GS_LOOP((size_t)(BATCH + DEC_BATCH) * RWKV_PROJ, b_shiftstate(i_, PRW, o_ + OO_SHP, o_ + OO_SHS));
        GS_LOOP((size_t)BATCH * H_SSD * P_SSD * N_SSD, b_copy_or_zero(i_, (const float*)nullptr, o_ + OO_SSMP, (size_t)BATCH * H_SSD * P_SSD * N_SSD));
        GS_LOOP((size_t)DEC_BATCH * H_SSD * P_SSD * N_SSD, b_copy_or_zero(i_, args.in[I_SSSM], o_ + OO_SSMS, (size_t)DEC_BATCH * H_SSD * P_SSD * N_SSD));
        GS_LOOP((size_t)BATCH * H_RWKV * HK * HK, b_copy_or_zero(i_, (const float*)nullptr, o_ + OO_WKVP, (size_t)BATCH * H_RWKV * HK * HK));
        GS_LOOP((size_t)DEC_BATCH * H_RWKV * HK * HK, b_copy_or_zero(i_, args.in[I_SWKV], o_ + OO_WKVS, (size_t)DEC_BATCH * H_RWKV * HK * HK));
    }
    SEAM(PH_MIXA);
    if (IN_PH(PH_SCAN)) {
        GS_LOOP((size_t)(BATCH + DEC_BATCH) * H_SSD * P_SSD, b_ssd(i_, (const bf16_t*)(ws + O_XC), (const float*)(ws + O_DT), args.in[I_DT_BIAS], args.in[I_A_LOG], args.in[I_D_SKIP], o_ + OO_SSMP, o_ + OO_SSMS, (bf16_t*)(ws + O_YS)));
        GS_LOOP((size_t)(BATCH + DEC_BATCH) * H_RWKV * HK, b_rwkv_scan(i_, (const f16_t*)(ws + O_R16), (const f16_t*)(ws + O_OMW16), (const f16_t*)(ws + O_K16), (const f16_t*)(ws + O_V16), (const f16_t*)(ws + O_KK16), (const f16_t*)(ws + O_B16), o_ + OO_WKVP, o_ + OO_WKVS, (bf16_t*)(o_ + OO_YP)));
    }
    SEAM(PH_SCAN);
    if (IN_PH(PH_MERGE)) {
        MergeW mw{args.in[I_SSD_NORM], args.in[I_R_K], args.in[I_LN_W], args.in[I_LN_B]};
        GS_LOOP((size_t)MT, b_merge(i_, (const bf16_t*)(ws + O_YS), (const bf16_t*)(o_ + OO_YP), (const bf16_t*)(ws + O_PZ), (const bf16_t*)(ws + O_PGATE), (const bf16_t*)(ws + O_GB), (const f16_t*)(ws + O_R16), (const f16_t*)(ws + O_K16), (const f16_t*)(ws + O_V16), mw, (bf16_t*)(ws + O_MERGED)));
        GS_LOOP((size_t)(MPAD - MT) * D, b_zero_u16(i_, (bf16_t*)(ws + O_MERGED) + (size_t)MT * D, (size_t)(MPAD - MT) * D));
    }
    SEAM(PH_MERGE);
    if (IN_PH(PH_OUT)) {
        pg8::Gemm g{(const bf16_t*)(ws + O_MERGED), (const bf16_t*)(ws + O_WT_OUT), MPAD, D, D}; pg8::StaticOrder S; S.init(MPAD, D, G, bx);
        pg8::EpiRes E{args.in[I_XP], args.in[I_XS], MP, (float*)(ws + O_X1), MT};
        pg8::gemm_phase<pg8::EpiRes, pg8::StaticOrder, true, true>(lds, g, S, E);
    }
    SEAM(PH_OUT);
    if (IN_PH(PH_NORM2)) {
        bf16_t* H2 = (bf16_t*)(ws + O_H2); const float* X1 = (const float*)(ws + O_X1);
        for (int m = gw; m < MPAD; m += NGW) {
            if (m < MT) norm_row<false>(X1 + (size_t)m * D, args.in[I_NORM_MEM], H2 + (size_t)m * D, nullptr, nullptr, lane);
            else { v4u z = {0u, 0u, 0u, 0u}; v4u* o = (v4u*)(H2 + (size_t)m * D) + lane; o[0] = z; o[64] = z; }
        }
    }
    SEAM(PH_NORM2);
    if (IN_PH(PH_Q)) {
        pg8::Gemm g{(const bf16_t*)(ws + O_H2), (const bf16_t*)(ws + O_WT_MQ), MPAD, D, D}; pg8::StaticOrder S; S.init(MPAD, D, G, bx);
        pg8::EpiB16 E{(bf16_t*)(ws + O_QB), D};
        pg8::gemm_phase<pg8::EpiB16, pg8::StaticOrder, true, true>(lds, g, S, E);
    }
    SEAM(PH_Q);
    if (IN_PH(PH_ATT1)) GS_LOOP((size_t)MT * MEM_HEADS * N_MEM, b_attn_scores(i_, (const bf16_t*)(ws + O_QB), o_ + OO_MKP, args.in[I_CK], (float*)(ws + O_SC)));
    SEAM(PH_ATT1);
    if (IN_PH(PH_ATT2)) GS_LOOP((size_t)MT * MEM_HEADS, b_attn_softmax(i_, (float*)(ws + O_SC)));
    SEAM(PH_ATT2);
    if (IN_PH(PH_ATT3)) {
        GS_LOOP((size_t)MT * D, b_attn_av(i_, (const float*)(ws + O_SC), o_ + OO_MVP, args.in[I_CV], (bf16_t*)(ws + O_AO)));
        GS_LOOP((size_t)(MPAD - MT) * D, b_zero_u16(i_, (bf16_t*)(ws + O_AO) + (size_t)MT * D, (size_t)(MPAD - MT) * D));
    }
    SEAM(PH_ATT3);
    if (IN_PH(PH_O)) {
        pg8::Gemm g{(const bf16_t*)(ws + O_AO), (const bf16_t*)(ws + O_WT_MO), MPAD, D, D}; pg8::StaticOrder S; S.init(MPAD, D, G, bx);
        pg8::EpiRes E{(const float*)(ws + O_X1), (const float*)(ws + O_X1), MPAD, (float*)(ws + O_X2), MT};
        pg8::gemm_phase<pg8::EpiRes, pg8::StaticOrder, true, true>(lds, g, S, E);
    }
    SEAM(PH_O);
    if (IN_PH(PH_NORM3)) {
        bf16_t* H3 = (bf16_t*)(ws + O_H3); const float* X2 = (const float*)(ws + O_X2);
        for (int m = gw; m < MPAD; m += NGW) {
            if (m < MT) norm_row<false>(X2 + (size_t)m * D, args.in[I_NORM_FFN], H3 + (size_t)m * D, nullptr, nullptr, lane);
            else { v4u z = {0u, 0u, 0u, 0u}; v4u* o = (v4u*)(H3 + (size_t)m * D) + lane; o[0] = z; o[64] = z; }
        }
    }
    SEAM(PH_NORM3);
    if (IN_PH(PH_PQ)) {
        pg8::Gemm g{(const bf16_t*)(ws + O_H3), (const bf16_t*)(ws + O_WT_PQ), MPAD, NPQ, D}; pg8::StaticOrder S; S.init(MPAD, NPQ, G, bx);
        pg8::EpiB16 E{(bf16_t*)(ws + O_PQ), NPQ};
        pg8::gemm_phase<pg8::EpiB16, pg8::StaticOrder, true, true>(lds, g, S, E);
    }
    SEAM(PH_PQ);
    if (IN_PH(PH_PK1)) GS_LOOP((size_t)MT * PEER_HEADS * 2 * N_KEYS, b_peer_scores(i_, (const bf16_t*)(ws + O_PQ), args.in[I_SUBK], (float*)(ws + O_SCP)));
    SEAM(PH_PK1);
    if (IN_PH(PH_PK2)) GS_LOOP((size_t)MT * PEER_HEADS, b_peer_topk(i_, (const float*)(ws + O_SCP), (float*)(ws + O_TS), (int*)(ws + O_TI), (int*)(ws + O_IDX), (float*)(ws + O_GATE)));
    SEAM(PH_PK2);
    if (IN_PH(PH_PE1)) GS_LOOP((size_t)MT * NSEL, b_peer_act(i_, (const bf16_t*)(ws + O_H3), args.in[I_EU], (const int*)(ws + O_IDX), (const float*)(ws + O_GATE), (float*)(ws + O_COEF)));
    SEAM(PH_PE1);
    if (IN_PH(PH_PE2)) GS_LOOP((size_t)MT * D, b_peer_out(i_, (float*)(ws + O_X2), args.in[I_EV], (const int*)(ws + O_IDX), (const float*)(ws + O_COEF)));
    SEAM(PH_PE2);
    if (IN_PH(PH_PE3)) GS_LOOP((size_t)MT, b_final(i_, (const float*)(ws + O_X2), args.in[I_NORM_FINAL], o_ + OO_YP, o_ + OO_YS));
#undef IN_PH
#undef SEAM
}
#endif

extern "C" void kernel_launch(void* const* d_in, const int* in_sizes, int n_in, void* d_out, int out_size, void* d_ws, size_t ws_size, hipStream_t stream) {
    const float* const* in = (const float* const*)d_in;
    const float *x_prompt = in[0], *x_sample = in[1], *mem_prompt = in[2], *state_ssm = in[3], *state_conv = in[4], *state_wkv = in[5], *state_shift = in[6], *cache_k = in[7], *cache_v = in[8];
    const float *norm_mix_w = in[9], *w_in = in[10], *conv_w = in[11], *conv_b = in[12], *dt_bias = in[13], *a_log = in[14], *d_skip = in[15], *ssd_norm_w = in[16];
    const float *rwkv_mu = in[17], *rwkv_w0 = in[18], *rwkv_w2 = in[19], *rwkv_a0 = in[20], *rwkv_a2 = in[21], *rwkv_g2 = in[22], *rwkv_k_k = in[23], *rwkv_k_a = in[24], *rwkv_r_k = in[25], *rwkv_ln_w = in[26], *rwkv_ln_b = in[27];
    const float *w_out = in[28], *norm_mem_w = in[29], *mem_norm_w = in[30], *w_mk = in[31], *w_mv = in[32], *w_mq = in[33], *w_mo = in[34], *norm_ffn_w = in[35], *w_pq = in[36], *sub_keys = in[37], *expert_u = in[38], *expert_v = in[39], *norm_final_w = in[40];
    (void)mem_prompt; (void)w_in; (void)w_out; (void)mem_norm_w; (void)w_mk; (void)w_mv; (void)w_mq; (void)w_mo; (void)w_pq; (void)norm_mix_w; (void)x_prompt; (void)x_sample;
    float* o = (float*)d_out;
    float *y_prompt = o + OO_YP, *y_sample = o + OO_YS, *ssm_p = o + OO_SSMP, *conv_p = o + OO_CONVP, *wkv_p = o + OO_WKVP, *shift_p = o + OO_SHP, *memk_p = o + OO_MKP, *memv_p = o + OO_MVP;
    float *ssm_s = o + OO_SSMS, *conv_s = o + OO_CONVS, *wkv_s = o + OO_WKVS, *shift_s = o + OO_SHS;
    unsigned char* ws = (unsigned char*)d_ws;
    if (O_END > ws_size || (size_t)out_size != OO_END || n_in != N_INPUTS) { fprintf(stderr, "kernel_launch: workspace %zu (need %zu), out %d (need %zu), n_in %d\n", ws_size, (size_t)O_END, out_size, (size_t)OO_END, n_in); return; }
    bf16_t *WT_out = (bf16_t*)(ws + O_WT_OUT), *WT_mq = (bf16_t*)(ws + O_WT_MQ), *WT_mo = (bf16_t*)(ws + O_WT_MO), *WT_pq = (bf16_t*)(ws + O_WT_PQ);
    bf16_t *PZ = (bf16_t*)(ws + O_PZ), *PXBC = (bf16_t*)(ws + O_PXBC), *PRW = (bf16_t*)(ws + O_PRW), *PGATE = (bf16_t*)(ws + O_PGATE); float* DT = (float*)(ws + O_DT);
    bf16_t* XC = (bf16_t*)(ws + O_XC);
    f16_t *R16 = (f16_t*)(ws + O_R16), *OMW16 = (f16_t*)(ws + O_OMW16), *K16 = (f16_t*)(ws + O_K16), *V16 = (f16_t*)(ws + O_V16), *KK16 = (f16_t*)(ws + O_KK16), *B16 = (f16_t*)(ws + O_B16);
    bf16_t* YR = (bf16_t*)y_prompt;
    bf16_t *Gb = (bf16_t*)(ws + O_GB), *YS = (bf16_t*)(ws + O_YS), *MERGED = (bf16_t*)(ws + O_MERGED); float* X1 = (float*)(ws + O_X1);
    bf16_t *H2 = (bf16_t*)(ws + O_H2), *Qb = (bf16_t*)(ws + O_QB), *AO = (bf16_t*)(ws + O_AO);
    float* SC = (float*)(ws + O_SC); float* X2 = (float*)(ws + O_X2); bf16_t *H3 = (bf16_t*)(ws + O_H3), *PQ = (bf16_t*)(ws + O_PQ);
    int* IDX = (int*)(ws + O_IDX); float *GATE = (float*)(ws + O_GATE), *COEF = (float*)(ws + O_COEF); float* TS = (float*)(ws + O_TS); int* TI = (int*)(ws + O_TI); float* SCP = (float*)(ws + O_SCP);

#ifndef HOST_EMU
    static int grid = 0;
    if (grid == 0) {
        int dev = 0, cus = 0, per_cu = 0;
        if (hipGetDevice(&dev) != hipSuccess || hipDeviceGetAttribute(&cus, hipDeviceAttributeMultiprocessorCount, dev) != hipSuccess) { fprintf(stderr, "kernel_launch: device query failed\n"); grid = -1; return; }
        if (hipFuncSetAttribute((const void*)mk_fwd, hipFuncAttributeMaxDynamicSharedMemorySize, LDS_BYTES) != hipSuccess) { fprintf(stderr, "kernel_launch: hipFuncSetAttribute failed\n"); grid = -1; return; }
        if (hipOccupancyMaxActiveBlocksPerMultiprocessor(&per_cu, (const void*)mk_fwd, NTHREADS, LDS_BYTES) != hipSuccess || per_cu < 1) { fprintf(stderr, "kernel_launch: occupancy query says %d blocks per CU\n", per_cu); (void)hipGetLastError(); grid = -1; return; }
        grid = cus;
    }
    if (grid < 0) return;
    (void)hipMemsetAsync(ws + O_CTL, 0, CTL_BYTES, stream);
    MkArgs a{};
    for (int i = 0; i < N_INPUTS; ++i) a.in[i] = (const float*)d_in[i];
    a.out = (float*)d_out; a.ws = ws; a.ph_lo = 0; a.ph_hi = N_PHASES; a.bar_idx = 0;
    hipLaunchKernelGGL(mk_fwd, dim3(grid), dim3(NTHREADS), LDS_BYTES, stream, a);
    return;
#define MK(lo_, hi_) do { } while (0)
#else
#define MK(lo_, hi_) do { } while (0)
    { bf16_t *WT_in = (bf16_t*)(ws + O_WT_IN), *WT_dt = (bf16_t*)(ws + O_WT_DT), *WT_mk = (bf16_t*)(ws + O_WT_MK), *WT_mv = (bf16_t*)(ws + O_WT_MV), *Hb = (bf16_t*)(ws + O_HB), *MN = (bf16_t*)(ws + O_MN);
    launch(k_wt, (size_t)NMAIN * D, stream, w_in, D, D_IN, 0, D + CONV_DIM, H_SSD, WT_in, NMAIN);
    launch(k_wt, (size_t)H_SSD * D, stream, w_in, D, D_IN, D + CONV_DIM, 1 << 30, 0, WT_dt, H_SSD);
    launch(k_wt, (size_t)D * D, stream, w_out, D, D, 0, 1 << 30, 0, WT_out, D);
    launch(k_wt, (size_t)D * D, stream, w_mk, D, D, 0, 1 << 30, 0, WT_mk, D);
    launch(k_wt, (size_t)D * D, stream, w_mv, D, D, 0, 1 << 30, 0, WT_mv, D);
    launch(k_wt, (size_t)D * D, stream, w_mq, D, D, 0, 1 << 30, 0, WT_mq, D);
    launch(k_wt, (size_t)D * D, stream, w_mo, D, D, 0, 1 << 30, 0, WT_mo, D);
    launch(k_wt, (size_t)NPQ * D, stream, w_pq, D, NPQ, 0, 1 << 30, 0, WT_pq, NPQ);
    launch(k_rmsnorm_bf16, (size_t)MP, stream, x_prompt, norm_mix_w, Hb, MP);
    launch(k_rmsnorm_bf16, (size_t)MS, stream, x_sample, norm_mix_w, Hb + (size_t)MP * D, MS);
    launch(k_rmsnorm_bf16, (size_t)NMEMROWS, stream, mem_prompt, mem_norm_w, MN, NMEMROWS);
    launch(k_gemm, (size_t)MT * D, stream, Hb, D, WT_in, D, MT, D, 0, PZ, D, (float*)nullptr, 0, (const float*)nullptr, 0);
    launch(k_gemm, (size_t)MT * CONV_DIM, stream, Hb, D, WT_in + (size_t)D * D, D, MT, CONV_DIM, 0, PXBC, CONV_DIM, (float*)nullptr, 0, (const float*)nullptr, 0);
    launch(k_gemm, (size_t)MT * RWKV_PROJ, stream, Hb, D, WT_in + (size_t)(D + CONV_DIM) * D, D, MT, RWKV_PROJ, 0, PRW, RWKV_PROJ, (float*)nullptr, 0, (const float*)nullptr, 0);
    launch(k_gemm, (size_t)MT * 2 * D, stream, Hb, D, WT_in + (size_t)(D + CONV_DIM + RWKV_PROJ) * D, D, MT, 2 * D, 0, PGATE, 2 * D, (float*)nullptr, 0, (const float*)nullptr, 0);
    launch(k_gemm, (size_t)MT * H_SSD, stream, Hb, D, WT_dt, D, MT, H_SSD, 1, (bf16_t*)nullptr, 0, DT, H_SSD, (const float*)nullptr, 0);
    launch(k_gemm, (size_t)NMEMROWS * D, stream, MN, D, WT_mk, D, NMEMROWS, D, 1, (bf16_t*)nullptr, 0, memk_p, D, (const float*)nullptr, 0);
    launch(k_gemm, (size_t)NMEMROWS * D, stream, MN, D, WT_mv, D, NMEMROWS, D, 1, (bf16_t*)nullptr, 0, memv_p, D, (const float*)nullptr, 0); }
#endif
    launch(k_conv, (size_t)MT * CONV_DIM, stream, PXBC, state_conv, conv_w, conv_b, XC);
    launch(k_convstate, (size_t)(BATCH + DEC_BATCH) * (CONV_K - 1) * CONV_DIM, stream, PXBC, state_conv, conv_p, conv_s);
    RwkvW rw{rwkv_mu, rwkv_w0, rwkv_w2, rwkv_a0, rwkv_a2, rwkv_g2, rwkv_k_k, rwkv_k_a};
    launch(k_rwkv_prep, (size_t)MT * D, stream, PRW, state_shift, rw, R16, OMW16, K16, V16, KK16, B16, Gb);
    launch(k_shiftstate, (size_t)(BATCH + DEC_BATCH) * RWKV_PROJ, stream, PRW, shift_p, shift_s);
    launch(k_copy_or_zero, (size_t)BATCH * H_SSD * P_SSD * N_SSD, stream, (const float*)nullptr, ssm_p, (size_t)BATCH * H_SSD * P_SSD * N_SSD);
    launch(k_copy_or_zero, (size_t)DEC_BATCH * H_SSD * P_SSD * N_SSD, stream, state_ssm, ssm_s, (size_t)DEC_BATCH * H_SSD * P_SSD * N_SSD);
    launch(k_ssd, (size_t)(BATCH + DEC_BATCH) * H_SSD * P_SSD, stream, XC, DT, dt_bias, a_log, d_skip, ssm_p, ssm_s, YS);
    launch(k_copy_or_zero, (size_t)BATCH * H_RWKV * HK * HK, stream, (const float*)nullptr, wkv_p, (size_t)BATCH * H_RWKV * HK * HK);
    launch(k_copy_or_zero, (size_t)DEC_BATCH * H_RWKV * HK * HK, stream, state_wkv, wkv_s, (size_t)DEC_BATCH * H_RWKV * HK * HK);
    launch(k_rwkv_scan, (size_t)(BATCH + DEC_BATCH) * H_RWKV * HK, stream, R16, OMW16, K16, V16, KK16, B16, wkv_p, wkv_s, YR);
    MergeW mw{ssd_norm_w, rwkv_r_k, rwkv_ln_w, rwkv_ln_b};
    launch(k_merge, (size_t)MT, stream, YS, YR, PZ, PGATE, Gb, R16, K16, V16, mw, MERGED);
#ifdef HOST_EMU
    launch(k_gemm, (size_t)MP * D, stream, MERGED, D, WT_out, D, MP, D, 2, (bf16_t*)nullptr, 0, X1, D, x_prompt, D);
    launch(k_gemm, (size_t)MS * D, stream, MERGED + (size_t)MP * D, D, WT_out, D, MS, D, 2, (bf16_t*)nullptr, 0, X1 + (size_t)MP * D, D, x_sample, D);
    launch(k_rmsnorm_f2b, (size_t)MT, stream, X1, norm_mem_w, H2, MT);
    launch(k_gemm, (size_t)MT * D, stream, H2, D, WT_mq, D, MT, D, 0, Qb, D, (float*)nullptr, 0, (const float*)nullptr, 0);
#else
    launch(k_zero_u16, (size_t)(MPAD - MT) * D, stream, MERGED + (size_t)MT * D, (size_t)(MPAD - MT) * D);
    MK(PH_OUT, PH_Q + 1);
#endif
    launch(k_attn_scores, (size_t)MT * MEM_HEADS * N_MEM, stream, Qb, memk_p, cache_k, SC);
    launch(k_attn_softmax, (size_t)MT * MEM_HEADS, stream, SC);
    launch(k_attn_av, (size_t)MT * D, stream, SC, memv_p, cache_v, AO);
#ifdef HOST_EMU
    launch(k_gemm, (size_t)MT * D, stream, AO, D, WT_mo, D, MT, D, 2, (bf16_t*)nullptr, 0, X2, D, X1, D);
    launch(k_rmsnorm_f2b, (size_t)MT, stream, X2, norm_ffn_w, H3, MT);
    launch(k_gemm, (size_t)MT * NPQ, stream, H3, D, WT_pq, D, MT, NPQ, 0, PQ, NPQ, (float*)nullptr, 0, (const float*)nullptr, 0);
#else
    launch(k_zero_u16, (size_t)(MPAD - MT) * D, stream, AO + (size_t)MT * D, (size_t)(MPAD - MT) * D);
    MK(PH_O, PH_PQ + 1);
#endif
    launch(k_peer_scores, (size_t)MT * PEER_HEADS * 2 * N_KEYS, stream, PQ, sub_keys, SCP);
    launch(k_peer_topk, (size_t)MT * PEER_HEADS, stream, SCP, TS, TI, IDX, GATE);
    launch(k_peer_act, (size_t)MT * NSEL, stream, H3, expert_u, IDX, GATE, COEF);
    launch(k_peer_out, (size_t)MT * D, stream, X2, expert_v, IDX, COEF);
    launch(k_final, (size_t)MT, stream, X2, norm_final_w, y_prompt, y_sample);
}
```

```cpp
#ifdef HOST_EMU
#include <cmath>
#include <cstring>
#include <cstdint>
#include <cstdio>
#include <cstddef>
typedef void* hipStream_t;
#define __global__
#define __device__
#define __host__
#define __forceinline__ inline
static thread_local size_t g_tid;
#define GTID g_tid
template <class F, class... A> static void launch(F f, size_t n, hipStream_t, A... a) {
#pragma omp parallel for schedule(static)
    for (long long i = 0; i < (long long)n; ++i) { g_tid = (size_t)i; f(a...); }
}
#else
#include <hip/hip_runtime.h>
#include <cstdint>
#include <cstdio>
#define GTID ((size_t)blockIdx.x * blockDim.x + threadIdx.x)
template <class F, class... A> static void launch(F f, size_t n, hipStream_t s, A... a) {
    if (n == 0) return;
    hipLaunchKernelGGL(f, dim3((unsigned)((n + 255) / 256)), dim3(256), 0, s, a...);
}
#endif

#ifndef D_MODEL
#define D_MODEL 1024
#define BATCH 8
#define SEQ 2048
#define DEC_BATCH 128
#define SSD_HEADDIM 64
#define SSD_GROUPS 2
#define SSD_STATE 128
#define HD_RWKV 64
#define W_RANK 64
#define A_RANK 64
#define G_RANK 128
#define N_MEM 256
#define MEM_HEADS 4
#define N_KEYS 128
#define PEER_HEADS 8
#define PEER_DKEY 256
#define PEER_TOPK 16
#endif
#define CONV_K 4
constexpr int D = D_MODEL;
constexpr int H_SSD = D / SSD_HEADDIM, P_SSD = SSD_HEADDIM, N_SSD = SSD_STATE, G_SSD = SSD_GROUPS;
constexpr int CONV_DIM = D + 2 * G_SSD * N_SSD;
constexpr int H_RWKV = D / HD_RWKV, HK = HD_RWKV;
constexpr int RWKV_PROJ = 3 * D + W_RANK + A_RANK + G_RANK;
constexpr int D_IN = D + CONV_DIM + H_SSD + RWKV_PROJ + 2 * D;
constexpr int MEM_HD = D / MEM_HEADS;
constexpr int N_EXPERTS = N_KEYS * N_KEYS, PEER_HALF = PEER_DKEY / 2, NPQ = PEER_HEADS * PEER_DKEY, NSEL = PEER_HEADS * PEER_TOPK;
constexpr int MP = BATCH * SEQ, MS = DEC_BATCH, MT = MP + MS, MPAD = (MT + 255) / 256 * 256, NMEMROWS = BATCH * N_MEM;
constexpr float NORM_EPS = 1e-6f, RWKV_LN_EPS = 64e-5f;
constexpr int NMAIN = D_IN - H_SSD;

typedef unsigned short bf16_t;
typedef _Float16 f16_t;
__host__ __device__ __forceinline__ float bf2f(bf16_t v) { unsigned u = (unsigned)v << 16; float f; memcpy(&f, &u, 4); return f; }
__host__ __device__ __forceinline__ bf16_t f2bf(float f) { unsigned u; memcpy(&u, &f, 4); u = (u + 0x7fffu + ((u >> 16) & 1u)) >> 16; return (bf16_t)u; }
__host__ __device__ __forceinline__ float siluf(float x) { return x / (1.f + expf(-x)); }
__host__ __device__ __forceinline__ float sigmoidf(float x) { return 1.f / (1.f + expf(-x)); }
__host__ __device__ __forceinline__ float softplusf(float x) { return x > 20.f ? x : log1pf(expf(x)); }
__host__ __device__ __forceinline__ float geluf(float x) { return 0.5f * x * (1.f + erff(x * 0.70710678118654752f)); }

struct RowInfo { int grp, b, t; };
__host__ __device__ __forceinline__ RowInfo rowinfo(int r) { RowInfo q; if (r < MP) { q.grp = 0; q.b = r / SEQ; q.t = r % SEQ; } else { q.grp = 1; q.b = r - MP; q.t = 0; } return q; }

__device__ __forceinline__ void b_zero_u16(size_t i, bf16_t* p, size_t n) {  if (i < n) p[i] = 0; }
__device__ __forceinline__ void b_rmsnorm_bf16(size_t i, const float* x, const float* w, bf16_t* out, int nrows) {
     if (i >= (size_t)nrows) return;
    const float* xr = x + i * D; float ss = 0.f;
    for (int c = 0; c < D; ++c) ss += xr[c] * xr[c];
    const float rs = 1.f / sqrtf(ss / D + NORM_EPS);
    for (int c = 0; c < D; ++c) out[i * D + c] = f2bf(xr[c] * rs * w[c]);
}
__device__ __forceinline__ void b_wt(size_t i, const float* W, int K, int ldw, int ncol0, int skip_at, int skip, bf16_t* WT, int N) {
     if (i >= (size_t)N * K) return;
    const int n = (int)(i / K), k = (int)(i % K); const int sc = ncol0 + n + (n >= skip_at ? skip : 0);
    WT[i] = f2bf(W[(size_t)k * ldw + sc]);
}
struct __attribute__((aligned(16))) V8 { bf16_t v[8]; };
__device__ __forceinline__ void b_gemm(size_t i, const bf16_t* A, int lda, const bf16_t* Bt, int K, int M, int N, int mode, bf16_t* ob, int ldob, float* of, int ldof, const float* base, int ldbase) {
     if (i >= (size_t)M * N) return;
    const int m = (int)(i / N), n = (int)(i % N);
    const bf16_t* a = A + (size_t)m * lda; const bf16_t* b = Bt + (size_t)n * K; float acc = 0.f;
    for (int k = 0; k < K; k += 8) { V8 va, vb; memcpy(&va, a + k, 16); memcpy(&vb, b + k, 16);
        for (int j = 0; j < 8; ++j) acc += bf2f(va.v[j]) * bf2f(vb.v[j]); }
    if (mode == 0) ob[(size_t)m * ldob + n] = f2bf(acc);
    else if (mode == 1) { of[(size_t)m * ldof + n] = acc; if (ob) ob[(size_t)m * ldob + n] = f2bf(acc); }
    else of[(size_t)m * ldof + n] = base[(size_t)m * ldbase + n] + acc;
}
__device__ __forceinline__ void b_conv(size_t i, const bf16_t* PXBC, const float* state_conv, const float* conv_w, const float* conv_b, bf16_t* XC) {
     if (i >= (size_t)MT * CONV_DIM) return;
    const int r = (int)(i / CONV_DIM), ch = (int)(i % CONV_DIM); const RowInfo q = rowinfo(r);
    float acc = conv_b[ch];
    for (int j = 0; j < CONV_K; ++j) { const int tp = q.t - (CONV_K - 1) + j; float v;
        if (tp >= 0) v = bf2f(PXBC[(size_t)(r - (q.t - tp)) * CONV_DIM + ch]);
        else v = q.grp ? state_conv[((size_t)q.b * (CONV_K - 1) + (CONV_K - 1 + tp)) * CONV_DIM + ch] : 0.f;
        acc += v * conv_w[j * CONV_DIM + ch]; }
    XC[i] = f2bf(siluf(acc));
}
__device__ __forceinline__ void b_convstate(size_t i, const bf16_t* PXBC, const float* state_conv, float* conv_p, float* conv_s) {
     const size_t np = (size_t)BATCH * (CONV_K - 1) * CONV_DIM, ns = (size_t)DEC_BATCH * (CONV_K - 1) * CONV_DIM; if (i >= np + ns) return;
    if (i < np) { const int ch = (int)(i % CONV_DIM), j = (int)((i / CONV_DIM) % (CONV_K - 1)), b = (int)(i / ((CONV_K - 1) * CONV_DIM));
        const int t = SEQ - (CONV_K - 1) + j; conv_p[i] = t >= 0 ? bf2f(PXBC[((size_t)b * SEQ + t) * CONV_DIM + ch]) : 0.f; }
    else { const size_t k = i - np; const int ch = (int)(k % CONV_DIM), j = (int)((k / CONV_DIM) % (CONV_K - 1)), b = (int)(k / ((CONV_K - 1) * CONV_DIM));
        conv_s[k] = (j + 1 < CONV_K - 1) ? state_conv[((size_t)b * (CONV_K - 1) + j + 1) * CONV_DIM + ch] : bf2f(PXBC[((size_t)MP + b) * CONV_DIM + ch]); }
}
__device__ __forceinline__ void b_copy_or_zero(size_t i, const float* src, float* dst, size_t n) {  if (i < n) dst[i] = src ? src[i] : 0.f; }
__device__ __forceinline__ void b_ssd(size_t i, const bf16_t* XC, const float* DT, const float* dt_bias, const float* a_log, const float* d_skip, float* Sp, float* Ss, bf16_t* YS) {
     const size_t np = (size_t)BATCH * H_SSD * P_SSD, ns = (size_t)DEC_BATCH * H_SSD * P_SSD; if (i >= np + ns) return;
    const int grp = i >= np; const size_t k = grp ? i - np : i; const int p = (int)(k % P_SSD), h = (int)((k / P_SSD) % H_SSD), b = (int)(k / (P_SSD * H_SSD));
    float* S = (grp ? Ss : Sp) + k * N_SSD; const int L = grp ? 1 : SEQ; const int g = h / (H_SSD / G_SSD);
    const float ah = -expf(a_log[h]), db = dt_bias[h], dsk = d_skip[h];
    for (int t = 0; t < L; ++t) { const size_t r = grp ? (size_t)MP + b : (size_t)b * SEQ + t;
        const float dt = softplusf(DT[r * H_SSD + h] + db), dA = expf(dt * ah), x = bf2f(XC[r * CONV_DIM + h * P_SSD + p]);
        const bf16_t* Bv = XC + r * CONV_DIM + D + g * N_SSD; const bf16_t* Cv = XC + r * CONV_DIM + D + G_SSD * N_SSD + g * N_SSD;
        float y = 0.f;
        for (int n = 0; n < N_SSD; ++n) { const float s = S[n] * dA + dt * x * bf2f(Bv[n]); S[n] = s; y += bf2f(Cv[n]) * s; }
        YS[r * D + h * P_SSD + p] = f2bf(y + dsk * x); }
}
__device__ __forceinline__ float rws_at(const bf16_t* PRW, const float* state_shift, const float* mu, int r, int c) {
    const RowInfo q = rowinfo(r); const float cur = bf2f(PRW[(size_t)r * RWKV_PROJ + c]);
    const float prev = q.t > 0 ? bf2f(PRW[(size_t)(r - 1) * RWKV_PROJ + c]) : (q.grp ? state_shift[(size_t)q.b * RWKV_PROJ + c] : 0.f);
    return cur + (prev - cur) * mu[c];
}
struct RwkvW { const float *mu, *w0, *w2, *a0, *a2, *g2, *k_k, *k_a; };
__device__ __forceinline__ void b_rwkv_prep(size_t i, const bf16_t* PRW, const float* state_shift, RwkvW W, f16_t* R16, f16_t* OMW16, f16_t* K16, f16_t* V16, f16_t* KK16, f16_t* B16, bf16_t* Gb) {
     if (i >= (size_t)MT * D) return;
    const int r = (int)(i / D), ch = (int)(i % D), h0 = ch / HK * HK;
    float dw = 0.f, da = 0.f, dg = 0.f;
    for (int j = 0; j < W_RANK; ++j) dw += tanhf(rws_at(PRW, state_shift, W.mu, r, 3 * D + j)) * W.w2[j * D + ch];
    for (int j = 0; j < A_RANK; ++j) da += rws_at(PRW, state_shift, W.mu, r, 3 * D + W_RANK + j) * W.a2[j * D + ch];
    for (int j = 0; j < G_RANK; ++j) dg += sigmoidf(rws_at(PRW, state_shift, W.mu, r, 3 * D + W_RANK + A_RANK + j)) * W.g2[j * D + ch];
    const float wlog = -softplusf(-(W.w0[ch] + dw)) - 0.5f, e = expf(wlog), omw = -expm1f(-e);
    const float ag = sigmoidf(W.a0[ch] + da);
    const float kv = rws_at(PRW, state_shift, W.mu, r, D + ch);
    float ss = 0.f;
    for (int c = h0; c < h0 + HK; ++c) { const float q = rws_at(PRW, state_shift, W.mu, r, D + c) * W.k_k[c]; ss += q * q; }
    const float kk = kv * W.k_k[ch] / sqrtf(fmaxf(ss, 1e-24f));
    R16[i] = (f16_t)rws_at(PRW, state_shift, W.mu, r, ch); OMW16[i] = (f16_t)omw; K16[i] = (f16_t)(kv * (1.f + (ag - 1.f) * W.k_a[ch]));
    V16[i] = (f16_t)rws_at(PRW, state_shift, W.mu, r, 2 * D + ch); KK16[i] = (f16_t)kk; B16[i] = (f16_t)(kk * ag); Gb[i] = f2bf(dg);
}
__device__ __forceinline__ void b_shiftstate(size_t i, const bf16_t* PRW, float* sh_p, float* sh_s) {
     const size_t np = (size_t)BATCH * RWKV_PROJ, ns = (size_t)DEC_BATCH * RWKV_PROJ; if (i >= np + ns) return;
    if (i < np) { const int c = (int)(i % RWKV_PROJ), b = (int)(i / RWKV_PROJ); sh_p[i] = bf2f(PRW[((size_t)b * SEQ + SEQ - 1) * RWKV_PROJ + c]); }
    else { const size_t k = i - np; const int c = (int)(k % RWKV_PROJ), b = (int)(k / RWKV_PROJ); sh_s[k] = bf2f(PRW[((size_t)MP + b) * RWKV_PROJ + c]); }
}
__device__ __forceinline__ void b_rwkv_scan(size_t i, const f16_t* R16, const f16_t* OMW16, const f16_t* K16, const f16_t* V16, const f16_t* KK16, const f16_t* B16, float* Sp, float* Ss, bf16_t* YR) {
     const size_t np = (size_t)BATCH * H_RWKV * HK, ns = (size_t)DEC_BATCH * H_RWKV * HK; if (i >= np + ns) return;
    const int grp = i >= np; const size_t k0 = grp ? i - np : i; const int v = (int)(k0 % HK), h = (int)((k0 / HK) % H_RWKV), b = (int)(k0 / (HK * H_RWKV));
    float* S = (grp ? Ss : Sp) + k0 * HK; const int L = grp ? 1 : SEQ;
    for (int t = 0; t < L; ++t) { const size_t r = grp ? (size_t)MP + b : (size_t)b * SEQ + t; const size_t o = r * D + h * HK;
        float sa = 0.f; for (int k = 0; k < HK; ++k) sa += S[k] * (float)KK16[o + k];
        const float vv = (float)V16[o + v]; float y = 0.f;
        for (int k = 0; k < HK; ++k) { float s = S[k]; s = s - s * (float)OMW16[o + k]; s = s - sa * (float)B16[o + k]; s = s + vv * (float)K16[o + k]; S[k] = s; y += s * (float)R16[o + k]; }
        YR[o + v] = f2bf(y); }
}
struct MergeW { const float *ssd_norm_w, *r_k, *ln_w, *ln_b; };
__device__ __forceinline__ void b_merge(size_t i, const bf16_t* YS, const bf16_t* YR, const bf16_t* PZ, const bf16_t* PGATE, const bf16_t* Gb, const f16_t* R16, const f16_t* K16, const f16_t* V16, MergeW W, bf16_t* MERGED) {
     if (i >= (size_t)MT) return; const size_t o = i * D;
    float ss = 0.f; for (int c = 0; c < D; ++c) { const float q = bf2f(YS[o + c]) * siluf(bf2f(PZ[o + c])); ss += q * q; }
    const float rs = 1.f / sqrtf(ss / D + NORM_EPS);
    for (int h = 0; h < H_RWKV; ++h) { float m = 0.f, bonus = 0.f;
        for (int k = 0; k < HK; ++k) { const int c = h * HK + k; m += bf2f(YR[o + c]); bonus += (float)R16[o + c] * (float)K16[o + c] * W.r_k[c]; }
        m /= HK; float var = 0.f; for (int k = 0; k < HK; ++k) { const float d = bf2f(YR[o + h * HK + k]) - m; var += d * d; } var /= HK;
        const float rstd = 1.f / sqrtf(var + RWKV_LN_EPS);
        for (int k = 0; k < HK; ++k) { const int c = h * HK + k;
            const float yssd = bf2f(YS[o + c]) * siluf(bf2f(PZ[o + c])) * rs * W.ssd_norm_w[c];
            const float yrn = (bf2f(YR[o + c]) - m) * rstd * W.ln_w[c] + W.ln_b[c];
            const float yrw = (yrn + bonus * (float)V16[o + c]) * bf2f(Gb[o + c]);
            MERGED[o + c] = f2bf(sigmoidf(bf2f(PGATE[i * 2 * D + c])) * yssd + sigmoidf(bf2f(PGATE[i * 2 * D + D + c])) * yrw); } }
}
__device__ __forceinline__ void b_rmsnorm_f2b(size_t i, const float* X, const float* w, bf16_t* out, int nrows) {  if (i >= (size_t)nrows) return;
    const float* xr = X + i * D; float ss = 0.f; for (int c = 0; c < D; ++c) ss += xr[c] * xr[c]; const float rs = 1.f / sqrtf(ss / D + NORM_EPS);
    for (int c = 0; c < D; ++c) out[i * D + c] = f2bf(xr[c] * rs * w[c]); }
__device__ __forceinline__ void b_attn_scores(size_t i, const bf16_t* Q, const float* kp, const float* kc, float* SC) {
     if (i >= (size_t)MT * MEM_HEADS * N_MEM) return;
    const int m = (int)(i % N_MEM), h = (int)((i / N_MEM) % MEM_HEADS), r = (int)(i / (N_MEM * MEM_HEADS)); const RowInfo q = rowinfo(r);
    const float* kr = (q.grp ? kc : kp) + ((size_t)q.b * N_MEM + m) * D + h * MEM_HD; const bf16_t* qr = Q + (size_t)r * D + h * MEM_HD; float acc = 0.f;
    for (int d = 0; d < MEM_HD; ++d) acc += bf2f(qr[d]) * kr[d];
    SC[i] = acc / sqrtf((float)MEM_HD);
}
__device__ __forceinline__ void b_attn_softmax(size_t i, float* SC) {  if (i >= (size_t)MT * MEM_HEADS) return; float* s = SC + i * N_MEM;
    float mx = s[0]; for (int m = 1; m < N_MEM; ++m) mx = fmaxf(mx, s[m]); float sum = 0.f; for (int m = 0; m < N_MEM; ++m) { const float e = expf(s[m] - mx); s[m] = e; sum += e; }
    const float inv = 1.f / sum; for (int m = 0; m < N_MEM; ++m) s[m] *= inv; }
__device__ __forceinline__ void b_attn_av(size_t i, const float* SC, const float* vp, const float* vc, bf16_t* AO) {
     if (i >= (size_t)MT * D) return; const int c = (int)(i % D), r = (int)(i / D), h = c / MEM_HD; const RowInfo q = rowinfo(r);
    const float* vb = (q.grp ? vc : vp) + (size_t)q.b * N_MEM * D + c; const float* s = SC + ((size_t)r * MEM_HEADS + h) * N_MEM; float acc = 0.f;
    for (int m = 0; m < N_MEM; ++m) acc += s[m] * vb[(size_t)m * D];
    AO[i] = f2bf(acc);
}
__device__ __forceinline__ void b_peer_scores(size_t i, const bf16_t* PQ, const float* sub_keys, float* SCP) {
     if (i >= (size_t)MT * PEER_HEADS * 2 * N_KEYS) return;
    const int key = (int)(i % N_KEYS), c = (int)((i / N_KEYS) % 2), h = (int)((i / (2 * N_KEYS)) % PEER_HEADS), r = (int)(i / ((size_t)2 * N_KEYS * PEER_HEADS));
    const bf16_t* q = PQ + (size_t)r * NPQ + h * PEER_DKEY + c * PEER_HALF; const float* kk = sub_keys + (((size_t)h * 2 + c) * N_KEYS + key) * PEER_HALF; float acc = 0.f;
    for (int d = 0; d < PEER_HALF; ++d) acc += bf2f(q[d]) * kk[d];
    SCP[i] = acc;
}
__device__ __forceinline__ void b_peer_topk(size_t i, const float* SCP, float* TS, int* TI, int* IDX, float* GATE) {
     if (i >= (size_t)MT * PEER_HEADS) return;
    float* ts = TS + i * 2 * PEER_TOPK; int* ti = TI + i * 2 * PEER_TOPK;
    for (int c = 0; c < 2; ++c) { const float* s = SCP + (i * 2 + c) * N_KEYS; float pv = INFINITY; int pi = -1;
        for (int j = 0; j < PEER_TOPK; ++j) { float bv = -INFINITY; int bi = -1;
            for (int k = 0; k < N_KEYS; ++k) { const float v = s[k]; const bool after = (v < pv) || (v == pv && k > pi); if (after && (v > bv)) { bv = v; bi = k; } }
            ts[c * PEER_TOPK + j] = bv; ti[c * PEER_TOPK + j] = bi; pv = bv; pi = bi; } }
    float pv = INFINITY; int pi = -1; float* g = GATE + i * PEER_TOPK; int* id = IDX + i * PEER_TOPK;
    for (int j = 0; j < PEER_TOPK; ++j) { float bv = -INFINITY; int bi = -1;
        for (int k = 0; k < PEER_TOPK * PEER_TOPK; ++k) { const float v = ts[k / PEER_TOPK] + ts[PEER_TOPK + k % PEER_TOPK]; const bool after = (v < pv) || (v == pv && k > pi); if (after && (v > bv)) { bv = v; bi = k; } }
        g[j] = bv; id[j] = ti[bi / PEER_TOPK] * N_KEYS + ti[PEER_TOPK + bi % PEER_TOPK]; pv = bv; pi = bi; }
    const float mx = g[0]; float sum = 0.f; for (int j = 0; j < PEER_TOPK; ++j) { const float e = expf(g[j] - mx); g[j] = e; sum += e; }
    for (int j = 0; j < PEER_TOPK; ++j) g[j] /= sum;
}
__device__ __forceinline__ void b_peer_act(size_t i, const bf16_t* H3, const float* eu, const int* IDX, const float* GATE, float* COEF) {
     if (i >= (size_t)MT * NSEL) return; const int r = (int)(i / NSEL);
    const float* u = eu + (size_t)IDX[i] * D; const bf16_t* x = H3 + (size_t)r * D; float acc = 0.f;
    for (int d = 0; d < D; ++d) acc += bf2f(x[d]) * u[d];
    COEF[i] = GATE[i] * geluf(acc);
}
__device__ __forceinline__ void b_peer_out(size_t i, float* X2, const float* ev, const int* IDX, const float* COEF) {
     if (i >= (size_t)MT * D) return; const int r = (int)(i / D), c = (int)(i % D); float acc = 0.f;
    for (int j = 0; j < NSEL; ++j) acc += COEF[(size_t)r * NSEL + j] * ev[(size_t)IDX[(size_t)r * NSEL + j] * D + c];
    X2[i] += acc;
}
__device__ __forceinline__ void b_final(size_t i, const float* X, const float* w, float* yp, float* ys) {  if (i >= (size_t)MT) return;
    const float* xr = X + i * D; float ss = 0.f; for (int c = 0; c < D; ++c) ss += xr[c] * xr[c]; const float rs = 1.f / sqrtf(ss / D + NORM_EPS);
    float* o = i < (size_t)MP ? yp + i * D : ys + (i - MP) * D; for (int c = 0; c < D; ++c) o[c] = xr[c] * rs * w[c]; }


__global__ void k_zero_u16(bf16_t* p, size_t n) { b_zero_u16(GTID, p, n); }
__global__ void k_rmsnorm_bf16(const float* x, const float* w, bf16_t* out, int nrows) { b_rmsnorm_bf16(GTID, x, w, out, nrows); }
__global__ void k_wt(const float* W, int K, int ldw, int ncol0, int skip_at, int skip, bf16_t* WT, int N) { b_wt(GTID, W, K, ldw, ncol0, skip_at, skip, WT, N); }
__global__ void k_gemm(const bf16_t* A, int lda, const bf16_t* Bt, int K, int M, int N, int mode, bf16_t* ob, int ldob, float* of, int ldof, const float* base, int ldbase) { b_gemm(GTID, A, lda, Bt, K, M, N, mode, ob, ldob, of, ldof, base, ldbase); }
__global__ void k_conv(const bf16_t* PXBC, const float* state_conv, const float* conv_w, const float* conv_b, bf16_t* XC) { b_conv(GTID, PXBC, state_conv, conv_w, conv_b, XC); }
__global__ void k_convstate(const bf16_t* PXBC, const float* state_conv, float* conv_p, float* conv_s) { b_convstate(GTID, PXBC, state_conv, conv_p, conv_s); }
__global__ void k_copy_or_zero(const float* src, float* dst, size_t n) { b_copy_or_zero(GTID, src, dst, n); }
__global__ void k_ssd(const bf16_t* XC, const float* DT, const float* dt_bias, const float* a_log, const float* d_skip, float* Sp, float* Ss, bf16_t* YS) { b_ssd(GTID, XC, DT, dt_bias, a_log, d_skip, Sp, Ss, YS); }
__global__ void k_rwkv_prep(const bf16_t* PRW, const float* state_shift, RwkvW W, f16_t* R16, f16_t* OMW16, f16_t* K16, f16_t* V16, f16_t* KK16, f16_t* B16, bf16_t* Gb) { b_rwkv_prep(GTID, PRW, state_shift, W, R16, OMW16, K16, V16, KK16, B16, Gb); }
__global__ void k_shiftstate(const bf16_t* PRW, float* sh_p, float* sh_s) { b_shiftstate(GTID, PRW, sh_p, sh_s); }
__global__ void k_rwkv_scan(const f16_t* R16, const f16_t* OMW16, const f16_t* K16, const f16_t* V16, const f16_t* KK16, const f16_t* B16, float* Sp, float* Ss, bf16_t* YR) { b_rwkv_scan(GTID, R16, OMW16, K16, V16, KK16, B16, Sp, Ss, YR); }
__global__ void k_merge(const bf16_t* YS, const bf16_t* YR, const bf16_t* PZ, const bf16_t* PGATE, const bf16_t* Gb, const f16_t* R16, const f16_t* K16, const f16_t* V16, MergeW W, bf16_t* MERGED) { b_merge(GTID, YS, YR, PZ, PGATE, Gb, R16, K16, V16, W, MERGED); }
__global__ void k_rmsnorm_f2b(const float* X, const float* w, bf16_t* out, int nrows) { b_rmsnorm_f2b(GTID, X, w, out, nrows); }
__global__ void k_attn_scores(const bf16_t* Q, const float* kp, const float* kc, float* SC) { b_attn_scores(GTID, Q, kp, kc, SC); }
__global__ void k_attn_softmax(float* SC) { b_attn_softmax(GTID, SC); }
__global__ void k_attn_av(const float* SC, const float* vp, const float* vc, bf16_t* AO) { b_attn_av(GTID, SC, vp, vc, AO); }
__global__ void k_peer_scores(const bf16_t* PQ, const float* sub_keys, float* SCP) { b_peer_scores(GTID, PQ, sub_keys, SCP); }
__global__ void k_peer_topk(const float* SCP, float* TS, int* TI, int* IDX, float* GATE) { b_peer_topk(GTID, SCP, TS, TI, IDX, GATE); }
__global__ void k_peer_act(const bf16_t* H3, const float* eu, const int* IDX, const float* GATE, float* COEF) { b_peer_act(GTID, H3, eu, IDX, GATE, COEF); }
__global__ void k_peer_out(float* X2, const float* ev, const int* IDX, const float* COEF) { b_peer_out(GTID, X2, ev, IDX, COEF); }
__global__ void k_final(const float* X, const float* w, float* yp, float* ys) { b_final(GTID, X, w, yp, ys); }
constexpr size_t al256(size_t x) { return (x + 255) & ~(size_t)255; }
constexpr size_t cmax(size_t a, size_t b) { return a > b ? a : b; }
constexpr size_t O_WT_IN = 0;
constexpr size_t O_WT_DT = O_WT_IN + al256((size_t)NMAIN * D * 2);
constexpr size_t O_WT_OUT = O_WT_DT + al256((size_t)H_SSD * D * 2);
constexpr size_t O_WT_MK = O_WT_OUT + al256((size_t)D * D * 2);
constexpr size_t O_WT_MV = O_WT_MK + al256((size_t)D * D * 2);
constexpr size_t O_WT_MQ = O_WT_MV + al256((size_t)D * D * 2);
constexpr size_t O_WT_MO = O_WT_MQ + al256((size_t)D * D * 2);
constexpr size_t O_WT_PQ = O_WT_MO + al256((size_t)D * D * 2);
constexpr size_t O_HB = O_WT_PQ + al256((size_t)NPQ * D * 2);
constexpr size_t O_MN = O_HB + al256((size_t)MPAD * D * 2);
constexpr size_t O_PZ = O_MN + al256((size_t)NMEMROWS * D * 2);
constexpr size_t O_PXBC = O_PZ + al256((size_t)MPAD * D * 2);
constexpr size_t O_PRW = O_PXBC + al256((size_t)MPAD * CONV_DIM * 2);
constexpr size_t O_PGATE = O_PRW + al256((size_t)MPAD * RWKV_PROJ * 2);
constexpr size_t O_DT = O_PGATE + al256((size_t)MPAD * 2 * D * 2);
constexpr size_t O_XC = O_DT + al256((size_t)MT * H_SSD * 4);
constexpr size_t O_R16 = O_XC + al256(cmax((size_t)MT * CONV_DIM * 2, (size_t)MPAD * D * 2));
constexpr size_t SZ16 = al256((size_t)MT * D * 2);
constexpr size_t O_OMW16 = O_R16 + SZ16, O_K16 = O_OMW16 + SZ16, O_V16 = O_K16 + SZ16, O_KK16 = O_V16 + SZ16, O_B16 = O_KK16 + SZ16;
constexpr size_t O_T1END = O_B16 + SZ16;
constexpr size_t O_CTL = O_T1END;
constexpr size_t CTL_BYTES = 1u << 20;
constexpr size_t O_EU8 = O_CTL + CTL_BYTES;
constexpr size_t O_EV8 = O_EU8 + al256((size_t)N_EXPERTS * D);
constexpr size_t O_ESC = O_EV8 + al256((size_t)N_EXPERTS * D);
constexpr size_t O_KVB = O_ESC + al256((size_t)2 * N_EXPERTS * 4);
constexpr size_t O_SKB = O_KVB + al256((size_t)NMEMROWS * 2 * D * 2);
constexpr size_t O_LW2 = O_SKB + al256((size_t)PEER_HEADS * 2 * N_KEYS * PEER_HALF * 2);
constexpr size_t O_LA2 = O_LW2 + al256((size_t)D * W_RANK * 2);
constexpr size_t O_LG2 = O_LA2 + al256((size_t)D * A_RANK * 2);
constexpr size_t O_BON = O_LG2 + al256((size_t)D * G_RANK * 2);
constexpr size_t O_END = O_BON + al256((size_t)MT * H_RWKV * 4);
constexpr size_t O_GB = O_HB, O_YS = O_R16  , O_MERGED = O_XC, O_X1 = O_PGATE;
constexpr size_t O_H2 = O_PRW, O_QB = O_H2 + al256((size_t)MPAD * D * 2), O_AO = O_QB + al256((size_t)MPAD * D * 2);
static_assert(O_AO + al256((size_t)MPAD * D * 2) <= O_PGATE, "late overlay 1");
static_assert((size_t)MPAD * D * 4 <= (size_t)MPAD * 2 * D * 2, "X1 overlay");
constexpr size_t O_SC = O_XC, O_X2 = O_SC + al256((size_t)MT * MEM_HEADS * N_MEM * 4), O_H3 = O_X2 + al256((size_t)MPAD * D * 4), O_PQ = O_H3 + al256((size_t)MPAD * D * 2);
static_assert(O_PQ + al256((size_t)MPAD * NPQ * 2) <= O_T1END, "late overlay 2");
constexpr size_t O_TS = O_HB, O_TI = O_TS + al256((size_t)MT * PEER_HEADS * 2 * PEER_TOPK * 4);
static_assert(O_TI + al256((size_t)MT * PEER_HEADS * 2 * PEER_TOPK * 4) <= O_PZ, "topk temp overlay");
constexpr size_t O_SCP = O_PZ;
constexpr size_t O_IDX = O_SCP + al256((size_t)MT * PEER_HEADS * 2 * N_KEYS * 4), O_GATE = O_IDX + al256((size_t)MT * NSEL * 4), O_COEF = O_GATE + al256((size_t)MT * NSEL * 4);
static_assert(O_COEF + al256((size_t)MT * NSEL * 4) <= O_PGATE, "SCP/IDX/GATE/COEF overlay");

constexpr size_t OO_YP = 0, OO_YS = OO_YP + (size_t)MP * D, OO_SSMP = OO_YS + (size_t)MS * D, OO_CONVP = OO_SSMP + (size_t)BATCH * H_SSD * P_SSD * N_SSD,
    OO_WKVP = OO_CONVP + (size_t)BATCH * (CONV_K - 1) * CONV_DIM, OO_SHP = OO_WKVP + (size_t)BATCH * H_RWKV * HK * HK, OO_MKP = OO_SHP + (size_t)BATCH * RWKV_PROJ,
    OO_MVP = OO_MKP + (size_t)NMEMROWS * D, OO_SSMS = OO_MVP + (size_t)NMEMROWS * D, OO_CONVS = OO_SSMS + (size_t)DEC_BATCH * H_SSD * P_SSD * N_SSD,
    OO_WKVS = OO_CONVS + (size_t)DEC_BATCH * (CONV_K - 1) * CONV_DIM, OO_SHS = OO_WKVS + (size_t)DEC_BATCH * H_RWKV * HK * HK, OO_END = OO_SHS + (size_t)DEC_BATCH * RWKV_PROJ;
enum InIdx { I_XP = 0, I_XS, I_MEM, I_SSSM, I_SCONV, I_SWKV, I_SSHIFT, I_CK, I_CV, I_NORM_MIX, I_W_IN, I_CONV_W, I_CONV_B, I_DT_BIAS, I_A_LOG, I_D_SKIP, I_SSD_NORM, I_MU, I_W0, I_W2, I_A0, I_A2, I_G2,
    I_K_K, I_K_A, I_R_K, I_LN_W, I_LN_B, I_W_OUT, I_NORM_MEM, I_MEM_NORM, I_W_MK, I_W_MV, I_W_MQ, I_W_MO, I_NORM_FFN, I_W_PQ, I_SUBK, I_EU, I_EV, I_NORM_FINAL, N_INPUTS };

#ifndef HOST_EMU
namespace pg8 {
#define PG8_LAS __attribute__((address_space(3)))
typedef unsigned short bf16_t;
typedef short bf16x8 __attribute__((ext_vector_type(8)));
typedef float f32x4 __attribute__((ext_vector_type(4)));
typedef unsigned u32x4 __attribute__((ext_vector_type(4)));
constexpr int BM = 256, BK = 64, HALF = 128, HTB = HALF * BK * 2  , STAGE_BYTES = 8 * HTB, NXCD = 8, WGM = 8;

__host__ __device__ __forceinline__ int lds_byte(int r, int c) { const int st = (r >> 4) * 2 + (c >> 5), rr = r & 15, cc = c & 31, ob = rr * 64 + cc * 2; return st * 1024 + (ob ^ (((ob >> 9) & 1) << 5)); }
__host__ __device__ __forceinline__ void stage_rc(int b, int& R, int& C) { const int st = b / 1024, sb = b % 1024, swz = sb ^ (((sb >> 9) & 1) << 5); R = (st >> 1) * 16 + swz / 64; C = (st & 1) * 32 + (swz % 64) / 2; }
__host__ __device__ __forceinline__ int perm32(int rho) { const int n = rho >> 4, i = rho & 15; return 8 * (i >> 2) + 4 * n + (i & 3); }

struct Unit { int pm, pn; };
struct Gemm { const bf16_t* A; const bf16_t* Bt; int M, N, K; };

struct StaticOrder {
    int nM, nN, nwg, G, c;
    __host__ __device__ void init(int M, int N, int G_, int c_) { nM = M / BM; nN = N / BM; nwg = nM * nN; G = G_; c = c_; }
    __host__ __device__ bool next(int i, Unit& u) const {
        const long L = (long)i * G + c; if (L >= nwg) return false;
        int wgid = (int)L; { const int q = nwg / NXCD, r = nwg % NXCD, xcd = wgid % NXCD, off = wgid / NXCD; wgid = (xcd < r ? xcd * (q + 1) : r * (q + 1) + (xcd - r) * q) + off; }
        const int nig = WGM * nN, gid = wgid / nig, fm = gid * WGM, gsz = (nM - fm) < WGM ? (nM - fm) : WGM;
        u.pm = fm + ((wgid % nig) % gsz); u.pn = (wgid % nig) / gsz; return true;
    }
    __device__ __forceinline__ void a_ready(const Unit&) const {}
    __device__ __forceinline__ void done(const Unit&) const {}
};

__device__ __forceinline__ unsigned cvt_pk_bf16(float lo, float hi) { unsigned r; asm volatile("v_cvt_pk_bf16_f32 %0, %1, %2" : "=v"(r) : "v"(lo), "v"(hi)); return r; }
typedef float f32x2 __attribute__((ext_vector_type(2)));
template <class Epi, class Sched, bool ALIGN_EPI = false, bool SP2 = false>
__device__ __forceinline__ void gemm_phase(PG8_LAS unsigned char* lds, const Gemm g, const Sched& S, const Epi& E) {
    const int tid = threadIdx.x, wid = __builtin_amdgcn_readfirstlane(tid >> 6), lane = tid & 63, wr = wid >> 2, wc = wid & 3, fr = lane & 15, fq = lane >> 4;
    const int K = g.K, nt = K / BK;
    unsigned voffA[2], voffB[2];
#pragma unroll
    for (int i = 0; i < 2; ++i) { int R, C; stage_rc(tid * 16 + i * 8192, R, C); const int Rb = Epi::PERM ? ((R & ~31) + perm32(R & 31)) : R;
        voffA[i] = (unsigned)(R * K + C) * 2u; voffB[i] = (unsigned)(Rb * K + C) * 2u; }
    const size_t kstep = (size_t)(BK * 2);
    const size_t hstep = (size_t)HALF * K * 2;
    const size_t tstep = 2 * hstep;
    const unsigned ldsw = (unsigned)wid * 1024u;
    const int aoff = lds_byte(wr * 64 + fr, fq * 8), boff = lds_byte(wc * 32 + fr, fq * 8);
#define PG8_SA(b, h) (((b) * 2 + (h)) * HTB)
#define PG8_SB(b, h) ((4 + (b) * 2 + (h)) * HTB)
#define PG8_STAGE(bufoff, gbase, voff) do { _Pragma("unroll") for (int _i = 0; _i < 2; ++_i) \
        __builtin_amdgcn_global_load_lds((const unsigned*)((const char*)(gbase) + (voff)[_i]), (PG8_LAS unsigned*)(lds + (bufoff) + ldsw + _i * 8192), 16, 0, 0); } while (0)
#define PG8_LDA(dst, b, h) do { _Pragma("unroll") for (int m = 0; m < 4; ++m) _Pragma("unroll") for (int k = 0; k < 2; ++k) dst[m][k] = *(const PG8_LAS bf16x8*)(lds + PG8_SA(b, h) + aoff + m * 2048 + k * 1024); } while (0)
#define PG8_LDB(dst, b, h) do { _Pragma("unroll") for (int n = 0; n < 2; ++n) _Pragma("unroll") for (int k = 0; k < 2; ++k) dst[n][k] = *(const PG8_LAS bf16x8*)(lds + PG8_SB(b, h) + boff + n * 2048 + k * 1024); } while (0)
#define PG8_MMA(ai, bj, At, Bt) do { __builtin_amdgcn_s_setprio(1); _Pragma("unroll") for (int m = 0; m < 4; ++m) _Pragma("unroll") for (int n = 0; n < 2; ++n) _Pragma("unroll") for (int k = 0; k < 2; ++k) \
        acc[ai][bj][m][n] = __builtin_amdgcn_mfma_f32_16x16x32_bf16(Bt[n][k], At[m][k], acc[ai][bj][m][n], 0, 0, 0); __builtin_amdgcn_s_setprio(0); } while (0)
#define PG8_WAIT_V(n) asm volatile("s_waitcnt vmcnt(" #n ")" ::: "memory")
#define PG8_WAIT_L(n) asm volatile("s_waitcnt lgkmcnt(" #n ")" ::: "memory")
#define PG8_BAR __builtin_amdgcn_s_barrier()
#define PG8_SCHED __builtin_amdgcn_sched_barrier(0)
    Unit cur, nxt; int ui = 0;
    if (!S.next(0, cur)) return;
    f32x4 acc[2][2][4][2];
#pragma unroll
    for (int a = 0; a < 2; ++a)
#pragma unroll
        for (int b = 0; b < 2; ++b)
#pragma unroll
            for (int m = 0; m < 4; ++m)
#pragma unroll
                for (int n = 0; n < 2; ++n) acc[a][b][m][n] = (f32x4){0.f, 0.f, 0.f, 0.f};
    bf16x8 At[4][2], B0[2][2], B1[2][2];
    const char* cA = (const char*)g.A + (size_t)cur.pm * tstep; const char* cB = (const char*)g.Bt + (size_t)cur.pn * tstep;
    S.a_ready(cur);
    if constexpr (SP2) {
        PG8_STAGE(PG8_SB(0, 0), cB, voffB); PG8_STAGE(PG8_SB(0, 1), cB + hstep, voffB); PG8_STAGE(PG8_SA(0, 0), cA, voffA); PG8_STAGE(PG8_SA(0, 1), cA + hstep, voffA);
        if (wr == 1) PG8_BAR;
        PG8_WAIT_V(2); PG8_BAR;
        PG8_STAGE(PG8_SB(1, 0), cB + kstep, voffB); PG8_STAGE(PG8_SA(1, 0), cA + kstep, voffA); PG8_STAGE(PG8_SB(1, 1), cB + hstep + kstep, voffB);
        PG8_WAIT_V(6); PG8_BAR;
    } else {
        PG8_STAGE(PG8_SB(0, 0), cB, voffB); PG8_STAGE(PG8_SA(0, 0), cA, voffA); PG8_STAGE(PG8_SB(0, 1), cB + hstep, voffB); PG8_STAGE(PG8_SA(0, 1), cA + hstep, voffA);
        if (wr == 1) PG8_BAR;
        PG8_WAIT_V(4); PG8_BAR;
        PG8_STAGE(PG8_SB(1, 0), cB + kstep, voffB); PG8_STAGE(PG8_SA(1, 0), cA + kstep, voffA); PG8_STAGE(PG8_SB(1, 1), cB + hstep + kstep, voffB);
        PG8_WAIT_V(6); PG8_BAR;
    }
    for (;;) {
        const bool has_next = S.next(ui + 1, nxt);
        const char* nA = has_next ? (const char*)g.A + (size_t)nxt.pm * tstep : cA; const char* nB = has_next ? (const char*)g.Bt + (size_t)nxt.pn * tstep : cB;
        for (int t = 0; t < nt; t += 2) {
            const bool last = (t == nt - 2);
            const char* a1 = cA + (size_t)(t + 1) * kstep;
            const char* a2 = last ? nA : cA + (size_t)(t + 2) * kstep; const char* b2 = last ? nB : cB + (size_t)(t + 2) * kstep;
            const char* a3 = a2 + kstep; const char* b3 = b2 + kstep;
            if (last && has_next) S.a_ready(nxt);
            if constexpr (SP2) {
            PG8_LDB(B0, 0, 0); PG8_LDB(B1, 0, 1); PG8_SCHED; PG8_LDA(At, 0, 0); PG8_STAGE(PG8_SA(1, 1), a1 + hstep, voffA);
            PG8_WAIT_V(8); PG8_WAIT_L(0); PG8_BAR; PG8_MMA(0, 0, At, B0); PG8_MMA(0, 1, At, B1); PG8_BAR; PG8_SCHED;
            PG8_LDA(At, 0, 1); PG8_STAGE(PG8_SB(0, 0), b2, voffB); PG8_STAGE(PG8_SB(0, 1), b2 + hstep, voffB); PG8_STAGE(PG8_SA(0, 0), a2, voffA);
            PG8_WAIT_V(8); PG8_WAIT_L(0); PG8_BAR; PG8_MMA(1, 0, At, B0); PG8_MMA(1, 1, At, B1); PG8_BAR; PG8_SCHED;
            PG8_LDB(B0, 1, 0); PG8_LDB(B1, 1, 1); PG8_SCHED; PG8_LDA(At, 1, 0); PG8_STAGE(PG8_SA(0, 1), a2 + hstep, voffA);
            PG8_WAIT_V(8); PG8_WAIT_L(0); PG8_BAR; PG8_MMA(0, 0, At, B0); PG8_MMA(0, 1, At, B1); PG8_BAR; PG8_SCHED;
            PG8_LDA(At, 1, 1); PG8_STAGE(PG8_SB(1, 0), b3, voffB); PG8_STAGE(PG8_SB(1, 1), b3 + hstep, voffB); PG8_STAGE(PG8_SA(1, 0), a3, voffA);
            PG8_WAIT_V(8); PG8_WAIT_L(0); PG8_BAR; PG8_MMA(1, 0, At, B0); PG8_MMA(1, 1, At, B1); PG8_BAR; PG8_SCHED;
            } else {
            PG8_LDB(B0, 0, 0); PG8_SCHED; PG8_LDA(At, 0, 0); PG8_STAGE(PG8_SA(1, 1), a1 + hstep, voffA);
            PG8_WAIT_L(8); PG8_BAR; PG8_WAIT_L(0); PG8_MMA(0, 0, At, B0); PG8_BAR; PG8_SCHED;
            PG8_LDB(B1, 0, 1); PG8_STAGE(PG8_SB(0, 0), b2, voffB);
            PG8_BAR; PG8_WAIT_L(0); PG8_MMA(0, 1, At, B1); PG8_BAR;
            PG8_LDA(At, 0, 1); PG8_STAGE(PG8_SA(0, 0), a2, voffA);
            PG8_BAR; PG8_WAIT_L(0); PG8_MMA(1, 0, At, B0); PG8_BAR; PG8_SCHED;
            PG8_STAGE(PG8_SB(0, 1), b2 + hstep, voffB);
            PG8_WAIT_V(6); PG8_BAR; PG8_MMA(1, 1, At, B1); PG8_BAR;
            PG8_LDB(B0, 1, 0); PG8_SCHED; PG8_LDA(At, 1, 0); PG8_STAGE(PG8_SA(0, 1), a2 + hstep, voffA);
            PG8_WAIT_L(8); PG8_BAR; PG8_WAIT_L(0); PG8_MMA(0, 0, At, B0); PG8_BAR; PG8_SCHED;
            PG8_LDB(B1, 1, 1); PG8_STAGE(PG8_SB(1, 0), b3, voffB);
            PG8_BAR; PG8_WAIT_L(0); PG8_MMA(0, 1, At, B1); PG8_BAR;
            PG8_LDA(At, 1, 1); PG8_STAGE(PG8_SA(1, 0), a3, voffA);
            PG8_BAR; PG8_WAIT_L(0); PG8_MMA(1, 0, At, B0); PG8_BAR; PG8_SCHED;
            PG8_STAGE(PG8_SB(1, 1), b3 + hstep, voffB);
            PG8_WAIT_V(6); PG8_BAR; PG8_MMA(1, 1, At, B1); PG8_BAR;
            }
        }
        if constexpr (ALIGN_EPI) { if (wr == 0) PG8_BAR; }
        if constexpr (!Epi::AFTER_DRAIN) { E(acc, cur, wr, wc, fr, fq); S.done(cur); }
        if (!has_next) break;
#pragma unroll
        for (int a = 0; a < 2; ++a)
#pragma unroll
            for (int b = 0; b < 2; ++b)
#pragma unroll
                for (int m = 0; m < 4; ++m)
#pragma unroll
                    for (int n = 0; n < 2; ++n) acc[a][b][m][n] = (f32x4){0.f, 0.f, 0.f, 0.f};
        cur = nxt; cA = nA; cB = nB; ++ui;
        if constexpr (ALIGN_EPI) { if (wr == 1) PG8_BAR; }
    }
    PG8_WAIT_V(0);
    if constexpr (!ALIGN_EPI) { if (wr == 0) PG8_BAR; }
    PG8_BAR;
    if constexpr (Epi::AFTER_DRAIN) { E.fused(acc, cur, wr, wc, fr, fq, lds, wid, lane); S.done(cur); }
#undef PG8_SA
#undef PG8_SB
#undef PG8_STAGE
#undef PG8_LDA
#undef PG8_LDB
#undef PG8_MMA
#undef PG8_WAIT_V
#undef PG8_WAIT_L
#undef PG8_BAR
#undef PG8_SCHED
}
}

namespace pg8 {
struct EpiProj {
    static constexpr bool PERM = true, AFTER_DRAIN = false;
    bf16_t *PZ, *PXBC, *PRW, *PGATE;
    __device__ __forceinline__ void operator()(const f32x4 (&acc)[2][2][4][2], const Unit& u, int wr, int wc, int fr, int fq) const {
        constexpr int T0 = D / 256, T1 = T0 + CONV_DIM / 256, T2 = T1 + RWKV_PROJ / 256;
        bf16_t* base; int ldc, colt;
        if (u.pn < T0) { base = PZ; ldc = D; colt = u.pn * BM; }
        else if (u.pn < T1) { base = PXBC; ldc = CONV_DIM; colt = (u.pn - T0) * BM; }
        else if (u.pn < T2) { base = PRW; ldc = RWKV_PROJ; colt = (u.pn - T1) * BM; }
        else { base = PGATE; ldc = 2 * D; colt = (u.pn - T2) * BM; }
        const int row0 = u.pm * BM + wr * 64 + fr, col0 = colt + wc * 32 + 8 * fq;
#pragma unroll
        for (int ai = 0; ai < 2; ++ai)
#pragma unroll
            for (int m = 0; m < 4; ++m) { bf16_t* rowp = base + (size_t)(row0 + ai * HALF + m * 16) * ldc + col0;
#pragma unroll
                for (int bj = 0; bj < 2; ++bj) { const f32x4 v0 = acc[ai][bj][m][0], v1 = acc[ai][bj][m][1];
                    u32x4 w; w.x = cvt_pk_bf16(v0[0], v0[1]); w.y = cvt_pk_bf16(v0[2], v0[3]); w.z = cvt_pk_bf16(v1[0], v1[1]); w.w = cvt_pk_bf16(v1[2], v1[3]);
                    *(u32x4*)(rowp + bj * HALF) = w; } }
    }
};
struct EpiB16 {
    static constexpr bool PERM = true, AFTER_DRAIN = false;
    bf16_t* O; int ldc;
    __device__ __forceinline__ void operator()(const f32x4 (&acc)[2][2][4][2], const Unit& u, int wr, int wc, int fr, int fq) const {
        const int row0 = u.pm * BM + wr * 64 + fr, col0 = u.pn * BM + wc * 32 + 8 * fq;
#pragma unroll
        for (int ai = 0; ai < 2; ++ai)
#pragma unroll
            for (int m = 0; m < 4; ++m) { bf16_t* rowp = O + (size_t)(row0 + ai * HALF + m * 16) * ldc + col0;
#pragma unroll
                for (int bj = 0; bj < 2; ++bj) { const f32x4 v0 = acc[ai][bj][m][0], v1 = acc[ai][bj][m][1];
                    u32x4 w; w.x = cvt_pk_bf16(v0[0], v0[1]); w.y = cvt_pk_bf16(v0[2], v0[3]); w.z = cvt_pk_bf16(v1[0], v1[1]); w.w = cvt_pk_bf16(v1[2], v1[3]);
                    *(u32x4*)(rowp + bj * HALF) = w; } }
    }
};
struct EpiKV {
    static constexpr bool PERM = false, AFTER_DRAIN = false;
    float *mk, *mv; bf16_t* kvb;
    __device__ __forceinline__ void operator()(const f32x4 (&acc)[2][2][4][2], const Unit& u, int wr, int wc, int fr, int fq) const {
        const int row0 = u.pm * BM + wr * 64 + fr, col0 = u.pn * BM + wc * 32 + 4 * fq;
        float* ob = col0 < D ? mk : mv; const int colo = col0 < D ? col0 : col0 - D;
#pragma unroll
        for (int ai = 0; ai < 2; ++ai)
#pragma unroll
            for (int m = 0; m < 4; ++m) { const size_t r = (size_t)(row0 + ai * HALF + m * 16);
#pragma unroll
                for (int bj = 0; bj < 2; ++bj)
#pragma unroll
                    for (int n = 0; n < 2; ++n) { const f32x4 v = acc[ai][bj][m][n];
                        *(f32x4*)(ob + r * D + colo + bj * HALF + n * 16) = v;
                        typedef unsigned u32x2 __attribute__((ext_vector_type(2))); u32x2 w; w.x = cvt_pk_bf16(v[0], v[1]); w.y = cvt_pk_bf16(v[2], v[3]);
                        *(u32x2*)(kvb + r * 2 * D + col0 + bj * HALF + n * 16) = w; } }
    }
};
struct EpiRes {
    static constexpr bool PERM = false, AFTER_DRAIN = false;
    const float* base0; const float* base1; int split; float* out; int nrows;
    __device__ __forceinline__ void operator()(const f32x4 (&acc)[2][2][4][2], const Unit& u, int wr, int wc, int fr, int fq) const {
        const int row0 = u.pm * BM + wr * 64 + fr, col0 = u.pn * BM + wc * 32 + 4 * fq;
#pragma unroll
        for (int ai = 0; ai < 2; ++ai)
#pragma unroll
            for (int m = 0; m < 4; ++m) { const int r = row0 + ai * HALF + m * 16; if (r < nrows) {
                const float* bp = r < split ? base0 + (size_t)r * D : base1 + (size_t)(r - split) * D;
#pragma unroll
                for (int bj = 0; bj < 2; ++bj)
#pragma unroll
                    for (int n = 0; n < 2; ++n) { const int c = col0 + bj * HALF + n * 16; *(f32x4*)(out + (size_t)r * D + c) = *(const f32x4*)(bp + c) + acc[ai][bj][m][n]; } } }
    }
};
}

#define GAS __attribute__((address_space(1)))
#define LAS __attribute__((address_space(3)))
typedef unsigned v4u __attribute__((ext_vector_type(4)));
typedef float f32x4 __attribute__((ext_vector_type(4)));
typedef GAS unsigned gu32;
#define RLX_AGENT __ATOMIC_RELAXED, __HIP_MEMORY_SCOPE_AGENT
#define LDS_WAIT() asm volatile("s_waitcnt lgkmcnt(0)" ::: "memory")
#define VM_WAIT() asm volatile("s_waitcnt vmcnt(0)" ::: "memory")
#define XB_TMO      128
#define XB_XCNT(j)  (256  + 64 * (j))
#define XB_XSUB(j)  (1280 + 64 * (j))
#define XB_XGEN(j)  (2304 + 64 * (j))
#define XB_TOP      3328
#define XB_TOPGEN   3392
#define XCD_BAR_WORDS 3456
#define XB_SPIN_CAP (1u << 30)

__device__ __forceinline__ unsigned xb_ld(unsigned* p)              { return __hip_atomic_load(p, __ATOMIC_RELAXED, __HIP_MEMORY_SCOPE_AGENT); }
__device__ __forceinline__ unsigned xb_add(unsigned* p, unsigned v) { return __hip_atomic_fetch_add(p, v, __ATOMIC_RELAXED, __HIP_MEMORY_SCOPE_AGENT); }
__device__ __forceinline__ unsigned xb_xcc_id() { return (unsigned)__builtin_amdgcn_s_getreg((3 << 11) | 20) & 0xFu; }
#define XB_SPIN(cond, bar) do { unsigned _sp = 0; while (cond) { __builtin_amdgcn_s_sleep(1); \
    if ((++_sp & 255u) == 0u) { if (xb_ld(&(bar)[XB_TMO])) break; if (_sp > XB_SPIN_CAP) { atomicAdd(&(bar)[XB_TMO], 1u); break; } } } } while (0)

struct XcdBarrier {
    unsigned* bar; unsigned x;
    volatile LAS unsigned* st;
};

__device__ __forceinline__ XcdBarrier xcd_barrier_post(unsigned* bar, volatile LAS unsigned* st) {
    XcdBarrier b; b.bar = bar; b.x = xb_xcc_id(); b.st = st;
    if (threadIdx.x == 0) (void)xb_add(&bar[XB_XCNT(b.x)], 1u);
    return b;
}
__device__ __forceinline__ void xcd_barrier_complete(unsigned* bar, unsigned x, unsigned& nloc, unsigned& nx) {
    const unsigned G = gridDim.x * gridDim.y * gridDim.z;
    unsigned sum, cnt, mine, sp = 0u;
    for (;;) {
        sum = 0u; cnt = 0u; mine = 0u;
#pragma unroll
        for (unsigned j = 0; j < 16; ++j) { const unsigned c = xb_ld(&bar[XB_XCNT(j)]); sum += c; cnt += (c > 0u) ? 1u : 0u; mine = (j == x) ? c : mine; }
        if (sum == G) break;
        __builtin_amdgcn_s_sleep(1);
        if ((++sp & 255u) == 0u) { if (xb_ld(&bar[XB_TMO])) break; if (sp > XB_SPIN_CAP) { atomicAdd(&bar[XB_TMO], 1u); break; } }
    }
    nloc = mine > 0u ? mine : 1u; nx = cnt > 0u ? cnt : 1u;
}

__device__ __forceinline__ void xcd_barrier(const XcdBarrier& b) {
    asm volatile("s_waitcnt vmcnt(0)" ::: "memory");
    __syncthreads();
    if (threadIdx.x == 0) {
        unsigned* bar = b.bar;
        __builtin_amdgcn_s_waitcnt(0);
        unsigned nloc = b.st[0], nx = b.st[1];
        if (nloc == 0u) { xcd_barrier_complete(bar, b.x, nloc, nx); b.st[0] = nloc; b.st[1] = nx; }
        const unsigned old = xb_add(&bar[XB_XSUB(b.x)], 1u);
        const unsigned gen = old / nloc;
        if (old + 1u == (gen + 1u) * nloc) {
            __builtin_amdgcn_fence(__ATOMIC_RELEASE, "agent");
            asm volatile("s_waitcnt vmcnt(0)" ::: "memory");
            const unsigned og = xb_add(&bar[XB_TOP], 1u);
            const unsigned tg = og / nx;
            if (og + 1u == (tg + 1u) * nx) xb_add(&bar[XB_TOPGEN], 1u);
            else XB_SPIN(xb_ld(&bar[XB_TOPGEN]) == tg, bar);
            __builtin_amdgcn_fence(__ATOMIC_ACQUIRE, "agent");
            xb_add(&bar[XB_XGEN(b.x)], 1u);
            asm volatile("s_waitcnt vmcnt(0)" ::: "memory");
        } else {
            XB_SPIN(xb_ld(&bar[XB_XGEN(b.x)]) == gen, bar);
            __builtin_amdgcn_fence(__ATOMIC_ACQUIRE, "agent");
            asm volatile("s_waitcnt vmcnt(0)" ::: "memory");
        }
    }
    __syncthreads();
}


constexpr int NWAVES = 8, NTHREADS = NWAVES * 64;
constexpr int LDS_BYTES = 163840, LDSCTL_OFF = LDS_BYTES - 1024;
constexpr int CW_BAR = 4096;

enum Phase { PH_PREP = 0, PH_INPROJ, PH_MIXA, PH_SCAN, PH_MERGE, PH_OUT, PH_NORM2, PH_Q, PH_ATT1, PH_ATT2, PH_ATT3, PH_O, PH_NORM3, PH_PQ, PH_PK1, PH_PK2, PH_PEER, N_PHASES };
constexpr int MAX_LAUNCHES = 16;
#define GS_LOOP(n, call) do { for (size_t i_ = (size_t)bx * NTHREADS + tid; i_ < (size_t)(n); i_ += (size_t)G * NTHREADS) { call; } } while (0)

__device__ __forceinline__ unsigned pk2(float lo, float hi) { return (unsigned)f2bf(lo) | ((unsigned)f2bf(hi) << 16); }
__device__ __forceinline__ float wave_sum(float v) {
#pragma unroll
    for (int o = 1; o < 64; o <<= 1) v += __shfl_xor(v, o);
    return v;
}
__device__ __forceinline__ float wave_max(float v) {
#pragma unroll
    for (int o = 1; o < 64; o <<= 1) v = fmaxf(v, __shfl_xor(v, o));
    return v;
}

struct MkArgs { const float* in[N_INPUTS]; float* out; unsigned char* ws; int ph_lo, ph_hi, bar_idx, pad; };
static_assert((CW_BAR + MAX_LAUNCHES * XCD_BAR_WORDS) * 4 <= (int)CTL_BYTES, "ctl");

__device__ __forceinline__ void p0_transpose_item(const float* W, int K, int ldw, int srccol0, bf16_t* WT, int row0, LAS float* scr, int kb, int lane) {
    const int k0 = 64 * kb;
#pragma unroll 8
    for (int i = 0; i < 32; ++i) { const int kk = 2 * i + (lane >> 5); scr[kk * 33 + (lane & 31)] = W[(size_t)(k0 + kk) * ldw + srccol0 + (lane & 31)]; }
    LDS_WAIT(); asm volatile("" ::: "memory");
    const int c = lane & 7;
#pragma unroll
    for (int j = 0; j < 4; ++j) { const int n = (lane >> 3) + 8 * j; const LAS float* s = scr + (8 * c) * 33 + n;
        v4u o; o.x = pk2(s[0 * 33], s[1 * 33]); o.y = pk2(s[2 * 33], s[3 * 33]); o.z = pk2(s[4 * 33], s[5 * 33]); o.w = pk2(s[6 * 33], s[7 * 33]);
        *(v4u*)(WT + (size_t)(row0 + n) * K + k0 + 8 * c) = o; }
    LDS_WAIT(); asm volatile("" ::: "memory");
}
template <bool WITH_DT>
__device__ __forceinline__ void norm_row(const float* xrow, const float* w, bf16_t* orow, const float* w_in, float* dtrow, int lane) {
    static_assert(D == 1024, "norm_row is written for D = 1024");
    const f32x4* xr = (const f32x4*)xrow + lane; const f32x4* wr4 = (const f32x4*)w + lane;
    f32x4 v[4]; float s = 0.f;
#pragma unroll
    for (int j = 0; j < 4; ++j) { v[j] = xr[64 * j]; s += (v[j].x * v[j].x + v[j].y * v[j].y) + (v[j].z * v[j].z + v[j].w * v[j].w); }
    const float rs = 1.f / sqrtf(wave_sum(s) * (1.f / D) + NORM_EPS);
    unsigned long long* o8 = (unsigned long long*)orow + lane;
#pragma unroll
    for (int j = 0; j < 4; ++j) { v[j] = v[j] * rs * wr4[64 * j]; o8[64 * j] = (unsigned long long)pk2(v[j].x, v[j].y) | ((unsigned long long)pk2(v[j].z, v[j].w) << 32); }
    if constexpr (WITH_DT) {
        static_assert(H_SSD == 16, "dt path is written for 16 heads");
        f32x4 acc[4] = {{0.f, 0.f, 0.f, 0.f}, {0.f, 0.f, 0.f, 0.f}, {0.f, 0.f, 0.f, 0.f}, {0.f, 0.f, 0.f, 0.f}};
#pragma unroll
        for (int j = 0; j < 4; ++j)
#pragma unroll
            for (int i = 0; i < 4; ++i) { const int k = 4 * (64 * j + lane) + i; const f32x4* wp = (const f32x4*)(w_in + (size_t)k * D_IN + D + CONV_DIM); const float h = v[j][i];
#pragma unroll
                for (int q = 0; q < 4; ++q) acc[q] += wp[q] * h; }
        float mine = 0.f;
#pragma unroll
        for (int q = 0; q < 4; ++q)
#pragma unroll
            for (int e = 0; e < 4; ++e) { const float t = wave_sum(acc[q][e]); if (lane == 4 * q + e) mine = t; }
        if (lane < 16) dtrow[lane] = mine;
    }
}
__device__ __forceinline__ void fp8_row(const float* src, unsigned char* dst, float* inv, int lane) {
    static_assert(D == 1024, "fp8_row is written for D = 1024");
    const f32x4* s4 = (const f32x4*)src + 4 * lane; f32x4 v[4]; float am = 0.f;
#pragma unroll
    for (int j = 0; j < 4; ++j) { v[j] = s4[j]; am = fmaxf(am, fmaxf(fmaxf(fabsf(v[j].x), fabsf(v[j].y)), fmaxf(fabsf(v[j].z), fabsf(v[j].w)))); }
    am = wave_max(am); const float sc = am > 0.f ? 224.f / am : 1.f;
    v4u o;
#pragma unroll
    for (int j = 0; j < 4; ++j) { int p = __builtin_amdgcn_cvt_pk_fp8_f32(v[j].x * sc, v[j].y * sc, 0, false); p = __builtin_amdgcn_cvt_pk_fp8_f32(v[j].z * sc, v[j].w * sc, p, true); o[j] = (unsigned)p; }
    *((v4u*)dst + lane) = o;
    if (lane == 0) *inv = am > 0.f ? am / 224.f : 1.f;
}

typedef float f32x2v __attribute__((ext_vector_type(2)));
#define FP8X4_FMA_DOT(accv, w, xb) do { const f32x2v lo_ = __builtin_amdgcn_cvt_pk_f32_fp8((int)(w), false), hi_ = __builtin_amdgcn_cvt_pk_f32_fp8((int)(w), true); \
    accv = fmaf(lo_.x, x[(xb)], accv); accv = fmaf(lo_.y, x[(xb) + 1], accv); accv = fmaf(hi_.x, x[(xb) + 2], accv); accv = fmaf(hi_.y, x[(xb) + 3], accv); } while (0)
#define FP8X4_AXPY(w, c, ob) do { const f32x2v lo_ = __builtin_amdgcn_cvt_pk_f32_fp8((int)(w), false), hi_ = __builtin_amdgcn_cvt_pk_f32_fp8((int)(w), true); \
    acc[(ob)] = fmaf(lo_.x, (c), acc[(ob)]); acc[(ob) + 1] = fmaf(lo_.y, (c), acc[(ob) + 1]); acc[(ob) + 2] = fmaf(hi_.x, (c), acc[(ob) + 2]); acc[(ob) + 3] = fmaf(hi_.y, (c), acc[(ob) + 3]); } while (0)
__device__ __forceinline__ void peer_token(int t, const bf16_t* H3, const int* IDX, const float* GATE, const unsigned char* EU8, const unsigned char* EV8, const float* ESC,
                                           const float* X2, const float* wfin, float* yout, int lane) {
    static_assert(D == 1024 && PEER_TOPK == 16 && PEER_HEADS == 8, "peer_token is written for D = 1024, 8 heads x 16 experts");
    float x[16], acc[16];
    { const v4u a = *((const v4u*)(H3 + (size_t)t * D) + 2 * lane), b = *((const v4u*)(H3 + (size_t)t * D) + 2 * lane + 1);
#pragma unroll
      for (int j = 0; j < 4; ++j) { x[2 * j] = __uint_as_float(a[j] << 16); x[2 * j + 1] = __uint_as_float(a[j] & 0xffff0000u); x[8 + 2 * j] = __uint_as_float(b[j] << 16); x[8 + 2 * j + 1] = __uint_as_float(b[j] & 0xffff0000u); } }
#pragma unroll
    for (int j = 0; j < 16; ++j) acc[j] = 0.f;
    const int idx_lo = IDX[(size_t)t * NSEL + lane], idx_hi = IDX[(size_t)t * NSEL + 64 + lane];
    const float gate_lo = GATE[(size_t)t * NSEL + lane], gate_hi = GATE[(size_t)t * NSEL + 64 + lane];
    const int me = (lane >> 2) & 15;
    v4u B0[8], B1[8];
#define PEER_ROW(tab, hh, e) ((const v4u*)((tab) + (size_t)(unsigned)__builtin_amdgcn_readlane((hh) < 4 ? idx_lo : idx_hi, ((hh) & 3) * 16 + (e)) * D) + lane)
#pragma unroll
    for (int e = 0; e < 8; ++e) B0[e] = *PEER_ROW(EU8, 0, e);
#pragma unroll 1
    for (int h = 0; h < PEER_HEADS; ++h) {
        float p[16];
#pragma unroll
        for (int e = 0; e < 8; ++e) B1[e] = *PEER_ROW(EU8, h, 8 + e);
#pragma unroll
        for (int e = 0; e < 8; ++e) { float a = 0.f; FP8X4_FMA_DOT(a, B0[e][0], 0); FP8X4_FMA_DOT(a, B0[e][1], 4); FP8X4_FMA_DOT(a, B0[e][2], 8); FP8X4_FMA_DOT(a, B0[e][3], 12); p[e] = a; }
#pragma unroll
        for (int e = 0; e < 8; ++e) B0[e] = *PEER_ROW(EV8, h, e);
#pragma unroll
        for (int e = 0; e < 8; ++e) { float a = 0.f; FP8X4_FMA_DOT(a, B1[e][0], 0); FP8X4_FMA_DOT(a, B1[e][1], 4); FP8X4_FMA_DOT(a, B1[e][2], 8); FP8X4_FMA_DOT(a, B1[e][3], 12); p[8 + e] = a; }
#pragma unroll
        for (int e = 0; e < 8; ++e) B1[e] = *PEER_ROW(EV8, h, 8 + e);
#pragma unroll
        for (int i = 0; i < 8; ++i) { const bool up = lane & 32; const float keep = up ? p[i + 8] : p[i], send = up ? p[i] : p[i + 8]; p[i] = keep + __shfl_xor(send, 32); }
#pragma unroll
        for (int i = 0; i < 4; ++i) { const bool up = lane & 16; const float keep = up ? p[i + 4] : p[i], send = up ? p[i] : p[i + 4]; p[i] = keep + __shfl_xor(send, 16); }
#pragma unroll
        for (int i = 0; i < 2; ++i) { const bool up = lane & 8; const float keep = up ? p[i + 2] : p[i], send = up ? p[i] : p[i + 2]; p[i] = keep + __shfl_xor(send, 8); }
        { const bool up = lane & 4; const float keep = up ? p[1] : p[0], send = up ? p[0] : p[1]; p[0] = keep + __shfl_xor(send, 4); }
        p[0] += __shfl_xor(p[0], 1); p[0] += __shfl_xor(p[0], 2);
        const int src = (h & 3) * 16 + me;
        const int myidx = __shfl(h < 4 ? idx_lo : idx_hi, src); const float gt = __shfl(h < 4 ? gate_lo : gate_hi, src);
        const float su = ESC[myidx], sv = ESC[N_EXPERTS + myidx];
        const float coef = gt * geluf(p[0] * su) * sv;
#pragma unroll
        for (int e = 0; e < 8; ++e) { const float c = __uint_as_float(__builtin_amdgcn_readlane(__float_as_uint(coef), 4 * e));
            FP8X4_AXPY(B0[e][0], c, 0); FP8X4_AXPY(B0[e][1], c, 4); FP8X4_AXPY(B0[e][2], c, 8); FP8X4_AXPY(B0[e][3], c, 12); }
        if (h + 1 < PEER_HEADS) {
#pragma unroll
            for (int e = 0; e < 8; ++e) B0[e] = *PEER_ROW(EU8, h + 1, e);
        }
#pragma unroll
        for (int e = 0; e < 8; ++e) { const float c = __uint_as_float(__builtin_amdgcn_readlane(__float_as_uint(coef), 32 + 4 * e));
            FP8X4_AXPY(B1[e][0], c, 0); FP8X4_AXPY(B1[e][1], c, 4); FP8X4_AXPY(B1[e][2], c, 8); FP8X4_AXPY(B1[e][3], c, 12); }
    }
#undef PEER_ROW
    const f32x4* x2 = (const f32x4*)(X2 + (size_t)t * D) + 4 * lane; const f32x4* wf = (const f32x4*)wfin + 4 * lane; f32x4 r[4]; float ss = 0.f;
#pragma unroll
    for (int j = 0; j < 4; ++j) { r[j] = x2[j]; r[j].x += acc[4 * j]; r[j].y += acc[4 * j + 1]; r[j].z += acc[4 * j + 2]; r[j].w += acc[4 * j + 3]; ss += (r[j].x * r[j].x + r[j].y * r[j].y) + (r[j].z * r[j].z + r[j].w * r[j].w); }
    const float rs = 1.f / sqrtf(wave_sum(ss) * (1.f / D) + NORM_EPS);
    f32x4* yo = (f32x4*)yout + 4 * lane;
#pragma unroll
    for (int j = 0; j < 4; ++j) yo[j] = r[j] * rs * wf[j];
}

__device__ __forceinline__ float fmix_lo(float a, unsigned pk, float c) { float d; asm("v_fma_mix_f32 %0, %1, %2, %3 op_sel_hi:[0,1,0]" : "=v"(d) : "v"(a), "v"(pk), "v"(c)); return d; }
__device__ __forceinline__ float fmix_hi(float a, unsigned pk, float c) { float d; asm("v_fma_mix_f32 %0, %1, %2, %3 op_sel:[0,1,0] op_sel_hi:[0,1,0]" : "=v"(d) : "v"(a), "v"(pk), "v"(c)); return d; }
__device__ __forceinline__ float rowsum16(float v) {
    v += __builtin_bit_cast(float, __builtin_amdgcn_update_dpp(0, __builtin_bit_cast(int, v), 0xB1, 0xF, 0xF, true));
    v += __builtin_bit_cast(float, __builtin_amdgcn_update_dpp(0, __builtin_bit_cast(int, v), 0x4E, 0xF, 0xF, true));
    v += __builtin_bit_cast(float, __builtin_amdgcn_update_dpp(0, __builtin_bit_cast(int, v), 0x141, 0xF, 0xF, true));
    v += __builtin_bit_cast(float, __builtin_amdgcn_update_dpp(0, __builtin_bit_cast(int, v), 0x140, 0xF, 0xF, true));
    return v;
}
__device__ __forceinline__ unsigned pkh2(float lo, float hi) { typedef _Float16 h2 __attribute__((ext_vector_type(2))); h2 v; v.x = (_Float16)lo; v.y = (_Float16)hi; return __builtin_bit_cast(unsigned, v); }
__device__ __forceinline__ float fsigmoid(float x) { return __builtin_amdgcn_rcpf(1.f + __expf(-x)); }
namespace rw {
constexpr int CH = 64;
constexpr int L_W2H = 0, L_A2H = 9216, L_CST = 18432, L_MU = 19712, L_OMW = 20992, L_KK = 29184, L_BB = 37376, L_KH = 45568, L_RR = 53760, L_VV = 61952, L_YO = 66048,
              L_AW = 70144, L_AA = 79360, L_RAW = 88576, L_END = L_RAW + (CH + 1) * 640;
static_assert(L_END <= LDSCTL_OFF, "rwkv LDS map");
constexpr int NPIECE = (CH + 1) * 40;
}
typedef unsigned u32x2 __attribute__((ext_vector_type(2)));
struct RwkvIn { const bf16_t* PRW; const bf16_t* LW2; const bf16_t* LA2; const float *mu, *w0, *a0, *k_k, *k_a, *r_k; bf16_t* YR; float* BON; float* state_out; };

__device__ __forceinline__ void rwkv_scan_unit(LAS unsigned char* lds, const RwkvIn& I, int b, int h, int half, int tid) {
    using namespace rw;
    static_assert(D == 1024 && HK == 64 && W_RANK == 64 && A_RANK == 64 && SEQ % CH == 0, "rwkv_scan_unit shapes");
    const int lane = tid & 63, w = tid >> 6, kg = lane & 15, r = 4 * w + (lane >> 4);
    const int segcol[5] = {h * HK, D + h * HK, 2 * D + h * HK, 3 * D, 3 * D + W_RANK};
    { const int row = tid >> 3, pc = tid & 7;
      *(v4u*)(lds + L_W2H + row * 144 + pc * 16) = *(const v4u*)(I.LW2 + (size_t)(h * HK + row) * W_RANK + pc * 8);
      *(v4u*)(lds + L_A2H + row * 144 + pc * 16) = *(const v4u*)(I.LA2 + (size_t)(h * HK + row) * A_RANK + pc * 8); }
    if (tid < 320) { const int s = tid >> 6, c = tid & 63; const int gc = (s == 0 ? h * HK : s == 1 ? D + h * HK : s == 2 ? 2 * D + h * HK : s == 3 ? 3 * D : 3 * D + W_RANK) + c;
        ((LAS float*)(lds + L_MU))[tid] = I.mu[gc];
        const float* src = s == 0 ? I.w0 : s == 1 ? I.a0 : s == 2 ? I.k_k : s == 3 ? I.k_a : I.r_k;
        ((LAS float*)(lds + L_CST))[tid] = src[h * HK + c]; }
    float S[4] = {0.f, 0.f, 0.f, 0.f};
    v4u G[6];
    const size_t row0 = (size_t)b * SEQ;
    auto issue_loads = [&](int c) {
#pragma unroll
        for (int i = 0; i < 6; ++i) { const int pid = tid + 512 * i; v4u z = {0u, 0u, 0u, 0u}; G[i] = z;
            if (pid < NPIECE) { const int rr = pid / 40, sp = pid % 40, sg = sp >> 3, pc = sp & 7; const int t = c * CH + rr - 1;
                const int col = (sg == 0 ? h * HK : sg == 1 ? D + h * HK : sg == 2 ? 2 * D + h * HK : sg == 3 ? 3 * D : 3 * D + W_RANK) + pc * 8;
                if (t >= 0) G[i] = *(const v4u*)(I.PRW + (row0 + t) * RWKV_PROJ + col); } }
    };
    (void)segcol;
    issue_loads(0);
    __syncthreads();
    for (int c = 0; c <= SEQ / CH; ++c) {
        if (c > 0) {
            const LAS unsigned char* pO = lds + L_OMW + kg * 8; const LAS _Float16* pV = (const LAS _Float16*)(lds + L_VV) + r;
            LAS bf16_t* pY = (LAS bf16_t*)(lds + L_YO) + r;
#pragma unroll 2
            for (int t = 0; t < CH; ++t) {
                const u32x2 no = *(const LAS u32x2*)(pO + t * 128), kk = *(const LAS u32x2*)(pO + (L_KK - L_OMW) + t * 128), nb = *(const LAS u32x2*)(pO + (L_BB - L_OMW) + t * 128),
                            kh = *(const LAS u32x2*)(pO + (L_KH - L_OMW) + t * 128), rr = *(const LAS u32x2*)(pO + (L_RR - L_OMW) + t * 128);
                const float vv = (float)pV[t * 32];
                float sa = fmix_lo(S[0], kk.x, 0.f); sa = fmix_hi(S[1], kk.x, sa); sa = fmix_lo(S[2], kk.y, sa); sa = fmix_hi(S[3], kk.y, sa);
                sa = rowsum16(sa);
                S[0] = fmix_lo(S[0], no.x, S[0]); S[1] = fmix_hi(S[1], no.x, S[1]); S[2] = fmix_lo(S[2], no.y, S[2]); S[3] = fmix_hi(S[3], no.y, S[3]);
                S[0] = fmix_lo(sa, nb.x, S[0]); S[1] = fmix_hi(sa, nb.x, S[1]); S[2] = fmix_lo(sa, nb.y, S[2]); S[3] = fmix_hi(sa, nb.y, S[3]);
                S[0] = fmix_lo(vv, kh.x, S[0]); S[1] = fmix_hi(vv, kh.x, S[1]); S[2] = fmix_lo(vv, kh.y, S[2]); S[3] = fmix_hi(vv, kh.y, S[3]);
                float y = fmix_lo(S[0], rr.x, 0.f); y = fmix_hi(S[1], rr.x, y); y = fmix_lo(S[2], rr.y, y); y = fmix_hi(S[3], rr.y, y);
                y = rowsum16(y);
                if (kg == 0) pY[t * 32] = f2bf(y);
            }
            __syncthreads();
            if (tid < 256) { const int t = tid >> 2, pc = tid & 3;
                *(v4u*)(I.YR + (row0 + (size_t)(c - 1) * CH + t) * D + h * HK + half * 32 + pc * 8) = *(const LAS v4u*)(lds + L_YO + t * 64 + pc * 16); }
        }
        if (c == SEQ / CH) break;
#pragma unroll
        for (int i = 0; i < 6; ++i) { const int pid = tid + 512 * i; if (pid < NPIECE) { const int rr_ = pid / 40, sp = pid % 40; *(LAS v4u*)(lds + L_RAW + rr_ * 640 + sp * 16) = G[i]; } }
        __syncthreads();
        if (c + 1 < SEQ / CH) issue_loads(c + 1);
#pragma unroll 2
        for (int it = 0; it < 10; ++it) { const int e = tid + 512 * it;
            const int t = e / 80, c4 = e % 80, col = c4 * 4, sg = col >> 6, cc = col & 63;
            const u32x2 cur = *(const LAS u32x2*)(lds + L_RAW + (t + 1) * 640 + col * 2), prv = *(const LAS u32x2*)(lds + L_RAW + t * 640 + col * 2);
            const f32x4 m4 = *(const LAS f32x4*)(lds + L_MU + col * 4);
            float x[4];
            { const float c0 = __uint_as_float(cur.x << 16), c1 = __uint_as_float(cur.x & 0xffff0000u), c2 = __uint_as_float(cur.y << 16), c3 = __uint_as_float(cur.y & 0xffff0000u);
              const float p0 = __uint_as_float(prv.x << 16), p1 = __uint_as_float(prv.x & 0xffff0000u), p2 = __uint_as_float(prv.y << 16), p3 = __uint_as_float(prv.y & 0xffff0000u);
              x[0] = c0 + (p0 - c0) * m4.x; x[1] = c1 + (p1 - c1) * m4.y; x[2] = c2 + (p2 - c2) * m4.z; x[3] = c3 + (p3 - c3) * m4.w; }
            if (sg == 0) { u32x2 o; o.x = pkh2(x[0], x[1]); o.y = pkh2(x[2], x[3]); *(LAS u32x2*)(lds + L_RR + t * 128 + cc * 2) = o; }
            else if (sg == 1) { u32x2 o; o.x = pkh2(x[0], x[1]); o.y = pkh2(x[2], x[3]); *(LAS u32x2*)(lds + L_KH + t * 128 + cc * 2) = o; }
            else if (sg == 2) { if ((cc >> 5) == half) { u32x2 o; o.x = pkh2(x[0], x[1]); o.y = pkh2(x[2], x[3]); *(LAS u32x2*)(lds + L_VV + t * 64 + (cc & 31) * 2) = o; } }
            else if (sg == 3) { u32x2 o;
#pragma unroll
                for (int j = 0; j < 4; ++j) x[j] = 1.f - 2.f * __builtin_amdgcn_rcpf(__expf(2.f * x[j]) + 1.f);
                o.x = pk2(x[0], x[1]); o.y = pk2(x[2], x[3]); *(LAS u32x2*)(lds + L_AW + t * 144 + cc * 2) = o; }
            else { u32x2 o; o.x = pk2(x[0], x[1]); o.y = pk2(x[2], x[3]); *(LAS u32x2*)(lds + L_AA + t * 144 + cc * 2) = o; }
        }
        __syncthreads();
        { const int role = w >> 2, tt = w & 3, fr = lane & 15, fq = lane >> 4;
          const LAS unsigned char* Aimg = lds + (role ? L_AA : L_AW); const LAS unsigned char* Wimg = lds + (role ? L_A2H : L_W2H);
          pg8::f32x4 acc[4];
#pragma unroll
          for (int nt = 0; nt < 4; ++nt) { acc[nt] = (pg8::f32x4){0.f, 0.f, 0.f, 0.f};
#pragma unroll
              for (int ks = 0; ks < 2; ++ks) { const pg8::bf16x8 af = *(const LAS pg8::bf16x8*)(Aimg + (tt * 16 + fr) * 144 + ks * 64 + fq * 16), bfr = *(const LAS pg8::bf16x8*)(Wimg + (nt * 16 + fr) * 144 + ks * 64 + fq * 16);
                  acc[nt] = __builtin_amdgcn_mfma_f32_16x16x32_bf16(af, bfr, acc[nt], 0, 0, 0); } }
          const LAS float* cst = (const LAS float*)(lds + L_CST);
          if (role == 0) {
#pragma unroll
              for (int nt = 0; nt < 4; ++nt) { const int ch = nt * 16 + fr; const float w0 = cst[ch];
#pragma unroll
                  for (int g = 0; g < 4; ++g) { const int t = tt * 16 + fq * 4 + g; const float e = 0.6065306597f * fsigmoid(w0 + acc[nt][g]); const float omw = 1.f - __expf(-e);
                      ((LAS _Float16*)(lds + L_OMW))[t * 64 + ch] = (_Float16)(-omw); } }
          } else {
              float kkr[4][4], ag[4][4], ss[4] = {0.f, 0.f, 0.f, 0.f}, bon[4] = {0.f, 0.f, 0.f, 0.f};
#pragma unroll
              for (int nt = 0; nt < 4; ++nt) { const int ch = nt * 16 + fr; const float a0 = cst[64 + ch], kk_ = cst[128 + ch], ka = cst[192 + ch], rk = cst[256 + ch];
#pragma unroll
                  for (int g = 0; g < 4; ++g) { const int t = tt * 16 + fq * 4 + g; const float a = fsigmoid(a0 + acc[nt][g]); const float k = (float)((LAS _Float16*)(lds + L_KH))[t * 64 + ch];
                      const float kh = k * (1.f + (a - 1.f) * ka), kq = k * kk_; ag[nt][g] = a; kkr[nt][g] = kq; ss[g] += kq * kq;
                      bon[g] += (float)((LAS _Float16*)(lds + L_RR))[t * 64 + ch] * kh * rk;
                      ((LAS _Float16*)(lds + L_KH))[t * 64 + ch] = (_Float16)kh; } }
#pragma unroll
              for (int g = 0; g < 4; ++g) { ss[g] = rowsum16(ss[g]); bon[g] = rowsum16(bon[g]); const float inv = 1.f / sqrtf(fmaxf(ss[g], 1e-24f)); const int t = tt * 16 + fq * 4 + g;
#pragma unroll
                  for (int nt = 0; nt < 4; ++nt) { const int ch = nt * 16 + fr; const float kk = kkr[nt][g] * inv; ((LAS _Float16*)(lds + L_KK))[t * 64 + ch] = (_Float16)kk; ((LAS _Float16*)(lds + L_BB))[t * 64 + ch] = (_Float16)(-kk * ag[nt][g]); }
                  if (fr == 0 && half == 0) I.BON[(row0 + (size_t)c * CH + t) * H_RWKV + h] = bon[g]; }
          } }
        __syncthreads();
    }
    *(f32x4*)(I.state_out + (((size_t)b * H_RWKV + h) * HK + half * 32 + r) * HK + kg * 4) = (f32x4){S[0], S[1], S[2], S[3]};
    __syncthreads();
}

struct RwkvSIn { const bf16_t* PRW; const float* state_shift; const float* state_wkv; const float *mu, *w0, *w2, *a0, *a2, *k_k, *k_a, *r_k; bf16_t* YR; float* BON; float* state_out; };
__device__ __forceinline__ void rwkv_sample_unit(const RwkvSIn& I, int s, int h, int lane) {
    static_assert(HK == 64 && W_RANK == 64 && A_RANK == 64, "rwkv_sample_unit shapes");
    const size_t row = (size_t)MP + s; const bf16_t* cur = I.PRW + row * RWKV_PROJ; const float* prv = I.state_shift + (size_t)s * RWKV_PROJ;
    auto lerp = [&](int col) { const float c = bf2f(cur[col]); return c + (prv[col] - c) * I.mu[col]; };
    const int ch = h * HK + lane;
    const float rr = lerp(ch), kx = lerp(D + ch), vx = lerp(2 * D + ch);
    const float twl = tanhf(lerp(3 * D + lane)), al = lerp(3 * D + W_RANK + lane);
    float dw = 0.f, da = 0.f;
#pragma unroll 8
    for (int j = 0; j < 64; ++j) { const float tj = __uint_as_float(__builtin_amdgcn_readlane(__float_as_uint(twl), j)), aj = __uint_as_float(__builtin_amdgcn_readlane(__float_as_uint(al), j));
        dw = fmaf(tj, I.w2[(size_t)j * D + ch], dw); da = fmaf(aj, I.a2[(size_t)j * D + ch], da); }
    const float e = 0.6065306597f * sigmoidf(I.w0[ch] + dw), omw = -expm1f(-e), ag = sigmoidf(I.a0[ch] + da);
    const float kh = kx * (1.f + (ag - 1.f) * I.k_a[ch]), kq = kx * I.k_k[ch];
    const float kk = kq / sqrtf(fmaxf(wave_sum(kq * kq), 1e-24f)), nb = -kk * ag;
    const float bon = wave_sum(rr * kh * I.r_k[ch]);
    if (lane == 0) I.BON[row * H_RWKV + h] = bon;
    const float* Sg = I.state_wkv + (((size_t)s * H_RWKV + h) * HK + lane) * HK; float* So = I.state_out + (((size_t)s * H_RWKV + h) * HK + lane) * HK;
    f32x4 S[16];
#pragma unroll
    for (int q = 0; q < 16; ++q) S[q] = *((const f32x4*)Sg + q);
    float sa = 0.f;
#pragma unroll
    for (int k = 0; k < 64; ++k) sa = fmaf(S[k >> 2][k & 3], __uint_as_float(__builtin_amdgcn_readlane(__float_as_uint(kk), k)), sa);
    float y = 0.f;
#pragma unroll
    for (int k = 0; k < 64; ++k) { float x = S[k >> 2][k & 3];
        x = fmaf(-x, __uint_as_float(__builtin_amdgcn_readlane(__float_as_uint(omw), k)), x);
        x = fmaf(sa, __uint_as_float(__builtin_amdgcn_readlane(__float_as_uint(nb), k)), x);
        x = fmaf(vx, __uint_as_float(__builtin_amdgcn_readlane(__float_as_uint(kh), k)), x);
        S[k >> 2][k & 3] = x; y = fmaf(x, __uint_as_float(__builtin_amdgcn_readlane(__float_as_uint(rr), k)), y); }
#pragma unroll
    for (int q = 0; q < 16; ++q) *((f32x4*)So + q) = S[q];
    I.YR[row * D + ch] = f2bf(y);
}

namespace mg {
constexpr int L_SG = 0;
constexpr int L_G = 8192;
constexpr int L_END = L_G + 16 * D * 4;
static_assert(L_END <= LDSCTL_OFF, "merge LDS map");
}
struct MergeIn { const bf16_t *YS, *YR, *PZ, *PGATE, *PRW, *LG2; const float *BON, *state_shift, *mu, *ssd_norm_w, *ln_w, *ln_b; bf16_t* MERGED; };
__device__ __forceinline__ void merge_unit(LAS unsigned char* lds, const MergeIn& I, int t0, int tid) {
    using namespace mg;
    static_assert(D == 1024 && G_RANK == 128 && HK == 64, "merge_unit shapes");
    const int lane = tid & 63, w = tid >> 6;
    { const int t = tid >> 5, j0 = (tid & 31) * 4; const int row = t0 + t; u32x2 o; o.x = 0u; o.y = 0u;
      if (row < MT) { const RowInfo q = rowinfo(row); const int col = 3 * D + W_RANK + A_RANK + j0; float x[4];
          const u32x2 cur = *(const u32x2*)(I.PRW + (size_t)row * RWKV_PROJ + col);
          float p[4];
          if (q.t > 0) { const u32x2 pv = *(const u32x2*)(I.PRW + (size_t)(row - 1) * RWKV_PROJ + col); p[0] = __uint_as_float(pv.x << 16); p[1] = __uint_as_float(pv.x & 0xffff0000u); p[2] = __uint_as_float(pv.y << 16); p[3] = __uint_as_float(pv.y & 0xffff0000u); }
          else if (q.grp) { const f32x4 pv = *(const f32x4*)(I.state_shift + (size_t)q.b * RWKV_PROJ + col); p[0] = pv.x; p[1] = pv.y; p[2] = pv.z; p[3] = pv.w; }
          else { p[0] = p[1] = p[2] = p[3] = 0.f; }
          const f32x4 m4 = *(const f32x4*)(I.mu + col);
          const float c0 = __uint_as_float(cur.x << 16), c1 = __uint_as_float(cur.x & 0xffff0000u), c2 = __uint_as_float(cur.y << 16), c3 = __uint_as_float(cur.y & 0xffff0000u);
          x[0] = fsigmoid(c0 + (p[0] - c0) * m4.x); x[1] = fsigmoid(c1 + (p[1] - c1) * m4.y); x[2] = fsigmoid(c2 + (p[2] - c2) * m4.z); x[3] = fsigmoid(c3 + (p[3] - c3) * m4.w);
          o.x = pk2(x[0], x[1]); o.y = pk2(x[2], x[3]); }
      *(LAS u32x2*)(lds + L_SG + t * 272 + j0 * 2) = o; }
    __syncthreads();
    { const int fr = lane & 15, fq = lane >> 4; pg8::bf16x8 af[4];
#pragma unroll
      for (int ks = 0; ks < 4; ++ks) af[ks] = *(const LAS pg8::bf16x8*)(lds + L_SG + fr * 272 + ks * 64 + fq * 16);
#pragma unroll 2
      for (int nt = 0; nt < 8; ++nt) { const int ch = w * 128 + nt * 16 + fr; pg8::f32x4 acc = {0.f, 0.f, 0.f, 0.f};
#pragma unroll
          for (int ks = 0; ks < 4; ++ks) { const pg8::bf16x8 bfr = *(const pg8::bf16x8*)(I.LG2 + (size_t)ch * G_RANK + ks * 32 + fq * 8); acc = __builtin_amdgcn_mfma_f32_16x16x32_bf16(af[ks], bfr, acc, 0, 0, 0); }
#pragma unroll
          for (int g = 0; g < 4; ++g) ((LAS float*)(lds + L_G))[(fq * 4 + g) * D + ch] = acc[g]; } }
    __syncthreads();
#pragma unroll 1
    for (int tt = 0; tt < 2; ++tt) { const int t = 2 * w + tt, row = t0 + t; if (row >= MT) break;
        const RowInfo q = rowinfo(row); const int c0 = 16 * lane;
        float ys[16], yr[16], zz[16];
        { const v4u a = *((const v4u*)(I.YS + (size_t)row * D) + 2 * lane), b = *((const v4u*)(I.YS + (size_t)row * D) + 2 * lane + 1);
          const v4u c = *((const v4u*)(I.PZ + (size_t)row * D) + 2 * lane), d = *((const v4u*)(I.PZ + (size_t)row * D) + 2 * lane + 1);
          const v4u e = *((const v4u*)(I.YR + (size_t)row * D) + 2 * lane), f = *((const v4u*)(I.YR + (size_t)row * D) + 2 * lane + 1);
#pragma unroll
          for (int j = 0; j < 4; ++j) { ys[2 * j] = __uint_as_float(a[j] << 16); ys[2 * j + 1] = __uint_as_float(a[j] & 0xffff0000u); ys[8 + 2 * j] = __uint_as_float(b[j] << 16); ys[8 + 2 * j + 1] = __uint_as_float(b[j] & 0xffff0000u);
              zz[2 * j] = __uint_as_float(c[j] << 16); zz[2 * j + 1] = __uint_as_float(c[j] & 0xffff0000u); zz[8 + 2 * j] = __uint_as_float(d[j] << 16); zz[8 + 2 * j + 1] = __uint_as_float(d[j] & 0xffff0000u);
              yr[2 * j] = __uint_as_float(e[j] << 16); yr[2 * j + 1] = __uint_as_float(e[j] & 0xffff0000u); yr[8 + 2 * j] = __uint_as_float(f[j] << 16); yr[8 + 2 * j + 1] = __uint_as_float(f[j] & 0xffff0000u); } }
        float ss = 0.f, sm = 0.f;
#pragma unroll
        for (int j = 0; j < 16; ++j) { ys[j] = ys[j] * zz[j] * fsigmoid(zz[j]); ss += ys[j] * ys[j]; sm += yr[j]; }
        const float rs = 1.f / sqrtf(wave_sum(ss) * (1.f / D) + NORM_EPS);
        sm += __shfl_xor(sm, 1); sm += __shfl_xor(sm, 2); const float mean = sm * (1.f / HK);
        float sv = 0.f;
#pragma unroll
        for (int j = 0; j < 16; ++j) { yr[j] -= mean; sv += yr[j] * yr[j]; }
        sv += __shfl_xor(sv, 1); sv += __shfl_xor(sv, 2); const float rstd = 1.f / sqrtf(sv * (1.f / HK) + RWKV_LN_EPS);
        const float bon = I.BON[(size_t)row * H_RWKV + (lane >> 2)];
        float vv[16], gs[16], gr[16];
        { const v4u a = *((const v4u*)(I.PRW + (size_t)row * RWKV_PROJ + 2 * D) + 2 * lane), b = *((const v4u*)(I.PRW + (size_t)row * RWKV_PROJ + 2 * D) + 2 * lane + 1);
#pragma unroll
          for (int j = 0; j < 4; ++j) { vv[2 * j] = __uint_as_float(a[j] << 16); vv[2 * j + 1] = __uint_as_float(a[j] & 0xffff0000u); vv[8 + 2 * j] = __uint_as_float(b[j] << 16); vv[8 + 2 * j + 1] = __uint_as_float(b[j] & 0xffff0000u); }
          float pv[16];
          if (q.t > 0) { const v4u pa = *((const v4u*)(I.PRW + (size_t)(row - 1) * RWKV_PROJ + 2 * D) + 2 * lane), pb = *((const v4u*)(I.PRW + (size_t)(row - 1) * RWKV_PROJ + 2 * D) + 2 * lane + 1);
#pragma unroll
              for (int j = 0; j < 4; ++j) { pv[2 * j] = __uint_as_float(pa[j] << 16); pv[2 * j + 1] = __uint_as_float(pa[j] & 0xffff0000u); pv[8 + 2 * j] = __uint_as_float(pb[j] << 16); pv[8 + 2 * j + 1] = __uint_as_float(pb[j] & 0xffff0000u); } }
          else if (q.grp) {
#pragma unroll
              for (int j = 0; j < 4; ++j) { const f32x4 x = *((const f32x4*)(I.state_shift + (size_t)q.b * RWKV_PROJ + 2 * D + c0) + j); pv[4 * j] = x.x; pv[4 * j + 1] = x.y; pv[4 * j + 2] = x.z; pv[4 * j + 3] = x.w; } }
          else {
#pragma unroll
              for (int j = 0; j < 16; ++j) pv[j] = 0.f; }
#pragma unroll
          for (int j = 0; j < 4; ++j) { const f32x4 m = *((const f32x4*)(I.mu + 2 * D + c0) + j);
              vv[4 * j] += (pv[4 * j] - vv[4 * j]) * m.x; vv[4 * j + 1] += (pv[4 * j + 1] - vv[4 * j + 1]) * m.y; vv[4 * j + 2] += (pv[4 * j + 2] - vv[4 * j + 2]) * m.z; vv[4 * j + 3] += (pv[4 * j + 3] - vv[4 * j + 3]) * m.w; }
          const v4u ga = *((const v4u*)(I.PGATE + (size_t)row * 2 * D) + 2 * lane), gb = *((const v4u*)(I.PGATE + (size_t)row * 2 * D) + 2 * lane + 1);
          const v4u ha = *((const v4u*)(I.PGATE + (size_t)row * 2 * D + D) + 2 * lane), hb = *((const v4u*)(I.PGATE + (size_t)row * 2 * D + D) + 2 * lane + 1);
#pragma unroll
          for (int j = 0; j < 4; ++j) { gs[2 * j] = __uint_as_float(ga[j] << 16); gs[2 * j + 1] = __uint_as_float(ga[j] & 0xffff0000u); gs[8 + 2 * j] = __uint_as_float(gb[j] << 16); gs[8 + 2 * j + 1] = __uint_as_float(gb[j] & 0xffff0000u);
              gr[2 * j] = __uint_as_float(ha[j] << 16); gr[2 * j + 1] = __uint_as_float(ha[j] & 0xffff0000u); gr[8 + 2 * j] = __uint_as_float(hb[j] << 16); gr[8 + 2 * j + 1] = __uint_as_float(hb[j] & 0xffff0000u); } }
        v4u o0, o1; float outv[16];
#pragma unroll
        for (int j = 0; j < 4; ++j) { const f32x4 gq = *((const LAS f32x4*)(lds + L_G + t * D * 4) + 4 * lane + j); const f32x4 nw = *((const f32x4*)(I.ssd_norm_w + c0) + j), lw = *((const f32x4*)(I.ln_w + c0) + j), lb = *((const f32x4*)(I.ln_b + c0) + j);
#pragma unroll
            for (int e = 0; e < 4; ++e) { const int k = 4 * j + e; const float yssd = ys[k] * rs * nw[e]; const float yrw = (yr[k] * rstd * lw[e] + lb[e] + bon * vv[k]) * gq[e];
                outv[k] = fsigmoid(gs[k]) * yssd + fsigmoid(gr[k]) * yrw; } }
#pragma unroll
        for (int j = 0; j < 4; ++j) { o0[j] = pk2(outv[2 * j], outv[2 * j + 1]); o1[j] = pk2(outv[8 + 2 * j], outv[8 + 2 * j + 1]); }
        *((v4u*)(I.MERGED + (size_t)row * D) + 2 * lane) = o0; *((v4u*)(I.MERGED + (size_t)row * D) + 2 * lane + 1) = o1;
    }
    __syncthreads();
}

namespace sd {
constexpr int STR = 272;
constexpr int L_C = 0, L_B = 34816, L_BTW = 69632, L_XT = 104448, L_SB = 121856, L_ACS = 139264, L_DTV = L_ACS + 512, L_END = L_DTV + 512;
static_assert(L_END <= LDSCTL_OFF, "ssd LDS map");
constexpr int CL = 128;
}
struct SsdIn { const bf16_t* PXBC; const float *DT, *conv_w, *conv_b, *dt_bias, *a_log, *d_skip; bf16_t* YS; float* state_out; };
__device__ __forceinline__ void bf8_unpack(const v4u& v, float (&x)[8]) {
#pragma unroll
    for (int j = 0; j < 4; ++j) { x[2 * j] = __uint_as_float(v[j] << 16); x[2 * j + 1] = __uint_as_float(v[j] & 0xffff0000u); }
}
__device__ __forceinline__ float fsilu(float x) { return x * fsigmoid(x); }
__device__ __forceinline__ void ssd_prompt_unit(LAS unsigned char* lds, const SsdIn& I, int b, int h, int tid) {
    using namespace sd;
    static_assert(D == 1024 && P_SSD == 64 && N_SSD == 128 && G_SSD == 2 && H_SSD == 16 && SEQ % CL == 0 && CONV_K == 4, "ssd_prompt_unit shapes");
    const int lane = tid & 63, w = tid >> 6, fr = lane & 15, fq = lane >> 4, g = h / (H_SSD / G_SSD);
    const float ah = -__expf(I.a_log[h]), dbias = I.dt_bias[h], dskip = I.d_skip[h];
    const int pc = tid % 40, tseg = tid / 40; const bool conv_on = tid < 480;
    const int kind = pc < 8 ? 0 : pc < 24 ? 1 : 2, loc0 = kind == 0 ? pc * 8 : kind == 1 ? (pc - 8) * 8 : (pc - 24) * 8;
    const int gch = kind == 0 ? h * P_SSD + loc0 : kind == 1 ? D + g * N_SSD + loc0 : D + G_SSD * N_SSD + g * N_SSD + loc0;
    float cw[4][8], cb[8];
#pragma unroll
    for (int i = 0; i < 4; ++i) { const f32x4 a = *(const f32x4*)(I.conv_w + (size_t)i * CONV_DIM + gch), c = *(const f32x4*)(I.conv_w + (size_t)i * CONV_DIM + gch + 4);
        cw[i][0] = a.x; cw[i][1] = a.y; cw[i][2] = a.z; cw[i][3] = a.w; cw[i][4] = c.x; cw[i][5] = c.y; cw[i][6] = c.z; cw[i][7] = c.w; }
    { const f32x4 a = *(const f32x4*)(I.conv_b + gch), c = *(const f32x4*)(I.conv_b + gch + 4); cb[0] = a.x; cb[1] = a.y; cb[2] = a.z; cb[3] = a.w; cb[4] = c.x; cb[5] = c.y; cb[6] = c.z; cb[7] = c.w; }
    pg8::f32x4 S[4];
#pragma unroll
    for (int nt = 0; nt < 4; ++nt) S[nt] = (pg8::f32x4){0.f, 0.f, 0.f, 0.f};
    for (int i = tid; i < 64 * STR / 16; i += NTHREADS) *(LAS v4u*)(lds + L_SB + i * 16) = (v4u){0u, 0u, 0u, 0u};
    const size_t row0 = (size_t)b * SEQ;
    LAS float* acs = (LAS float*)(lds + L_ACS); LAS float* dtv = (LAS float*)(lds + L_DTV);
#pragma unroll 1
    for (int c = 0; c < SEQ / CL; ++c) {
        const size_t rowc = row0 + (size_t)c * CL;
        if (tid < CL) { const float dt = softplusf(I.DT[(rowc + tid) * H_SSD + h] + dbias); dtv[tid] = dt; acs[tid] = dt * ah; }
        __syncthreads();
        if (w == 0) { const float a0 = acs[2 * lane], a1 = acs[2 * lane + 1]; float sc = a0 + a1;
#pragma unroll
            for (int o = 1; o < 64; o <<= 1) { const float t = __shfl_up(sc, o); if (lane >= o) sc += t; }
            acs[2 * lane] = sc - a1; acs[2 * lane + 1] = sc; }
        __syncthreads();
        const float acs_last = acs[CL - 1];
        if (conv_on) { const int ts = tseg * 11, te = ts + 11 < CL ? ts + 11 : CL;
            v4u W0, W1, W2; const v4u z = {0u, 0u, 0u, 0u};
            { const long q0 = (long)c * CL + ts - 3; W0 = q0 >= 0 ? *(const v4u*)(I.PXBC + (row0 + q0) * CONV_DIM + gch) : z; W1 = q0 + 1 >= 0 ? *(const v4u*)(I.PXBC + (row0 + q0 + 1) * CONV_DIM + gch) : z; W2 = q0 + 2 >= 0 ? *(const v4u*)(I.PXBC + (row0 + q0 + 2) * CONV_DIM + gch) : z; }
#pragma unroll 1
            for (int t = ts; t < te; ++t) { const v4u W3 = *(const v4u*)(I.PXBC + (rowc + t) * CONV_DIM + gch);
                float x0[8], x1[8], x2[8], x3[8], o[8]; bf8_unpack(W0, x0); bf8_unpack(W1, x1); bf8_unpack(W2, x2); bf8_unpack(W3, x3);
#pragma unroll
                for (int j = 0; j < 8; ++j) o[j] = fsilu(cb[j] + cw[0][j] * x0[j] + cw[1][j] * x1[j] + cw[2][j] * x2[j] + cw[3][j] * x3[j]);
                if (kind == 0) {
#pragma unroll
                    for (int j = 0; j < 8; ++j) *(LAS bf16_t*)(lds + L_XT + (loc0 + j) * STR + t * 2) = f2bf(o[j]);
                } else if (kind == 1) { v4u pk; pk.x = pk2(o[0], o[1]); pk.y = pk2(o[2], o[3]); pk.z = pk2(o[4], o[5]); pk.w = pk2(o[6], o[7]); *(LAS v4u*)(lds + L_B + t * STR + loc0 * 2) = pk;
                    const float wt = __expf(acs_last - acs[t]) * dtv[t];
#pragma unroll
                    for (int j = 0; j < 8; ++j) *(LAS bf16_t*)(lds + L_BTW + (loc0 + j) * STR + t * 2) = f2bf(o[j] * wt);
                } else { v4u pk; pk.x = pk2(o[0], o[1]); pk.y = pk2(o[2], o[3]); pk.z = pk2(o[4], o[5]); pk.w = pk2(o[6], o[7]); *(LAS v4u*)(lds + L_C + t * STR + loc0 * 2) = pk; }
                W0 = W1; W1 = W2; W2 = W3; } }
        __syncthreads();
        pg8::bf16x8 Cf[4];
#pragma unroll
        for (int ks = 0; ks < 4; ++ks) Cf[ks] = *(const LAS pg8::bf16x8*)(lds + L_C + (16 * w + fr) * STR + ks * 64 + fq * 16);
        pg8::f32x4 cbacc[8];
#pragma unroll
        for (int jt = 0; jt < 8; ++jt) { cbacc[jt] = (pg8::f32x4){0.f, 0.f, 0.f, 0.f};
#pragma unroll
            for (int ks = 0; ks < 4; ++ks) { const pg8::bf16x8 bf_ = *(const LAS pg8::bf16x8*)(lds + L_B + (16 * jt + fr) * STR + ks * 64 + fq * 16); cbacc[jt] = __builtin_amdgcn_mfma_f32_16x16x32_bf16(bf_, Cf[ks], cbacc[jt], 0, 0, 0); } }
        __syncthreads();
        { const int i = 16 * w + fr; const float ai = acs[i];
#pragma unroll
          for (int jt = 0; jt < 8; ++jt) { const int j0 = 16 * jt + 4 * fq; const f32x4 aj = *(const LAS f32x4*)(lds + L_ACS + j0 * 4), dj = *(const LAS f32x4*)(lds + L_DTV + j0 * 4); float gv[4];
#pragma unroll
              for (int e = 0; e < 4; ++e) gv[e] = (j0 + e <= i) ? cbacc[jt][e] * __expf(ai - aj[e]) * dj[e] : 0.f;
              u32x2 o; o.x = pk2(gv[0], gv[1]); o.y = pk2(gv[2], gv[3]); *(LAS u32x2*)(lds + L_B + i * STR + j0 * 2) = o; } }
        __syncthreads();
        { pg8::bf16x8 Gf[4];
#pragma unroll
          for (int ks = 0; ks < 4; ++ks) Gf[ks] = *(const LAS pg8::bf16x8*)(lds + L_B + (16 * w + fr) * STR + ks * 64 + fq * 16);
          const int i = 16 * w + fr; const float ei = __expf(acs[i]);
#pragma unroll
          for (int pt = 0; pt < 4; ++pt) { pg8::f32x4 ay = {0.f, 0.f, 0.f, 0.f}, ao = {0.f, 0.f, 0.f, 0.f};
#pragma unroll
              for (int ks = 0; ks < 4; ++ks) { const pg8::bf16x8 xf = *(const LAS pg8::bf16x8*)(lds + L_XT + (16 * pt + fr) * STR + ks * 64 + fq * 16), sf = *(const LAS pg8::bf16x8*)(lds + L_SB + (16 * pt + fr) * STR + ks * 64 + fq * 16);
                  ay = __builtin_amdgcn_mfma_f32_16x16x32_bf16(xf, Gf[ks], ay, 0, 0, 0); ao = __builtin_amdgcn_mfma_f32_16x16x32_bf16(sf, Cf[ks], ao, 0, 0, 0); }
              float yv[4];
#pragma unroll
              for (int e = 0; e < 4; ++e) { const int p = 16 * pt + 4 * fq + e; yv[e] = ay[e] + ei * ao[e] + dskip * bf2f(*(const LAS bf16_t*)(lds + L_XT + p * STR + i * 2)); }
              u32x2 o; o.x = pk2(yv[0], yv[1]); o.y = pk2(yv[2], yv[3]); *(u32x2*)(I.YS + (rowc + i) * D + h * P_SSD + 16 * pt + 4 * fq) = o; } }
        { pg8::bf16x8 Xf[4];
#pragma unroll
          for (int ks = 0; ks < 4; ++ks) Xf[ks] = *(const LAS pg8::bf16x8*)(lds + L_XT + (16 * (w & 3) + fr) * STR + ks * 64 + fq * 16);
          const float dec = __expf(acs_last);
#pragma unroll
          for (int nt = 0; nt < 4; ++nt) { pg8::f32x4 as_ = {0.f, 0.f, 0.f, 0.f};
#pragma unroll
              for (int ks = 0; ks < 4; ++ks) { const pg8::bf16x8 bf_ = *(const LAS pg8::bf16x8*)(lds + L_BTW + (64 * (w >> 2) + 16 * nt + fr) * STR + ks * 64 + fq * 16); as_ = __builtin_amdgcn_mfma_f32_16x16x32_bf16(bf_, Xf[ks], as_, 0, 0, 0); }
              S[nt] = S[nt] * dec + as_; } }
        __syncthreads();
#pragma unroll
        for (int nt = 0; nt < 4; ++nt) { u32x2 o; o.x = pk2(S[nt][0], S[nt][1]); o.y = pk2(S[nt][2], S[nt][3]); *(LAS u32x2*)(lds + L_SB + (16 * (w & 3) + fr) * STR + (64 * (w >> 2) + 16 * nt + 4 * fq) * 2) = o; }
    }
#pragma unroll
    for (int nt = 0; nt < 4; ++nt) *(f32x4*)(I.state_out + (((size_t)b * H_SSD + h) * P_SSD + 16 * (w & 3) + fr) * N_SSD + 64 * (w >> 2) + 16 * nt + 4 * fq) = (f32x4){S[nt][0], S[nt][1], S[nt][2], S[nt][3]};
    __syncthreads();
}
struct SsdSIn { const bf16_t* PXBC; const float *state_conv, *state_ssm, *DT, *conv_w, *conv_b, *dt_bias, *a_log, *d_skip; bf16_t* YS; float* state_out; };
__device__ __forceinline__ void ssd_sample_unit(const SsdSIn& I, int s, int h, int lane) {
    static_assert(P_SSD == 64 && N_SSD == 128 && CONV_K == 4, "ssd_sample_unit shapes");
    const size_t row = (size_t)MP + s; const int g = h / (H_SSD / G_SSD);
    auto conv1 = [&](int ch) { float a = I.conv_b[ch];
#pragma unroll
        for (int i = 0; i < 3; ++i) a = fmaf(I.conv_w[(size_t)i * CONV_DIM + ch], I.state_conv[((size_t)s * 3 + i) * CONV_DIM + ch], a);
        a = fmaf(I.conv_w[(size_t)3 * CONV_DIM + ch], bf2f(I.PXBC[row * CONV_DIM + ch]), a); return siluf(a); };
    const float x = conv1(h * P_SSD + lane);
    const float b0 = conv1(D + g * N_SSD + lane), b1 = conv1(D + g * N_SSD + 64 + lane), c0 = conv1(D + G_SSD * N_SSD + g * N_SSD + lane), c1 = conv1(D + G_SSD * N_SSD + g * N_SSD + 64 + lane);
    const float dt = softplusf(I.DT[row * H_SSD + h] + I.dt_bias[h]), dA = expf(dt * -expf(I.a_log[h])), dtx = dt * x;
    const float* Sg = I.state_ssm + (((size_t)s * H_SSD + h) * P_SSD + lane) * N_SSD; float* So = I.state_out + (((size_t)s * H_SSD + h) * P_SSD + lane) * N_SSD;
    float y = 0.f;
#pragma unroll
    for (int q = 0; q < 32; ++q) { f32x4 v = *((const f32x4*)Sg + q);
#pragma unroll
        for (int e = 0; e < 4; ++e) { const int n = 4 * q + e; const float bn = __uint_as_float(__builtin_amdgcn_readlane(__float_as_uint(n < 64 ? b0 : b1), n & 63)), cn = __uint_as_float(__builtin_amdgcn_readlane(__float_as_uint(n < 64 ? c0 : c1), n & 63));
            const float sv = fmaf(v[e], dA, dtx * bn); v[e] = sv; y = fmaf(cn, sv, y); }
        *((f32x4*)So + q) = v; }
    I.YS[row * D + h * P_SSD + lane] = f2bf(y + I.d_skip[h] * x);
}

__global__ void __launch_bounds__(NTHREADS, 2) mk_fwd(MkArgs args) {
    extern __shared__ __attribute__((aligned(16))) unsigned char lds_raw[];
    LAS unsigned char* lds = (LAS unsigned char*)lds_raw;
    volatile LAS unsigned* MISC = (volatile LAS unsigned*)(lds + LDSCTL_OFF);
    const int tid = threadIdx.x, lane = tid & 63, wave = __builtin_amdgcn_readfirstlane(tid >> 6);
    const int G = gridDim.x, bx = blockIdx.x, vcu = (G % 8 == 0) ? (bx % 8) * (G / 8) + bx / 8 : bx;
    unsigned char* ws = args.ws; float* out = args.out;
    for (int u = tid; u < (LDS_BYTES - LDSCTL_OFF) / 4; u += NTHREADS) ((LAS unsigned*)(lds + LDSCTL_OFF))[u] = 0u;
    __syncthreads();
    XcdBarrier bar = xcd_barrier_post((unsigned*)(ws + O_CTL) + CW_BAR + args.bar_idx * XCD_BAR_WORDS, MISC + 8);
    const int lo = args.ph_lo, hi = args.ph_hi;
#define IN_PH(k) (lo <= (k) && (k) < hi)
#define SEAM(k) do { if (IN_PH(k) && IN_PH((k) + 1)) xcd_barrier(bar); } while (0)
    bf16_t* WT_in = (bf16_t*)(ws + O_WT_IN); bf16_t* Hb = (bf16_t*)(ws + O_HB); bf16_t* MN = (bf16_t*)(ws + O_MN);
    const int gw = vcu * NWAVES + wave, NGW = G * NWAVES;

    if (IN_PH(PH_PREP)) {
        LAS float* scr = (LAS float*)(lds + wave * 16384);
        constexpr int KB = D / 64;
        constexpr int I_IN = (NMAIN / 32) * KB, I_SQ = (D / 32) * KB, I_PQ = (NPQ / 32) * KB, I_L64 = D / 32, I_L128 = (D / 32) * 2;
        constexpr int NITEMS = I_IN + 5 * I_SQ + I_PQ + 2 * I_L64 + I_L128;
        static_assert(W_RANK == 64 && A_RANK == 64 && G_RANK == 128 && (D + CONV_DIM) % 32 == 0, "P0 item shapes");
        for (int it = gw; it < NITEMS; it += NGW) {
            int r = it;
            if (r < I_IN) { const int kb = r / (NMAIN / 32), nb = r % (NMAIN / 32), n0 = 32 * nb; p0_transpose_item(args.in[I_W_IN], D, D_IN, n0 + (n0 >= D + CONV_DIM ? H_SSD : 0), WT_in, n0, scr, kb, lane); continue; } r -= I_IN;
            if (r < 5 * I_SQ) { const int wsel = r / I_SQ; r %= I_SQ; const int kb = r / (D / 32), nb = r % (D / 32);
                const float* W = args.in[wsel == 0 ? I_W_OUT : wsel == 1 ? I_W_MK : wsel == 2 ? I_W_MV : wsel == 3 ? I_W_MQ : I_W_MO];
                bf16_t* WT = (bf16_t*)(ws + (wsel == 0 ? O_WT_OUT : wsel == 1 ? O_WT_MK : wsel == 2 ? O_WT_MV : wsel == 3 ? O_WT_MQ : O_WT_MO));
                p0_transpose_item(W, D, D, 32 * nb, WT, 32 * nb, scr, kb, lane); continue; } r -= 5 * I_SQ;
            if (r < I_PQ) { const int kb = r / (NPQ / 32), nb = r % (NPQ / 32); p0_transpose_item(args.in[I_W_PQ], D, NPQ, 32 * nb, (bf16_t*)(ws + O_WT_PQ), 32 * nb, scr, kb, lane); continue; } r -= I_PQ;
            if (r < I_L64) { p0_transpose_item(args.in[I_W2], W_RANK, D, 32 * r, (bf16_t*)(ws + O_LW2), 32 * r, scr, 0, lane); continue; } r -= I_L64;
            if (r < I_L64) { p0_transpose_item(args.in[I_A2], A_RANK, D, 32 * r, (bf16_t*)(ws + O_LA2), 32 * r, scr, 0, lane); continue; } r -= I_L64;
            { const int kb = r / (D / 32), nb = r % (D / 32); p0_transpose_item(args.in[I_G2], G_RANK, D, 32 * nb, (bf16_t*)(ws + O_LG2), 32 * nb, scr, kb, lane); }
        }
        float* DT = (float*)(ws + O_DT);
        for (int m = gw; m < MPAD; m += NGW) {
            if (m < MT) norm_row<true>(m < MP ? args.in[I_XP] + (size_t)m * D : args.in[I_XS] + (size_t)(m - MP) * D, args.in[I_NORM_MIX], Hb + (size_t)m * D, args.in[I_W_IN], DT + (size_t)m * H_SSD, lane);
            else { v4u z = {0u, 0u, 0u, 0u}; v4u* o = (v4u*)(Hb + (size_t)m * D) + lane; o[0] = z; o[64] = z; }
        }
        for (int m = gw; m < NMEMROWS; m += NGW) norm_row<false>(args.in[I_MEM] + (size_t)m * D, args.in[I_MEM_NORM], MN + (size_t)m * D, nullptr, nullptr, lane);
        float* esc = (float*)(ws + O_ESC);
        for (int e = gw; e < 2 * N_EXPERTS; e += NGW) { const int t = e >= N_EXPERTS, r = e - t * N_EXPERTS;
            fp8_row(args.in[t ? I_EV : I_EU] + (size_t)r * D, ws + (t ? O_EV8 : O_EU8) + (size_t)r * D, esc + e, lane); }
        { const float* sk = args.in[I_SUBK]; bf16_t* skb = (bf16_t*)(ws + O_SKB); constexpr int NSK = PEER_HEADS * 2 * N_KEYS * PEER_HALF;
          for (int i = (vcu * NTHREADS + tid) * 4; i < NSK; i += G * NTHREADS * 4) { const f32x4 v = *(const f32x4*)(sk + i); typedef unsigned u32x2 __attribute__((ext_vector_type(2))); u32x2 w; w.x = pk2(v.x, v.y); w.y = pk2(v.z, v.w); *(u32x2*)(skb + i) = w; } }
    }
    SEAM(PH_PREP);
    if (IN_PH(PH_INPROJ)) {
        { pg8::Gemm g{Hb, WT_in, MPAD, NMAIN, D}; pg8::StaticOrder S; S.init(MPAD, NMAIN, G, bx);
          pg8::EpiProj E{(bf16_t*)(ws + O_PZ), (bf16_t*)(ws + O_PXBC), (bf16_t*)(ws + O_PRW), (bf16_t*)(ws + O_PGATE)};
          pg8::gemm_phase<pg8::EpiProj, pg8::StaticOrder, true, true>(lds, g, S, E); }
        { pg8::Gemm g{MN, (const bf16_t*)(ws + O_WT_MK), NMEMROWS, 2 * D, D}; pg8::StaticOrder S; S.init(NMEMROWS, 2 * D, G, G - 1 - bx);
          pg8::EpiKV E{out + OO_MKP, out + OO_MVP, (bf16_t*)(ws + O_KVB)};
          pg8::gemm_phase<pg8::EpiKV, pg8::StaticOrder, true, true>(lds, g, S, E); }
    }
    SEAM(PH_INPROJ);
    float* o_ = out;
    if (IN_PH(PH_MIXA)) {
        const bf16_t* PXBC = (const bf16_t*)(ws + O_PXBC); const bf16_t* PRW = (const bf16_t*)(ws + O_PRW);
        GS_LOOP((size_t)(BATCH + DEC_BATCH) * (CONV_K - 1) * CONV_DIM, b_convstate(i_, PXBC, args.in[I_SCONV], o_ + OO_CONVP, o_ + OO_CONVS));
        GS_LOOP((size_t)(BATCH + DEC_BATCH) * RWKV_PROJ, b_shiftstate(i_, PRW, o_ + OO_SHP, o_ + OO_SHS));
        constexpr int NHEAVY = BATCH * H_SSD;
        { SsdIn I{PXBC, (const float*)(ws + O_DT), args.in[I_CONV_W], args.in[I_CONV_B], args.in[I_DT_BIAS], args.in[I_A_LOG], args.in[I_D_SKIP], (bf16_t*)(ws + O_YS), o_ + OO_SSMP};
          __syncthreads();
          for (int u = bx; u < NHEAVY; u += G) ssd_prompt_unit(lds, I, u / H_SSD, u % H_SSD, tid); }
        { const int lw0 = G > NHEAVY ? (bx - NHEAVY) * NWAVES + wave : gw, nlw = G > NHEAVY ? (G - NHEAVY) * NWAVES : NGW;
          if (G <= NHEAVY || bx >= NHEAVY) {
              SsdSIn J{PXBC, args.in[I_SCONV], args.in[I_SSSM], (const float*)(ws + O_DT), args.in[I_CONV_W], args.in[I_CONV_B], args.in[I_DT_BIAS], args.in[I_A_LOG], args.in[I_D_SKIP], (bf16_t*)(ws + O_YS), o_ + OO_SSMS};
              for (int u = lw0; u < DEC_BATCH * H_SSD; u += nlw) ssd_sample_unit(J, u / H_SSD, u % H_SSD, lane);
              RwkvSIn K{PRW, args.in[I_SSHIFT], args.in[I_SWKV], args.in[I_MU], args.in[I_W0], args.in[I_W2], args.in[I_A0], args.in[I_A2], args.in[I_K_K], args.in[I_K_A], args.in[I_R_K], (bf16_t*)(o_ + OO_YP), (float*)(ws + O_BON), o_ + OO_WKVS};
              for (int u = lw0; u < DEC_BATCH * H_RWKV; u += nlw) rwkv_sample_unit(K, u / H_RWKV, u % H_RWKV, lane); } }
    }
    SEAM(PH_MIXA);
    if (IN_PH(PH_SCAN)) {
        { RwkvIn I{(const bf16_t*)(ws + O_PRW), (const bf16_t*)(ws + O_LW2), (const bf16_t*)(ws + O_LA2), args.in[I_MU], args.in[I_W0], args.in[I_A0], args.in[I_K_K], args.in[I_K_A], args.in[I_R_K], (bf16_t*)(o_ + OO_YP), (float*)(ws + O_BON), o_ + OO_WKVP};
          __syncthreads();
          for (int u = bx; u < BATCH * H_RWKV * 2; u += G) rwkv_scan_unit(lds, I, u / (2 * H_RWKV), (u >> 1) % H_RWKV, u & 1, tid); }
    }
    SEAM(PH_SCAN);
    if (IN_PH(PH_MERGE)) {
        static_assert(MT % 16 == 0, "merge units");
        MergeIn I{(const bf16_t*)(ws + O_YS), (const bf16_t*)(o_ + OO_YP), (const bf16_t*)(ws + O_PZ), (const bf16_t*)(ws + O_PGATE), (const bf16_t*)(ws + O_PRW), (const bf16_t*)(ws + O_LG2),
                  (const float*)(ws + O_BON), args.in[I_SSHIFT], args.in[I_MU], args.in[I_SSD_NORM], args.in[I_LN_W], args.in[I_LN_B], (bf16_t*)(ws + O_MERGED)};
        for (int u = bx; u < MT / 16; u += G) merge_unit(lds, I, 16 * u, tid);
        GS_LOOP((size_t)(MPAD - MT) * D, b_zero_u16(i_, (bf16_t*)(ws + O_MERGED) + (size_t)MT * D, (size_t)(MPAD - MT) * D));
    }
    SEAM(PH_MERGE);
    if (IN_PH(PH_OUT)) {
        pg8::Gemm g{(const bf16_t*)(ws + O_MERGED), (const bf16_t*)(ws + O_WT_OUT), MPAD, D, D}; pg8::StaticOrder S; S.init(MPAD, D, G, bx);
        pg8::EpiRes E{args.in[I_XP], args.in[I_XS], MP, (float*)(ws + O_X1), MT};
        pg8::gemm_phase<pg8::EpiRes, pg8::StaticOrder, true, true>(lds, g, S, E);
    }
    SEAM(PH_OUT);
    if (IN_PH(PH_NORM2)) {
        bf16_t* H2 = (bf16_t*)(ws + O_H2); const float* X1 = (const float*)(ws + O_X1);
        for (int m = gw; m < MPAD; m += NGW) {
            if (m < MT) norm_row<false>(X1 + (size_t)m * D, args.in[I_NORM_MEM], H2 + (size_t)m * D, nullptr, nullptr, lane);
            else { v4u z = {0u, 0u, 0u, 0u}; v4u* o = (v4u*)(H2 + (size_t)m * D) + lane; o[0] = z; o[64] = z; }
        }
    }
    SEAM(PH_NORM2);
    if (IN_PH(PH_Q)) {
        pg8::Gemm g{(const bf16_t*)(ws + O_H2), (const bf16_t*)(ws + O_WT_MQ), MPAD, D, D}; pg8::StaticOrder S; S.init(MPAD, D, G, bx);
        pg8::EpiB16 E{(bf16_t*)(ws + O_QB), D};
        pg8::gemm_phase<pg8::EpiB16, pg8::StaticOrder, true, true>(lds, g, S, E);
    }
    SEAM(PH_Q);
    if (IN_PH(PH_ATT1)) GS_LOOP((size_t)MT * MEM_HEADS * N_MEM, b_attn_scores(i_, (const bf16_t*)(ws + O_QB), o_ + OO_MKP, args.in[I_CK], (float*)(ws + O_SC)));
    SEAM(PH_ATT1);
    if (IN_PH(PH_ATT2)) GS_LOOP((size_t)MT * MEM_HEADS, b_attn_softmax(i_, (float*)(ws + O_SC)));
    SEAM(PH_ATT2);
    if (IN_PH(PH_ATT3)) {
        GS_LOOP((size_t)MT * D, b_attn_av(i_, (const float*)(ws + O_SC), o_ + OO_MVP, args.in[I_CV], (bf16_t*)(ws + O_AO)));
        GS_LOOP((size_t)(MPAD - MT) * D, b_zero_u16(i_, (bf16_t*)(ws + O_AO) + (size_t)MT * D, (size_t)(MPAD - MT) * D));
    }
    SEAM(PH_ATT3);
    if (IN_PH(PH_O)) {
        pg8::Gemm g{(const bf16_t*)(ws + O_AO), (const bf16_t*)(ws + O_WT_MO), MPAD, D, D}; pg8::StaticOrder S; S.init(MPAD, D, G, bx);
        pg8::EpiRes E{(const float*)(ws + O_X1), (const float*)(ws + O_X1), MPAD, (float*)(ws + O_X2), MT};
        pg8::gemm_phase<pg8::EpiRes, pg8::StaticOrder, true, true>(lds, g, S, E);
    }
    SEAM(PH_O);
    if (IN_PH(PH_NORM3)) {
        bf16_t* H3 = (bf16_t*)(ws + O_H3); const float* X2 = (const float*)(ws + O_X2);
        for (int m = gw; m < MPAD; m += NGW) {
            if (m < MT) norm_row<false>(X2 + (size_t)m * D, args.in[I_NORM_FFN], H3 + (size_t)m * D, nullptr, nullptr, lane);
            else { v4u z = {0u, 0u, 0u, 0u}; v4u* o = (v4u*)(H3 + (size_t)m * D) + lane; o[0] = z; o[64] = z; }
        }
    }
    SEAM(PH_NORM3);
    if (IN_PH(PH_PQ)) {
        pg8::Gemm g{(const bf16_t*)(ws + O_H3), (const bf16_t*)(ws + O_WT_PQ), MPAD, NPQ, D}; pg8::StaticOrder S; S.init(MPAD, NPQ, G, bx);
        pg8::EpiB16 E{(bf16_t*)(ws + O_PQ), NPQ};
        pg8::gemm_phase<pg8::EpiB16, pg8::StaticOrder, true, true>(lds, g, S, E);
    }
    SEAM(PH_PQ);
    if (IN_PH(PH_PK1)) GS_LOOP((size_t)MT * PEER_HEADS * 2 * N_KEYS, b_peer_scores(i_, (const bf16_t*)(ws + O_PQ), args.in[I_SUBK], (float*)(ws + O_SCP)));
    SEAM(PH_PK1);
    if (IN_PH(PH_PK2)) GS_LOOP((size_t)MT * PEER_HEADS, b_peer_topk(i_, (const float*)(ws + O_SCP), (float*)(ws + O_TS), (int*)(ws + O_TI), (int*)(ws + O_IDX), (float*)(ws + O_GATE)));
    SEAM(PH_PK2);
    if (IN_PH(PH_PEER)) {
        for (int t = gw; t < MT; t += NGW)
            peer_token(t, (const bf16_t*)(ws + O_H3), (const int*)(ws + O_IDX), (const float*)(ws + O_GATE), ws + O_EU8, ws + O_EV8, (const float*)(ws + O_ESC),
                       (const float*)(ws + O_X2), args.in[I_NORM_FINAL], t < MP ? o_ + OO_YP + (size_t)t * D : o_ + OO_YS + (size_t)(t - MP) * D, lane);
    }
#undef IN_PH
#undef SEAM
}
#endif

extern "C" void kernel_launch(void* const* d_in, const int* in_sizes, int n_in, void* d_out, int out_size, void* d_ws, size_t ws_size, hipStream_t stream) {
    const float* const* in = (const float* const*)d_in;
    const float *x_prompt = in[0], *x_sample = in[1], *mem_prompt = in[2], *state_ssm = in[3], *state_conv = in[4], *state_wkv = in[5], *state_shift = in[6], *cache_k = in[7], *cache_v = in[8];
    const float *norm_mix_w = in[9], *w_in = in[10], *conv_w = in[11], *conv_b = in[12], *dt_bias = in[13], *a_log = in[14], *d_skip = in[15], *ssd_norm_w = in[16];
    const float *rwkv_mu = in[17], *rwkv_w0 = in[18], *rwkv_w2 = in[19], *rwkv_a0 = in[20], *rwkv_a2 = in[21], *rwkv_g2 = in[22], *rwkv_k_k = in[23], *rwkv_k_a = in[24], *rwkv_r_k = in[25], *rwkv_ln_w = in[26], *rwkv_ln_b = in[27];
    const float *w_out = in[28], *norm_mem_w = in[29], *mem_norm_w = in[30], *w_mk = in[31], *w_mv = in[32], *w_mq = in[33], *w_mo = in[34], *norm_ffn_w = in[35], *w_pq = in[36], *sub_keys = in[37], *expert_u = in[38], *expert_v = in[39], *norm_final_w = in[40];
    (void)mem_prompt; (void)w_in; (void)w_out; (void)mem_norm_w; (void)w_mk; (void)w_mv; (void)w_mq; (void)w_mo; (void)w_pq; (void)norm_mix_w; (void)x_prompt; (void)x_sample;
    float* o = (float*)d_out;
    float *y_prompt = o + OO_YP, *y_sample = o + OO_YS, *ssm_p = o + OO_SSMP, *conv_p = o + OO_CONVP, *wkv_p = o + OO_WKVP, *shift_p = o + OO_SHP, *memk_p = o + OO_MKP, *memv_p = o + OO_MVP;
    float *ssm_s = o + OO_SSMS, *conv_s = o + OO_CONVS, *wkv_s = o + OO_WKVS, *shift_s = o + OO_SHS;
    unsigned char* ws = (unsigned char*)d_ws;
    if (O_END > ws_size || (size_t)out_size != OO_END || n_in != N_INPUTS) { fprintf(stderr, "kernel_launch: workspace %zu (need %zu), out %d (need %zu), n_in %d\n", ws_size, (size_t)O_END, out_size, (size_t)OO_END, n_in); return; }
    bf16_t *WT_out = (bf16_t*)(ws + O_WT_OUT), *WT_mq = (bf16_t*)(ws + O_WT_MQ), *WT_mo = (bf16_t*)(ws + O_WT_MO), *WT_pq = (bf16_t*)(ws + O_WT_PQ);
    bf16_t *PZ = (bf16_t*)(ws + O_PZ), *PXBC = (bf16_t*)(ws + O_PXBC), *PRW = (bf16_t*)(ws + O_PRW), *PGATE = (bf16_t*)(ws + O_PGATE); float* DT = (float*)(ws + O_DT);
    bf16_t* XC = (bf16_t*)(ws + O_XC);
    f16_t *R16 = (f16_t*)(ws + O_R16), *OMW16 = (f16_t*)(ws + O_OMW16), *K16 = (f16_t*)(ws + O_K16), *V16 = (f16_t*)(ws + O_V16), *KK16 = (f16_t*)(ws + O_KK16), *B16 = (f16_t*)(ws + O_B16);
    bf16_t* YR = (bf16_t*)y_prompt;
    bf16_t *Gb = (bf16_t*)(ws + O_GB), *YS = (bf16_t*)(ws + O_YS), *MERGED = (bf16_t*)(ws + O_MERGED); float* X1 = (float*)(ws + O_X1);
    bf16_t *H2 = (bf16_t*)(ws + O_H2), *Qb = (bf16_t*)(ws + O_QB), *AO = (bf16_t*)(ws + O_AO);
    float* SC = (float*)(ws + O_SC); float* X2 = (float*)(ws + O_X2); bf16_t *H3 = (bf16_t*)(ws + O_H3), *PQ = (bf16_t*)(ws + O_PQ);
    int* IDX = (int*)(ws + O_IDX); float *GATE = (float*)(ws + O_GATE), *COEF = (float*)(ws + O_COEF); float* TS = (float*)(ws + O_TS); int* TI = (int*)(ws + O_TI); float* SCP = (float*)(ws + O_SCP);

#ifndef HOST_EMU
    static int grid = 0;
    if (grid == 0) {
        int dev = 0, cus = 0, per_cu = 0;
        if (hipGetDevice(&dev) != hipSuccess || hipDeviceGetAttribute(&cus, hipDeviceAttributeMultiprocessorCount, dev) != hipSuccess) { fprintf(stderr, "kernel_launch: device query failed\n"); grid = -1; return; }
        if (hipFuncSetAttribute((const void*)mk_fwd, hipFuncAttributeMaxDynamicSharedMemorySize, LDS_BYTES) != hipSuccess) { fprintf(stderr, "kernel_launch: hipFuncSetAttribute failed\n"); grid = -1; return; }
        if (hipOccupancyMaxActiveBlocksPerMultiprocessor(&per_cu, (const void*)mk_fwd, NTHREADS, LDS_BYTES) != hipSuccess || per_cu < 1) { fprintf(stderr, "kernel_launch: occupancy query says %d blocks per CU\n", per_cu); (void)hipGetLastError(); grid = -1; return; }
        grid = cus;
    }
    if (grid < 0) return;
    (void)hipMemsetAsync(ws + O_CTL, 0, CTL_BYTES, stream);
    MkArgs a{};
    for (int i = 0; i < N_INPUTS; ++i) a.in[i] = (const float*)d_in[i];
    a.out = (float*)d_out; a.ws = ws; a.ph_lo = 0; a.ph_hi = N_PHASES; a.bar_idx = 0;
    hipLaunchKernelGGL(mk_fwd, dim3(grid), dim3(NTHREADS), LDS_BYTES, stream, a);
    return;
#define MK(lo_, hi_) do { } while (0)
#else
#define MK(lo_, hi_) do { } while (0)
    { bf16_t *WT_in = (bf16_t*)(ws + O_WT_IN), *WT_dt = (bf16_t*)(ws + O_WT_DT), *WT_mk = (bf16_t*)(ws + O_WT_MK), *WT_mv = (bf16_t*)(ws + O_WT_MV), *Hb = (bf16_t*)(ws + O_HB), *MN = (bf16_t*)(ws + O_MN);
    launch(k_wt, (size_t)NMAIN * D, stream, w_in, D, D_IN, 0, D + CONV_DIM, H_SSD, WT_in, NMAIN);
    launch(k_wt, (size_t)H_SSD * D, stream, w_in, D, D_IN, D + CONV_DIM, 1 << 30, 0, WT_dt, H_SSD);
    launch(k_wt, (size_t)D * D, stream, w_out, D, D, 0, 1 << 30, 0, WT_out, D);
    launch(k_wt, (size_t)D * D, stream, w_mk, D, D, 0, 1 << 30, 0, WT_mk, D);
    launch(k_wt, (size_t)D * D, stream, w_mv, D, D, 0, 1 << 30, 0, WT_mv, D);
    launch(k_wt, (size_t)D * D, stream, w_mq, D, D, 0, 1 << 30, 0, WT_mq, D);
    launch(k_wt, (size_t)D * D, stream, w_mo, D, D, 0, 1 << 30, 0, WT_mo, D);
    launch(k_wt, (size_t)NPQ * D, stream, w_pq, D, NPQ, 0, 1 << 30, 0, WT_pq, NPQ);
    launch(k_rmsnorm_bf16, (size_t)MP, stream, x_prompt, norm_mix_w, Hb, MP);
    launch(k_rmsnorm_bf16, (size_t)MS, stream, x_sample, norm_mix_w, Hb + (size_t)MP * D, MS);
    launch(k_rmsnorm_bf16, (size_t)NMEMROWS, stream, mem_prompt, mem_norm_w, MN, NMEMROWS);
    launch(k_gemm, (size_t)MT * D, stream, Hb, D, WT_in, D, MT, D, 0, PZ, D, (float*)nullptr, 0, (const float*)nullptr, 0);
    launch(k_gemm, (size_t)MT * CONV_DIM, stream, Hb, D, WT_in + (size_t)D * D, D, MT, CONV_DIM, 0, PXBC, CONV_DIM, (float*)nullptr, 0, (const float*)nullptr, 0);
    launch(k_gemm, (size_t)MT * RWKV_PROJ, stream, Hb, D, WT_in + (size_t)(D + CONV_DIM) * D, D, MT, RWKV_PROJ, 0, PRW, RWKV_PROJ, (float*)nullptr, 0, (const float*)nullptr, 0);
    launch(k_gemm, (size_t)MT * 2 * D, stream, Hb, D, WT_in + (size_t)(D + CONV_DIM + RWKV_PROJ) * D, D, MT, 2 * D, 0, PGATE, 2 * D, (float*)nullptr, 0, (const float*)nullptr, 0);
    launch(k_gemm, (size_t)MT * H_SSD, stream, Hb, D, WT_dt, D, MT, H_SSD, 1, (bf16_t*)nullptr, 0, DT, H_SSD, (const float*)nullptr, 0);
    launch(k_gemm, (size_t)NMEMROWS * D, stream, MN, D, WT_mk, D, NMEMROWS, D, 1, (bf16_t*)nullptr, 0, memk_p, D, (const float*)nullptr, 0);
    launch(k_gemm, (size_t)NMEMROWS * D, stream, MN, D, WT_mv, D, NMEMROWS, D, 1, (bf16_t*)nullptr, 0, memv_p, D, (const float*)nullptr, 0); }
#endif
    launch(k_conv, (size_t)MT * CONV_DIM, stream, PXBC, state_conv, conv_w, conv_b, XC);
    launch(k_convstate, (size_t)(BATCH + DEC_BATCH) * (CONV_K - 1) * CONV_DIM, stream, PXBC, state_conv, conv_p, conv_s);
    RwkvW rw{rwkv_mu, rwkv_w0, rwkv_w2, rwkv_a0, rwkv_a2, rwkv_g2, rwkv_k_k, rwkv_k_a};
    launch(k_rwkv_prep, (size_t)MT * D, stream, PRW, state_shift, rw, R16, OMW16, K16, V16, KK16, B16, Gb);
    launch(k_shiftstate, (size_t)(BATCH + DEC_BATCH) * RWKV_PROJ, stream, PRW, shift_p, shift_s);
    launch(k_copy_or_zero, (size_t)BATCH * H_SSD * P_SSD * N_SSD, stream, (const float*)nullptr, ssm_p, (size_t)BATCH * H_SSD * P_SSD * N_SSD);
    launch(k_copy_or_zero, (size_t)DEC_BATCH * H_SSD * P_SSD * N_SSD, stream, state_ssm, ssm_s, (size_t)DEC_BATCH * H_SSD * P_SSD * N_SSD);
    launch(k_ssd, (size_t)(BATCH + DEC_BATCH) * H_SSD * P_SSD, stream, XC, DT, dt_bias, a_log, d_skip, ssm_p, ssm_s, YS);
    launch(k_copy_or_zero, (size_t)BATCH * H_RWKV * HK * HK, stream, (const float*)nullptr, wkv_p, (size_t)BATCH * H_RWKV * HK * HK);
    launch(k_copy_or_zero, (size_t)DEC_BATCH * H_RWKV * HK * HK, stream, state_wkv, wkv_s, (size_t)DEC_BATCH * H_RWKV * HK * HK);
    launch(k_rwkv_scan, (size_t)(BATCH + DEC_BATCH) * H_RWKV * HK, stream, R16, OMW16, K16, V16, KK16, B16, wkv_p, wkv_s, YR);
    MergeW mw{ssd_norm_w, rwkv_r_k, rwkv_ln_w, rwkv_ln_b};
    launch(k_merge, (size_t)MT, stream, YS, YR, PZ, PGATE, Gb, R16, K16, V16, mw, MERGED);
#ifdef HOST_EMU
    launch(k_gemm, (size_t)MP * D, stream, MERGED, D, WT_out, D, MP, D, 2, (bf16_t*)nullptr, 0, X1, D, x_prompt, D);
    launch(k_gemm, (size_t)MS * D, stream, MERGED + (size_t)MP * D, D, WT_out, D, MS, D, 2, (bf16_t*)nullptr, 0, X1 + (size_t)MP * D, D, x_sample, D);
    launch(k_rmsnorm_f2b, (size_t)MT, stream, X1, norm_mem_w, H2, MT);
    launch(k_gemm, (size_t)MT * D, stream, H2, D, WT_mq, D, MT, D, 0, Qb, D, (float*)nullptr, 0, (const float*)nullptr, 0);
#else
    launch(k_zero_u16, (size_t)(MPAD - MT) * D, stream, MERGED + (size_t)MT * D, (size_t)(MPAD - MT) * D);
    MK(PH_OUT, PH_Q + 1);
#endif
    launch(k_attn_scores, (size_t)MT * MEM_HEADS * N_MEM, stream, Qb, memk_p, cache_k, SC);
    launch(k_attn_softmax, (size_t)MT * MEM_HEADS, stream, SC);
    launch(k_attn_av, (size_t)MT * D, stream, SC, memv_p, cache_v, AO);
#ifdef HOST_EMU
    launch(k_gemm, (size_t)MT * D, stream, AO, D, WT_mo, D, MT, D, 2, (bf16_t*)nullptr, 0, X2, D, X1, D);
    launch(k_rmsnorm_f2b, (size_t)MT, stream, X2, norm_ffn_w, H3, MT);
    launch(k_gemm, (size_t)MT * NPQ, stream, H3, D, WT_pq, D, MT, NPQ, 0, PQ, NPQ, (float*)nullptr, 0, (const float*)nullptr, 0);
#else
    launch(k_zero_u16, (size_t)(MPAD - MT) * D, stream, AO + (size_t)MT * D, (size_t)(MPAD - MT) * D);
    MK(PH_O, PH_PQ + 1);
#endif
    launch(k_peer_scores, (size_t)MT * PEER_HEADS * 2 * N_KEYS, stream, PQ, sub_keys, SCP);
    launch(k_peer_topk, (size_t)MT * PEER_HEADS, stream, SCP, TS, TI, IDX, GATE);
    launch(k_peer_act, (size_t)MT * NSEL, stream, H3, expert_u, IDX, GATE, COEF);
    launch(k_peer_out, (size_t)MT * D, stream, X2, expert_v, IDX, COEF);
    launch(k_final, (size_t)MT, stream, X2, norm_final_w, y_prompt, y_sample);
}
```

```cpp
#ifdef HOST_EMU
#include <cmath>
#include <cstring>
#include <cstdint>
#include <cstdio>
#include <cstddef>
typedef void* hipStream_t;
#define __global__
#define __device__
#define __host__
#define __forceinline__ inline
static thread_local size_t g_tid;
#define GTID g_tid
template <class F, class... A> static void launch(F f, size_t n, hipStream_t, A... a) {
#pragma omp parallel for schedule(static)
    for (long long i = 0; i < (long long)n; ++i) { g_tid = (size_t)i; f(a...); }
}
#else
#include <hip/hip_runtime.h>
#include <cstdint>
#include <cstdio>
#define GTID ((size_t)blockIdx.x * blockDim.x + threadIdx.x)
template <class F, class... A> static void launch(F f, size_t n, hipStream_t s, A... a) {
    if (n == 0) return;
    hipLaunchKernelGGL(f, dim3((unsigned)((n + 255) / 256)), dim3(256), 0, s, a...);
}
#endif

#ifndef D_MODEL
#define D_MODEL 1024
#define BATCH 8
#define SEQ 2048
#define DEC_BATCH 128
#define SSD_HEADDIM 64
#define SSD_GROUPS 2
#define SSD_STATE 128
#define HD_RWKV 64
#define W_RANK 64
#define A_RANK 64
#define G_RANK 128
#define N_MEM 256
#define MEM_HEADS 4
#define N_KEYS 128
#define PEER_HEADS 8
#define PEER_DKEY 256
#define PEER_TOPK 16
#endif
#define CONV_K 4
constexpr int D = D_MODEL;
constexpr int H_SSD = D / SSD_HEADDIM, P_SSD = SSD_HEADDIM, N_SSD = SSD_STATE, G_SSD = SSD_GROUPS;
constexpr int CONV_DIM = D + 2 * G_SSD * N_SSD;
constexpr int H_RWKV = D / HD_RWKV, HK = HD_RWKV;
constexpr int RWKV_PROJ = 3 * D + W_RANK + A_RANK + G_RANK;
constexpr int D_IN = D + CONV_DIM + H_SSD + RWKV_PROJ + 2 * D;
constexpr int MEM_HD = D / MEM_HEADS;
constexpr int N_EXPERTS = N_KEYS * N_KEYS, PEER_HALF = PEER_DKEY / 2, NPQ = PEER_HEADS * PEER_DKEY, NSEL = PEER_HEADS * PEER_TOPK;
constexpr int MP = BATCH * SEQ, MS = DEC_BATCH, MT = MP + MS, MPAD = (MT + 255) / 256 * 256, NMEMROWS = BATCH * N_MEM;
constexpr float NORM_EPS = 1e-6f, RWKV_LN_EPS = 64e-5f;
constexpr int NMAIN = D_IN - H_SSD;

typedef unsigned short bf16_t;
typedef _Float16 f16_t;
__host__ __device__ __forceinline__ float bf2f(bf16_t v) { unsigned u = (unsigned)v << 16; float f; memcpy(&f, &u, 4); return f; }
__host__ __device__ __forceinline__ bf16_t f2bf(float f) { unsigned u; memcpy(&u, &f, 4); u = (u + 0x7fffu + ((u >> 16) & 1u)) >> 16; return (bf16_t)u; }
__host__ __device__ __forceinline__ float siluf(float x) { return x / (1.f + expf(-x)); }
__host__ __device__ __forceinline__ float sigmoidf(float x) { return 1.f / (1.f + expf(-x)); }
__host__ __device__ __forceinline__ float softplusf(float x) { return x > 20.f ? x : log1pf(expf(x)); }
__host__ __device__ __forceinline__ float geluf(float x) { return 0.5f * x * (1.f + erff(x * 0.70710678118654752f)); }

struct RowInfo { int grp, b, t; };
__host__ __device__ __forceinline__ RowInfo rowinfo(int r) { RowInfo q; if (r < MP) { q.grp = 0; q.b = r / SEQ; q.t = r % SEQ; } else { q.grp = 1; q.b = r - MP; q.t = 0; } return q; }

__device__ __forceinline__ void b_zero_u16(size_t i, bf16_t* p, size_t n) {  if (i < n) p[i] = 0; }
__device__ __forceinline__ void b_rmsnorm_bf16(size_t i, const float* x, const float* w, bf16_t* out, int nrows) {
     if (i >= (size_t)nrows) return;
    const float* xr = x + i * D; float ss = 0.f;
    for (int c = 0; c < D; ++c) ss += xr[c] * xr[c];
    const float rs = 1.f / sqrtf(ss / D + NORM_EPS);
    for (int c = 0; c < D; ++c) out[i * D + c] = f2bf(xr[c] * rs * w[c]);
}
__device__ __forceinline__ void b_wt(size_t i, const float* W, int K, int ldw, int ncol0, int skip_at, int skip, bf16_t* WT, int N) {
     if (i >= (size_t)N * K) return;
    const int n = (int)(i / K), k = (int)(i % K); const int sc = ncol0 + n + (n >= skip_at ? skip : 0);
    WT[i] = f2bf(W[(size_t)k * ldw + sc]);
}
struct __attribute__((aligned(16))) V8 { bf16_t v[8]; };
__device__ __forceinline__ void b_gemm(size_t i, const bf16_t* A, int lda, const bf16_t* Bt, int K, int M, int N, int mode, bf16_t* ob, int ldob, float* of, int ldof, const float* base, int ldbase) {
     if (i >= (size_t)M * N) return;
    const int m = (int)(i / N), n = (int)(i % N);
    const bf16_t* a = A + (size_t)m * lda; const bf16_t* b = Bt + (size_t)n * K; float acc = 0.f;
    for (int k = 0; k < K; k += 8) { V8 va, vb; memcpy(&va, a + k, 16); memcpy(&vb, b + k, 16);
        for (int j = 0; j < 8; ++j) acc += bf2f(va.v[j]) * bf2f(vb.v[j]); }
    if (mode == 0) ob[(size_t)m * ldob + n] = f2bf(acc);
    else if (mode == 1) { of[(size_t)m * ldof + n] = acc; if (ob) ob[(size_t)m * ldob + n] = f2bf(acc); }
    else of[(size_t)m * ldof + n] = base[(size_t)m * ldbase + n] + acc;
}
__device__ __forceinline__ void b_conv(size_t i, const bf16_t* PXBC, const float* state_conv, const float* conv_w, const float* conv_b, bf16_t* XC) {
     if (i >= (size_t)MT * CONV_DIM) return;
    const int r = (int)(i / CONV_DIM), ch = (int)(i % CONV_DIM); const RowInfo q = rowinfo(r);
    float acc = conv_b[ch];
    for (int j = 0; j < CONV_K; ++j) { const int tp = q.t - (CONV_K - 1) + j; float v;
        if (tp >= 0) v = bf2f(PXBC[(size_t)(r - (q.t - tp)) * CONV_DIM + ch]);
        else v = q.grp ? state_conv[((size_t)q.b * (CONV_K - 1) + (CONV_K - 1 + tp)) * CONV_DIM + ch] : 0.f;
        acc += v * conv_w[j * CONV_DIM + ch]; }
    XC[i] = f2bf(siluf(acc));
}
__device__ __forceinline__ void b_convstate(size_t i, const bf16_t* PXBC, const float* state_conv, float* conv_p, float* conv_s) {
     const size_t np = (size_t)BATCH * (CONV_K - 1) * CONV_DIM, ns = (size_t)DEC_BATCH * (CONV_K - 1) * CONV_DIM; if (i >= np + ns) return;
    if (i < np) { const int ch = (int)(i % CONV_DIM), j = (int)((i / CONV_DIM) % (CONV_K - 1)), b = (int)(i / ((CONV_K - 1) * CONV_DIM));
        const int t = SEQ - (CONV_K - 1) + j; conv_p[i] = t >= 0 ? bf2f(PXBC[((size_t)b * SEQ + t) * CONV_DIM + ch]) : 0.f; }
    else { const size_t k = i - np; const int ch = (int)(k % CONV_DIM), j = (int)((k / CONV_DIM) % (CONV_K - 1)), b = (int)(k / ((CONV_K - 1) * CONV_DIM));
        conv_s[k] = (j + 1 < CONV_K - 1) ? state_conv[((size_t)b * (CONV_K - 1) + j + 1) * CONV_DIM + ch] : bf2f(PXBC[((size_t)MP + b) * CONV_DIM + ch]); }
}
__device__ __forceinline__ void b_copy_or_zero(size_t i, const float* src, float* dst, size_t n) {  if (i < n) dst[i] = src ? src[i] : 0.f; }
__device__ __forceinline__ void b_ssd(size_t i, const bf16_t* XC, const float* DT, const float* dt_bias, const float* a_log, const float* d_skip, float* Sp, float* Ss, bf16_t* YS) {
     const size_t np = (size_t)BATCH * H_SSD * P_SSD, ns = (size_t)DEC_BATCH * H_SSD * P_SSD; if (i >= np + ns) return;
    const int grp = i >= np; const size_t k = grp ? i - np : i; const int p = (int)(k % P_SSD), h = (int)((k / P_SSD) % H_SSD), b = (int)(k / (P_SSD * H_SSD));
    float* S = (grp ? Ss : Sp) + k * N_SSD; const int L = grp ? 1 : SEQ; const int g = h / (H_SSD / G_SSD);
    const float ah = -expf(a_log[h]), db = dt_bias[h], dsk = d_skip[h];
    for (int t = 0; t < L; ++t) { const size_t r = grp ? (size_t)MP + b : (size_t)b * SEQ + t;
        const float dt = softplusf(DT[r * H_SSD + h] + db), dA = expf(dt * ah), x = bf2f(XC[r * CONV_DIM + h * P_SSD + p]);
        const bf16_t* Bv = XC + r * CONV_DIM + D + g * N_SSD; const bf16_t* Cv = XC + r * CONV_DIM + D + G_SSD * N_SSD + g * N_SSD;
        float y = 0.f;
        for (int n = 0; n < N_SSD; ++n) { const float s = S[n] * dA + dt * x * bf2f(Bv[n]); S[n] = s; y += bf2f(Cv[n]) * s; }
        YS[r * D + h * P_SSD + p] = f2bf(y + dsk * x); }
}
__device__ __forceinline__ float rws_at(const bf16_t* PRW, const float* state_shift, const float* mu, int r, int c) {
    const RowInfo q = rowinfo(r); const float cur = bf2f(PRW[(size_t)r * RWKV_PROJ + c]);
    const float prev = q.t > 0 ? bf2f(PRW[(size_t)(r - 1) * RWKV_PROJ + c]) : (q.grp ? state_shift[(size_t)q.b * RWKV_PROJ + c] : 0.f);
    return cur + (prev - cur) * mu[c];
}
struct RwkvW { const float *mu, *w0, *w2, *a0, *a2, *g2, *k_k, *k_a; };
__device__ __forceinline__ void b_rwkv_prep(size_t i, const bf16_t* PRW, const float* state_shift, RwkvW W, f16_t* R16, f16_t* OMW16, f16_t* K16, f16_t* V16, f16_t* KK16, f16_t* B16, bf16_t* Gb) {
     if (i >= (size_t)MT * D) return;
    const int r = (int)(i / D), ch = (int)(i % D), h0 = ch / HK * HK;
    float dw = 0.f, da = 0.f, dg = 0.f;
    for (int j = 0; j < W_RANK; ++j) dw += tanhf(rws_at(PRW, state_shift, W.mu, r, 3 * D + j)) * W.w2[j * D + ch];
    for (int j = 0; j < A_RANK; ++j) da += rws_at(PRW, state_shift, W.mu, r, 3 * D + W_RANK + j) * W.a2[j * D + ch];
    for (int j = 0; j < G_RANK; ++j) dg += sigmoidf(rws_at(PRW, state_shift, W.mu, r, 3 * D + W_RANK + A_RANK + j)) * W.g2[j * D + ch];
    const float wlog = -softplusf(-(W.w0[ch] + dw)) - 0.5f, e = expf(wlog), omw = -expm1f(-e);
    const float ag = sigmoidf(W.a0[ch] + da);
    const float kv = rws_at(PRW, state_shift, W.mu, r, D + ch);
    float ss = 0.f;
    for (int c = h0; c < h0 + HK; ++c) { const float q = rws_at(PRW, state_shift, W.mu, r, D + c) * W.k_k[c]; ss += q * q; }
    const float kk = kv * W.k_k[ch] / sqrtf(fmaxf(ss, 1e-24f));
    R16[i] = (f16_t)rws_at(PRW, state_shift, W.mu, r, ch); OMW16[i] = (f16_t)omw; K16[i] = (f16_t)(kv * (1.f + (ag - 1.f) * W.k_a[ch]));
    V16[i] = (f16_t)rws_at(PRW, state_shift, W.mu, r, 2 * D + ch); KK16[i] = (f16_t)kk; B16[i] = (f16_t)(kk * ag); Gb[i] = f2bf(dg);
}
__device__ __forceinline__ void b_shiftstate(size_t i, const bf16_t* PRW, float* sh_p, float* sh_s) {
     const size_t np = (size_t)BATCH * RWKV_PROJ, ns = (size_t)DEC_BATCH * RWKV_PROJ; if (i >= np + ns) return;
    if (i < np) { const int c = (int)(i % RWKV_PROJ), b = (int)(i / RWKV_PROJ); sh_p[i] = bf2f(PRW[((size_t)b * SEQ + SEQ - 1) * RWKV_PROJ + c]); }
    else { const size_t k = i - np; const int c = (int)(k % RWKV_PROJ), b = (int)(k / RWKV_PROJ); sh_s[k] = bf2f(PRW[((size_t)MP + b) * RWKV_PROJ + c]); }
}
__device__ __forceinline__ void b_rwkv_scan(size_t i, const f16_t* R16, const f16_t* OMW16, const f16_t* K16, const f16_t* V16, const f16_t* KK16, const f16_t* B16, float* Sp, float* Ss, bf16_t* YR) {
     const size_t np = (size_t)BATCH * H_RWKV * HK, ns = (size_t)DEC_BATCH * H_RWKV * HK; if (i >= np + ns) return;
    const int grp = i >= np; const size_t k0 = grp ? i - np : i; const int v = (int)(k0 % HK), h = (int)((k0 / HK) % H_RWKV), b = (int)(k0 / (HK * H_RWKV));
    float* S = (grp ? Ss : Sp) + k0 * HK; const int L = grp ? 1 : SEQ;
    for (int t = 0; t < L; ++t) { const size_t r = grp ? (size_t)MP + b : (size_t)b * SEQ + t; const size_t o = r * D + h * HK;
        float sa = 0.f; for (int k = 0; k < HK; ++k) sa += S[k] * (float)KK16[o + k];
        const float vv = (float)V16[o + v]; float y = 0.f;
        for (int k = 0; k < HK; ++k) { float s = S[k]; s = s - s * (float)OMW16[o + k]; s = s - sa * (float)B16[o + k]; s = s + vv * (float)K16[o + k]; S[k] = s; y += s * (float)R16[o + k]; }
        YR[o + v] = f2bf(y); }
}
struct MergeW { const float *ssd_norm_w, *r_k, *ln_w, *ln_b; };
__device__ __forceinline__ void b_merge(size_t i, const bf16_t* YS, const bf16_t* YR, const bf16_t* PZ, const bf16_t* PGATE, const bf16_t* Gb, const f16_t* R16, const f16_t* K16, const f16_t* V16, MergeW W, bf16_t* MERGED) {
     if (i >= (size_t)MT) return; const size_t o = i * D;
    float ss = 0.f; for (int c = 0; c < D; ++c) { const float q = bf2f(YS[o + c]) * siluf(bf2f(PZ[o + c])); ss += q * q; }
    const float rs = 1.f / sqrtf(ss / D + NORM_EPS);
    for (int h = 0; h < H_RWKV; ++h) { float m = 0.f, bonus = 0.f;
        for (int k = 0; k < HK; ++k) { const int c = h * HK + k; m += bf2f(YR[o + c]); bonus += (float)R16[o + c] * (float)K16[o + c] * W.r_k[c]; }
        m /= HK; float var = 0.f; for (int k = 0; k < HK; ++k) { const float d = bf2f(YR[o + h * HK + k]) - m; var += d * d; } var /= HK;
        const float rstd = 1.f / sqrtf(var + RWKV_LN_EPS);
        for (int k = 0; k < HK; ++k) { const int c = h * HK + k;
            const float yssd = bf2f(YS[o + c]) * siluf(bf2f(PZ[o + c])) * rs * W.ssd_norm_w[c];
            const float yrn = (bf2f(YR[o + c]) - m) * rstd * W.ln_w[c] + W.ln_b[c];
            const float yrw = (yrn + bonus * (float)V16[o + c]) * bf2f(Gb[o + c]);
            MERGED[o + c] = f2bf(sigmoidf(bf2f(PGATE[i * 2 * D + c])) * yssd + sigmoidf(bf2f(PGATE[i * 2 * D + D + c])) * yrw); } }
}
__device__ __forceinline__ void b_rmsnorm_f2b(size_t i, const float* X, const float* w, bf16_t* out, int nrows) {  if (i >= (size_t)nrows) return;
    const float* xr = X + i * D; float ss = 0.f; for (int c = 0; c < D; ++c) ss += xr[c] * xr[c]; const float rs = 1.f / sqrtf(ss / D + NORM_EPS);
    for (int c = 0; c < D; ++c) out[i * D + c] = f2bf(xr[c] * rs * w[c]); }
__device__ __forceinline__ void b_attn_scores(size_t i, const bf16_t* Q, const float* kp, const float* kc, float* SC) {
     if (i >= (size_t)MT * MEM_HEADS * N_MEM) return;
    const int m = (int)(i % N_MEM), h = (int)((i / N_MEM) % MEM_HEADS), r = (int)(i / (N_MEM * MEM_HEADS)); const RowInfo q = rowinfo(r);
    const float* kr = (q.grp ? kc : kp) + ((size_t)q.b * N_MEM + m) * D + h * MEM_HD; const bf16_t* qr = Q + (size_t)r * D + h * MEM_HD; float acc = 0.f;
    for (int d = 0; d < MEM_HD; ++d) acc += bf2f(qr[d]) * kr[d];
    SC[i] = acc / sqrtf((float)MEM_HD);
}
__device__ __forceinline__ void b_attn_softmax(size_t i, float* SC) {  if (i >= (size_t)MT * MEM_HEADS) return; float* s = SC + i * N_MEM;
    float mx = s[0]; for (int m = 1; m < N_MEM; ++m) mx = fmaxf(mx, s[m]); float sum = 0.f; for (int m = 0; m < N_MEM; ++m) { const float e = expf(s[m] - mx); s[m] = e; sum += e; }
    const float inv = 1.f / sum; for (int m = 0; m < N_MEM; ++m) s[m] *= inv; }
__device__ __forceinline__ void b_attn_av(size_t i, const float* SC, const float* vp, const float* vc, bf16_t* AO) {
     if (i >= (size_t)MT * D) return; const int c = (int)(i % D), r = (int)(i / D), h = c / MEM_HD; const RowInfo q = rowinfo(r);
    const float* vb = (q.grp ? vc : vp) + (size_t)q.b * N_MEM * D + c; const float* s = SC + ((size_t)r * MEM_HEADS + h) * N_MEM; float acc = 0.f;
    for (int m = 0; m < N_MEM; ++m) acc += s[m] * vb[(size_t)m * D];
    AO[i] = f2bf(acc);
}
__device__ __forceinline__ void b_peer_scores(size_t i, const bf16_t* PQ, const float* sub_keys, float* SCP) {
     if (i >= (size_t)MT * PEER_HEADS * 2 * N_KEYS) return;
    const int key = (int)(i % N_KEYS), c = (int)((i / N_KEYS) % 2), h = (int)((i / (2 * N_KEYS)) % PEER_HEADS), r = (int)(i / ((size_t)2 * N_KEYS * PEER_HEADS));
    const bf16_t* q = PQ + (size_t)r * NPQ + h * PEER_DKEY + c * PEER_HALF; const float* kk = sub_keys + (((size_t)h * 2 + c) * N_KEYS + key) * PEER_HALF; float acc = 0.f;
    for (int d = 0; d < PEER_HALF; ++d) acc += bf2f(q[d]) * kk[d];
    SCP[i] = acc;
}
__device__ __forceinline__ void b_peer_topk(size_t i, const float* SCP, float* TS, int* TI, int* IDX, float* GATE) {
     if (i >= (size_t)MT * PEER_HEADS) return;
    float* ts = TS + i * 2 * PEER_TOPK; int* ti = TI + i * 2 * PEER_TOPK;
    for (int c = 0; c < 2; ++c) { const float* s = SCP + (i * 2 + c) * N_KEYS; float pv = INFINITY; int pi = -1;
        for (int j = 0; j < PEER_TOPK; ++j) { float bv = -INFINITY; int bi = -1;
            for (int k = 0; k < N_KEYS; ++k) { const float v = s[k]; const bool after = (v < pv) || (v == pv && k > pi); if (after && (v > bv)) { bv = v; bi = k; } }
            ts[c * PEER_TOPK + j] = bv; ti[c * PEER_TOPK + j] = bi; pv = bv; pi = bi; } }
    float pv = INFINITY; int pi = -1; float* g = GATE + i * PEER_TOPK; int* id = IDX + i * PEER_TOPK;
    for (int j = 0; j < PEER_TOPK; ++j) { float bv = -INFINITY; int bi = -1;
        for (int k = 0; k < PEER_TOPK * PEER_TOPK; ++k) { const float v = ts[k / PEER_TOPK] + ts[PEER_TOPK + k % PEER_TOPK]; const bool after = (v < pv) || (v == pv && k > pi); if (after && (v > bv)) { bv = v; bi = k; } }
        g[j] = bv; id[j] = ti[bi / PEER_TOPK] * N_KEYS + ti[PEER_TOPK + bi % PEER_TOPK]; pv = bv; pi = bi; }
    const float mx = g[0]; float sum = 0.f; for (int j = 0; j < PEER_TOPK; ++j) { const float e = expf(g[j] - mx); g[j] = e; sum += e; }
    for (int j = 0; j < PEER_TOPK; ++j) g[j] /= sum;
}
__device__ __forceinline__ void b_peer_act(size_t i, const bf16_t* H3, const float* eu, const int* IDX, const float* GATE, float* COEF) {
     if (i >= (size_t)MT * NSEL) return; const int r = (int)(i / NSEL);
    const float* u = eu + (size_t)IDX[i] * D; const bf16_t* x = H3 + (size_t)r * D; float acc = 0.f;
    for (int d = 0; d < D; ++d) acc += bf2f(x[d]) * u[d];
    COEF[i] = GATE[i] * geluf(acc);
}
__device__ __forceinline__ void b_peer_out(size_t i, float* X2, const float* ev, const int* IDX, const float* COEF) {
     if (i >= (size_t)MT * D) return; const int r = (int)(i / D), c = (int)(i % D); float acc = 0.f;
    for (int j = 0; j < NSEL; ++j) acc += COEF[(size_t)r * NSEL + j] * ev[(size_t)IDX[(size_t)r * NSEL + j] * D + c];
    X2[i] += acc;
}
__device__ __forceinline__ void b_final(size_t i, const float* X, const float* w, float* yp, float* ys) {  if (i >= (size_t)MT) return;
    const float* xr = X + i * D; float ss = 0.f; for (int c = 0; c < D; ++c) ss += xr[c] * xr[c]; const float rs = 1.f / sqrtf(ss / D + NORM_EPS);
    float* o = i < (size_t)MP ? yp + i * D : ys + (i - MP) * D; for (int c = 0; c < D; ++c) o[c] = xr[c] * rs * w[c]; }


__global__ void k_zero_u16(bf16_t* p, size_t n) { b_zero_u16(GTID, p, n); }
__global__ void k_rmsnorm_bf16(const float* x, const float* w, bf16_t* out, int nrows) { b_rmsnorm_bf16(GTID, x, w, out, nrows); }
__global__ void k_wt(const float* W, int K, int ldw, int ncol0, int skip_at, int skip, bf16_t* WT, int N) { b_wt(GTID, W, K, ldw, ncol0, skip_at, skip, WT, N); }
__global__ void k_gemm(const bf16_t* A, int lda, const bf16_t* Bt, int K, int M, int N, int mode, bf16_t* ob, int ldob, float* of, int ldof, const float* base, int ldbase) { b_gemm(GTID, A, lda, Bt, K, M, N, mode, ob, ldob, of, ldof, base, ldbase); }
__global__ void k_conv(const bf16_t* PXBC, const float* state_conv, const float* conv_w, const float* conv_b, bf16_t* XC) { b_conv(GTID, PXBC, state_conv, conv_w, conv_b, XC); }
__global__ void k_convstate(const bf16_t* PXBC, const float* state_conv, float* conv_p, float* conv_s) { b_convstate(GTID, PXBC, state_conv, conv_p, conv_s); }
__global__ void k_copy_or_zero(const float* src, float* dst, size_t n) { b_copy_or_zero(GTID, src, dst, n); }
__global__ void k_ssd(const bf16_t* XC, const float* DT, const float* dt_bias, const float* a_log, const float* d_skip, float* Sp, float* Ss, bf16_t* YS) { b_ssd(GTID, XC, DT, dt_bias, a_log, d_skip, Sp, Ss, YS); }
__global__ void k_rwkv_prep(const bf16_t* PRW, const float* state_shift, RwkvW W, f16_t* R16, f16_t* OMW16, f16_t* K16, f16_t* V16, f16_t* KK16, f16_t* B16, bf16_t* Gb) { b_rwkv_prep(GTID, PRW, state_shift, W, R16, OMW16, K16, V16, KK16, B16, Gb); }
__global__ void k_shiftstate(const bf16_t* PRW, float* sh_p, float* sh_s) { b_shiftstate(GTID, PRW, sh_p, sh_s); }
__global__ void k_rwkv_scan(const f16_t* R16, const f16_t* OMW16, const f16_t* K16, const f16_t* V16, const f16_t* KK16, const f16_t* B16, float* Sp, float* Ss, bf16_t* YR) { b_rwkv_scan(GTID, R16, OMW16, K16, V16, KK16, B16, Sp, Ss, YR); }
__global__ void k_merge(const bf16_t* YS, const bf16_t* YR, const bf16_t* PZ, const bf16_t* PGATE, const bf16_t* Gb, const f16_t* R16, const f16_t* K16, const f16_t* V16, MergeW W, bf16_t* MERGED) { b_merge(GTID, YS, YR, PZ, PGATE, Gb, R16, K16, V16, W, MERGED); }
__global__ void k_rmsnorm_f2b(const float* X, const float* w, bf16_t* out, int nrows) { b_rmsnorm_f2b(GTID, X, w, out, nrows); }
__global__ void k_attn_scores(const bf16_t* Q, const float* kp, const float* kc, float* SC) { b_attn_scores(GTID, Q, kp, kc, SC); }
__global__ void k_attn_softmax(float* SC) { b_attn_softmax(GTID, SC); }
__global__ void k_attn_av(const float* SC, const float* vp, const float* vc, bf16_t* AO) { b_attn_av(GTID, SC, vp, vc, AO); }
__global__ void k_peer_scores(const bf16_t* PQ, const float* sub_keys, float* SCP) { b_peer_scores(GTID, PQ, sub_keys, SCP); }
__global__ void k_peer_topk(const float* SCP, float* TS, int* TI, int* IDX, float* GATE) { b_peer_topk(GTID, SCP, TS, TI, IDX, GATE); }
__global__ void k_peer_act(const bf16_t* H3, const float* eu, const int* IDX, const float* GATE, float* COEF) { b_peer_act(GTID, H3, eu, IDX, GATE, COEF); }
__global__ void k_peer_out(float* X2, const float* ev, const int* IDX, const float* COEF) { b_peer_out(GTID, X2, ev, IDX, COEF); }
__global__ void k_final(const float* X, const float* w, float* yp, float* ys) { b_final(GTID, X, w, yp, ys); }
constexpr size_t al256(size_t x) { return (x + 255) & ~(size_t)255; }
constexpr size_t cmax(size_t a, size_t b) { return a > b ? a : b; }
constexpr size_t O_WT_IN = 0;
constexpr size_t O_WT_DT = O_WT_IN + al256((size_t)NMAIN * D * 2);
constexpr size_t O_WT_OUT = O_WT_DT + al256((size_t)H_SSD * D * 2);
constexpr size_t O_WT_MK = O_WT_OUT + al256((size_t)D * D * 2);
constexpr size_t O_WT_MV = O_WT_MK + al256((size_t)D * D * 2);
constexpr size_t O_WT_MQ = O_WT_MV + al256((size_t)D * D * 2);
constexpr size_t O_WT_MO = O_WT_MQ + al256((size_t)D * D * 2);
constexpr size_t O_WT_PQ = O_WT_MO + al256((size_t)D * D * 2);
constexpr size_t O_HB = O_WT_PQ + al256((size_t)NPQ * D * 2);
constexpr size_t O_MN = O_HB + al256((size_t)MPAD * D * 2);
constexpr size_t O_PZ = O_MN + al256((size_t)NMEMROWS * D * 2);
constexpr size_t O_PXBC = O_PZ + al256((size_t)MPAD * D * 2);
constexpr size_t O_PRW = O_PXBC + al256((size_t)MPAD * CONV_DIM * 2);
constexpr size_t O_PGATE = O_PRW + al256((size_t)MPAD * RWKV_PROJ * 2);
constexpr size_t O_DT = O_PGATE + al256((size_t)MPAD * 2 * D * 2);
constexpr size_t O_XC = O_DT + al256((size_t)MT * H_SSD * 4);
constexpr size_t O_R16 = O_XC + al256(cmax((size_t)MT * CONV_DIM * 2, (size_t)MPAD * D * 2));
constexpr size_t SZ16 = al256((size_t)MT * D * 2);
constexpr size_t O_OMW16 = O_R16 + SZ16, O_K16 = O_OMW16 + SZ16, O_V16 = O_K16 + SZ16, O_KK16 = O_V16 + SZ16, O_B16 = O_KK16 + SZ16;
constexpr size_t O_T1END = O_B16 + SZ16;
constexpr size_t O_CTL = O_T1END;
constexpr size_t CTL_BYTES = 1u << 20;
constexpr size_t O_EU8 = O_CTL + CTL_BYTES;
constexpr size_t O_EV8 = O_EU8 + al256((size_t)N_EXPERTS * D);
constexpr size_t O_ESC = O_EV8 + al256((size_t)N_EXPERTS * D);
constexpr size_t O_KVB = O_ESC + al256((size_t)2 * N_EXPERTS * 4);
constexpr size_t O_SKB = O_KVB + al256((size_t)NMEMROWS * 2 * D * 2);
constexpr size_t O_LW2 = O_SKB + al256((size_t)PEER_HEADS * 2 * N_KEYS * PEER_HALF * 2);
constexpr size_t O_LA2 = O_LW2 + al256((size_t)D * W_RANK * 2);
constexpr size_t O_LG2 = O_LA2 + al256((size_t)D * A_RANK * 2);
constexpr size_t O_BON = O_LG2 + al256((size_t)D * G_RANK * 2);
constexpr size_t O_VTB = O_BON + al256((size_t)MT * H_RWKV * 4);
constexpr size_t O_END = O_VTB + al256((size_t)NMEMROWS * D * 2);
constexpr size_t O_GB = O_HB, O_YS = O_R16  , O_MERGED = O_XC, O_X1 = O_PGATE;
constexpr size_t O_H2 = O_PRW, O_QB = O_H2 + al256((size_t)MPAD * D * 2), O_AO = O_QB + al256((size_t)MPAD * D * 2);
static_assert(O_AO + al256((size_t)MPAD * D * 2) <= O_PGATE, "late overlay 1");
static_assert((size_t)MPAD * D * 4 <= (size_t)MPAD * 2 * D * 2, "X1 overlay");
constexpr size_t O_SC = O_XC, O_X2 = O_SC + al256((size_t)MT * MEM_HEADS * N_MEM * 4), O_H3 = O_X2 + al256((size_t)MPAD * D * 4), O_PQ = O_H3 + al256((size_t)MPAD * D * 2);
static_assert(O_PQ + al256((size_t)MPAD * NPQ * 2) <= O_T1END, "late overlay 2");
constexpr size_t O_TS = O_HB, O_TI = O_TS + al256((size_t)MT * PEER_HEADS * 2 * PEER_TOPK * 4);
static_assert(O_TI + al256((size_t)MT * PEER_HEADS * 2 * PEER_TOPK * 4) <= O_PZ, "topk temp overlay");
constexpr size_t O_SCP = O_PZ;
constexpr size_t O_IDX = O_SCP + al256((size_t)MT * PEER_HEADS * 2 * N_KEYS * 4), O_GATE = O_IDX + al256((size_t)MT * NSEL * 4), O_COEF = O_GATE + al256((size_t)MT * NSEL * 4);
static_assert(O_COEF + al256((size_t)MT * NSEL * 4) <= O_PGATE, "SCP/IDX/GATE/COEF overlay");

constexpr size_t OO_YP = 0, OO_YS = OO_YP + (size_t)MP * D, OO_SSMP = OO_YS + (size_t)MS * D, OO_CONVP = OO_SSMP + (size_t)BATCH * H_SSD * P_SSD * N_SSD,
    OO_WKVP = OO_CONVP + (size_t)BATCH * (CONV_K - 1) * CONV_DIM, OO_SHP = OO_WKVP + (size_t)BATCH * H_RWKV * HK * HK, OO_MKP = OO_SHP + (size_t)BATCH * RWKV_PROJ,
    OO_MVP = OO_MKP + (size_t)NMEMROWS * D, OO_SSMS = OO_MVP + (size_t)NMEMROWS * D, OO_CONVS = OO_SSMS + (size_t)DEC_BATCH * H_SSD * P_SSD * N_SSD,
    OO_WKVS = OO_CONVS + (size_t)DEC_BATCH * (CONV_K - 1) * CONV_DIM, OO_SHS = OO_WKVS + (size_t)DEC_BATCH * H_RWKV * HK * HK, OO_END = OO_SHS + (size_t)DEC_BATCH * RWKV_PROJ;
enum InIdx { I_XP = 0, I_XS, I_MEM, I_SSSM, I_SCONV, I_SWKV, I_SSHIFT, I_CK, I_CV, I_NORM_MIX, I_W_IN, I_CONV_W, I_CONV_B, I_DT_BIAS, I_A_LOG, I_D_SKIP, I_SSD_NORM, I_MU, I_W0, I_W2, I_A0, I_A2, I_G2,
    I_K_K, I_K_A, I_R_K, I_LN_W, I_LN_B, I_W_OUT, I_NORM_MEM, I_MEM_NORM, I_W_MK, I_W_MV, I_W_MQ, I_W_MO, I_NORM_FFN, I_W_PQ, I_SUBK, I_EU, I_EV, I_NORM_FINAL, N_INPUTS };

#ifndef HOST_EMU
namespace pg8 {
#define PG8_LAS __attribute__((address_space(3)))
typedef unsigned short bf16_t;
typedef short bf16x8 __attribute__((ext_vector_type(8)));
typedef float f32x4 __attribute__((ext_vector_type(4)));
typedef unsigned u32x4 __attribute__((ext_vector_type(4)));
constexpr int BM = 256, BK = 64, HALF = 128, HTB = HALF * BK * 2  , STAGE_BYTES = 8 * HTB, NXCD = 8, WGM = 8;

__host__ __device__ __forceinline__ int lds_byte(int r, int c) { const int st = (r >> 4) * 2 + (c >> 5), rr = r & 15, cc = c & 31, ob = rr * 64 + cc * 2; return st * 1024 + (ob ^ (((ob >> 9) & 1) << 5)); }
__host__ __device__ __forceinline__ void stage_rc(int b, int& R, int& C) { const int st = b / 1024, sb = b % 1024, swz = sb ^ (((sb >> 9) & 1) << 5); R = (st >> 1) * 16 + swz / 64; C = (st & 1) * 32 + (swz % 64) / 2; }
__host__ __device__ __forceinline__ int perm32(int rho) { const int n = rho >> 4, i = rho & 15; return 8 * (i >> 2) + 4 * n + (i & 3); }

struct Unit { int pm, pn; };
struct Gemm { const bf16_t* A; const bf16_t* Bt; int M, N, K; };

struct StaticOrder {
    int nM, nN, nwg, G, c;
    __host__ __device__ void init(int M, int N, int G_, int c_) { nM = M / BM; nN = N / BM; nwg = nM * nN; G = G_; c = c_; }
    __host__ __device__ bool next(int i, Unit& u) const {
        const long L = (long)i * G + c; if (L >= nwg) return false;
        int wgid = (int)L; { const int q = nwg / NXCD, r = nwg % NXCD, xcd = wgid % NXCD, off = wgid / NXCD; wgid = (xcd < r ? xcd * (q + 1) : r * (q + 1) + (xcd - r) * q) + off; }
        const int nig = WGM * nN, gid = wgid / nig, fm = gid * WGM, gsz = (nM - fm) < WGM ? (nM - fm) : WGM;
        u.pm = fm + ((wgid % nig) % gsz); u.pn = (wgid % nig) / gsz; return true;
    }
    __device__ __forceinline__ void a_ready(const Unit&) const {}
    __device__ __forceinline__ void done(const Unit&) const {}
};

__device__ __forceinline__ unsigned cvt_pk_bf16(float lo, float hi) { unsigned r; asm volatile("v_cvt_pk_bf16_f32 %0, %1, %2" : "=v"(r) : "v"(lo), "v"(hi)); return r; }
typedef float f32x2 __attribute__((ext_vector_type(2)));
template <class Epi, class Sched, bool ALIGN_EPI = false, bool SP2 = false>
__device__ __forceinline__ void gemm_phase(PG8_LAS unsigned char* lds, const Gemm g, const Sched& S, const Epi& E) {
    const int tid = threadIdx.x, wid = __builtin_amdgcn_readfirstlane(tid >> 6), lane = tid & 63, wr = wid >> 2, wc = wid & 3, fr = lane & 15, fq = lane >> 4;
    const int K = g.K, nt = K / BK;
    unsigned voffA[2], voffB[2];
#pragma unroll
    for (int i = 0; i < 2; ++i) { int R, C; stage_rc(tid * 16 + i * 8192, R, C); const int Rb = Epi::PERM ? ((R & ~31) + perm32(R & 31)) : R;
        voffA[i] = (unsigned)(R * K + C) * 2u; voffB[i] = (unsigned)(Rb * K + C) * 2u; }
    const size_t kstep = (size_t)(BK * 2);
    const size_t hstep = (size_t)HALF * K * 2;
    const size_t tstep = 2 * hstep;
    const unsigned ldsw = (unsigned)wid * 1024u;
    const int aoff = lds_byte(wr * 64 + fr, fq * 8), boff = lds_byte(wc * 32 + fr, fq * 8);
#define PG8_SA(b, h) (((b) * 2 + (h)) * HTB)
#define PG8_SB(b, h) ((4 + (b) * 2 + (h)) * HTB)
#define PG8_STAGE(bufoff, gbase, voff) do { _Pragma("unroll") for (int _i = 0; _i < 2; ++_i) \
        __builtin_amdgcn_global_load_lds((const unsigned*)((const char*)(gbase) + (voff)[_i]), (PG8_LAS unsigned*)(lds + (bufoff) + ldsw + _i * 8192), 16, 0, 0); } while (0)
#define PG8_LDA(dst, b, h) do { _Pragma("unroll") for (int m = 0; m < 4; ++m) _Pragma("unroll") for (int k = 0; k < 2; ++k) dst[m][k] = *(const PG8_LAS bf16x8*)(lds + PG8_SA(b, h) + aoff + m * 2048 + k * 1024); } while (0)
#define PG8_LDB(dst, b, h) do { _Pragma("unroll") for (int n = 0; n < 2; ++n) _Pragma("unroll") for (int k = 0; k < 2; ++k) dst[n][k] = *(const PG8_LAS bf16x8*)(lds + PG8_SB(b, h) + boff + n * 2048 + k * 1024); } while (0)
#define PG8_MMA(ai, bj, At, Bt) do { __builtin_amdgcn_s_setprio(1); _Pragma("unroll") for (int m = 0; m < 4; ++m) _Pragma("unroll") for (int n = 0; n < 2; ++n) _Pragma("unroll") for (int k = 0; k < 2; ++k) \
        acc[ai][bj][m][n] = __builtin_amdgcn_mfma_f32_16x16x32_bf16(Bt[n][k], At[m][k], acc[ai][bj][m][n], 0, 0, 0); __builtin_amdgcn_s_setprio(0); } while (0)
#define PG8_WAIT_V(n) asm volatile("s_waitcnt vmcnt(" #n ")" ::: "memory")
#define PG8_WAIT_L(n) asm volatile("s_waitcnt lgkmcnt(" #n ")" ::: "memory")
#define PG8_BAR __builtin_amdgcn_s_barrier()
#define PG8_SCHED __builtin_amdgcn_sched_barrier(0)
    Unit cur, nxt; int ui = 0;
    if (!S.next(0, cur)) return;
    f32x4 acc[2][2][4][2];
#pragma unroll
    for (int a = 0; a < 2; ++a)
#pragma unroll
        for (int b = 0; b < 2; ++b)
#pragma unroll
            for (int m = 0; m < 4; ++m)
#pragma unroll
                for (int n = 0; n < 2; ++n) acc[a][b][m][n] = (f32x4){0.f, 0.f, 0.f, 0.f};
    bf16x8 At[4][2], B0[2][2], B1[2][2];
    const char* cA = (const char*)g.A + (size_t)cur.pm * tstep; const char* cB = (const char*)g.Bt + (size_t)cur.pn * tstep;
    S.a_ready(cur);
    if constexpr (SP2) {
        PG8_STAGE(PG8_SB(0, 0), cB, voffB); PG8_STAGE(PG8_SB(0, 1), cB + hstep, voffB); PG8_STAGE(PG8_SA(0, 0), cA, voffA); PG8_STAGE(PG8_SA(0, 1), cA + hstep, voffA);
        if (wr == 1) PG8_BAR;
        PG8_WAIT_V(2); PG8_BAR;
        PG8_STAGE(PG8_SB(1, 0), cB + kstep, voffB); PG8_STAGE(PG8_SA(1, 0), cA + kstep, voffA); PG8_STAGE(PG8_SB(1, 1), cB + hstep + kstep, voffB);
        PG8_WAIT_V(6); PG8_BAR;
    } else {
        PG8_STAGE(PG8_SB(0, 0), cB, voffB); PG8_STAGE(PG8_SA(0, 0), cA, voffA); PG8_STAGE(PG8_SB(0, 1), cB + hstep, voffB); PG8_STAGE(PG8_SA(0, 1), cA + hstep, voffA);
        if (wr == 1) PG8_BAR;
        PG8_WAIT_V(4); PG8_BAR;
        PG8_STAGE(PG8_SB(1, 0), cB + kstep, voffB); PG8_STAGE(PG8_SA(1, 0), cA + kstep, voffA); PG8_STAGE(PG8_SB(1, 1), cB + hstep + kstep, voffB);
        PG8_WAIT_V(6); PG8_BAR;
    }
    for (;;) {
        const bool has_next = S.next(ui + 1, nxt);
        const char* nA = has_next ? (const char*)g.A + (size_t)nxt.pm * tstep : cA; const char* nB = has_next ? (const char*)g.Bt + (size_t)nxt.pn * tstep : cB;
        for (int t = 0; t < nt; t += 2) {
            const bool last = (t == nt - 2);
            const char* a1 = cA + (size_t)(t + 1) * kstep;
            const char* a2 = last ? nA : cA + (size_t)(t + 2) * kstep; const char* b2 = last ? nB : cB + (size_t)(t + 2) * kstep;
            const char* a3 = a2 + kstep; const char* b3 = b2 + kstep;
            if (last && has_next) S.a_ready(nxt);
            if constexpr (SP2) {
            PG8_LDB(B0, 0, 0); PG8_LDB(B1, 0, 1); PG8_SCHED; PG8_LDA(At, 0, 0); PG8_STAGE(PG8_SA(1, 1), a1 + hstep, voffA);
            PG8_WAIT_V(8); PG8_WAIT_L(0); PG8_BAR; PG8_MMA(0, 0, At, B0); PG8_MMA(0, 1, At, B1); PG8_BAR; PG8_SCHED;
            PG8_LDA(At, 0, 1); PG8_STAGE(PG8_SB(0, 0), b2, voffB); PG8_STAGE(PG8_SB(0, 1), b2 + hstep, voffB); PG8_STAGE(PG8_SA(0, 0), a2, voffA);
            PG8_WAIT_V(8); PG8_WAIT_L(0); PG8_BAR; PG8_MMA(1, 0, At, B0); PG8_MMA(1, 1, At, B1); PG8_BAR; PG8_SCHED;
            PG8_LDB(B0, 1, 0); PG8_LDB(B1, 1, 1); PG8_SCHED; PG8_LDA(At, 1, 0); PG8_STAGE(PG8_SA(0, 1), a2 + hstep, voffA);
            PG8_WAIT_V(8); PG8_WAIT_L(0); PG8_BAR; PG8_MMA(0, 0, At, B0); PG8_MMA(0, 1, At, B1); PG8_BAR; PG8_SCHED;
            PG8_LDA(At, 1, 1); PG8_STAGE(PG8_SB(1, 0), b3, voffB); PG8_STAGE(PG8_SB(1, 1), b3 + hstep, voffB); PG8_STAGE(PG8_SA(1, 0), a3, voffA);
            PG8_WAIT_V(8); PG8_WAIT_L(0); PG8_BAR; PG8_MMA(1, 0, At, B0); PG8_MMA(1, 1, At, B1); PG8_BAR; PG8_SCHED;
            } else {
            PG8_LDB(B0, 0, 0); PG8_SCHED; PG8_LDA(At, 0, 0); PG8_STAGE(PG8_SA(1, 1), a1 + hstep, voffA);
            PG8_WAIT_L(8); PG8_BAR; PG8_WAIT_L(0); PG8_MMA(0, 0, At, B0); PG8_BAR; PG8_SCHED;
            PG8_LDB(B1, 0, 1); PG8_STAGE(PG8_SB(0, 0), b2, voffB);
            PG8_BAR; PG8_WAIT_L(0); PG8_MMA(0, 1, At, B1); PG8_BAR;
            PG8_LDA(At, 0, 1); PG8_STAGE(PG8_SA(0, 0), a2, voffA);
            PG8_BAR; PG8_WAIT_L(0); PG8_MMA(1, 0, At, B0); PG8_BAR; PG8_SCHED;
            PG8_STAGE(PG8_SB(0, 1), b2 + hstep, voffB);
            PG8_WAIT_V(6); PG8_BAR; PG8_MMA(1, 1, At, B1); PG8_BAR;
            PG8_LDB(B0, 1, 0); PG8_SCHED; PG8_LDA(At, 1, 0); PG8_STAGE(PG8_SA(0, 1), a2 + hstep, voffA);
            PG8_WAIT_L(8); PG8_BAR; PG8_WAIT_L(0); PG8_MMA(0, 0, At, B0); PG8_BAR; PG8_SCHED;
            PG8_LDB(B1, 1, 1); PG8_STAGE(PG8_SB(1, 0), b3, voffB);
            PG8_BAR; PG8_WAIT_L(0); PG8_MMA(0, 1, At, B1); PG8_BAR;
            PG8_LDA(At, 1, 1); PG8_STAGE(PG8_SA(1, 0), a3, voffA);
            PG8_BAR; PG8_WAIT_L(0); PG8_MMA(1, 0, At, B0); PG8_BAR; PG8_SCHED;
            PG8_STAGE(PG8_SB(1, 1), b3 + hstep, voffB);
            PG8_WAIT_V(6); PG8_BAR; PG8_MMA(1, 1, At, B1); PG8_BAR;
            }
        }
        if constexpr (ALIGN_EPI) { if (wr == 0) PG8_BAR; }
        if constexpr (!Epi::AFTER_DRAIN) { E(acc, cur, wr, wc, fr, fq); S.done(cur); }
        if (!has_next) break;
#pragma unroll
        for (int a = 0; a < 2; ++a)
#pragma unroll
            for (int b = 0; b < 2; ++b)
#pragma unroll
                for (int m = 0; m < 4; ++m)
#pragma unroll
                    for (int n = 0; n < 2; ++n) acc[a][b][m][n] = (f32x4){0.f, 0.f, 0.f, 0.f};
        cur = nxt; cA = nA; cB = nB; ++ui;
        if constexpr (ALIGN_EPI) { if (wr == 1) PG8_BAR; }
    }
    PG8_WAIT_V(0);
    if constexpr (!ALIGN_EPI) { if (wr == 0) PG8_BAR; }
    PG8_BAR;
    if constexpr (Epi::AFTER_DRAIN) { E.fused(acc, cur, wr, wc, fr, fq, lds, wid, lane); S.done(cur); }
#undef PG8_SA
#undef PG8_SB
#undef PG8_STAGE
#undef PG8_LDA
#undef PG8_LDB
#undef PG8_MMA
#undef PG8_WAIT_V
#undef PG8_WAIT_L
#undef PG8_BAR
#undef PG8_SCHED
}
}

namespace pg8 {
struct EpiProj {
    static constexpr bool PERM = true, AFTER_DRAIN = false;
    bf16_t *PZ, *PXBC, *PRW, *PGATE;
    __device__ __forceinline__ void operator()(const f32x4 (&acc)[2][2][4][2], const Unit& u, int wr, int wc, int fr, int fq) const {
        constexpr int T0 = D / 256, T1 = T0 + CONV_DIM / 256, T2 = T1 + RWKV_PROJ / 256;
        bf16_t* base; int ldc, colt;
        if (u.pn < T0) { base = PZ; ldc = D; colt = u.pn * BM; }
        else if (u.pn < T1) { base = PXBC; ldc = CONV_DIM; colt = (u.pn - T0) * BM; }
        else if (u.pn < T2) { base = PRW; ldc = RWKV_PROJ; colt = (u.pn - T1) * BM; }
        else { base = PGATE; ldc = 2 * D; colt = (u.pn - T2) * BM; }
        const int row0 = u.pm * BM + wr * 64 + fr, col0 = colt + wc * 32 + 8 * fq;
#pragma unroll
        for (int ai = 0; ai < 2; ++ai)
#pragma unroll
            for (int m = 0; m < 4; ++m) { bf16_t* rowp = base + (size_t)(row0 + ai * HALF + m * 16) * ldc + col0;
#pragma unroll
                for (int bj = 0; bj < 2; ++bj) { const f32x4 v0 = acc[ai][bj][m][0], v1 = acc[ai][bj][m][1];
                    u32x4 w; w.x = cvt_pk_bf16(v0[0], v0[1]); w.y = cvt_pk_bf16(v0[2], v0[3]); w.z = cvt_pk_bf16(v1[0], v1[1]); w.w = cvt_pk_bf16(v1[2], v1[3]);
                    *(u32x4*)(rowp + bj * HALF) = w; } }
    }
};
struct EpiB16 {
    static constexpr bool PERM = true, AFTER_DRAIN = false;
    bf16_t* O; int ldc;
    __device__ __forceinline__ void operator()(const f32x4 (&acc)[2][2][4][2], const Unit& u, int wr, int wc, int fr, int fq) const {
        const int row0 = u.pm * BM + wr * 64 + fr, col0 = u.pn * BM + wc * 32 + 8 * fq;
#pragma unroll
        for (int ai = 0; ai < 2; ++ai)
#pragma unroll
            for (int m = 0; m < 4; ++m) { bf16_t* rowp = O + (size_t)(row0 + ai * HALF + m * 16) * ldc + col0;
#pragma unroll
                for (int bj = 0; bj < 2; ++bj) { const f32x4 v0 = acc[ai][bj][m][0], v1 = acc[ai][bj][m][1];
                    u32x4 w; w.x = cvt_pk_bf16(v0[0], v0[1]); w.y = cvt_pk_bf16(v0[2], v0[3]); w.z = cvt_pk_bf16(v1[0], v1[1]); w.w = cvt_pk_bf16(v1[2], v1[3]);
                    *(u32x4*)(rowp + bj * HALF) = w; } }
    }
};
struct EpiKV {
    static constexpr bool PERM = false, AFTER_DRAIN = false;
    float *mk, *mv; bf16_t* kvb; bf16_t* vtb;
    __device__ __forceinline__ void operator()(const f32x4 (&acc)[2][2][4][2], const Unit& u, int wr, int wc, int fr, int fq) const {
        const int row0 = u.pm * BM + wr * 64 + fr, col0 = u.pn * BM + wc * 32 + 4 * fq;
        float* ob = col0 < D ? mk : mv; const int colo = col0 < D ? col0 : col0 - D;
#pragma unroll
        for (int ai = 0; ai < 2; ++ai)
#pragma unroll
            for (int m = 0; m < 4; ++m) { const size_t r = (size_t)(row0 + ai * HALF + m * 16);
#pragma unroll
                for (int bj = 0; bj < 2; ++bj)
#pragma unroll
                    for (int n = 0; n < 2; ++n) { const f32x4 v = acc[ai][bj][m][n];
                        *(f32x4*)(ob + r * D + colo + bj * HALF + n * 16) = v;
                        typedef unsigned u32x2 __attribute__((ext_vector_type(2))); u32x2 w; w.x = cvt_pk_bf16(v[0], v[1]); w.y = cvt_pk_bf16(v[2], v[3]);
                        *(u32x2*)(kvb + r * 2 * D + col0 + bj * HALF + n * 16) = w;
                        if (col0 >= D) { const int cc = colo + bj * HALF + n * 16, hh_ = cc / MEM_HD, dd = cc % MEM_HD; const size_t bb_ = r / N_MEM, mm = r % N_MEM;
                            bf16_t* vp = vtb + ((bb_ * MEM_HEADS + hh_) * MEM_HD + dd) * N_MEM + mm;
                            vp[0] = (bf16_t)(w.x & 0xffffu); vp[N_MEM] = (bf16_t)(w.x >> 16); vp[2 * N_MEM] = (bf16_t)(w.y & 0xffffu); vp[3 * N_MEM] = (bf16_t)(w.y >> 16); } } }
    }
};
struct EpiRes {
    static constexpr bool PERM = false, AFTER_DRAIN = false;
    const float* base0; const float* base1; int split; float* out; int nrows;
    __device__ __forceinline__ void operator()(const f32x4 (&acc)[2][2][4][2], const Unit& u, int wr, int wc, int fr, int fq) const {
        const int row0 = u.pm * BM + wr * 64 + fr, col0 = u.pn * BM + wc * 32 + 4 * fq;
#pragma unroll
        for (int ai = 0; ai < 2; ++ai)
#pragma unroll
            for (int m = 0; m < 4; ++m) { const int r = row0 + ai * HALF + m * 16; if (r < nrows) {
                const float* bp = r < split ? base0 + (size_t)r * D : base1 + (size_t)(r - split) * D;
#pragma unroll
                for (int bj = 0; bj < 2; ++bj)
#pragma unroll
                    for (int n = 0; n < 2; ++n) { const int c = col0 + bj * HALF + n * 16; *(f32x4*)(out + (size_t)r * D + c) = *(const f32x4*)(bp + c) + acc[ai][bj][m][n]; } } }
    }
};
}

#define GAS __attribute__((address_space(1)))
#define LAS __attribute__((address_space(3)))
typedef unsigned v4u __attribute__((ext_vector_type(4)));
typedef float f32x4 __attribute__((ext_vector_type(4)));
typedef GAS unsigned gu32;
#define RLX_AGENT __ATOMIC_RELAXED, __HIP_MEMORY_SCOPE_AGENT
#define LDS_WAIT() asm volatile("s_waitcnt lgkmcnt(0)" ::: "memory")
#define VM_WAIT() asm volatile("s_waitcnt vmcnt(0)" ::: "memory")
#define XB_TMO      128
#define XB_XCNT(j)  (256  + 64 * (j))
#define XB_XSUB(j)  (1280 + 64 * (j))
#define XB_XGEN(j)  (2304 + 64 * (j))
#define XB_TOP      3328
#define XB_TOPGEN   3392
#define XCD_BAR_WORDS 3456
#define XB_SPIN_CAP (1u << 30)

__device__ __forceinline__ unsigned xb_ld(unsigned* p)              { return __hip_atomic_load(p, __ATOMIC_RELAXED, __HIP_MEMORY_SCOPE_AGENT); }
__device__ __forceinline__ unsigned xb_add(unsigned* p, unsigned v) { return __hip_atomic_fetch_add(p, v, __ATOMIC_RELAXED, __HIP_MEMORY_SCOPE_AGENT); }
__device__ __forceinline__ unsigned xb_xcc_id() { return (unsigned)__builtin_amdgcn_s_getreg((3 << 11) | 20) & 0xFu; }
#define XB_SPIN(cond, bar) do { unsigned _sp = 0; while (cond) { __builtin_amdgcn_s_sleep(1); \
    if ((++_sp & 255u) == 0u) { if (xb_ld(&(bar)[XB_TMO])) break; if (_sp > XB_SPIN_CAP) { atomicAdd(&(bar)[XB_TMO], 1u); break; } } } } while (0)

struct XcdBarrier {
    unsigned* bar; unsigned x;
    volatile LAS unsigned* st;
};

__device__ __forceinline__ XcdBarrier xcd_barrier_post(unsigned* bar, volatile LAS unsigned* st) {
    XcdBarrier b; b.bar = bar; b.x = xb_xcc_id(); b.st = st;
    if (threadIdx.x == 0) (void)xb_add(&bar[XB_XCNT(b.x)], 1u);
    return b;
}
__device__ __forceinline__ void xcd_barrier_complete(unsigned* bar, unsigned x, unsigned& nloc, unsigned& nx) {
    const unsigned G = gridDim.x * gridDim.y * gridDim.z;
    unsigned sum, cnt, mine, sp = 0u;
    for (;;) {
        sum = 0u; cnt = 0u; mine = 0u;
#pragma unroll
        for (unsigned j = 0; j < 16; ++j) { const unsigned c = xb_ld(&bar[XB_XCNT(j)]); sum += c; cnt += (c > 0u) ? 1u : 0u; mine = (j == x) ? c : mine; }
        if (sum == G) break;
        __builtin_amdgcn_s_sleep(1);
        if ((++sp & 255u) == 0u) { if (xb_ld(&bar[XB_TMO])) break; if (sp > XB_SPIN_CAP) { atomicAdd(&bar[XB_TMO], 1u); break; } }
    }
    nloc = mine > 0u ? mine : 1u; nx = cnt > 0u ? cnt : 1u;
}

__device__ __forceinline__ void xcd_barrier(const XcdBarrier& b) {
    asm volatile("s_waitcnt vmcnt(0)" ::: "memory");
    __syncthreads();
    if (threadIdx.x == 0) {
        unsigned* bar = b.bar;
        __builtin_amdgcn_s_waitcnt(0);
        unsigned nloc = b.st[0], nx = b.st[1];
        if (nloc == 0u) { xcd_barrier_complete(bar, b.x, nloc, nx); b.st[0] = nloc; b.st[1] = nx; }
        const unsigned old = xb_add(&bar[XB_XSUB(b.x)], 1u);
        const unsigned gen = old / nloc;
        if (old + 1u == (gen + 1u) * nloc) {
            __builtin_amdgcn_fence(__ATOMIC_RELEASE, "agent");
            asm volatile("s_waitcnt vmcnt(0)" ::: "memory");
            const unsigned og = xb_add(&bar[XB_TOP], 1u);
            const unsigned tg = og / nx;
            if (og + 1u == (tg + 1u) * nx) xb_add(&bar[XB_TOPGEN], 1u);
            else XB_SPIN(xb_ld(&bar[XB_TOPGEN]) == tg, bar);
            __builtin_amdgcn_fence(__ATOMIC_ACQUIRE, "agent");
            xb_add(&bar[XB_XGEN(b.x)], 1u);
            asm volatile("s_waitcnt vmcnt(0)" ::: "memory");
        } else {
            XB_SPIN(xb_ld(&bar[XB_XGEN(b.x)]) == gen, bar);
            __builtin_amdgcn_fence(__ATOMIC_ACQUIRE, "agent");
            asm volatile("s_waitcnt vmcnt(0)" ::: "memory");
        }
    }
    __syncthreads();
}


constexpr int NWAVES = 8, NTHREADS = NWAVES * 64;
constexpr int LDS_BYTES = 163840, LDSCTL_OFF = LDS_BYTES - 1024;
constexpr int CW_BAR = 4096;

enum Phase { PH_PREP = 0, PH_INPROJ, PH_MIXA, PH_SCAN, PH_MERGE, PH_OUT, PH_NORM2, PH_Q, PH_ATT1, PH_O, PH_NORM3, PH_PQ, PH_PK1, PH_PEER, N_PHASES };
constexpr int MAX_LAUNCHES = 16;
#define GS_LOOP(n, call) do { for (size_t i_ = (size_t)bx * NTHREADS + tid; i_ < (size_t)(n); i_ += (size_t)G * NTHREADS) { call; } } while (0)

__device__ __forceinline__ unsigned pk2(float lo, float hi) { return (unsigned)f2bf(lo) | ((unsigned)f2bf(hi) << 16); }
__device__ __forceinline__ float wave_sum(float v) {
#pragma unroll
    for (int o = 1; o < 64; o <<= 1) v += __shfl_xor(v, o);
    return v;
}
__device__ __forceinline__ float wave_max(float v) {
#pragma unroll
    for (int o = 1; o < 64; o <<= 1) v = fmaxf(v, __shfl_xor(v, o));
    return v;
}

struct MkArgs { const float* in[N_INPUTS]; float* out; unsigned char* ws; int ph_lo, ph_hi, bar_idx, pad; };
static_assert((CW_BAR + MAX_LAUNCHES * XCD_BAR_WORDS) * 4 <= (int)CTL_BYTES, "ctl");

__device__ __forceinline__ void p0_transpose_item(const float* W, int K, int ldw, int srccol0, bf16_t* WT, int row0, LAS float* scr, int kb, int lane) {
    const int k0 = 64 * kb;
#pragma unroll 8
    for (int i = 0; i < 32; ++i) { const int kk = 2 * i + (lane >> 5); scr[kk * 33 + (lane & 31)] = W[(size_t)(k0 + kk) * ldw + srccol0 + (lane & 31)]; }
    LDS_WAIT(); asm volatile("" ::: "memory");
    const int c = lane & 7;
#pragma unroll
    for (int j = 0; j < 4; ++j) { const int n = (lane >> 3) + 8 * j; const LAS float* s = scr + (8 * c) * 33 + n;
        v4u o; o.x = pk2(s[0 * 33], s[1 * 33]); o.y = pk2(s[2 * 33], s[3 * 33]); o.z = pk2(s[4 * 33], s[5 * 33]); o.w = pk2(s[6 * 33], s[7 * 33]);
        *(v4u*)(WT + (size_t)(row0 + n) * K + k0 + 8 * c) = o; }
    LDS_WAIT(); asm volatile("" ::: "memory");
}
template <bool WITH_DT>
__device__ __forceinline__ void norm_row(const float* xrow, const float* w, bf16_t* orow, const float* w_in, float* dtrow, int lane) {
    static_assert(D == 1024, "norm_row is written for D = 1024");
    const f32x4* xr = (const f32x4*)xrow + lane; const f32x4* wr4 = (const f32x4*)w + lane;
    f32x4 v[4]; float s = 0.f;
#pragma unroll
    for (int j = 0; j < 4; ++j) { v[j] = xr[64 * j]; s += (v[j].x * v[j].x + v[j].y * v[j].y) + (v[j].z * v[j].z + v[j].w * v[j].w); }
    const float rs = 1.f / sqrtf(wave_sum(s) * (1.f / D) + NORM_EPS);
    unsigned long long* o8 = (unsigned long long*)orow + lane;
#pragma unroll
    for (int j = 0; j < 4; ++j) { v[j] = v[j] * rs * wr4[64 * j]; o8[64 * j] = (unsigned long long)pk2(v[j].x, v[j].y) | ((unsigned long long)pk2(v[j].z, v[j].w) << 32); }
    if constexpr (WITH_DT) {
        static_assert(H_SSD == 16, "dt path is written for 16 heads");
        f32x4 acc[4] = {{0.f, 0.f, 0.f, 0.f}, {0.f, 0.f, 0.f, 0.f}, {0.f, 0.f, 0.f, 0.f}, {0.f, 0.f, 0.f, 0.f}};
#pragma unroll
        for (int j = 0; j < 4; ++j)
#pragma unroll
            for (int i = 0; i < 4; ++i) { const int k = 4 * (64 * j + lane) + i; const f32x4* wp = (const f32x4*)(w_in + (size_t)k * D_IN + D + CONV_DIM); const float h = v[j][i];
#pragma unroll
                for (int q = 0; q < 4; ++q) acc[q] += wp[q] * h; }
        float mine = 0.f;
#pragma unroll
        for (int q = 0; q < 4; ++q)
#pragma unroll
            for (int e = 0; e < 4; ++e) { const float t = wave_sum(acc[q][e]); if (lane == 4 * q + e) mine = t; }
        if (lane < 16) dtrow[lane] = mine;
    }
}
__device__ __forceinline__ void fp8_row(const float* src, unsigned char* dst, float* inv, int lane) {
    static_assert(D == 1024, "fp8_row is written for D = 1024");
    const f32x4* s4 = (const f32x4*)src + 4 * lane; f32x4 v[4]; float am = 0.f;
#pragma unroll
    for (int j = 0; j < 4; ++j) { v[j] = s4[j]; am = fmaxf(am, fmaxf(fmaxf(fabsf(v[j].x), fabsf(v[j].y)), fmaxf(fabsf(v[j].z), fabsf(v[j].w)))); }
    am = wave_max(am); const float sc = am > 0.f ? 224.f / am : 1.f;
    v4u o;
#pragma unroll
    for (int j = 0; j < 4; ++j) { int p = __builtin_amdgcn_cvt_pk_fp8_f32(v[j].x * sc, v[j].y * sc, 0, false); p = __builtin_amdgcn_cvt_pk_fp8_f32(v[j].z * sc, v[j].w * sc, p, true); o[j] = (unsigned)p; }
    *((v4u*)dst + lane) = o;
    if (lane == 0) *inv = am > 0.f ? am / 224.f : 1.f;
}

typedef float f32x2v __attribute__((ext_vector_type(2)));
#define FP8X4_FMA_DOT(accv, w, xb) do { const f32x2v lo_ = __builtin_amdgcn_cvt_pk_f32_fp8((int)(w), false), hi_ = __builtin_amdgcn_cvt_pk_f32_fp8((int)(w), true); \
    accv = fmaf(lo_.x, x[(xb)], accv); accv = fmaf(lo_.y, x[(xb) + 1], accv); accv = fmaf(hi_.x, x[(xb) + 2], accv); accv = fmaf(hi_.y, x[(xb) + 3], accv); } while (0)
#define FP8X4_AXPY(w, c, ob) do { const f32x2v lo_ = __builtin_amdgcn_cvt_pk_f32_fp8((int)(w), false), hi_ = __builtin_amdgcn_cvt_pk_f32_fp8((int)(w), true); \
    acc[(ob)] = fmaf(lo_.x, (c), acc[(ob)]); acc[(ob) + 1] = fmaf(lo_.y, (c), acc[(ob) + 1]); acc[(ob) + 2] = fmaf(hi_.x, (c), acc[(ob) + 2]); acc[(ob) + 3] = fmaf(hi_.y, (c), acc[(ob) + 3]); } while (0)
__device__ __forceinline__ void peer_token(int t, const bf16_t* H3, const int* IDX, const float* GATE, const unsigned char* EU8, const unsigned char* EV8, const float* ESC,
                                           const float* X2, const float* wfin, float* yout, int lane) {
    static_assert(D == 1024 && PEER_TOPK == 16 && PEER_HEADS == 8, "peer_token is written for D = 1024, 8 heads x 16 experts");
    float x[16], acc[16];
    { const v4u a = *((const v4u*)(H3 + (size_t)t * D) + 2 * lane), b = *((const v4u*)(H3 + (size_t)t * D) + 2 * lane + 1);
#pragma unroll
      for (int j = 0; j < 4; ++j) { x[2 * j] = __uint_as_float(a[j] << 16); x[2 * j + 1] = __uint_as_float(a[j] & 0xffff0000u); x[8 + 2 * j] = __uint_as_float(b[j] << 16); x[8 + 2 * j + 1] = __uint_as_float(b[j] & 0xffff0000u); } }
#pragma unroll
    for (int j = 0; j < 16; ++j) acc[j] = 0.f;
    const int idx_lo = IDX[(size_t)t * NSEL + lane], idx_hi = IDX[(size_t)t * NSEL + 64 + lane];
    const float gate_lo = GATE[(size_t)t * NSEL + lane], gate_hi = GATE[(size_t)t * NSEL + 64 + lane];
    const int me = (lane >> 2) & 15;
    v4u B0[8], B1[8];
#define PEER_ROW(tab, hh, e) ((const v4u*)((tab) + (size_t)(unsigned)__builtin_amdgcn_readlane((hh) < 4 ? idx_lo : idx_hi, ((hh) & 3) * 16 + (e)) * D) + lane)
#pragma unroll
    for (int e = 0; e < 8; ++e) B0[e] = *PEER_ROW(EU8, 0, e);
#pragma unroll 1
    for (int h = 0; h < PEER_HEADS; ++h) {
        float p[16];
#pragma unroll
        for (int e = 0; e < 8; ++e) B1[e] = *PEER_ROW(EU8, h, 8 + e);
#pragma unroll
        for (int e = 0; e < 8; ++e) { float a = 0.f; FP8X4_FMA_DOT(a, B0[e][0], 0); FP8X4_FMA_DOT(a, B0[e][1], 4); FP8X4_FMA_DOT(a, B0[e][2], 8); FP8X4_FMA_DOT(a, B0[e][3], 12); p[e] = a; }
#pragma unroll
        for (int e = 0; e < 8; ++e) B0[e] = *PEER_ROW(EV8, h, e);
#pragma unroll
        for (int e = 0; e < 8; ++e) { float a = 0.f; FP8X4_FMA_DOT(a, B1[e][0], 0); FP8X4_FMA_DOT(a, B1[e][1], 4); FP8X4_FMA_DOT(a, B1[e][2], 8); FP8X4_FMA_DOT(a, B1[e][3], 12); p[8 + e] = a; }
#pragma unroll
        for (int e = 0; e < 8; ++e) B1[e] = *PEER_ROW(EV8, h, 8 + e);
#pragma unroll
        for (int i = 0; i < 8; ++i) { const bool up = lane & 32; const float keep = up ? p[i + 8] : p[i], send = up ? p[i] : p[i + 8]; p[i] = keep + __shfl_xor(send, 32); }
#pragma unroll
        for (int i = 0; i < 4; ++i) { const bool up = lane & 16; const float keep = up ? p[i + 4] : p[i], send = up ? p[i] : p[i + 4]; p[i] = keep + __shfl_xor(send, 16); }
#pragma unroll
        for (int i = 0; i < 2; ++i) { const bool up = lane & 8; const float keep = up ? p[i + 2] : p[i], send = up ? p[i] : p[i + 2]; p[i] = keep + __shfl_xor(send, 8); }
        { const bool up = lane & 4; const float keep = up ? p[1] : p[0], send = up ? p[0] : p[1]; p[0] = keep + __shfl_xor(send, 4); }
        p[0] += __shfl_xor(p[0], 1); p[0] += __shfl_xor(p[0], 2);
        const int src = (h & 3) * 16 + me;
        const int myidx = __shfl(h < 4 ? idx_lo : idx_hi, src); const float gt = __shfl(h < 4 ? gate_lo : gate_hi, src);
        const float su = ESC[myidx], sv = ESC[N_EXPERTS + myidx];
        const float coef = gt * geluf(p[0] * su) * sv;
#pragma unroll
        for (int e = 0; e < 8; ++e) { const float c = __uint_as_float(__builtin_amdgcn_readlane(__float_as_uint(coef), 4 * e));
            FP8X4_AXPY(B0[e][0], c, 0); FP8X4_AXPY(B0[e][1], c, 4); FP8X4_AXPY(B0[e][2], c, 8); FP8X4_AXPY(B0[e][3], c, 12); }
        if (h + 1 < PEER_HEADS) {
#pragma unroll
            for (int e = 0; e < 8; ++e) B0[e] = *PEER_ROW(EU8, h + 1, e);
        }
#pragma unroll
        for (int e = 0; e < 8; ++e) { const float c = __uint_as_float(__builtin_amdgcn_readlane(__float_as_uint(coef), 32 + 4 * e));
            FP8X4_AXPY(B1[e][0], c, 0); FP8X4_AXPY(B1[e][1], c, 4); FP8X4_AXPY(B1[e][2], c, 8); FP8X4_AXPY(B1[e][3], c, 12); }
    }
#undef PEER_ROW
    const f32x4* x2 = (const f32x4*)(X2 + (size_t)t * D) + 4 * lane; const f32x4* wf = (const f32x4*)wfin + 4 * lane; f32x4 r[4]; float ss = 0.f;
#pragma unroll
    for (int j = 0; j < 4; ++j) { r[j] = x2[j]; r[j].x += acc[4 * j]; r[j].y += acc[4 * j + 1]; r[j].z += acc[4 * j + 2]; r[j].w += acc[4 * j + 3]; ss += (r[j].x * r[j].x + r[j].y * r[j].y) + (r[j].z * r[j].z + r[j].w * r[j].w); }
    const float rs = 1.f / sqrtf(wave_sum(ss) * (1.f / D) + NORM_EPS);
    f32x4* yo = (f32x4*)yout + 4 * lane;
#pragma unroll
    for (int j = 0; j < 4; ++j) yo[j] = r[j] * rs * wf[j];
}

__device__ __forceinline__ float fmix_lo(float a, unsigned pk, float c) { float d; asm("v_fma_mix_f32 %0, %1, %2, %3 op_sel_hi:[0,1,0]" : "=v"(d) : "v"(a), "v"(pk), "v"(c)); return d; }
__device__ __forceinline__ float fmix_hi(float a, unsigned pk, float c) { float d; asm("v_fma_mix_f32 %0, %1, %2, %3 op_sel:[0,1,0] op_sel_hi:[0,1,0]" : "=v"(d) : "v"(a), "v"(pk), "v"(c)); return d; }
__device__ __forceinline__ float rowsum16(float v) {
    v += __builtin_bit_cast(float, __builtin_amdgcn_update_dpp(0, __builtin_bit_cast(int, v), 0xB1, 0xF, 0xF, true));
    v += __builtin_bit_cast(float, __builtin_amdgcn_update_dpp(0, __builtin_bit_cast(int, v), 0x4E, 0xF, 0xF, true));
    v += __builtin_bit_cast(float, __builtin_amdgcn_update_dpp(0, __builtin_bit_cast(int, v), 0x141, 0xF, 0xF, true));
    v += __builtin_bit_cast(float, __builtin_amdgcn_update_dpp(0, __builtin_bit_cast(int, v), 0x140, 0xF, 0xF, true));
    return v;
}
__device__ __forceinline__ unsigned pkh2(float lo, float hi) { typedef _Float16 h2 __attribute__((ext_vector_type(2))); h2 v; v.x = (_Float16)lo; v.y = (_Float16)hi; return __builtin_bit_cast(unsigned, v); }
__device__ __forceinline__ float fsigmoid(float x) { return __builtin_amdgcn_rcpf(1.f + __expf(-x)); }
namespace rw {
constexpr int CH = 64;
constexpr int L_W2H = 0, L_A2H = 9216, L_CST = 18432, L_MU = 19712, L_OMW = 20992, L_KK = 29184, L_BB = 37376, L_KH = 45568, L_RR = 53760, L_VV = 61952, L_YO = 66048,
              L_AW = 70144, L_AA = 79360, L_RAW = 88576, L_END = L_RAW + (CH + 1) * 640;
static_assert(L_END <= LDSCTL_OFF, "rwkv LDS map");
constexpr int NPIECE = (CH + 1) * 40;
}
typedef unsigned u32x2 __attribute__((ext_vector_type(2)));
struct RwkvIn { const bf16_t* PRW; const bf16_t* LW2; const bf16_t* LA2; const float *mu, *w0, *a0, *k_k, *k_a, *r_k; bf16_t* YR; float* BON; float* state_out; };

__device__ __forceinline__ void rwkv_scan_unit(LAS unsigned char* lds, const RwkvIn& I, int b, int h, int half, int tid) {
    using namespace rw;
    static_assert(D == 1024 && HK == 64 && W_RANK == 64 && A_RANK == 64 && SEQ % CH == 0, "rwkv_scan_unit shapes");
    const int lane = tid & 63, w = tid >> 6, kg = lane & 15, r = 4 * w + (lane >> 4);
    const int segcol[5] = {h * HK, D + h * HK, 2 * D + h * HK, 3 * D, 3 * D + W_RANK};
    { const int row = tid >> 3, pc = tid & 7;
      *(v4u*)(lds + L_W2H + row * 144 + pc * 16) = *(const v4u*)(I.LW2 + (size_t)(h * HK + row) * W_RANK + pc * 8);
      *(v4u*)(lds + L_A2H + row * 144 + pc * 16) = *(const v4u*)(I.LA2 + (size_t)(h * HK + row) * A_RANK + pc * 8); }
    if (tid < 320) { const int s = tid >> 6, c = tid & 63; const int gc = (s == 0 ? h * HK : s == 1 ? D + h * HK : s == 2 ? 2 * D + h * HK : s == 3 ? 3 * D : 3 * D + W_RANK) + c;
        ((LAS float*)(lds + L_MU))[tid] = I.mu[gc];
        const float* src = s == 0 ? I.w0 : s == 1 ? I.a0 : s == 2 ? I.k_k : s == 3 ? I.k_a : I.r_k;
        ((LAS float*)(lds + L_CST))[tid] = src[h * HK + c]; }
    float S[4] = {0.f, 0.f, 0.f, 0.f};
    v4u G[6];
    const size_t row0 = (size_t)b * SEQ;
    auto issue_loads = [&](int c) {
#pragma unroll
        for (int i = 0; i < 6; ++i) { const int pid = tid + 512 * i; v4u z = {0u, 0u, 0u, 0u}; G[i] = z;
            if (pid < NPIECE) { const int rr = pid / 40, sp = pid % 40, sg = sp >> 3, pc = sp & 7; const int t = c * CH + rr - 1;
                const int col = (sg == 0 ? h * HK : sg == 1 ? D + h * HK : sg == 2 ? 2 * D + h * HK : sg == 3 ? 3 * D : 3 * D + W_RANK) + pc * 8;
                if (t >= 0) G[i] = *(const v4u*)(I.PRW + (row0 + t) * RWKV_PROJ + col); } }
    };
    (void)segcol;
    issue_loads(0);
    __syncthreads();
    for (int c = 0; c <= SEQ / CH; ++c) {
        if (c > 0) {
            const LAS unsigned char* pO = lds + L_OMW + kg * 8; const LAS _Float16* pV = (const LAS _Float16*)(lds + L_VV) + r;
            LAS bf16_t* pY = (LAS bf16_t*)(lds + L_YO) + r;
#pragma unroll 2
            for (int t = 0; t < CH; ++t) {
                const u32x2 no = *(const LAS u32x2*)(pO + t * 128), kk = *(const LAS u32x2*)(pO + (L_KK - L_OMW) + t * 128), nb = *(const LAS u32x2*)(pO + (L_BB - L_OMW) + t * 128),
                            kh = *(const LAS u32x2*)(pO + (L_KH - L_OMW) + t * 128), rr = *(const LAS u32x2*)(pO + (L_RR - L_OMW) + t * 128);
                const float vv = (float)pV[t * 32];
                float sa = fmix_lo(S[0], kk.x, 0.f); sa = fmix_hi(S[1], kk.x, sa); sa = fmix_lo(S[2], kk.y, sa); sa = fmix_hi(S[3], kk.y, sa);
                sa = rowsum16(sa);
                S[0] = fmix_lo(S[0], no.x, S[0]); S[1] = fmix_hi(S[1], no.x, S[1]); S[2] = fmix_lo(S[2], no.y, S[2]); S[3] = fmix_hi(S[3], no.y, S[3]);
                S[0] = fmix_lo(sa, nb.x, S[0]); S[1] = fmix_hi(sa, nb.x, S[1]); S[2] = fmix_lo(sa, nb.y, S[2]); S[3] = fmix_hi(sa, nb.y, S[3]);
                S[0] = fmix_lo(vv, kh.x, S[0]); S[1] = fmix_hi(vv, kh.x, S[1]); S[2] = fmix_lo(vv, kh.y, S[2]); S[3] = fmix_hi(vv, kh.y, S[3]);
                float y = fmix_lo(S[0], rr.x, 0.f); y = fmix_hi(S[1], rr.x, y); y = fmix_lo(S[2], rr.y, y); y = fmix_hi(S[3], rr.y, y);
                y = rowsum16(y);
                if (kg == 0) pY[t * 32] = f2bf(y);
            }
            __syncthreads();
            if (tid < 256) { const int t = tid >> 2, pc = tid & 3;
                *(v4u*)(I.YR + (row0 + (size_t)(c - 1) * CH + t) * D + h * HK + half * 32 + pc * 8) = *(const LAS v4u*)(lds + L_YO + t * 64 + pc * 16); }
        }
        if (c == SEQ / CH) break;
#pragma unroll
        for (int i = 0; i < 6; ++i) { const int pid = tid + 512 * i; if (pid < NPIECE) { const int rr_ = pid / 40, sp = pid % 40; *(LAS v4u*)(lds + L_RAW + rr_ * 640 + sp * 16) = G[i]; } }
        __syncthreads();
        if (c + 1 < SEQ / CH) issue_loads(c + 1);
#pragma unroll 2
        for (int it = 0; it < 10; ++it) { const int e = tid + 512 * it;
            const int t = e / 80, c4 = e % 80, col = c4 * 4, sg = col >> 6, cc = col & 63;
            const u32x2 cur = *(const LAS u32x2*)(lds + L_RAW + (t + 1) * 640 + col * 2), prv = *(const LAS u32x2*)(lds + L_RAW + t * 640 + col * 2);
            const f32x4 m4 = *(const LAS f32x4*)(lds + L_MU + col * 4);
            float x[4];
            { const float c0 = __uint_as_float(cur.x << 16), c1 = __uint_as_float(cur.x & 0xffff0000u), c2 = __uint_as_float(cur.y << 16), c3 = __uint_as_float(cur.y & 0xffff0000u);
              const float p0 = __uint_as_float(prv.x << 16), p1 = __uint_as_float(prv.x & 0xffff0000u), p2 = __uint_as_float(prv.y << 16), p3 = __uint_as_float(prv.y & 0xffff0000u);
              x[0] = c0 + (p0 - c0) * m4.x; x[1] = c1 + (p1 - c1) * m4.y; x[2] = c2 + (p2 - c2) * m4.z; x[3] = c3 + (p3 - c3) * m4.w; }
            if (sg == 0) { u32x2 o; o.x = pkh2(x[0], x[1]); o.y = pkh2(x[2], x[3]); *(LAS u32x2*)(lds + L_RR + t * 128 + cc * 2) = o; }
            else if (sg == 1) { u32x2 o; o.x = pkh2(x[0], x[1]); o.y = pkh2(x[2], x[3]); *(LAS u32x2*)(lds + L_KH + t * 128 + cc * 2) = o; }
            else if (sg == 2) { if ((cc >> 5) == half) { u32x2 o; o.x = pkh2(x[0], x[1]); o.y = pkh2(x[2], x[3]); *(LAS u32x2*)(lds + L_VV + t * 64 + (cc & 31) * 2) = o; } }
            else if (sg == 3) { u32x2 o;
#pragma unroll
                for (int j = 0; j < 4; ++j) x[j] = 1.f - 2.f * __builtin_amdgcn_rcpf(__expf(2.f * x[j]) + 1.f);
                o.x = pk2(x[0], x[1]); o.y = pk2(x[2], x[3]); *(LAS u32x2*)(lds + L_AW + t * 144 + cc * 2) = o; }
            else { u32x2 o; o.x = pk2(x[0], x[1]); o.y = pk2(x[2], x[3]); *(LAS u32x2*)(lds + L_AA + t * 144 + cc * 2) = o; }
        }
        __syncthreads();
        { const int role = w >> 2, tt = w & 3, fr = lane & 15, fq = lane >> 4;
          const LAS unsigned char* Aimg = lds + (role ? L_AA : L_AW); const LAS unsigned char* Wimg = lds + (role ? L_A2H : L_W2H);
          pg8::f32x4 acc[4];
#pragma unroll
          for (int nt = 0; nt < 4; ++nt) { acc[nt] = (pg8::f32x4){0.f, 0.f, 0.f, 0.f};
#pragma unroll
              for (int ks = 0; ks < 2; ++ks) { const pg8::bf16x8 af = *(const LAS pg8::bf16x8*)(Aimg + (tt * 16 + fr) * 144 + ks * 64 + fq * 16), bfr = *(const LAS pg8::bf16x8*)(Wimg + (nt * 16 + fr) * 144 + ks * 64 + fq * 16);
                  acc[nt] = __builtin_amdgcn_mfma_f32_16x16x32_bf16(af, bfr, acc[nt], 0, 0, 0); } }
          const LAS float* cst = (const LAS float*)(lds + L_CST);
          if (role == 0) {
#pragma unroll
              for (int nt = 0; nt < 4; ++nt) { const int ch = nt * 16 + fr; const float w0 = cst[ch];
#pragma unroll
                  for (int g = 0; g < 4; ++g) { const int t = tt * 16 + fq * 4 + g; const float e = 0.6065306597f * fsigmoid(w0 + acc[nt][g]); const float omw = 1.f - __expf(-e);
                      ((LAS _Float16*)(lds + L_OMW))[t * 64 + ch] = (_Float16)(-omw); } }
          } else {
              float kkr[4][4], ag[4][4], ss[4] = {0.f, 0.f, 0.f, 0.f}, bon[4] = {0.f, 0.f, 0.f, 0.f};
#pragma unroll
              for (int nt = 0; nt < 4; ++nt) { const int ch = nt * 16 + fr; const float a0 = cst[64 + ch], kk_ = cst[128 + ch], ka = cst[192 + ch], rk = cst[256 + ch];
#pragma unroll
                  for (int g = 0; g < 4; ++g) { const int t = tt * 16 + fq * 4 + g; const float a = fsigmoid(a0 + acc[nt][g]); const float k = (float)((LAS _Float16*)(lds + L_KH))[t * 64 + ch];
                      const float kh = k * (1.f + (a - 1.f) * ka), kq = k * kk_; ag[nt][g] = a; kkr[nt][g] = kq; ss[g] += kq * kq;
                      bon[g] += (float)((LAS _Float16*)(lds + L_RR))[t * 64 + ch] * kh * rk;
                      ((LAS _Float16*)(lds + L_KH))[t * 64 + ch] = (_Float16)kh; } }
#pragma unroll
              for (int g = 0; g < 4; ++g) { ss[g] = rowsum16(ss[g]); bon[g] = rowsum16(bon[g]); const float inv = 1.f / sqrtf(fmaxf(ss[g], 1e-24f)); const int t = tt * 16 + fq * 4 + g;
#pragma unroll
                  for (int nt = 0; nt < 4; ++nt) { const int ch = nt * 16 + fr; const float kk = kkr[nt][g] * inv; ((LAS _Float16*)(lds + L_KK))[t * 64 + ch] = (_Float16)kk; ((LAS _Float16*)(lds + L_BB))[t * 64 + ch] = (_Float16)(-kk * ag[nt][g]); }
                  if (fr == 0 && half == 0) I.BON[(row0 + (size_t)c * CH + t) * H_RWKV + h] = bon[g]; }
          } }
        __syncthreads();
    }
    *(f32x4*)(I.state_out + (((size_t)b * H_RWKV + h) * HK + half * 32 + r) * HK + kg * 4) = (f32x4){S[0], S[1], S[2], S[3]};
    __syncthreads();
}

struct RwkvSIn { const bf16_t* PRW; const float* state_shift; const float* state_wkv; const float *mu, *w0, *w2, *a0, *a2, *k_k, *k_a, *r_k; bf16_t* YR; float* BON; float* state_out; };
__device__ __forceinline__ void rwkv_sample_unit(const RwkvSIn& I, int s, int h, int lane) {
    static_assert(HK == 64 && W_RANK == 64 && A_RANK == 64, "rwkv_sample_unit shapes");
    const size_t row = (size_t)MP + s; const bf16_t* cur = I.PRW + row * RWKV_PROJ; const float* prv = I.state_shift + (size_t)s * RWKV_PROJ;
    auto lerp = [&](int col) { const float c = bf2f(cur[col]); return c + (prv[col] - c) * I.mu[col]; };
    const int ch = h * HK + lane;
    const float rr = lerp(ch), kx = lerp(D + ch), vx = lerp(2 * D + ch);
    const float twl = tanhf(lerp(3 * D + lane)), al = lerp(3 * D + W_RANK + lane);
    float dw = 0.f, da = 0.f;
#pragma unroll 8
    for (int j = 0; j < 64; ++j) { const float tj = __uint_as_float(__builtin_amdgcn_readlane(__float_as_uint(twl), j)), aj = __uint_as_float(__builtin_amdgcn_readlane(__float_as_uint(al), j));
        dw = fmaf(tj, I.w2[(size_t)j * D + ch], dw); da = fmaf(aj, I.a2[(size_t)j * D + ch], da); }
    const float e = 0.6065306597f * sigmoidf(I.w0[ch] + dw), omw = -expm1f(-e), ag = sigmoidf(I.a0[ch] + da);
    const float kh = kx * (1.f + (ag - 1.f) * I.k_a[ch]), kq = kx * I.k_k[ch];
    const float kk = kq / sqrtf(fmaxf(wave_sum(kq * kq), 1e-24f)), nb = -kk * ag;
    const float bon = wave_sum(rr * kh * I.r_k[ch]);
    if (lane == 0) I.BON[row * H_RWKV + h] = bon;
    const float* Sg = I.state_wkv + (((size_t)s * H_RWKV + h) * HK + lane) * HK; float* So = I.state_out + (((size_t)s * H_RWKV + h) * HK + lane) * HK;
    f32x4 S[16];
#pragma unroll
    for (int q = 0; q < 16; ++q) S[q] = *((const f32x4*)Sg + q);
    float sa = 0.f;
#pragma unroll
    for (int k = 0; k < 64; ++k) sa = fmaf(S[k >> 2][k & 3], __uint_as_float(__builtin_amdgcn_readlane(__float_as_uint(kk), k)), sa);
    float y = 0.f;
#pragma unroll
    for (int k = 0; k < 64; ++k) { float x = S[k >> 2][k & 3];
        x = fmaf(-x, __uint_as_float(__builtin_amdgcn_readlane(__float_as_uint(omw), k)), x);
        x = fmaf(sa, __uint_as_float(__builtin_amdgcn_readlane(__float_as_uint(nb), k)), x);
        x = fmaf(vx, __uint_as_float(__builtin_amdgcn_readlane(__float_as_uint(kh), k)), x);
        S[k >> 2][k & 3] = x; y = fmaf(x, __uint_as_float(__builtin_amdgcn_readlane(__float_as_uint(rr), k)), y); }
#pragma unroll
    for (int q = 0; q < 16; ++q) *((f32x4*)So + q) = S[q];
    I.YR[row * D + ch] = f2bf(y);
}

namespace mg {
constexpr int L_SG = 0;
constexpr int L_G = 8192;
constexpr int L_END = L_G + 16 * D * 4;
static_assert(L_END <= LDSCTL_OFF, "merge LDS map");
}
struct MergeIn { const bf16_t *YS, *YR, *PZ, *PGATE, *PRW, *LG2; const float *BON, *state_shift, *mu, *ssd_norm_w, *ln_w, *ln_b; bf16_t* MERGED; };
__device__ __forceinline__ void merge_unit(LAS unsigned char* lds, const MergeIn& I, int t0, int tid) {
    using namespace mg;
    static_assert(D == 1024 && G_RANK == 128 && HK == 64, "merge_unit shapes");
    const int lane = tid & 63, w = tid >> 6;
    { const int t = tid >> 5, j0 = (tid & 31) * 4; const int row = t0 + t; u32x2 o; o.x = 0u; o.y = 0u;
      if (row < MT) { const RowInfo q = rowinfo(row); const int col = 3 * D + W_RANK + A_RANK + j0; float x[4];
          const u32x2 cur = *(const u32x2*)(I.PRW + (size_t)row * RWKV_PROJ + col);
          float p[4];
          if (q.t > 0) { const u32x2 pv = *(const u32x2*)(I.PRW + (size_t)(row - 1) * RWKV_PROJ + col); p[0] = __uint_as_float(pv.x << 16); p[1] = __uint_as_float(pv.x & 0xffff0000u); p[2] = __uint_as_float(pv.y << 16); p[3] = __uint_as_float(pv.y & 0xffff0000u); }
          else if (q.grp) { const f32x4 pv = *(const f32x4*)(I.state_shift + (size_t)q.b * RWKV_PROJ + col); p[0] = pv.x; p[1] = pv.y; p[2] = pv.z; p[3] = pv.w; }
          else { p[0] = p[1] = p[2] = p[3] = 0.f; }
          const f32x4 m4 = *(const f32x4*)(I.mu + col);
          const float c0 = __uint_as_float(cur.x << 16), c1 = __uint_as_float(cur.x & 0xffff0000u), c2 = __uint_as_float(cur.y << 16), c3 = __uint_as_float(cur.y & 0xffff0000u);
          x[0] = fsigmoid(c0 + (p[0] - c0) * m4.x); x[1] = fsigmoid(c1 + (p[1] - c1) * m4.y); x[2] = fsigmoid(c2 + (p[2] - c2) * m4.z); x[3] = fsigmoid(c3 + (p[3] - c3) * m4.w);
          o.x = pk2(x[0], x[1]); o.y = pk2(x[2], x[3]); }
      *(LAS u32x2*)(lds + L_SG + t * 272 + j0 * 2) = o; }
    __syncthreads();
    { const int fr = lane & 15, fq = lane >> 4; pg8::bf16x8 af[4];
#pragma unroll
      for (int ks = 0; ks < 4; ++ks) af[ks] = *(const LAS pg8::bf16x8*)(lds + L_SG + fr * 272 + ks * 64 + fq * 16);
#pragma unroll 2
      for (int nt = 0; nt < 8; ++nt) { const int ch = w * 128 + nt * 16 + fr; pg8::f32x4 acc = {0.f, 0.f, 0.f, 0.f};
#pragma unroll
          for (int ks = 0; ks < 4; ++ks) { const pg8::bf16x8 bfr = *(const pg8::bf16x8*)(I.LG2 + (size_t)ch * G_RANK + ks * 32 + fq * 8); acc = __builtin_amdgcn_mfma_f32_16x16x32_bf16(af[ks], bfr, acc, 0, 0, 0); }
#pragma unroll
          for (int g = 0; g < 4; ++g) ((LAS float*)(lds + L_G))[(fq * 4 + g) * D + ch] = acc[g]; } }
    __syncthreads();
#pragma unroll 1
    for (int tt = 0; tt < 2; ++tt) { const int t = 2 * w + tt, row = t0 + t; if (row >= MT) break;
        const RowInfo q = rowinfo(row); const int c0 = 16 * lane;
        float ys[16], yr[16], zz[16];
        { const v4u a = *((const v4u*)(I.YS + (size_t)row * D) + 2 * lane), b = *((const v4u*)(I.YS + (size_t)row * D) + 2 * lane + 1);
          const v4u c = *((const v4u*)(I.PZ + (size_t)row * D) + 2 * lane), d = *((const v4u*)(I.PZ + (size_t)row * D) + 2 * lane + 1);
          const v4u e = *((const v4u*)(I.YR + (size_t)row * D) + 2 * lane), f = *((const v4u*)(I.YR + (size_t)row * D) + 2 * lane + 1);
#pragma unroll
          for (int j = 0; j < 4; ++j) { ys[2 * j] = __uint_as_float(a[j] << 16); ys[2 * j + 1] = __uint_as_float(a[j] & 0xffff0000u); ys[8 + 2 * j] = __uint_as_float(b[j] << 16); ys[8 + 2 * j + 1] = __uint_as_float(b[j] & 0xffff0000u);
              zz[2 * j] = __uint_as_float(c[j] << 16); zz[2 * j + 1] = __uint_as_float(c[j] & 0xffff0000u); zz[8 + 2 * j] = __uint_as_float(d[j] << 16); zz[8 + 2 * j + 1] = __uint_as_float(d[j] & 0xffff0000u);
              yr[2 * j] = __uint_as_float(e[j] << 16); yr[2 * j + 1] = __uint_as_float(e[j] & 0xffff0000u); yr[8 + 2 * j] = __uint_as_float(f[j] << 16); yr[8 + 2 * j + 1] = __uint_as_float(f[j] & 0xffff0000u); } }
        float ss = 0.f, sm = 0.f;
#pragma unroll
        for (int j = 0; j < 16; ++j) { ys[j] = ys[j] * zz[j] * fsigmoid(zz[j]); ss += ys[j] * ys[j]; sm += yr[j]; }
        const float rs = 1.f / sqrtf(wave_sum(ss) * (1.f / D) + NORM_EPS);
        sm += __shfl_xor(sm, 1); sm += __shfl_xor(sm, 2); const float mean = sm * (1.f / HK);
        float sv = 0.f;
#pragma unroll
        for (int j = 0; j < 16; ++j) { yr[j] -= mean; sv += yr[j] * yr[j]; }
        sv += __shfl_xor(sv, 1); sv += __shfl_xor(sv, 2); const float rstd = 1.f / sqrtf(sv * (1.f / HK) + RWKV_LN_EPS);
        const float bon = I.BON[(size_t)row * H_RWKV + (lane >> 2)];
        float vv[16], gs[16], gr[16];
        { const v4u a = *((const v4u*)(I.PRW + (size_t)row * RWKV_PROJ + 2 * D) + 2 * lane), b = *((const v4u*)(I.PRW + (size_t)row * RWKV_PROJ + 2 * D) + 2 * lane + 1);
#pragma unroll
          for (int j = 0; j < 4; ++j) { vv[2 * j] = __uint_as_float(a[j] << 16); vv[2 * j + 1] = __uint_as_float(a[j] & 0xffff0000u); vv[8 + 2 * j] = __uint_as_float(b[j] << 16); vv[8 + 2 * j + 1] = __uint_as_float(b[j] & 0xffff0000u); }
          float pv[16];
          if (q.t > 0) { const v4u pa = *((const v4u*)(I.PRW + (size_t)(row - 1) * RWKV_PROJ + 2 * D) + 2 * lane), pb = *((const v4u*)(I.PRW + (size_t)(row - 1) * RWKV_PROJ + 2 * D) + 2 * lane + 1);
#pragma unroll
              for (int j = 0; j < 4; ++j) { pv[2 * j] = __uint_as_float(pa[j] << 16); pv[2 * j + 1] = __uint_as_float(pa[j] & 0xffff0000u); pv[8 + 2 * j] = __uint_as_float(pb[j] << 16); pv[8 + 2 * j + 1] = __uint_as_float(pb[j] & 0xffff0000u); } }
          else if (q.grp) {
#pragma unroll
              for (int j = 0; j < 4; ++j) { const f32x4 x = *((const f32x4*)(I.state_shift + (size_t)q.b * RWKV_PROJ + 2 * D + c0) + j); pv[4 * j] = x.x; pv[4 * j + 1] = x.y; pv[4 * j + 2] = x.z; pv[4 * j + 3] = x.w; } }
          else {
#pragma unroll
              for (int j = 0; j < 16; ++j) pv[j] = 0.f; }
#pragma unroll
          for (int j = 0; j < 4; ++j) { const f32x4 m = *((const f32x4*)(I.mu + 2 * D + c0) + j);
              vv[4 * j] += (pv[4 * j] - vv[4 * j]) * m.x; vv[4 * j + 1] += (pv[4 * j + 1] - vv[4 * j + 1]) * m.y; vv[4 * j + 2] += (pv[4 * j + 2] - vv[4 * j + 2]) * m.z; vv[4 * j + 3] += (pv[4 * j + 3] - vv[4 * j + 3]) * m.w; }
          const v4u ga = *((const v4u*)(I.PGATE + (size_t)row * 2 * D) + 2 * lane), gb = *((const v4u*)(I.PGATE + (size_t)row * 2 * D) + 2 * lane + 1);
          const v4u ha = *((const v4u*)(I.PGATE + (size_t)row * 2 * D + D) + 2 * lane), hb = *((const v4u*)(I.PGATE + (size_t)row * 2 * D + D) + 2 * lane + 1);
#pragma unroll
          for (int j = 0; j < 4; ++j) { gs[2 * j] = __uint_as_float(ga[j] << 16); gs[2 * j + 1] = __uint_as_float(ga[j] & 0xffff0000u); gs[8 + 2 * j] = __uint_as_float(gb[j] << 16); gs[8 + 2 * j + 1] = __uint_as_float(gb[j] & 0xffff0000u);
              gr[2 * j] = __uint_as_float(ha[j] << 16); gr[2 * j + 1] = __uint_as_float(ha[j] & 0xffff0000u); gr[8 + 2 * j] = __uint_as_float(hb[j] << 16); gr[8 + 2 * j + 1] = __uint_as_float(hb[j] & 0xffff0000u); } }
        v4u o0, o1; float outv[16];
#pragma unroll
        for (int j = 0; j < 4; ++j) { const f32x4 gq = *((const LAS f32x4*)(lds + L_G + t * D * 4) + 4 * lane + j); const f32x4 nw = *((const f32x4*)(I.ssd_norm_w + c0) + j), lw = *((const f32x4*)(I.ln_w + c0) + j), lb = *((const f32x4*)(I.ln_b + c0) + j);
#pragma unroll
            for (int e = 0; e < 4; ++e) { const int k = 4 * j + e; const float yssd = ys[k] * rs * nw[e]; const float yrw = (yr[k] * rstd * lw[e] + lb[e] + bon * vv[k]) * gq[e];
                outv[k] = fsigmoid(gs[k]) * yssd + fsigmoid(gr[k]) * yrw; } }
#pragma unroll
        for (int j = 0; j < 4; ++j) { o0[j] = pk2(outv[2 * j], outv[2 * j + 1]); o1[j] = pk2(outv[8 + 2 * j], outv[8 + 2 * j + 1]); }
        *((v4u*)(I.MERGED + (size_t)row * D) + 2 * lane) = o0; *((v4u*)(I.MERGED + (size_t)row * D) + 2 * lane + 1) = o1;
    }
    __syncthreads();
}

namespace sd {
constexpr int STR = 272;
constexpr int L_C = 0, L_B = 34816, L_BTW = 69632, L_XT = 104448, L_SB = 121856, L_ACS = 139264, L_DTV = L_ACS + 512, L_END = L_DTV + 512;
static_assert(L_END <= LDSCTL_OFF, "ssd LDS map");
constexpr int CL = 128;
}
struct SsdIn { const bf16_t* PXBC; const float *DT, *conv_w, *conv_b, *dt_bias, *a_log, *d_skip; bf16_t* YS; float* state_out; };
__device__ __forceinline__ void bf8_unpack(const v4u& v, float (&x)[8]) {
#pragma unroll
    for (int j = 0; j < 4; ++j) { x[2 * j] = __uint_as_float(v[j] << 16); x[2 * j + 1] = __uint_as_float(v[j] & 0xffff0000u); }
}
__device__ __forceinline__ float fsilu(float x) { return x * fsigmoid(x); }
__device__ __forceinline__ void ssd_prompt_unit(LAS unsigned char* lds, const SsdIn& I, int b, int h, int tid) {
    using namespace sd;
    static_assert(D == 1024 && P_SSD == 64 && N_SSD == 128 && G_SSD == 2 && H_SSD == 16 && SEQ % CL == 0 && CONV_K == 4, "ssd_prompt_unit shapes");
    const int lane = tid & 63, w = tid >> 6, fr = lane & 15, fq = lane >> 4, g = h / (H_SSD / G_SSD);
    const float ah = -__expf(I.a_log[h]), dbias = I.dt_bias[h], dskip = I.d_skip[h];
    const int pc = tid % 40, tseg = tid / 40; const bool conv_on = tid < 480;
    const int kind = pc < 8 ? 0 : pc < 24 ? 1 : 2, loc0 = kind == 0 ? pc * 8 : kind == 1 ? (pc - 8) * 8 : (pc - 24) * 8;
    const int gch = kind == 0 ? h * P_SSD + loc0 : kind == 1 ? D + g * N_SSD + loc0 : D + G_SSD * N_SSD + g * N_SSD + loc0;
    float cw[4][8], cb[8];
#pragma unroll
    for (int i = 0; i < 4; ++i) { const f32x4 a = *(const f32x4*)(I.conv_w + (size_t)i * CONV_DIM + gch), c = *(const f32x4*)(I.conv_w + (size_t)i * CONV_DIM + gch + 4);
        cw[i][0] = a.x; cw[i][1] = a.y; cw[i][2] = a.z; cw[i][3] = a.w; cw[i][4] = c.x; cw[i][5] = c.y; cw[i][6] = c.z; cw[i][7] = c.w; }
    { const f32x4 a = *(const f32x4*)(I.conv_b + gch), c = *(const f32x4*)(I.conv_b + gch + 4); cb[0] = a.x; cb[1] = a.y; cb[2] = a.z; cb[3] = a.w; cb[4] = c.x; cb[5] = c.y; cb[6] = c.z; cb[7] = c.w; }
    pg8::f32x4 S[4];
#pragma unroll
    for (int nt = 0; nt < 4; ++nt) S[nt] = (pg8::f32x4){0.f, 0.f, 0.f, 0.f};
    for (int i = tid; i < 64 * STR / 16; i += NTHREADS) *(LAS v4u*)(lds + L_SB + i * 16) = (v4u){0u, 0u, 0u, 0u};
    const size_t row0 = (size_t)b * SEQ;
    LAS float* acs = (LAS float*)(lds + L_ACS); LAS float* dtv = (LAS float*)(lds + L_DTV);
#pragma unroll 1
    for (int c = 0; c < SEQ / CL; ++c) {
        const size_t rowc = row0 + (size_t)c * CL;
        if (tid < CL) { const float dt = softplusf(I.DT[(rowc + tid) * H_SSD + h] + dbias); dtv[tid] = dt; acs[tid] = dt * ah; }
        __syncthreads();
        if (w == 0) { const float a0 = acs[2 * lane], a1 = acs[2 * lane + 1]; float sc = a0 + a1;
#pragma unroll
            for (int o = 1; o < 64; o <<= 1) { const float t = __shfl_up(sc, o); if (lane >= o) sc += t; }
            acs[2 * lane] = sc - a1; acs[2 * lane + 1] = sc; }
        __syncthreads();
        const float acs_last = acs[CL - 1];
        if (conv_on) { const int ts = tseg * 11, te = ts + 11 < CL ? ts + 11 : CL;
            v4u W0, W1, W2; const v4u z = {0u, 0u, 0u, 0u};
            { const long q0 = (long)c * CL + ts - 3; W0 = q0 >= 0 ? *(const v4u*)(I.PXBC + (row0 + q0) * CONV_DIM + gch) : z; W1 = q0 + 1 >= 0 ? *(const v4u*)(I.PXBC + (row0 + q0 + 1) * CONV_DIM + gch) : z; W2 = q0 + 2 >= 0 ? *(const v4u*)(I.PXBC + (row0 + q0 + 2) * CONV_DIM + gch) : z; }
#pragma unroll 1
            for (int t = ts; t < te; ++t) { const v4u W3 = *(const v4u*)(I.PXBC + (rowc + t) * CONV_DIM + gch);
                float x0[8], x1[8], x2[8], x3[8], o[8]; bf8_unpack(W0, x0); bf8_unpack(W1, x1); bf8_unpack(W2, x2); bf8_unpack(W3, x3);
#pragma unroll
                for (int j = 0; j < 8; ++j) o[j] = fsilu(cb[j] + cw[0][j] * x0[j] + cw[1][j] * x1[j] + cw[2][j] * x2[j] + cw[3][j] * x3[j]);
                if (kind == 0) {
#pragma unroll
                    for (int j = 0; j < 8; ++j) *(LAS bf16_t*)(lds + L_XT + (loc0 + j) * STR + t * 2) = f2bf(o[j]);
                } else if (kind == 1) { v4u pk; pk.x = pk2(o[0], o[1]); pk.y = pk2(o[2], o[3]); pk.z = pk2(o[4], o[5]); pk.w = pk2(o[6], o[7]); *(LAS v4u*)(lds + L_B + t * STR + loc0 * 2) = pk;
                    const float wt = __expf(acs_last - acs[t]) * dtv[t];
#pragma unroll
                    for (int j = 0; j < 8; ++j) *(LAS bf16_t*)(lds + L_BTW + (loc0 + j) * STR + t * 2) = f2bf(o[j] * wt);
                } else { v4u pk; pk.x = pk2(o[0], o[1]); pk.y = pk2(o[2], o[3]); pk.z = pk2(o[4], o[5]); pk.w = pk2(o[6], o[7]); *(LAS v4u*)(lds + L_C + t * STR + loc0 * 2) = pk; }
                W0 = W1; W1 = W2; W2 = W3; } }
        __syncthreads();
        pg8::bf16x8 Cf[4];
#pragma unroll
        for (int ks = 0; ks < 4; ++ks) Cf[ks] = *(const LAS pg8::bf16x8*)(lds + L_C + (16 * w + fr) * STR + ks * 64 + fq * 16);
        pg8::f32x4 cbacc[8];
#pragma unroll
        for (int jt = 0; jt < 8; ++jt) { cbacc[jt] = (pg8::f32x4){0.f, 0.f, 0.f, 0.f};
#pragma unroll
            for (int ks = 0; ks < 4; ++ks) { const pg8::bf16x8 bf_ = *(const LAS pg8::bf16x8*)(lds + L_B + (16 * jt + fr) * STR + ks * 64 + fq * 16); cbacc[jt] = __builtin_amdgcn_mfma_f32_16x16x32_bf16(bf_, Cf[ks], cbacc[jt], 0, 0, 0); } }
        __syncthreads();
        { const int i = 16 * w + fr; const float ai = acs[i];
#pragma unroll
          for (int jt = 0; jt < 8; ++jt) { const int j0 = 16 * jt + 4 * fq; const f32x4 aj = *(const LAS f32x4*)(lds + L_ACS + j0 * 4), dj = *(const LAS f32x4*)(lds + L_DTV + j0 * 4); float gv[4];
#pragma unroll
              for (int e = 0; e < 4; ++e) gv[e] = (j0 + e <= i) ? cbacc[jt][e] * __expf(ai - aj[e]) * dj[e] : 0.f;
              u32x2 o; o.x = pk2(gv[0], gv[1]); o.y = pk2(gv[2], gv[3]); *(LAS u32x2*)(lds + L_B + i * STR + j0 * 2) = o; } }
        __syncthreads();
        { pg8::bf16x8 Gf[4];
#pragma unroll
          for (int ks = 0; ks < 4; ++ks) Gf[ks] = *(const LAS pg8::bf16x8*)(lds + L_B + (16 * w + fr) * STR + ks * 64 + fq * 16);
          const int i = 16 * w + fr; const float ei = __expf(acs[i]);
#pragma unroll
          for (int pt = 0; pt < 4; ++pt) { pg8::f32x4 ay = {0.f, 0.f, 0.f, 0.f}, ao = {0.f, 0.f, 0.f, 0.f};
#pragma unroll
              for (int ks = 0; ks < 4; ++ks) { const pg8::bf16x8 xf = *(const LAS pg8::bf16x8*)(lds + L_XT + (16 * pt + fr) * STR + ks * 64 + fq * 16), sf = *(const LAS pg8::bf16x8*)(lds + L_SB + (16 * pt + fr) * STR + ks * 64 + fq * 16);
                  ay = __builtin_amdgcn_mfma_f32_16x16x32_bf16(xf, Gf[ks], ay, 0, 0, 0); ao = __builtin_amdgcn_mfma_f32_16x16x32_bf16(sf, Cf[ks], ao, 0, 0, 0); }
              float yv[4];
#pragma unroll
              for (int e = 0; e < 4; ++e) { const int p = 16 * pt + 4 * fq + e; yv[e] = ay[e] + ei * ao[e] + dskip * bf2f(*(const LAS bf16_t*)(lds + L_XT + p * STR + i * 2)); }
              u32x2 o; o.x = pk2(yv[0], yv[1]); o.y = pk2(yv[2], yv[3]); *(u32x2*)(I.YS + (rowc + i) * D + h * P_SSD + 16 * pt + 4 * fq) = o; } }
        { pg8::bf16x8 Xf[4];
#pragma unroll
          for (int ks = 0; ks < 4; ++ks) Xf[ks] = *(const LAS pg8::bf16x8*)(lds + L_XT + (16 * (w & 3) + fr) * STR + ks * 64 + fq * 16);
          const float dec = __expf(acs_last);
#pragma unroll
          for (int nt = 0; nt < 4; ++nt) { pg8::f32x4 as_ = {0.f, 0.f, 0.f, 0.f};
#pragma unroll
              for (int ks = 0; ks < 4; ++ks) { const pg8::bf16x8 bf_ = *(const LAS pg8::bf16x8*)(lds + L_BTW + (64 * (w >> 2) + 16 * nt + fr) * STR + ks * 64 + fq * 16); as_ = __builtin_amdgcn_mfma_f32_16x16x32_bf16(bf_, Xf[ks], as_, 0, 0, 0); }
              S[nt] = S[nt] * dec + as_; } }
        __syncthreads();
#pragma unroll
        for (int nt = 0; nt < 4; ++nt) { u32x2 o; o.x = pk2(S[nt][0], S[nt][1]); o.y = pk2(S[nt][2], S[nt][3]); *(LAS u32x2*)(lds + L_SB + (16 * (w & 3) + fr) * STR + (64 * (w >> 2) + 16 * nt + 4 * fq) * 2) = o; }
    }
#pragma unroll
    for (int nt = 0; nt < 4; ++nt) *(f32x4*)(I.state_out + (((size_t)b * H_SSD + h) * P_SSD + 16 * (w & 3) + fr) * N_SSD + 64 * (w >> 2) + 16 * nt + 4 * fq) = (f32x4){S[nt][0], S[nt][1], S[nt][2], S[nt][3]};
    __syncthreads();
}
struct SsdSIn { const bf16_t* PXBC; const float *state_conv, *state_ssm, *DT, *conv_w, *conv_b, *dt_bias, *a_log, *d_skip; bf16_t* YS; float* state_out; };
__device__ __forceinline__ void ssd_sample_unit(const SsdSIn& I, int s, int h, int lane) {
    static_assert(P_SSD == 64 && N_SSD == 128 && CONV_K == 4, "ssd_sample_unit shapes");
    const size_t row = (size_t)MP + s; const int g = h / (H_SSD / G_SSD);
    auto conv1 = [&](int ch) { float a = I.conv_b[ch];
#pragma unroll
        for (int i = 0; i < 3; ++i) a = fmaf(I.conv_w[(size_t)i * CONV_DIM + ch], I.state_conv[((size_t)s * 3 + i) * CONV_DIM + ch], a);
        a = fmaf(I.conv_w[(size_t)3 * CONV_DIM + ch], bf2f(I.PXBC[row * CONV_DIM + ch]), a); return siluf(a); };
    const float x = conv1(h * P_SSD + lane);
    const float b0 = conv1(D + g * N_SSD + lane), b1 = conv1(D + g * N_SSD + 64 + lane), c0 = conv1(D + G_SSD * N_SSD + g * N_SSD + lane), c1 = conv1(D + G_SSD * N_SSD + g * N_SSD + 64 + lane);
    const float dt = softplusf(I.DT[row * H_SSD + h] + I.dt_bias[h]), dA = expf(dt * -expf(I.a_log[h])), dtx = dt * x;
    const float* Sg = I.state_ssm + (((size_t)s * H_SSD + h) * P_SSD + lane) * N_SSD; float* So = I.state_out + (((size_t)s * H_SSD + h) * P_SSD + lane) * N_SSD;
    float y = 0.f;
#pragma unroll
    for (int q = 0; q < 32; ++q) { f32x4 v = *((const f32x4*)Sg + q);
#pragma unroll
        for (int e = 0; e < 4; ++e) { const int n = 4 * q + e; const float bn = __uint_as_float(__builtin_amdgcn_readlane(__float_as_uint(n < 64 ? b0 : b1), n & 63)), cn = __uint_as_float(__builtin_amdgcn_readlane(__float_as_uint(n < 64 ? c0 : c1), n & 63));
            const float sv = fmaf(v[e], dA, dtx * bn); v[e] = sv; y = fmaf(cn, sv, y); }
        *((f32x4*)So + q) = v; }
    I.YS[row * D + h * P_SSD + lane] = f2bf(y + I.d_skip[h] * x);
}

__device__ __forceinline__ unsigned ford(float f) { const unsigned u = __float_as_uint(f); return u ^ ((u >> 31) ? 0xFFFFFFFFu : 0x80000000u); }
__device__ __forceinline__ float funord(unsigned u) { return __uint_as_float((u & 0x80000000u) ? (u ^ 0x80000000u) : ~u); }
__device__ __forceinline__ unsigned rowmax16u(unsigned v) {
    v = max(v, (unsigned)__builtin_amdgcn_update_dpp(0, (int)v, 0xB1, 0xF, 0xF, true));
    v = max(v, (unsigned)__builtin_amdgcn_update_dpp(0, (int)v, 0x4E, 0xF, 0xF, true));
    v = max(v, (unsigned)__builtin_amdgcn_update_dpp(0, (int)v, 0x141, 0xF, 0xF, true));
    v = max(v, (unsigned)__builtin_amdgcn_update_dpp(0, (int)v, 0x140, 0xF, 0xF, true));
    return v;
}
#define CEX(a, b) do { const unsigned hi_ = max(a, b), lo_ = min(a, b); a = hi_; b = lo_; } while (0)
__device__ __forceinline__ unsigned top16_of_128(unsigned (&k)[8], int fr) {
    CEX(k[0], k[1]); CEX(k[2], k[3]); CEX(k[4], k[5]); CEX(k[6], k[7]);
    CEX(k[0], k[2]); CEX(k[1], k[3]); CEX(k[4], k[6]); CEX(k[5], k[7]);
    CEX(k[1], k[2]); CEX(k[5], k[6]);
    CEX(k[0], k[4]); CEX(k[1], k[5]); CEX(k[2], k[6]); CEX(k[3], k[7]);
    CEX(k[2], k[4]); CEX(k[3], k[5]);
    CEX(k[1], k[2]); CEX(k[3], k[4]); CEX(k[5], k[6]);
    unsigned mine = 0u;
#pragma unroll
    for (int it = 0; it < 16; ++it) { const unsigned m = rowmax16u(k[0]); const bool win = k[0] == m;
        k[0] = win ? k[1] : k[0]; k[1] = win ? k[2] : k[1]; k[2] = win ? k[3] : k[2]; k[3] = win ? k[4] : k[3]; k[4] = win ? k[5] : k[4]; k[5] = win ? k[6] : k[5]; k[6] = win ? k[7] : k[6]; k[7] = win ? 0u : k[7];
        mine = fr == it ? m : mine; }
    return mine;
}
struct TopkIn { const bf16_t* PQ; const bf16_t* SKB; int* IDX; float* GATE; };
__device__ __forceinline__ void peer_topk_unit(const TopkIn& I, int tg, int h, int lane) {
    static_assert(N_KEYS == 128 && PEER_HALF == 128 && PEER_TOPK == 16, "peer_topk_unit shapes");
    const int fr = lane & 15, fq = lane >> 4, t0 = tg * 16;
    unsigned sel[2][4];
#pragma unroll
    for (int c = 0; c < 2; ++c) {
        pg8::bf16x8 qf[4];
#pragma unroll
        for (int ks = 0; ks < 4; ++ks) qf[ks] = *(const pg8::bf16x8*)(I.PQ + (size_t)(t0 + fr) * NPQ + h * PEER_DKEY + c * PEER_HALF + ks * 32 + fq * 8);
        pg8::f32x4 acc[8];
        const bf16_t* kb = I.SKB + ((size_t)(h * 2 + c) * N_KEYS) * PEER_HALF;
#pragma unroll
        for (int nt = 0; nt < 8; ++nt) { acc[nt] = (pg8::f32x4){0.f, 0.f, 0.f, 0.f};
#pragma unroll
            for (int ks = 0; ks < 4; ++ks) { const pg8::bf16x8 kf = *(const pg8::bf16x8*)(kb + (size_t)(nt * 16 + fr) * PEER_HALF + ks * 32 + fq * 8); acc[nt] = __builtin_amdgcn_mfma_f32_16x16x32_bf16(qf[ks], kf, acc[nt], 0, 0, 0); } }
#pragma unroll
        for (int g = 0; g < 4; ++g) { unsigned k[8];
#pragma unroll
            for (int nt = 0; nt < 8; ++nt) k[nt] = (ford(acc[nt][g]) & ~127u) | (unsigned)(127 - (nt * 16 + fr));
            sel[c][g] = top16_of_128(k, fr); }
    }
    const int base = lane & 48;
#pragma unroll
    for (int g = 0; g < 4; ++g) { const int row = t0 + 4 * fq + g;
        const float s1 = funord(sel[0][g] & ~127u), s2 = funord(sel[1][g] & ~127u); const int i1 = 127 - (int)(sel[0][g] & 127u), i2 = 127 - (int)(sel[1][g] & 127u);
        int p = 0; unsigned key = (ford(s1 + __shfl(s2, base)) & ~255u) | (unsigned)(255 - fr * 16); unsigned mine = 0u;
#pragma unroll
        for (int it = 0; it < 16; ++it) { const unsigned m = rowmax16u(key); const bool win = key == m; const int np = p + (win ? 1 : 0);
            const float s2n = __shfl(s2, base + (np < 16 ? np : 15));
            const unsigned nk = np < 16 ? ((ford(s1 + s2n) & ~255u) | (unsigned)(255 - (fr * 16 + np))) : 0u;
            key = win ? nk : key; p = np; mine = fr == it ? m : mine; }
        const int pos = 255 - (int)(mine & 255u), a = pos >> 4, bb = pos & 15; const float ts = funord(mine & ~255u);
        const int e1 = __shfl(i1, base + a), e2 = __shfl(i2, base + bb);
        const float mx = funord(rowmax16u(ford(ts))); const float ex = __expf(ts - mx); const float sm = rowsum16(ex);
        if (row < MT) { I.IDX[(size_t)row * NSEL + h * PEER_TOPK + fr] = e1 * N_KEYS + e2; I.GATE[(size_t)row * NSEL + h * PEER_TOPK + fr] = ex / sm; }
    }
}

typedef float f32x16 __attribute__((ext_vector_type(16)));
namespace at {
constexpr int KSTR = 528, VSTR = 520;
constexpr int L_IMG = 0, L_END = 256 * KSTR;
static_assert(L_END <= LDSCTL_OFF, "attention LDS map");
}
struct AttnIn { const bf16_t* Q; const bf16_t* KVB; const bf16_t* VTB; bf16_t* AO; };
__device__ __forceinline__ void attn_prompt_unit(LAS unsigned char* lds, const AttnIn& I, int b, int h, int tile, int tid) {
    using namespace at;
    static_assert(N_MEM == 256 && MEM_HD == 256 && MEM_HEADS == 4, "attn_prompt_unit shapes");
    const int lane = tid & 63, w = tid >> 6, r = lane & 31, hh = lane >> 5;
    const size_t tok = (size_t)b * SEQ + tile * 256 + w * 32 + r;
    __syncthreads();
    { const bf16_t* kb = I.KVB + (size_t)b * N_MEM * 2 * D + h * MEM_HD;
#pragma unroll 4
      for (int i = 0; i < 16; ++i) { const int pid = tid + 512 * i, row = pid >> 5, pc = pid & 31; *(LAS v4u*)(lds + L_IMG + row * KSTR + pc * 16) = *(const v4u*)(kb + (size_t)row * 2 * D + pc * 8); } }
    pg8::bf16x8 qf[16];
#pragma unroll
    for (int ks = 0; ks < 16; ++ks) qf[ks] = *(const pg8::bf16x8*)(I.Q + tok * D + h * MEM_HD + ks * 16 + hh * 8);
    __syncthreads();
    f32x16 sacc[8];
#pragma unroll
    for (int mt = 0; mt < 8; ++mt) {
#pragma unroll
        for (int e = 0; e < 16; ++e) sacc[mt][e] = 0.f;
#pragma unroll
        for (int ks = 0; ks < 16; ++ks) { const pg8::bf16x8 kf = *(const LAS pg8::bf16x8*)(lds + L_IMG + (mt * 32 + r) * KSTR + ks * 32 + hh * 16); sacc[mt] = __builtin_amdgcn_mfma_f32_32x32x16_bf16(kf, qf[ks], sacc[mt], 0, 0, 0); } }
    float mx = -INFINITY;
#pragma unroll
    for (int mt = 0; mt < 8; ++mt)
#pragma unroll
        for (int e = 0; e < 16; ++e) mx = fmaxf(mx, sacc[mt][e]);
    mx = fmaxf(mx, __shfl_xor(mx, 32));
    const float c = 1.4426950408889634f / 16.0f; float sum = 0.f;
#pragma unroll
    for (int mt = 0; mt < 8; ++mt)
#pragma unroll
        for (int e = 0; e < 16; ++e) { const float p = __builtin_amdgcn_exp2f((sacc[mt][e] - mx) * c); sacc[mt][e] = p; sum += p; }
    sum += __shfl_xor(sum, 32);
    pg8::bf16x8 pf[8][2];
#pragma unroll
    for (int mt = 0; mt < 8; ++mt)
#pragma unroll
        for (int s = 0; s < 2; ++s) { v4u pk;
#pragma unroll
            for (int j = 0; j < 4; ++j) pk[j] = pk2(sacc[mt][8 * s + 2 * j], sacc[mt][8 * s + 2 * j + 1]);
            pf[mt][s] = __builtin_bit_cast(pg8::bf16x8, pk); }
    __syncthreads();
    { const bf16_t* vb = I.VTB + (size_t)(b * MEM_HEADS + h) * MEM_HD * N_MEM;
#pragma unroll 4
      for (int i = 0; i < 16; ++i) { const int pid = tid + 512 * i, row = pid >> 5, pc = pid & 31; const v4u v = *(const v4u*)(vb + (size_t)row * N_MEM + pc * 8);
          u32x2 lo, hi; lo.x = v.x; lo.y = v.y; hi.x = v.z; hi.y = v.w; *(LAS u32x2*)(lds + L_IMG + row * VSTR + pc * 16) = lo; *(LAS u32x2*)(lds + L_IMG + row * VSTR + pc * 16 + 8) = hi; } }
    __syncthreads();
    const float inv = 1.f / sum;
#pragma unroll 1
    for (int dt = 0; dt < 8; ++dt) { f32x16 oacc;
#pragma unroll
        for (int e = 0; e < 16; ++e) oacc[e] = 0.f;
#pragma unroll
        for (int mt = 0; mt < 8; ++mt)
#pragma unroll
            for (int s = 0; s < 2; ++s) { const LAS unsigned char* vp = lds + L_IMG + (dt * 32 + r) * VSTR + (mt * 32 + 16 * s + 4 * hh) * 2;
                const u32x2 lo = *(const LAS u32x2*)vp, hi = *(const LAS u32x2*)(vp + 16); v4u vv; vv.x = lo.x; vv.y = lo.y; vv.z = hi.x; vv.w = hi.y;
                oacc = __builtin_amdgcn_mfma_f32_32x32x16_bf16(__builtin_bit_cast(pg8::bf16x8, vv), pf[mt][s], oacc, 0, 0, 0); }
#pragma unroll
        for (int g = 0; g < 4; ++g) { u32x2 o; o.x = pk2(oacc[4 * g] * inv, oacc[4 * g + 1] * inv); o.y = pk2(oacc[4 * g + 2] * inv, oacc[4 * g + 3] * inv);
            *(u32x2*)(I.AO + tok * D + h * MEM_HD + dt * 32 + 8 * g + 4 * hh) = o; } }
}
struct AttnSIn { const bf16_t* Q; const float* ck; const float* cv; bf16_t* AO; };
__device__ __forceinline__ void attn_sample_block(LAS unsigned char* lds, const AttnSIn& I, int pp, int tid) {
    const int lane = tid & 63, w = tid >> 6, slot = w >> 2, mq = w & 3; const int pair = 2 * pp + slot, s = pair / MEM_HEADS, h = pair % MEM_HEADS;
    LAS float* red = (LAS float*)lds;
    __syncthreads();
    float q[4];
    { const u32x2 qv = *(const u32x2*)(I.Q + ((size_t)MP + s) * D + h * MEM_HD + 4 * lane); q[0] = __uint_as_float(qv.x << 16); q[1] = __uint_as_float(qv.x & 0xffff0000u); q[2] = __uint_as_float(qv.y << 16); q[3] = __uint_as_float(qv.y & 0xffff0000u); }
    const float* kb = I.ck + (((size_t)s * N_MEM + mq * 64) * MEM_HEADS + h) * MEM_HD + 4 * lane; const float* vb = I.cv + (((size_t)s * N_MEM + mq * 64) * MEM_HEADS + h) * MEM_HD + 4 * lane;
    float sc = 0.f;
#pragma unroll 1
    for (int m0 = 0; m0 < 64; m0 += 16) { f32x4 kr[16];
#pragma unroll
        for (int i = 0; i < 16; ++i) kr[i] = *(const f32x4*)(kb + (size_t)(m0 + i) * D);
#pragma unroll
        for (int i = 0; i < 16; ++i) { const float d = wave_sum((kr[i].x * q[0] + kr[i].y * q[1]) + (kr[i].z * q[2] + kr[i].w * q[3])); sc = lane == m0 + i ? d : sc; } }
    sc *= 1.f / 16.f;
    const float wm = wave_max(sc); if (lane == 0) red[slot * 4 + mq] = wm;
    __syncthreads();
    const float gm = fmaxf(fmaxf(red[slot * 4], red[slot * 4 + 1]), fmaxf(red[slot * 4 + 2], red[slot * 4 + 3]));
    const float e = __expf(sc - gm); const float wsum = wave_sum(e); if (lane == 0) red[8 + slot * 4 + mq] = wsum;
    f32x4 o = {0.f, 0.f, 0.f, 0.f};
#pragma unroll 1
    for (int m0 = 0; m0 < 64; m0 += 16) { f32x4 vr[16];
#pragma unroll
        for (int i = 0; i < 16; ++i) vr[i] = *(const f32x4*)(vb + (size_t)(m0 + i) * D);
#pragma unroll
        for (int i = 0; i < 16; ++i) { const float p = __uint_as_float(__builtin_amdgcn_readlane(__float_as_uint(e), m0 + i)); o += vr[i] * p; } }
    *(LAS f32x4*)(lds + 64 + ((slot * 4 + mq) * 256 + 4 * lane) * 4) = o;
    __syncthreads();
    if (mq == 0) { const float gs = (red[8 + slot * 4] + red[8 + slot * 4 + 1]) + (red[8 + slot * 4 + 2] + red[8 + slot * 4 + 3]); f32x4 t = o;
#pragma unroll
        for (int k = 1; k < 4; ++k) t += *(const LAS f32x4*)(lds + 64 + ((slot * 4 + k) * 256 + 4 * lane) * 4);
        const float inv = 1.f / gs; u32x2 ov; ov.x = pk2(t.x * inv, t.y * inv); ov.y = pk2(t.z * inv, t.w * inv);
        *(u32x2*)(I.AO + ((size_t)MP + s) * D + h * MEM_HD + 4 * lane) = ov; }
}

__global__ void __launch_bounds__(NTHREADS, 2) mk_fwd(MkArgs args) {
    extern __shared__ __attribute__((aligned(16))) unsigned char lds_raw[];
    LAS unsigned char* lds = (LAS unsigned char*)lds_raw;
    volatile LAS unsigned* MISC = (volatile LAS unsigned*)(lds + LDSCTL_OFF);
    const int tid = threadIdx.x, lane = tid & 63, wave = __builtin_amdgcn_readfirstlane(tid >> 6);
    const int G = gridDim.x, bx = blockIdx.x, vcu = (G % 8 == 0) ? (bx % 8) * (G / 8) + bx / 8 : bx;
    unsigned char* ws = args.ws; float* out = args.out;
    for (int u = tid; u < (LDS_BYTES - LDSCTL_OFF) / 4; u += NTHREADS) ((LAS unsigned*)(lds + LDSCTL_OFF))[u] = 0u;
    __syncthreads();
    XcdBarrier bar = xcd_barrier_post((unsigned*)(ws + O_CTL) + CW_BAR + args.bar_idx * XCD_BAR_WORDS, MISC + 8);
    const int lo = args.ph_lo, hi = args.ph_hi;
#define IN_PH(k) (lo <= (k) && (k) < hi)
#define SEAM(k) do { if (IN_PH(k) && IN_PH((k) + 1)) xcd_barrier(bar); } while (0)
    bf16_t* WT_in = (bf16_t*)(ws + O_WT_IN); bf16_t* Hb = (bf16_t*)(ws + O_HB); bf16_t* MN = (bf16_t*)(ws + O_MN);
    const int gw = vcu * NWAVES + wave, NGW = G * NWAVES;

    if (IN_PH(PH_PREP)) {
        LAS float* scr = (LAS float*)(lds + wave * 16384);
        constexpr int KB = D / 64;
        constexpr int I_IN = (NMAIN / 32) * KB, I_SQ = (D / 32) * KB, I_PQ = (NPQ / 32) * KB, I_L64 = D / 32, I_L128 = (D / 32) * 2;
        constexpr int NITEMS = I_IN + 5 * I_SQ + I_PQ + 2 * I_L64 + I_L128;
        static_assert(W_RANK == 64 && A_RANK == 64 && G_RANK == 128 && (D + CONV_DIM) % 32 == 0, "P0 item shapes");
        for (int it = gw; it < NITEMS; it += NGW) {
            int r = it;
            if (r < I_IN) { const int kb = r / (NMAIN / 32), nb = r % (NMAIN / 32), n0 = 32 * nb; p0_transpose_item(args.in[I_W_IN], D, D_IN, n0 + (n0 >= D + CONV_DIM ? H_SSD : 0), WT_in, n0, scr, kb, lane); continue; } r -= I_IN;
            if (r < 5 * I_SQ) { const int wsel = r / I_SQ; r %= I_SQ; const int kb = r / (D / 32), nb = r % (D / 32);
                const float* W = args.in[wsel == 0 ? I_W_OUT : wsel == 1 ? I_W_MK : wsel == 2 ? I_W_MV : wsel == 3 ? I_W_MQ : I_W_MO];
                bf16_t* WT = (bf16_t*)(ws + (wsel == 0 ? O_WT_OUT : wsel == 1 ? O_WT_MK : wsel == 2 ? O_WT_MV : wsel == 3 ? O_WT_MQ : O_WT_MO));
                p0_transpose_item(W, D, D, 32 * nb, WT, 32 * nb, scr, kb, lane); continue; } r -= 5 * I_SQ;
            if (r < I_PQ) { const int kb = r / (NPQ / 32), nb = r % (NPQ / 32); p0_transpose_item(args.in[I_W_PQ], D, NPQ, 32 * nb, (bf16_t*)(ws + O_WT_PQ), 32 * nb, scr, kb, lane); continue; } r -= I_PQ;
            if (r < I_L64) { p0_transpose_item(args.in[I_W2], W_RANK, D, 32 * r, (bf16_t*)(ws + O_LW2), 32 * r, scr, 0, lane); continue; } r -= I_L64;
            if (r < I_L64) { p0_transpose_item(args.in[I_A2], A_RANK, D, 32 * r, (bf16_t*)(ws + O_LA2), 32 * r, scr, 0, lane); continue; } r -= I_L64;
            { const int kb = r / (D / 32), nb = r % (D / 32); p0_transpose_item(args.in[I_G2], G_RANK, D, 32 * nb, (bf16_t*)(ws + O_LG2), 32 * nb, scr, kb, lane); }
        }
        float* DT = (float*)(ws + O_DT);
        for (int m = gw; m < MPAD; m += NGW) {
            if (m < MT) norm_row<true>(m < MP ? args.in[I_XP] + (size_t)m * D : args.in[I_XS] + (size_t)(m - MP) * D, args.in[I_NORM_MIX], Hb + (size_t)m * D, args.in[I_W_IN], DT + (size_t)m * H_SSD, lane);
            else { v4u z = {0u, 0u, 0u, 0u}; v4u* o = (v4u*)(Hb + (size_t)m * D) + lane; o[0] = z; o[64] = z; }
        }
        for (int m = gw; m < NMEMROWS; m += NGW) norm_row<false>(args.in[I_MEM] + (size_t)m * D, args.in[I_MEM_NORM], MN + (size_t)m * D, nullptr, nullptr, lane);
        float* esc = (float*)(ws + O_ESC);
        for (int e = gw; e < 2 * N_EXPERTS; e += NGW) { const int t = e >= N_EXPERTS, r = e - t * N_EXPERTS;
            fp8_row(args.in[t ? I_EV : I_EU] + (size_t)r * D, ws + (t ? O_EV8 : O_EU8) + (size_t)r * D, esc + e, lane); }
        { const float* sk = args.in[I_SUBK]; bf16_t* skb = (bf16_t*)(ws + O_SKB); constexpr int NSK = PEER_HEADS * 2 * N_KEYS * PEER_HALF;
          for (int i = (vcu * NTHREADS + tid) * 4; i < NSK; i += G * NTHREADS * 4) { const f32x4 v = *(const f32x4*)(sk + i); typedef unsigned u32x2 __attribute__((ext_vector_type(2))); u32x2 w; w.x = pk2(v.x, v.y); w.y = pk2(v.z, v.w); *(u32x2*)(skb + i) = w; } }
    }
    SEAM(PH_PREP);
    if (IN_PH(PH_INPROJ)) {
        { pg8::Gemm g{Hb, WT_in, MPAD, NMAIN, D}; pg8::StaticOrder S; S.init(MPAD, NMAIN, G, bx);
          pg8::EpiProj E{(bf16_t*)(ws + O_PZ), (bf16_t*)(ws + O_PXBC), (bf16_t*)(ws + O_PRW), (bf16_t*)(ws + O_PGATE)};
          pg8::gemm_phase<pg8::EpiProj, pg8::StaticOrder, true, true>(lds, g, S, E); }
        { pg8::Gemm g{MN, (const bf16_t*)(ws + O_WT_MK), NMEMROWS, 2 * D, D}; pg8::StaticOrder S; S.init(NMEMROWS, 2 * D, G, G - 1 - bx);
          pg8::EpiKV E{out + OO_MKP, out + OO_MVP, (bf16_t*)(ws + O_KVB), (bf16_t*)(ws + O_VTB)};
          pg8::gemm_phase<pg8::EpiKV, pg8::StaticOrder, true, true>(lds, g, S, E); }
    }
    SEAM(PH_INPROJ);
    float* o_ = out;
    if (IN_PH(PH_MIXA)) {
        const bf16_t* PXBC = (const bf16_t*)(ws + O_PXBC); const bf16_t* PRW = (const bf16_t*)(ws + O_PRW);
        GS_LOOP((size_t)(BATCH + DEC_BATCH) * (CONV_K - 1) * CONV_DIM, b_convstate(i_, PXBC, args.in[I_SCONV], o_ + OO_CONVP, o_ + OO_CONVS));
        GS_LOOP((size_t)(BATCH + DEC_BATCH) * RWKV_PROJ, b_shiftstate(i_, PRW, o_ + OO_SHP, o_ + OO_SHS));
        constexpr int NHEAVY = BATCH * H_SSD;
        { SsdIn I{PXBC, (const float*)(ws + O_DT), args.in[I_CONV_W], args.in[I_CONV_B], args.in[I_DT_BIAS], args.in[I_A_LOG], args.in[I_D_SKIP], (bf16_t*)(ws + O_YS), o_ + OO_SSMP};
          __syncthreads();
          for (int u = bx; u < NHEAVY; u += G) ssd_prompt_unit(lds, I, u / H_SSD, u % H_SSD, tid); }
        { const int lw0 = G > NHEAVY ? (bx - NHEAVY) * NWAVES + wave : gw, nlw = G > NHEAVY ? (G - NHEAVY) * NWAVES : NGW;
          if (G <= NHEAVY || bx >= NHEAVY) {
              SsdSIn J{PXBC, args.in[I_SCONV], args.in[I_SSSM], (const float*)(ws + O_DT), args.in[I_CONV_W], args.in[I_CONV_B], args.in[I_DT_BIAS], args.in[I_A_LOG], args.in[I_D_SKIP], (bf16_t*)(ws + O_YS), o_ + OO_SSMS};
              for (int u = lw0; u < DEC_BATCH * H_SSD; u += nlw) ssd_sample_unit(J, u / H_SSD, u % H_SSD, lane);
              RwkvSIn K{PRW, args.in[I_SSHIFT], args.in[I_SWKV], args.in[I_MU], args.in[I_W0], args.in[I_W2], args.in[I_A0], args.in[I_A2], args.in[I_K_K], args.in[I_K_A], args.in[I_R_K], (bf16_t*)(o_ + OO_YP), (float*)(ws + O_BON), o_ + OO_WKVS};
              for (int u = lw0; u < DEC_BATCH * H_RWKV; u += nlw) rwkv_sample_unit(K, u / H_RWKV, u % H_RWKV, lane); } }
    }
    SEAM(PH_MIXA);
    if (IN_PH(PH_SCAN)) {
        { RwkvIn I{(const bf16_t*)(ws + O_PRW), (const bf16_t*)(ws + O_LW2), (const bf16_t*)(ws + O_LA2), args.in[I_MU], args.in[I_W0], args.in[I_A0], args.in[I_K_K], args.in[I_K_A], args.in[I_R_K], (bf16_t*)(o_ + OO_YP), (float*)(ws + O_BON), o_ + OO_WKVP};
          __syncthreads();
          for (int u = bx; u < BATCH * H_RWKV * 2; u += G) rwkv_scan_unit(lds, I, u / (2 * H_RWKV), (u >> 1) % H_RWKV, u & 1, tid); }
    }
    SEAM(PH_SCAN);
    if (IN_PH(PH_MERGE)) {
        static_assert(MT % 16 == 0, "merge units");
        MergeIn I{(const bf16_t*)(ws + O_YS), (const bf16_t*)(o_ + OO_YP), (const bf16_t*)(ws + O_PZ), (const bf16_t*)(ws + O_PGATE), (const bf16_t*)(ws + O_PRW), (const bf16_t*)(ws + O_LG2),
                  (const float*)(ws + O_BON), args.in[I_SSHIFT], args.in[I_MU], args.in[I_SSD_NORM], args.in[I_LN_W], args.in[I_LN_B], (bf16_t*)(ws + O_MERGED)};
        for (int u = bx; u < MT / 16; u += G) merge_unit(lds, I, 16 * u, tid);
        GS_LOOP((size_t)(MPAD - MT) * D, b_zero_u16(i_, (bf16_t*)(ws + O_MERGED) + (size_t)MT * D, (size_t)(MPAD - MT) * D));
    }
    SEAM(PH_MERGE);
    if (IN_PH(PH_OUT)) {
        pg8::Gemm g{(const bf16_t*)(ws + O_MERGED), (const bf16_t*)(ws + O_WT_OUT), MPAD, D, D}; pg8::StaticOrder S; S.init(MPAD, D, G, bx);
        pg8::EpiRes E{args.in[I_XP], args.in[I_XS], MP, (float*)(ws + O_X1), MT};
        pg8::gemm_phase<pg8::EpiRes, pg8::StaticOrder, true, true>(lds, g, S, E);
    }
    SEAM(PH_OUT);
    if (IN_PH(PH_NORM2)) {
        bf16_t* H2 = (bf16_t*)(ws + O_H2); const float* X1 = (const float*)(ws + O_X1);
        for (int m = gw; m < MPAD; m += NGW) {
            if (m < MT) norm_row<false>(X1 + (size_t)m * D, args.in[I_NORM_MEM], H2 + (size_t)m * D, nullptr, nullptr, lane);
            else { v4u z = {0u, 0u, 0u, 0u}; v4u* o = (v4u*)(H2 + (size_t)m * D) + lane; o[0] = z; o[64] = z; }
        }
    }
    SEAM(PH_NORM2);
    if (IN_PH(PH_Q)) {
        pg8::Gemm g{(const bf16_t*)(ws + O_H2), (const bf16_t*)(ws + O_WT_MQ), MPAD, D, D}; pg8::StaticOrder S; S.init(MPAD, D, G, bx);
        pg8::EpiB16 E{(bf16_t*)(ws + O_QB), D};
        pg8::gemm_phase<pg8::EpiB16, pg8::StaticOrder, true, true>(lds, g, S, E);
    }
    SEAM(PH_Q);
    if (IN_PH(PH_ATT1)) {
        AttnIn I{(const bf16_t*)(ws + O_QB), (const bf16_t*)(ws + O_KVB), (const bf16_t*)(ws + O_VTB), (bf16_t*)(ws + O_AO)};
        for (int u = bx; u < BATCH * MEM_HEADS * (SEQ / 256); u += G) attn_prompt_unit(lds, I, u / (MEM_HEADS * (SEQ / 256)), (u / (SEQ / 256)) % MEM_HEADS, u % (SEQ / 256), tid);
        AttnSIn J{(const bf16_t*)(ws + O_QB), args.in[I_CK], args.in[I_CV], (bf16_t*)(ws + O_AO)};
        for (int u = bx; u < DEC_BATCH * MEM_HEADS / 2; u += G) attn_sample_block(lds, J, u, tid);
        GS_LOOP((size_t)(MPAD - MT) * D, b_zero_u16(i_, (bf16_t*)(ws + O_AO) + (size_t)MT * D, (size_t)(MPAD - MT) * D));
    }
    SEAM(PH_ATT1);
    if (IN_PH(PH_O)) {
        pg8::Gemm g{(const bf16_t*)(ws + O_AO), (const bf16_t*)(ws + O_WT_MO), MPAD, D, D}; pg8::StaticOrder S; S.init(MPAD, D, G, bx);
        pg8::EpiRes E{(const float*)(ws + O_X1), (const float*)(ws + O_X1), MPAD, (float*)(ws + O_X2), MT};
        pg8::gemm_phase<pg8::EpiRes, pg8::StaticOrder, true, true>(lds, g, S, E);
    }
    SEAM(PH_O);
    if (IN_PH(PH_NORM3)) {
        bf16_t* H3 = (bf16_t*)(ws + O_H3); const float* X2 = (const float*)(ws + O_X2);
        for (int m = gw; m < MPAD; m += NGW) {
            if (m < MT) norm_row<false>(X2 + (size_t)m * D, args.in[I_NORM_FFN], H3 + (size_t)m * D, nullptr, nullptr, lane);
            else { v4u z = {0u, 0u, 0u, 0u}; v4u* o = (v4u*)(H3 + (size_t)m * D) + lane; o[0] = z; o[64] = z; }
        }
    }
    SEAM(PH_NORM3);
    if (IN_PH(PH_PQ)) {
        pg8::Gemm g{(const bf16_t*)(ws + O_H3), (const bf16_t*)(ws + O_WT_PQ), MPAD, NPQ, D}; pg8::StaticOrder S; S.init(MPAD, NPQ, G, bx);
        pg8::EpiB16 E{(bf16_t*)(ws + O_PQ), NPQ};
        pg8::gemm_phase<pg8::EpiB16, pg8::StaticOrder, true, true>(lds, g, S, E);
    }
    SEAM(PH_PQ);
    if (IN_PH(PH_PK1)) {
        static_assert(MT % 16 == 0, "topk units");
        TopkIn I{(const bf16_t*)(ws + O_PQ), (const bf16_t*)(ws + O_SKB), (int*)(ws + O_IDX), (float*)(ws + O_GATE)};
        for (int u = gw; u < (MT / 16) * PEER_HEADS; u += NGW) peer_topk_unit(I, u / PEER_HEADS, u % PEER_HEADS, lane);
    }
    SEAM(PH_PK1);
    if (IN_PH(PH_PEER)) {
        for (int t = gw; t < MT; t += NGW)
            peer_token(t, (const bf16_t*)(ws + O_H3), (const int*)(ws + O_IDX), (const float*)(ws + O_GATE), ws + O_EU8, ws + O_EV8, (const float*)(ws + O_ESC),
                       (const float*)(ws + O_X2), args.in[I_NORM_FINAL], t < MP ? o_ + OO_YP + (size_t)t * D : o_ + OO_YS + (size_t)(t - MP) * D, lane);
    }
#undef IN_PH
#undef SEAM
}
#endif

extern "C" void kernel_launch(void* const* d_in, const int* in_sizes, int n_in, void* d_out, int out_size, void* d_ws, size_t ws_size, hipStream_t stream) {
    const float* const* in = (const float* const*)d_in;
    const float *x_prompt = in[0], *x_sample = in[1], *mem_prompt = in[2], *state_ssm = in[3], *state_conv = in[4], *state_wkv = in[5], *state_shift = in[6], *cache_k = in[7], *cache_v = in[8];
    const float *norm_mix_w = in[9], *w_in = in[10], *conv_w = in[11], *conv_b = in[12], *dt_bias = in[13], *a_log = in[14], *d_skip = in[15], *ssd_norm_w = in[16];
    const float *rwkv_mu = in[17], *rwkv_w0 = in[18], *rwkv_w2 = in[19], *rwkv_a0 = in[20], *rwkv_a2 = in[21], *rwkv_g2 = in[22], *rwkv_k_k = in[23], *rwkv_k_a = in[24], *rwkv_r_k = in[25], *rwkv_ln_w = in[26], *rwkv_ln_b = in[27];
    const float *w_out = in[28], *norm_mem_w = in[29], *mem_norm_w = in[30], *w_mk = in[31], *w_mv = in[32], *w_mq = in[33], *w_mo = in[34], *norm_ffn_w = in[35], *w_pq = in[36], *sub_keys = in[37], *expert_u = in[38], *expert_v = in[39], *norm_final_w = in[40];
    (void)mem_prompt; (void)w_in; (void)w_out; (void)mem_norm_w; (void)w_mk; (void)w_mv; (void)w_mq; (void)w_mo; (void)w_pq; (void)norm_mix_w; (void)x_prompt; (void)x_sample;
    float* o = (float*)d_out;
    float *y_prompt = o + OO_YP, *y_sample = o + OO_YS, *ssm_p = o + OO_SSMP, *conv_p = o + OO_CONVP, *wkv_p = o + OO_WKVP, *shift_p = o + OO_SHP, *memk_p = o + OO_MKP, *memv_p = o + OO_MVP;
    float *ssm_s = o + OO_SSMS, *conv_s = o + OO_CONVS, *wkv_s = o + OO_WKVS, *shift_s = o + OO_SHS;
    unsigned char* ws = (unsigned char*)d_ws;
    if (O_END > ws_size || (size_t)out_size != OO_END || n_in != N_INPUTS) { fprintf(stderr, "kernel_launch: workspace %zu (need %zu), out %d (need %zu), n_in %d\n", ws_size, (size_t)O_END, out_size, (size_t)OO_END, n_in); return; }
    bf16_t *WT_out = (bf16_t*)(ws + O_WT_OUT), *WT_mq = (bf16_t*)(ws + O_WT_MQ), *WT_mo = (bf16_t*)(ws + O_WT_MO), *WT_pq = (bf16_t*)(ws + O_WT_PQ);
    bf16_t *PZ = (bf16_t*)(ws + O_PZ), *PXBC = (bf16_t*)(ws + O_PXBC), *PRW = (bf16_t*)(ws + O_PRW), *PGATE = (bf16_t*)(ws + O_PGATE); float* DT = (float*)(ws + O_DT);
    bf16_t* XC = (bf16_t*)(ws + O_XC);
    f16_t *R16 = (f16_t*)(ws + O_R16), *OMW16 = (f16_t*)(ws + O_OMW16), *K16 = (f16_t*)(ws + O_K16), *V16 = (f16_t*)(ws + O_V16), *KK16 = (f16_t*)(ws + O_KK16), *B16 = (f16_t*)(ws + O_B16);
    bf16_t* YR = (bf16_t*)y_prompt;
    bf16_t *Gb = (bf16_t*)(ws + O_GB), *YS = (bf16_t*)(ws + O_YS), *MERGED = (bf16_t*)(ws + O_MERGED); float* X1 = (float*)(ws + O_X1);
    bf16_t *H2 = (bf16_t*)(ws + O_H2), *Qb = (bf16_t*)(ws + O_QB), *AO = (bf16_t*)(ws + O_AO);
    float* SC = (float*)(ws + O_SC); float* X2 = (float*)(ws + O_X2); bf16_t *H3 = (bf16_t*)(ws + O_H3), *PQ = (bf16_t*)(ws + O_PQ);
    int* IDX = (int*)(ws + O_IDX); float *GATE = (float*)(ws + O_GATE), *COEF = (float*)(ws + O_COEF); float* TS = (float*)(ws + O_TS); int* TI = (int*)(ws + O_TI); float* SCP = (float*)(ws + O_SCP);

#ifndef HOST_EMU
    static int grid = 0;
    if (grid == 0) {
        int dev = 0, cus = 0, per_cu = 0;
        if (hipGetDevice(&dev) != hipSuccess || hipDeviceGetAttribute(&cus, hipDeviceAttributeMultiprocessorCount, dev) != hipSuccess) { fprintf(stderr, "kernel_launch: device query failed\n"); grid = -1; return; }
        if (hipFuncSetAttribute((const void*)mk_fwd, hipFuncAttributeMaxDynamicSharedMemorySize, LDS_BYTES) != hipSuccess) { fprintf(stderr, "kernel_launch: hipFuncSetAttribute failed\n"); grid = -1; return; }
        if (hipOccupancyMaxActiveBlocksPerMultiprocessor(&per_cu, (const void*)mk_fwd, NTHREADS, LDS_BYTES) != hipSuccess || per_cu < 1) { fprintf(stderr, "kernel_launch: occupancy query says %d blocks per CU\n", per_cu); (void)hipGetLastError(); grid = -1; return; }
        grid = cus;
    }
    if (grid < 0) return;
    (void)hipMemsetAsync(ws + O_CTL, 0, CTL_BYTES, stream);
    MkArgs a{};
    for (int i = 0; i < N_INPUTS; ++i) a.in[i] = (const float*)d_in[i];
    a.out = (float*)d_out; a.ws = ws; a.ph_lo = 0; a.ph_hi = N_PHASES; a.bar_idx = 0;
    hipLaunchKernelGGL(mk_fwd, dim3(grid), dim3(NTHREADS), LDS_BYTES, stream, a);
    return;
#define MK(lo_, hi_) do { } while (0)
#else
#define MK(lo_, hi_) do { } while (0)
    { bf16_t *WT_in = (bf16_t*)(ws + O_WT_IN), *WT_dt = (bf16_t*)(ws + O_WT_DT), *WT_mk = (bf16_t*)(ws + O_WT_MK), *WT_mv = (bf16_t*)(ws + O_WT_MV), *Hb = (bf16_t*)(ws + O_HB), *MN = (bf16_t*)(ws + O_MN);
    launch(k_wt, (size_t)NMAIN * D, stream, w_in, D, D_IN, 0, D + CONV_DIM, H_SSD, WT_in, NMAIN);
    launch(k_wt, (size_t)H_SSD * D, stream, w_in, D, D_IN, D + CONV_DIM, 1 << 30, 0, WT_dt, H_SSD);
    launch(k_wt, (size_t)D * D, stream, w_out, D, D, 0, 1 << 30, 0, WT_out, D);
    launch(k_wt, (size_t)D * D, stream, w_mk, D, D, 0, 1 << 30, 0, WT_mk, D);
    launch(k_wt, (size_t)D * D, stream, w_mv, D, D, 0, 1 << 30, 0, WT_mv, D);
    launch(k_wt, (size_t)D * D, stream, w_mq, D, D, 0, 1 << 30, 0, WT_mq, D);
    launch(k_wt, (size_t)D * D, stream, w_mo, D, D, 0, 1 << 30, 0, WT_mo, D);
    launch(k_wt, (size_t)NPQ * D, stream, w_pq, D, NPQ, 0, 1 << 30, 0, WT_pq, NPQ);
    launch(k_rmsnorm_bf16, (size_t)MP, stream, x_prompt, norm_mix_w, Hb, MP);
    launch(k_rmsnorm_bf16, (size_t)MS, stream, x_sample, norm_mix_w, Hb + (size_t)MP * D, MS);
    launch(k_rmsnorm_bf16, (size_t)NMEMROWS, stream, mem_prompt, mem_norm_w, MN, NMEMROWS);
    launch(k_gemm, (size_t)MT * D, stream, Hb, D, WT_in, D, MT, D, 0, PZ, D, (float*)nullptr, 0, (const float*)nullptr, 0);
    launch(k_gemm, (size_t)MT * CONV_DIM, stream, Hb, D, WT_in + (size_t)D * D, D, MT, CONV_DIM, 0, PXBC, CONV_DIM, (float*)nullptr, 0, (const float*)nullptr, 0);
    launch(k_gemm, (size_t)MT * RWKV_PROJ, stream, Hb, D, WT_in + (size_t)(D + CONV_DIM) * D, D, MT, RWKV_PROJ, 0, PRW, RWKV_PROJ, (float*)nullptr, 0, (const float*)nullptr, 0);
    launch(k_gemm, (size_t)MT * 2 * D, stream, Hb, D, WT_in + (size_t)(D + CONV_DIM + RWKV_PROJ) * D, D, MT, 2 * D, 0, PGATE, 2 * D, (float*)nullptr, 0, (const float*)nullptr, 0);
    launch(k_gemm, (size_t)MT * H_SSD, stream, Hb, D, WT_dt, D, MT, H_SSD, 1, (bf16_t*)nullptr, 0, DT, H_SSD, (const float*)nullptr, 0);
    launch(k_gemm, (size_t)NMEMROWS * D, stream, MN, D, WT_mk, D, NMEMROWS, D, 1, (bf16_t*)nullptr, 0, memk_p, D, (const float*)nullptr, 0);
    launch(k_gemm, (size_t)NMEMROWS * D, stream, MN, D, WT_mv, D, NMEMROWS, D, 1, (bf16_t*)nullptr, 0, memv_p, D, (const float*)nullptr, 0); }
#endif
    launch(k_conv, (size_t)MT * CONV_DIM, stream, PXBC, state_conv, conv_w, conv_b, XC);
    launch(k_convstate, (size_t)(BATCH + DEC_BATCH) * (CONV_K - 1) * CONV_DIM, stream, PXBC, state_conv, conv_p, conv_s);
    RwkvW rw{rwkv_mu, rwkv_w0, rwkv_w2, rwkv_a0, rwkv_a2, rwkv_g2, rwkv_k_k, rwkv_k_a};
    launch(k_rwkv_prep, (size_t)MT * D, stream, PRW, state_shift, rw, R16, OMW16, K16, V16, KK16, B16, Gb);
    launch(k_shiftstate, (size_t)(BATCH + DEC_BATCH) * RWKV_PROJ, stream, PRW, shift_p, shift_s);
    launch(k_copy_or_zero, (size_t)BATCH * H_SSD * P_SSD * N_SSD, stream, (const float*)nullptr, ssm_p, (size_t)BATCH * H_SSD * P_SSD * N_SSD);
    launch(k_copy_or_zero, (size_t)DEC_BATCH * H_SSD * P_SSD * N_SSD, stream, state_ssm, ssm_s, (size_t)DEC_BATCH * H_SSD * P_SSD * N_SSD);
    launch(k_ssd, (size_t)(BATCH + DEC_BATCH) * H_SSD * P_SSD, stream, XC, DT, dt_bias, a_log, d_skip, ssm_p, ssm_s, YS);
    launch(k_copy_or_zero, (size_t)BATCH * H_RWKV * HK * HK, stream, (const float*)nullptr, wkv_p, (size_t)BATCH * H_RWKV * HK * HK);
    launch(k_copy_or_zero, (size_t)DEC_BATCH * H_RWKV * HK * HK, stream, state_wkv, wkv_s, (size_t)DEC_BATCH * H_RWKV * HK * HK);
    launch(k_rwkv_scan, (size_t)(BATCH + DEC_BATCH) * H_RWKV * HK, stream, R16, OMW16, K16, V16, KK16, B16, wkv_p, wkv_s, YR);
    MergeW mw{ssd_norm_w, rwkv_r_k, rwkv_ln_w, rwkv_ln_b};
    launch(k_merge, (size_t)MT, stream, YS, YR, PZ, PGATE, Gb, R16, K16, V16, mw, MERGED);
#ifdef HOST_EMU
    launch(k_gemm, (size_t)MP * D, stream, MERGED, D, WT_out, D, MP, D, 2, (bf16_t*)nullptr, 0, X1, D, x_prompt, D);
    launch(k_gemm, (size_t)MS * D, stream, MERGED + (size_t)MP * D, D, WT_out, D, MS, D, 2, (bf16_t*)nullptr, 0, X1 + (size_t)MP * D, D, x_sample, D);
    launch(k_rmsnorm_f2b, (size_t)MT, stream, X1, norm_mem_w, H2, MT);
    launch(k_gemm, (size_t)MT * D, stream, H2, D, WT_mq, D, MT, D, 0, Qb, D, (float*)nullptr, 0, (const float*)nullptr, 0);
#else
    launch(k_zero_u16, (size_t)(MPAD - MT) * D, stream, MERGED + (size_t)MT * D, (size_t)(MPAD - MT) * D);
    MK(PH_OUT, PH_Q + 1);
#endif
    launch(k_attn_scores, (size_t)MT * MEM_HEADS * N_MEM, stream, Qb, memk_p, cache_k, SC);
    launch(k_attn_softmax, (size_t)MT * MEM_HEADS, stream, SC);
    launch(k_attn_av, (size_t)MT * D, stream, SC, memv_p, cache_v, AO);
#ifdef HOST_EMU
    launch(k_gemm, (size_t)MT * D, stream, AO, D, WT_mo, D, MT, D, 2, (bf16_t*)nullptr, 0, X2, D, X1, D);
    launch(k_rmsnorm_f2b, (size_t)MT, stream, X2, norm_ffn_w, H3, MT);
    launch(k_gemm, (size_t)MT * NPQ, stream, H3, D, WT_pq, D, MT, NPQ, 0, PQ, NPQ, (float*)nullptr, 0, (const float*)nullptr, 0);
#else
    launch(k_zero_u16, (size_t)(MPAD - MT) * D, stream, AO + (size_t)MT * D, (size_t)(MPAD - MT) * D);
    MK(PH_O, PH_PQ + 1);
#endif
    launch(k_peer_scores, (size_t)MT * PEER_HEADS * 2 * N_KEYS, stream, PQ, sub_keys, SCP);
    launch(k_peer_topk, (size_t)MT * PEER_HEADS, stream, SCP, TS, TI, IDX, GATE);
    launch(k_peer_act, (size_t)MT * NSEL, stream, H3, expert_u, IDX, GATE, COEF);
    launch(k_peer_out, (size_t)MT * D, stream, X2, expert_v, IDX, COEF);
    launch(k_final, (size_t)MT, stream, X2, norm_final_w, y_prompt, y_sample);
}
```

```cpp
#define PACK_ASM 1
#ifdef HOST_EMU
#include <cmath>
#include <cstring>
#include <cstdint>
#include <cstdio>
#include <cstddef>
typedef void* hipStream_t;
#define __global__
#define __device__
#define __host__
#define __forceinline__ inline
static thread_local size_t g_tid;
#define GTID g_tid
template <class F, class... A> static void launch(F f, size_t n, hipStream_t, A... a) {
#pragma omp parallel for schedule(static)
    for (long long i = 0; i < (long long)n; ++i) { g_tid = (size_t)i; f(a...); }
}
#else
#include <hip/hip_runtime.h>
#include <cstdint>
#include <cstdio>
#define GTID ((size_t)blockIdx.x * blockDim.x + threadIdx.x)
template <class F, class... A> static void launch(F f, size_t n, hipStream_t s, A... a) {
    if (n == 0) return;
    hipLaunchKernelGGL(f, dim3((unsigned)((n + 255) / 256)), dim3(256), 0, s, a...);
}
#endif

#ifndef D_MODEL
#define D_MODEL 1024
#define BATCH 8
#define SEQ 2048
#define DEC_BATCH 128
#define SSD_HEADDIM 64
#define SSD_GROUPS 2
#define SSD_STATE 128
#define HD_RWKV 64
#define W_RANK 64
#define A_RANK 64
#define G_RANK 128
#define N_MEM 256
#define MEM_HEADS 4
#define N_KEYS 128
#define PEER_HEADS 8
#define PEER_DKEY 256
#define PEER_TOPK 16
#endif
#define CONV_K 4
constexpr int D = D_MODEL;
constexpr int H_SSD = D / SSD_HEADDIM, P_SSD = SSD_HEADDIM, N_SSD = SSD_STATE, G_SSD = SSD_GROUPS;
constexpr int CONV_DIM = D + 2 * G_SSD * N_SSD;
constexpr int H_RWKV = D / HD_RWKV, HK = HD_RWKV;
constexpr int RWKV_PROJ = 3 * D + W_RANK + A_RANK + G_RANK;
constexpr int D_IN = D + CONV_DIM + H_SSD + RWKV_PROJ + 2 * D;
constexpr int MEM_HD = D / MEM_HEADS;
constexpr int N_EXPERTS = N_KEYS * N_KEYS, PEER_HALF = PEER_DKEY / 2, NPQ = PEER_HEADS * PEER_DKEY, NSEL = PEER_HEADS * PEER_TOPK;
constexpr int MP = BATCH * SEQ, MS = DEC_BATCH, MT = MP + MS, MPAD = (MT + 255) / 256 * 256, NMEMROWS = BATCH * N_MEM;
constexpr float NORM_EPS = 1e-6f, RWKV_LN_EPS = 64e-5f;
constexpr int NMAIN = D_IN - H_SSD;

typedef unsigned short bf16_t;
typedef _Float16 f16_t;
__host__ __device__ __forceinline__ float bf2f(bf16_t v) { unsigned u = (unsigned)v << 16; float f; memcpy(&f, &u, 4); return f; }
__host__ __device__ __forceinline__ bf16_t f2bf(float f) { unsigned u; memcpy(&u, &f, 4); u = (u + 0x7fffu + ((u >> 16) & 1u)) >> 16; return (bf16_t)u; }
__host__ __device__ __forceinline__ float siluf(float x) { return x / (1.f + expf(-x)); }
__host__ __device__ __forceinline__ float sigmoidf(float x) { return 1.f / (1.f + expf(-x)); }
__host__ __device__ __forceinline__ float softplusf(float x) { return x > 20.f ? x : log1pf(expf(x)); }
__host__ __device__ __forceinline__ float geluf(float x) { return 0.5f * x * (1.f + erff(x * 0.70710678118654752f)); }

struct RowInfo { int grp, b, t; };
__host__ __device__ __forceinline__ RowInfo rowinfo(int r) { RowInfo q; if (r < MP) { q.grp = 0; q.b = r / SEQ; q.t = r % SEQ; } else { q.grp = 1; q.b = r - MP; q.t = 0; } return q; }

__device__ __forceinline__ void b_zero_u16(size_t i, bf16_t* p, size_t n) {  if (i < n) p[i] = 0; }
__device__ __forceinline__ void b_rmsnorm_bf16(size_t i, const float* x, const float* w, bf16_t* out, int nrows) {
     if (i >= (size_t)nrows) return;
    const float* xr = x + i * D; float ss = 0.f;
    for (int c = 0; c < D; ++c) ss += xr[c] * xr[c];
    const float rs = 1.f / sqrtf(ss / D + NORM_EPS);
    for (int c = 0; c < D; ++c) out[i * D + c] = f2bf(xr[c] * rs * w[c]);
}
__device__ __forceinline__ void b_wt(size_t i, const float* W, int K, int ldw, int ncol0, int skip_at, int skip, bf16_t* WT, int N) {
     if (i >= (size_t)N * K) return;
    const int n = (int)(i / K), k = (int)(i % K); const int sc = ncol0 + n + (n >= skip_at ? skip : 0);
    WT[i] = f2bf(W[(size_t)k * ldw + sc]);
}
struct __attribute__((aligned(16))) V8 { bf16_t v[8]; };
__device__ __forceinline__ void b_gemm(size_t i, const bf16_t* A, int lda, const bf16_t* Bt, int K, int M, int N, int mode, bf16_t* ob, int ldob, float* of, int ldof, const float* base, int ldbase) {
     if (i >= (size_t)M * N) return;
    const int m = (int)(i / N), n = (int)(i % N);
    const bf16_t* a = A + (size_t)m * lda; const bf16_t* b = Bt + (size_t)n * K; float acc = 0.f;
    for (int k = 0; k < K; k += 8) { V8 va, vb; memcpy(&va, a + k, 16); memcpy(&vb, b + k, 16);
        for (int j = 0; j < 8; ++j) acc += bf2f(va.v[j]) * bf2f(vb.v[j]); }
    if (mode == 0) ob[(size_t)m * ldob + n] = f2bf(acc);
    else if (mode == 1) { of[(size_t)m * ldof + n] = acc; if (ob) ob[(size_t)m * ldob + n] = f2bf(acc); }
    else of[(size_t)m * ldof + n] = base[(size_t)m * ldbase + n] + acc;
}
__device__ __forceinline__ void b_conv(size_t i, const bf16_t* PXBC, const float* state_conv, const float* conv_w, const float* conv_b, bf16_t* XC) {
     if (i >= (size_t)MT * CONV_DIM) return;
    const int r = (int)(i / CONV_DIM), ch = (int)(i % CONV_DIM); const RowInfo q = rowinfo(r);
    float acc = conv_b[ch];
    for (int j = 0; j < CONV_K; ++j) { const int tp = q.t - (CONV_K - 1) + j; float v;
        if (tp >= 0) v = bf2f(PXBC[(size_t)(r - (q.t - tp)) * CONV_DIM + ch]);
        else v = q.grp ? state_conv[((size_t)q.b * (CONV_K - 1) + (CONV_K - 1 + tp)) * CONV_DIM + ch] : 0.f;
        acc += v * conv_w[j * CONV_DIM + ch]; }
    XC[i] = f2bf(siluf(acc));
}
__device__ __forceinline__ void b_convstate(size_t i, const bf16_t* PXBC, const float* state_conv, float* conv_p, float* conv_s) {
     const size_t np = (size_t)BATCH * (CONV_K - 1) * CONV_DIM, ns = (size_t)DEC_BATCH * (CONV_K - 1) * CONV_DIM; if (i >= np + ns) return;
    if (i < np) { const int ch = (int)(i % CONV_DIM), j = (int)((i / CONV_DIM) % (CONV_K - 1)), b = (int)(i / ((CONV_K - 1) * CONV_DIM));
        const int t = SEQ - (CONV_K - 1) + j; conv_p[i] = t >= 0 ? bf2f(PXBC[((size_t)b * SEQ + t) * CONV_DIM + ch]) : 0.f; }
    else { const size_t k = i - np; const int ch = (int)(k % CONV_DIM), j = (int)((k / CONV_DIM) % (CONV_K - 1)), b = (int)(k / ((CONV_K - 1) * CONV_DIM));
        conv_s[k] = (j + 1 < CONV_K - 1) ? state_conv[((size_t)b * (CONV_K - 1) + j + 1) * CONV_DIM + ch] : bf2f(PXBC[((size_t)MP + b) * CONV_DIM + ch]); }
}
__device__ __forceinline__ void b_copy_or_zero(size_t i, const float* src, float* dst, size_t n) {  if (i < n) dst[i] = src ? src[i] : 0.f; }
__device__ __forceinline__ void b_ssd(size_t i, const bf16_t* XC, const float* DT, const float* dt_bias, const float* a_log, const float* d_skip, float* Sp, float* Ss, bf16_t* YS) {
     const size_t np = (size_t)BATCH * H_SSD * P_SSD, ns = (size_t)DEC_BATCH * H_SSD * P_SSD; if (i >= np + ns) return;
    const int grp = i >= np; const size_t k = grp ? i - np : i; const int p = (int)(k % P_SSD), h = (int)((k / P_SSD) % H_SSD), b = (int)(k / (P_SSD * H_SSD));
    float* S = (grp ? Ss : Sp) + k * N_SSD; const int L = grp ? 1 : SEQ; const int g = h / (H_SSD / G_SSD);
    const float ah = -expf(a_log[h]), db = dt_bias[h], dsk = d_skip[h];
    for (int t = 0; t < L; ++t) { const size_t r = grp ? (size_t)MP + b : (size_t)b * SEQ + t;
        const float dt = softplusf(DT[r * H_SSD + h] + db), dA = expf(dt * ah), x = bf2f(XC[r * CONV_DIM + h * P_SSD + p]);
        const bf16_t* Bv = XC + r * CONV_DIM + D + g * N_SSD; const bf16_t* Cv = XC + r * CONV_DIM + D + G_SSD * N_SSD + g * N_SSD;
        float y = 0.f;
        for (int n = 0; n < N_SSD; ++n) { const float s = S[n] * dA + dt * x * bf2f(Bv[n]); S[n] = s; y += bf2f(Cv[n]) * s; }
        YS[r * D + h * P_SSD + p] = f2bf(y + dsk * x); }
}
__device__ __forceinline__ float rws_at(const bf16_t* PRW, const float* state_shift, const float* mu, int r, int c) {
    const RowInfo q = rowinfo(r); const float cur = bf2f(PRW[(size_t)r * RWKV_PROJ + c]);
    const float prev = q.t > 0 ? bf2f(PRW[(size_t)(r - 1) * RWKV_PROJ + c]) : (q.grp ? state_shift[(size_t)q.b * RWKV_PROJ + c] : 0.f);
    return cur + (prev - cur) * mu[c];
}
struct RwkvW { const float *mu, *w0, *w2, *a0, *a2, *g2, *k_k, *k_a; };
__device__ __forceinline__ void b_rwkv_prep(size_t i, const bf16_t* PRW, const float* state_shift, RwkvW W, f16_t* R16, f16_t* OMW16, f16_t* K16, f16_t* V16, f16_t* KK16, f16_t* B16, bf16_t* Gb) {
     if (i >= (size_t)MT * D) return;
    const int r = (int)(i / D), ch = (int)(i % D), h0 = ch / HK * HK;
    float dw = 0.f, da = 0.f, dg = 0.f;
    for (int j = 0; j < W_RANK; ++j) dw += tanhf(rws_at(PRW, state_shift, W.mu, r, 3 * D + j)) * W.w2[j * D + ch];
    for (int j = 0; j < A_RANK; ++j) da += rws_at(PRW, state_shift, W.mu, r, 3 * D + W_RANK + j) * W.a2[j * D + ch];
    for (int j = 0; j < G_RANK; ++j) dg += sigmoidf(rws_at(PRW, state_shift, W.mu, r, 3 * D + W_RANK + A_RANK + j)) * W.g2[j * D + ch];
    const float wlog = -softplusf(-(W.w0[ch] + dw)) - 0.5f, e = expf(wlog), omw = -expm1f(-e);
    const float ag = sigmoidf(W.a0[ch] + da);
    const float kv = rws_at(PRW, state_shift, W.mu, r, D + ch);
    float ss = 0.f;
    for (int c = h0; c < h0 + HK; ++c) { const float q = rws_at(PRW, state_shift, W.mu, r, D + c) * W.k_k[c]; ss += q * q; }
    const float kk = kv * W.k_k[ch] / sqrtf(fmaxf(ss, 1e-24f));
    R16[i] = (f16_t)rws_at(PRW, state_shift, W.mu, r, ch); OMW16[i] = (f16_t)omw; K16[i] = (f16_t)(kv * (1.f + (ag - 1.f) * W.k_a[ch]));
    V16[i] = (f16_t)rws_at(PRW, state_shift, W.mu, r, 2 * D + ch); KK16[i] = (f16_t)kk; B16[i] = (f16_t)(kk * ag); Gb[i] = f2bf(dg);
}
__device__ __forceinline__ void b_shiftstate(size_t i, const bf16_t* PRW, float* sh_p, float* sh_s) {
     const size_t np = (size_t)BATCH * RWKV_PROJ, ns = (size_t)DEC_BATCH * RWKV_PROJ; if (i >= np + ns) return;
    if (i < np) { const int c = (int)(i % RWKV_PROJ), b = (int)(i / RWKV_PROJ); sh_p[i] = bf2f(PRW[((size_t)b * SEQ + SEQ - 1) * RWKV_PROJ + c]); }
    else { const size_t k = i - np; const int c = (int)(k % RWKV_PROJ), b = (int)(k / RWKV_PROJ); sh_s[k] = bf2f(PRW[((size_t)MP + b) * RWKV_PROJ + c]); }
}
__device__ __forceinline__ void b_rwkv_scan(size_t i, const f16_t* R16, const f16_t* OMW16, const f16_t* K16, const f16_t* V16, const f16_t* KK16, const f16_t* B16, float* Sp, float* Ss, bf16_t* YR) {
     const size_t np = (size_t)BATCH * H_RWKV * HK, ns = (size_t)DEC_BATCH * H_RWKV * HK; if (i >= np + ns) return;
    const int grp = i >= np; const size_t k0 = grp ? i - np : i; const int v = (int)(k0 % HK), h = (int)((k0 / HK) % H_RWKV), b = (int)(k0 / (HK * H_RWKV));
    float* S = (grp ? Ss : Sp) + k0 * HK; const int L = grp ? 1 : SEQ;
    for (int t = 0; t < L; ++t) { const size_t r = grp ? (size_t)MP + b : (size_t)b * SEQ + t; const size_t o = r * D + h * HK;
        float sa = 0.f; for (int k = 0; k < HK; ++k) sa += S[k] * (float)KK16[o + k];
        const float vv = (float)V16[o + v]; float y = 0.f;
        for (int k = 0; k < HK; ++k) { float s = S[k]; s = s - s * (float)OMW16[o + k]; s = s - sa * (float)B16[o + k]; s = s + vv * (float)K16[o + k]; S[k] = s; y += s * (float)R16[o + k]; }
        YR[o + v] = f2bf(y); }
}
struct MergeW { const float *ssd_norm_w, *r_k, *ln_w, *ln_b; };
__device__ __forceinline__ void b_merge(size_t i, const bf16_t* YS, const bf16_t* YR, const bf16_t* PZ, const bf16_t* PGATE, const bf16_t* Gb, const f16_t* R16, const f16_t* K16, const f16_t* V16, MergeW W, bf16_t* MERGED) {
     if (i >= (size_t)MT) return; const size_t o = i * D;
    float ss = 0.f; for (int c = 0; c < D; ++c) { const float q = bf2f(YS[o + c]) * siluf(bf2f(PZ[o + c])); ss += q * q; }
    const float rs = 1.f / sqrtf(ss / D + NORM_EPS);
    for (int h = 0; h < H_RWKV; ++h) { float m = 0.f, bonus = 0.f;
        for (int k = 0; k < HK; ++k) { const int c = h * HK + k; m += bf2f(YR[o + c]); bonus += (float)R16[o + c] * (float)K16[o + c] * W.r_k[c]; }
        m /= HK; float var = 0.f; for (int k = 0; k < HK; ++k) { const float d = bf2f(YR[o + h * HK + k]) - m; var += d * d; } var /= HK;
        const float rstd = 1.f / sqrtf(var + RWKV_LN_EPS);
        for (int k = 0; k < HK; ++k) { const int c = h * HK + k;
            const float yssd = bf2f(YS[o + c]) * siluf(bf2f(PZ[o + c])) * rs * W.ssd_norm_w[c];
            const float yrn = (bf2f(YR[o + c]) - m) * rstd * W.ln_w[c] + W.ln_b[c];
            const float yrw = (yrn + bonus * (float)V16[o + c]) * bf2f(Gb[o + c]);
            MERGED[o + c] = f2bf(sigmoidf(bf2f(PGATE[i * 2 * D + c])) * yssd + sigmoidf(bf2f(PGATE[i * 2 * D + D + c])) * yrw); } }
}
__device__ __forceinline__ void b_rmsnorm_f2b(size_t i, const float* X, const float* w, bf16_t* out, int nrows) {  if (i >= (size_t)nrows) return;
    const float* xr = X + i * D; float ss = 0.f; for (int c = 0; c < D; ++c) ss += xr[c] * xr[c]; const float rs = 1.f / sqrtf(ss / D + NORM_EPS);
    for (int c = 0; c < D; ++c) out[i * D + c] = f2bf(xr[c] * rs * w[c]); }
__device__ __forceinline__ void b_attn_scores(size_t i, const bf16_t* Q, const float* kp, const float* kc, float* SC) {
     if (i >= (size_t)MT * MEM_HEADS * N_MEM) return;
    const int m = (int)(i % N_MEM), h = (int)((i / N_MEM) % MEM_HEADS), r = (int)(i / (N_MEM * MEM_HEADS)); const RowInfo q = rowinfo(r);
    const float* kr = (q.grp ? kc : kp) + ((size_t)q.b * N_MEM + m) * D + h * MEM_HD; const bf16_t* qr = Q + (size_t)r * D + h * MEM_HD; float acc = 0.f;
    for (int d = 0; d < MEM_HD; ++d) acc += bf2f(qr[d]) * kr[d];
    SC[i] = acc / sqrtf((float)MEM_HD);
}
__device__ __forceinline__ void b_attn_softmax(size_t i, float* SC) {  if (i >= (size_t)MT * MEM_HEADS) return; float* s = SC + i * N_MEM;
    float mx = s[0]; for (int m = 1; m < N_MEM; ++m) mx = fmaxf(mx, s[m]); float sum = 0.f; for (int m = 0; m < N_MEM; ++m) { const float e = expf(s[m] - mx); s[m] = e; sum += e; }
    const float inv = 1.f / sum; for (int m = 0; m < N_MEM; ++m) s[m] *= inv; }
__device__ __forceinline__ void b_attn_av(size_t i, const float* SC, const float* vp, const float* vc, bf16_t* AO) {
     if (i >= (size_t)MT * D) return; const int c = (int)(i % D), r = (int)(i / D), h = c / MEM_HD; const RowInfo q = rowinfo(r);
    const float* vb = (q.grp ? vc : vp) + (size_t)q.b * N_MEM * D + c; const float* s = SC + ((size_t)r * MEM_HEADS + h) * N_MEM; float acc = 0.f;
    for (int m = 0; m < N_MEM; ++m) acc += s[m] * vb[(size_t)m * D];
    AO[i] = f2bf(acc);
}
__device__ __forceinline__ void b_peer_scores(size_t i, const bf16_t* PQ, const float* sub_keys, float* SCP) {
     if (i >= (size_t)MT * PEER_HEADS * 2 * N_KEYS) return;
    const int key = (int)(i % N_KEYS), c = (int)((i / N_KEYS) % 2), h = (int)((i / (2 * N_KEYS)) % PEER_HEADS), r = (int)(i / ((size_t)2 * N_KEYS * PEER_HEADS));
    const bf16_t* q = PQ + (size_t)r * NPQ + h * PEER_DKEY + c * PEER_HALF; const float* kk = sub_keys + (((size_t)h * 2 + c) * N_KEYS + key) * PEER_HALF; float acc = 0.f;
    for (int d = 0; d < PEER_HALF; ++d) acc += bf2f(q[d]) * kk[d];
    SCP[i] = acc;
}
__device__ __forceinline__ void b_peer_topk(size_t i, const float* SCP, float* TS, int* TI, int* IDX, float* GATE) {
     if (i >= (size_t)MT * PEER_HEADS) return;
    float* ts = TS + i * 2 * PEER_TOPK; int* ti = TI + i * 2 * PEER_TOPK;
    for (int c = 0; c < 2; ++c) { const float* s = SCP + (i * 2 + c) * N_KEYS; float pv = INFINITY; int pi = -1;
        for (int j = 0; j < PEER_TOPK; ++j) { float bv = -INFINITY; int bi = -1;
            for (int k = 0; k < N_KEYS; ++k) { const float v = s[k]; const bool after = (v < pv) || (v == pv && k > pi); if (after && (v > bv)) { bv = v; bi = k; } }
            ts[c * PEER_TOPK + j] = bv; ti[c * PEER_TOPK + j] = bi; pv = bv; pi = bi; } }
    float pv = INFINITY; int pi = -1; float* g = GATE + i * PEER_TOPK; int* id = IDX + i * PEER_TOPK;
    for (int j = 0; j < PEER_TOPK; ++j) { float bv = -INFINITY; int bi = -1;
        for (int k = 0; k < PEER_TOPK * PEER_TOPK; ++k) { const float v = ts[k / PEER_TOPK] + ts[PEER_TOPK + k % PEER_TOPK]; const bool after = (v < pv) || (v == pv && k > pi); if (after && (v > bv)) { bv = v; bi = k; } }
        g[j] = bv; id[j] = ti[bi / PEER_TOPK] * N_KEYS + ti[PEER_TOPK + bi % PEER_TOPK]; pv = bv; pi = bi; }
    const float mx = g[0]; float sum = 0.f; for (int j = 0; j < PEER_TOPK; ++j) { const float e = expf(g[j] - mx); g[j] = e; sum += e; }
    for (int j = 0; j < PEER_TOPK; ++j) g[j] /= sum;
}
__device__ __forceinline__ void b_peer_act(size_t i, const bf16_t* H3, const float* eu, const int* IDX, const float* GATE, float* COEF) {
     if (i >= (size_t)MT * NSEL) return; const int r = (int)(i / NSEL);
    const float* u = eu + (size_t)IDX[i] * D; const bf16_t* x = H3 + (size_t)r * D; float acc = 0.f;
    for (int d = 0; d < D; ++d) acc += bf2f(x[d]) * u[d];
    COEF[i] = GATE[i] * geluf(acc);
}
__device__ __forceinline__ void b_peer_out(size_t i, float* X2, const float* ev, const int* IDX, const float* COEF) {
     if (i >= (size_t)MT * D) return; const int r = (int)(i / D), c = (int)(i % D); float acc = 0.f;
    for (int j = 0; j < NSEL; ++j) acc += COEF[(size_t)r * NSEL + j] * ev[(size_t)IDX[(size_t)r * NSEL + j] * D + c];
    X2[i] += acc;
}
__device__ __forceinline__ void b_final(size_t i, const float* X, const float* w, float* yp, float* ys) {  if (i >= (size_t)MT) return;
    const float* xr = X + i * D; float ss = 0.f; for (int c = 0; c < D; ++c) ss += xr[c] * xr[c]; const float rs = 1.f / sqrtf(ss / D + NORM_EPS);
    float* o = i < (size_t)MP ? yp + i * D : ys + (i - MP) * D; for (int c = 0; c < D; ++c) o[c] = xr[c] * rs * w[c]; }


__global__ void k_zero_u16(bf16_t* p, size_t n) { b_zero_u16(GTID, p, n); }
__global__ void k_rmsnorm_bf16(const float* x, const float* w, bf16_t* out, int nrows) { b_rmsnorm_bf16(GTID, x, w, out, nrows); }
__global__ void k_wt(const float* W, int K, int ldw, int ncol0, int skip_at, int skip, bf16_t* WT, int N) { b_wt(GTID, W, K, ldw, ncol0, skip_at, skip, WT, N); }
__global__ void k_gemm(const bf16_t* A, int lda, const bf16_t* Bt, int K, int M, int N, int mode, bf16_t* ob, int ldob, float* of, int ldof, const float* base, int ldbase) { b_gemm(GTID, A, lda, Bt, K, M, N, mode, ob, ldob, of, ldof, base, ldbase); }
__global__ void k_conv(const bf16_t* PXBC, const float* state_conv, const float* conv_w, const float* conv_b, bf16_t* XC) { b_conv(GTID, PXBC, state_conv, conv_w, conv_b, XC); }
__global__ void k_convstate(const bf16_t* PXBC, const float* state_conv, float* conv_p, float* conv_s) { b_convstate(GTID, PXBC, state_conv, conv_p, conv_s); }
__global__ void k_copy_or_zero(const float* src, float* dst, size_t n) { b_copy_or_zero(GTID, src, dst, n); }
__global__ void k_ssd(const bf16_t* XC, const float* DT, const float* dt_bias, const float* a_log, const float* d_skip, float* Sp, float* Ss, bf16_t* YS) { b_ssd(GTID, XC, DT, dt_bias, a_log, d_skip, Sp, Ss, YS); }
__global__ void k_rwkv_prep(const bf16_t* PRW, const float* state_shift, RwkvW W, f16_t* R16, f16_t* OMW16, f16_t* K16, f16_t* V16, f16_t* KK16, f16_t* B16, bf16_t* Gb) { b_rwkv_prep(GTID, PRW, state_shift, W, R16, OMW16, K16, V16, KK16, B16, Gb); }
__global__ void k_shiftstate(const bf16_t* PRW, float* sh_p, float* sh_s) { b_shiftstate(GTID, PRW, sh_p, sh_s); }
__global__ void k_rwkv_scan(const f16_t* R16, const f16_t* OMW16, const f16_t* K16, const f16_t* V16, const f16_t* KK16, const f16_t* B16, float* Sp, float* Ss, bf16_t* YR) { b_rwkv_scan(GTID, R16, OMW16, K16, V16, KK16, B16, Sp, Ss, YR); }
__global__ void k_merge(const bf16_t* YS, const bf16_t* YR, const bf16_t* PZ, const bf16_t* PGATE, const bf16_t* Gb, const f16_t* R16, const f16_t* K16, const f16_t* V16, MergeW W, bf16_t* MERGED) { b_merge(GTID, YS, YR, PZ, PGATE, Gb, R16, K16, V16, W, MERGED); }
__global__ void k_rmsnorm_f2b(const float* X, const float* w, bf16_t* out, int nrows) { b_rmsnorm_f2b(GTID, X, w, out, nrows); }
__global__ void k_attn_scores(const bf16_t* Q, const float* kp, const float* kc, float* SC) { b_attn_scores(GTID, Q, kp, kc, SC); }
__global__ void k_attn_softmax(float* SC) { b_attn_softmax(GTID, SC); }
__global__ void k_attn_av(const float* SC, const float* vp, const float* vc, bf16_t* AO) { b_attn_av(GTID, SC, vp, vc, AO); }
__global__ void k_peer_scores(const bf16_t* PQ, const float* sub_keys, float* SCP) { b_peer_scores(GTID, PQ, sub_keys, SCP); }
__global__ void k_peer_topk(const float* SCP, float* TS, int* TI, int* IDX, float* GATE) { b_peer_topk(GTID, SCP, TS, TI, IDX, GATE); }
__global__ void k_peer_act(const bf16_t* H3, const float* eu, const int* IDX, const float* GATE, float* COEF) { b_peer_act(GTID, H3, eu, IDX, GATE, COEF); }
__global__ void k_peer_out(float* X2, const float* ev, const int* IDX, const float* COEF) { b_peer_out(GTID, X2, ev, IDX, COEF); }
__global__ void k_final(const float* X, const float* w, float* yp, float* ys) { b_final(GTID, X, w, yp, ys); }
constexpr size_t al256(size_t x) { return (x + 255) & ~(size_t)255; }
constexpr size_t cmax(size_t a, size_t b) { return a > b ? a : b; }
constexpr size_t O_WT_IN = 0;
constexpr size_t O_WT_DT = O_WT_IN + al256((size_t)NMAIN * D * 2);
constexpr size_t O_WT_OUT = O_WT_DT + al256((size_t)H_SSD * D * 2);
constexpr size_t O_WT_MK = O_WT_OUT + al256((size_t)D * D * 2);
constexpr size_t O_WT_MV = O_WT_MK + al256((size_t)D * D * 2);
constexpr size_t O_WT_MQ = O_WT_MV + al256((size_t)D * D * 2);
constexpr size_t O_WT_MO = O_WT_MQ + al256((size_t)D * D * 2);
constexpr size_t O_WT_PQ = O_WT_MO + al256((size_t)D * D * 2);
constexpr size_t O_HB = O_WT_PQ + al256((size_t)NPQ * D * 2);
constexpr size_t O_MN = O_HB + al256((size_t)MPAD * D * 2);
constexpr size_t O_PZ = O_MN + al256((size_t)NMEMROWS * D * 2);
constexpr size_t O_PXBC = O_PZ + al256((size_t)MPAD * D * 2);
constexpr size_t O_PRW = O_PXBC + al256((size_t)MPAD * CONV_DIM * 2);
constexpr size_t O_PGATE = O_PRW + al256((size_t)MPAD * RWKV_PROJ * 2);
constexpr size_t O_DT = O_PGATE + al256((size_t)MPAD * 2 * D * 2);
constexpr size_t O_XC = O_DT + al256((size_t)MT * H_SSD * 4);
constexpr size_t O_R16 = O_XC + al256(cmax((size_t)MT * CONV_DIM * 2, (size_t)MPAD * D * 2));
constexpr size_t SZ16 = al256((size_t)MT * D * 2);
constexpr size_t O_OMW16 = O_R16 + SZ16, O_K16 = O_OMW16 + SZ16, O_V16 = O_K16 + SZ16, O_KK16 = O_V16 + SZ16, O_B16 = O_KK16 + SZ16;
constexpr size_t O_T1END = O_B16 + SZ16;
constexpr size_t O_CTL = O_T1END;
constexpr size_t CTL_BYTES = 1u << 20;
constexpr size_t O_EU8 = O_CTL + CTL_BYTES;
constexpr size_t O_EV8 = O_EU8 + al256((size_t)N_EXPERTS * D);
constexpr size_t O_WT_MQS = O_EV8;
static_assert((size_t)D * D * 2 <= (size_t)N_EXPERTS * D, "scaled w_mq copy fits the former v-table slot");
constexpr size_t O_ESC = O_EV8 + al256((size_t)N_EXPERTS * D);
constexpr size_t O_KVB = O_ESC + al256((size_t)2 * N_EXPERTS * 4);
constexpr size_t O_SKB = O_KVB + al256((size_t)NMEMROWS * 2 * D * 2);
constexpr size_t O_LW2 = O_SKB + al256((size_t)PEER_HEADS * 2 * N_KEYS * PEER_HALF * 2);
constexpr size_t O_LA2 = O_LW2 + al256((size_t)D * W_RANK * 2);
constexpr size_t O_LG2 = O_LA2 + al256((size_t)D * A_RANK * 2);
constexpr size_t O_BON = O_LG2 + al256((size_t)D * G_RANK * 2);
constexpr size_t O_VTB = O_BON + al256((size_t)MT * H_RWKV * 4);
constexpr size_t O_PROF = O_VTB + al256((size_t)NMEMROWS * D * 2);
constexpr size_t O_END = O_PROF + 256;
constexpr size_t SSD_IMG_BYTES = (size_t)BATCH * (SEQ / 128) * G_SSD * 128 * N_SSD * 2;
constexpr size_t O_CG = O_XC, O_BTG = O_CG + SSD_IMG_BYTES, O_CBG = O_BTG + SSD_IMG_BYTES;
static_assert(O_CBG + SSD_IMG_BYTES <= O_R16, "ssd conv products");
constexpr size_t O_RWK = O_R16;
constexpr size_t O_GB = O_HB, O_YS = O_HB  , O_MERGED = O_XC, O_X1 = O_PGATE;
constexpr size_t O_H2 = O_PRW, O_QB = O_H2 + al256((size_t)MPAD * D * 2), O_AO = O_QB + al256((size_t)MPAD * D * 2);
static_assert(O_AO + al256((size_t)MPAD * D * 2) <= O_PGATE, "late overlay 1");
static_assert((size_t)MPAD * D * 4 <= (size_t)MPAD * 2 * D * 2, "X1 overlay");
constexpr size_t O_SC = O_XC, O_X2 = O_SC + al256((size_t)MT * MEM_HEADS * N_MEM * 4), O_H3 = O_X2 + al256((size_t)MPAD * D * 4), O_PQ = O_H3 + al256((size_t)MPAD * D * 2);
static_assert(O_PQ + al256((size_t)MPAD * NPQ * 2) <= O_T1END, "late overlay 2");
constexpr size_t O_TS = O_HB, O_TI = O_TS + al256((size_t)MT * PEER_HEADS * 2 * PEER_TOPK * 4);
static_assert(O_TI + al256((size_t)MT * PEER_HEADS * 2 * PEER_TOPK * 4) <= O_PZ, "topk temp overlay");
constexpr size_t O_SCP = O_PZ;
constexpr size_t O_IDX = O_SCP + al256((size_t)MT * PEER_HEADS * 2 * N_KEYS * 4), O_GATE = O_IDX + al256((size_t)MT * NSEL * 4), O_COEF = O_GATE + al256((size_t)MT * NSEL * 4);
static_assert(O_COEF + al256((size_t)MT * NSEL * 4) <= O_PGATE, "SCP/IDX/GATE/COEF overlay");

constexpr size_t OO_YP = 0, OO_YS = OO_YP + (size_t)MP * D, OO_SSMP = OO_YS + (size_t)MS * D, OO_CONVP = OO_SSMP + (size_t)BATCH * H_SSD * P_SSD * N_SSD,
    OO_WKVP = OO_CONVP + (size_t)BATCH * (CONV_K - 1) * CONV_DIM, OO_SHP = OO_WKVP + (size_t)BATCH * H_RWKV * HK * HK, OO_MKP = OO_SHP + (size_t)BATCH * RWKV_PROJ,
    OO_MVP = OO_MKP + (size_t)NMEMROWS * D, OO_SSMS = OO_MVP + (size_t)NMEMROWS * D, OO_CONVS = OO_SSMS + (size_t)DEC_BATCH * H_SSD * P_SSD * N_SSD,
    OO_WKVS = OO_CONVS + (size_t)DEC_BATCH * (CONV_K - 1) * CONV_DIM, OO_SHS = OO_WKVS + (size_t)DEC_BATCH * H_RWKV * HK * HK, OO_END = OO_SHS + (size_t)DEC_BATCH * RWKV_PROJ;
enum InIdx { I_XP = 0, I_XS, I_MEM, I_SSSM, I_SCONV, I_SWKV, I_SSHIFT, I_CK, I_CV, I_NORM_MIX, I_W_IN, I_CONV_W, I_CONV_B, I_DT_BIAS, I_A_LOG, I_D_SKIP, I_SSD_NORM, I_MU, I_W0, I_W2, I_A0, I_A2, I_G2,
    I_K_K, I_K_A, I_R_K, I_LN_W, I_LN_B, I_W_OUT, I_NORM_MEM, I_MEM_NORM, I_W_MK, I_W_MV, I_W_MQ, I_W_MO, I_NORM_FFN, I_W_PQ, I_SUBK, I_EU, I_EV, I_NORM_FINAL, N_INPUTS };

#ifndef HOST_EMU
namespace pg8 {
#define PG8_LAS __attribute__((address_space(3)))
typedef unsigned short bf16_t;
typedef short bf16x8 __attribute__((ext_vector_type(8)));
typedef float f32x4 __attribute__((ext_vector_type(4)));
typedef unsigned u32x4 __attribute__((ext_vector_type(4)));
constexpr int BM = 256, BK = 64, HALF = 128, HTB = HALF * BK * 2  , STAGE_BYTES = 8 * HTB, NXCD = 8, WGM = 8;

__host__ __device__ __forceinline__ int lds_byte(int r, int c) { const int st = (r >> 4) * 2 + (c >> 5), rr = r & 15, cc = c & 31, ob = rr * 64 + cc * 2; return st * 1024 + (ob ^ (((ob >> 9) & 1) << 5)); }
__host__ __device__ __forceinline__ void stage_rc(int b, int& R, int& C) { const int st = b / 1024, sb = b % 1024, swz = sb ^ (((sb >> 9) & 1) << 5); R = (st >> 1) * 16 + swz / 64; C = (st & 1) * 32 + (swz % 64) / 2; }
__host__ __device__ __forceinline__ int perm32(int rho) { const int n = rho >> 4, i = rho & 15; return 8 * (i >> 2) + 4 * n + (i & 3); }

struct Unit { int pm, pn; };
struct Gemm { const bf16_t* A; const bf16_t* Bt; int M, N, K; };

struct StaticOrder {
    int nM, nN, nwg, G, c;
    __host__ __device__ void init(int M, int N, int G_, int c_) { nM = M / BM; nN = N / BM; nwg = nM * nN; G = G_; c = c_; }
    __host__ __device__ __attribute__((always_inline)) bool next(int i, Unit& u) const {
        const long L = (long)i * G + c; if (L >= nwg) return false;
        int wgid = (int)L; { const int q = nwg / NXCD, r = nwg % NXCD, xcd = wgid % NXCD, off = wgid / NXCD; wgid = (xcd < r ? xcd * (q + 1) : r * (q + 1) + (xcd - r) * q) + off; }
        const int nig = WGM * nN, gid = wgid / nig, fm = gid * WGM, gsz = (nM - fm) < WGM ? (nM - fm) : WGM;
        u.pm = fm + ((wgid % nig) % gsz); u.pn = (wgid % nig) / gsz; return true;
    }
    __device__ __forceinline__ void a_ready(const Unit&) const {}
    __device__ __forceinline__ void done(const Unit&) const {}
};

__device__ __forceinline__ unsigned cvt_pk_bf16(float lo, float hi) { unsigned r; asm volatile("v_cvt_pk_bf16_f32 %0, %1, %2" : "=v"(r) : "v"(lo), "v"(hi)); return r; }
typedef float f32x2 __attribute__((ext_vector_type(2)));
template <class Epi, class Sched, bool ALIGN_EPI = false, bool SP2 = false>
__device__ __forceinline__ void gemm_phase(PG8_LAS unsigned char* lds, const Gemm g, const Sched& S, const Epi& E) {
    const int tid = threadIdx.x, wid = __builtin_amdgcn_readfirstlane(tid >> 6), lane = tid & 63, wr = wid >> 2, wc = wid & 3, fr = lane & 15, fq = lane >> 4;
    const int K = g.K, nt = K / BK;
    unsigned voffA[2], voffB[2];
#pragma unroll
    for (int i = 0; i < 2; ++i) { int R, C; stage_rc(tid * 16 + i * 8192, R, C); const int Rb = Epi::PERM ? ((R & ~31) + perm32(R & 31)) : R;
        voffA[i] = (unsigned)(R * K + C) * 2u; voffB[i] = (unsigned)(Rb * K + C) * 2u; }
    const size_t kstep = (size_t)(BK * 2);
    const size_t hstep = (size_t)HALF * K * 2;
    const size_t tstep = 2 * hstep;
    const unsigned ldsw = (unsigned)wid * 1024u;
    const int aoff = lds_byte(wr * 64 + fr, fq * 8), boff = lds_byte(wc * 32 + fr, fq * 8);
#define PG8_SA(b, h) (((b) * 2 + (h)) * HTB)
#define PG8_SB(b, h) ((4 + (b) * 2 + (h)) * HTB)
#define PG8_STAGE(bufoff, gbase, voff) do { _Pragma("unroll") for (int _i = 0; _i < 2; ++_i) \
        __builtin_amdgcn_global_load_lds((const unsigned*)((const char*)(gbase) + (voff)[_i]), (PG8_LAS unsigned*)(lds + (bufoff) + ldsw + _i * 8192), 16, 0, 0); } while (0)
#define PG8_LDA(dst, b, h) do { _Pragma("unroll") for (int m = 0; m < 4; ++m) _Pragma("unroll") for (int k = 0; k < 2; ++k) dst[m][k] = *(const PG8_LAS bf16x8*)(lds + PG8_SA(b, h) + aoff + m * 2048 + k * 1024); } while (0)
#define PG8_LDB(dst, b, h) do { _Pragma("unroll") for (int n = 0; n < 2; ++n) _Pragma("unroll") for (int k = 0; k < 2; ++k) dst[n][k] = *(const PG8_LAS bf16x8*)(lds + PG8_SB(b, h) + boff + n * 2048 + k * 1024); } while (0)
#define PG8_MMA(ai, bj, At, Bt) do { __builtin_amdgcn_s_setprio(1); _Pragma("unroll") for (int m = 0; m < 4; ++m) _Pragma("unroll") for (int n = 0; n < 2; ++n) _Pragma("unroll") for (int k = 0; k < 2; ++k) \
        acc[ai][bj][m][n] = __builtin_amdgcn_mfma_f32_16x16x32_bf16(Bt[n][k], At[m][k], acc[ai][bj][m][n], 0, 0, 0); __builtin_amdgcn_s_setprio(0); } while (0)
#define PG8_WAIT_V(n) asm volatile("s_waitcnt vmcnt(" #n ")" ::: "memory")
#define PG8_WAIT_L(n) asm volatile("s_waitcnt lgkmcnt(" #n ")" ::: "memory")
#define PG8_BAR __builtin_amdgcn_s_barrier()
#define PG8_SCHED __builtin_amdgcn_sched_barrier(0)
    Unit cur, nxt; int ui = 0;
    if (!S.next(0, cur)) return;
    f32x4 acc[2][2][4][2];
#pragma unroll
    for (int a = 0; a < 2; ++a)
#pragma unroll
        for (int b = 0; b < 2; ++b)
#pragma unroll
            for (int m = 0; m < 4; ++m)
#pragma unroll
                for (int n = 0; n < 2; ++n) acc[a][b][m][n] = (f32x4){0.f, 0.f, 0.f, 0.f};
    bf16x8 At[4][2], B0[2][2], B1[2][2];
    const char* cA = (const char*)g.A + (size_t)cur.pm * tstep; const char* cB = (const char*)g.Bt + (size_t)cur.pn * tstep;
    S.a_ready(cur);
    if constexpr (SP2) {
        PG8_STAGE(PG8_SB(0, 0), cB, voffB); PG8_STAGE(PG8_SB(0, 1), cB + hstep, voffB); PG8_STAGE(PG8_SA(0, 0), cA, voffA); PG8_STAGE(PG8_SA(0, 1), cA + hstep, voffA);
        if (wr == 1) PG8_BAR;
        PG8_WAIT_V(2); PG8_BAR;
        PG8_STAGE(PG8_SB(1, 0), cB + kstep, voffB); PG8_STAGE(PG8_SA(1, 0), cA + kstep, voffA); PG8_STAGE(PG8_SB(1, 1), cB + hstep + kstep, voffB);
        PG8_WAIT_V(6); PG8_BAR;
    } else {
        PG8_STAGE(PG8_SB(0, 0), cB, voffB); PG8_STAGE(PG8_SA(0, 0), cA, voffA); PG8_STAGE(PG8_SB(0, 1), cB + hstep, voffB); PG8_STAGE(PG8_SA(0, 1), cA + hstep, voffA);
        if (wr == 1) PG8_BAR;
        PG8_WAIT_V(4); PG8_BAR;
        PG8_STAGE(PG8_SB(1, 0), cB + kstep, voffB); PG8_STAGE(PG8_SA(1, 0), cA + kstep, voffA); PG8_STAGE(PG8_SB(1, 1), cB + hstep + kstep, voffB);
        PG8_WAIT_V(6); PG8_BAR;
    }
    for (;;) {
        const bool has_next = S.next(ui + 1, nxt);
        const char* nA = has_next ? (const char*)g.A + (size_t)nxt.pm * tstep : cA; const char* nB = has_next ? (const char*)g.Bt + (size_t)nxt.pn * tstep : cB;
        for (int t = 0; t < nt; t += 2) {
            const bool last = (t == nt - 2);
            const char* a1 = cA + (size_t)(t + 1) * kstep;
            const char* a2 = last ? nA : cA + (size_t)(t + 2) * kstep; const char* b2 = last ? nB : cB + (size_t)(t + 2) * kstep;
            const char* a3 = a2 + kstep; const char* b3 = b2 + kstep;
            if (last && has_next) S.a_ready(nxt);
            if constexpr (SP2) {
            PG8_LDB(B0, 0, 0); PG8_LDB(B1, 0, 1); PG8_SCHED; PG8_LDA(At, 0, 0); PG8_STAGE(PG8_SA(1, 1), a1 + hstep, voffA);
            PG8_WAIT_V(8); PG8_WAIT_L(0); PG8_BAR; PG8_MMA(0, 0, At, B0); PG8_MMA(0, 1, At, B1); PG8_BAR; PG8_SCHED;
            PG8_LDA(At, 0, 1); PG8_STAGE(PG8_SB(0, 0), b2, voffB); PG8_STAGE(PG8_SB(0, 1), b2 + hstep, voffB); PG8_STAGE(PG8_SA(0, 0), a2, voffA);
            PG8_WAIT_V(8); PG8_WAIT_L(0); PG8_BAR; PG8_MMA(1, 0, At, B0); PG8_MMA(1, 1, At, B1); PG8_BAR; PG8_SCHED;
            PG8_LDB(B0, 1, 0); PG8_LDB(B1, 1, 1); PG8_SCHED; PG8_LDA(At, 1, 0); PG8_STAGE(PG8_SA(0, 1), a2 + hstep, voffA);
            PG8_WAIT_V(8); PG8_WAIT_L(0); PG8_BAR; PG8_MMA(0, 0, At, B0); PG8_MMA(0, 1, At, B1); PG8_BAR; PG8_SCHED;
            PG8_LDA(At, 1, 1); PG8_STAGE(PG8_SB(1, 0), b3, voffB); PG8_STAGE(PG8_SB(1, 1), b3 + hstep, voffB); PG8_STAGE(PG8_SA(1, 0), a3, voffA);
            PG8_WAIT_V(8); PG8_WAIT_L(0); PG8_BAR; PG8_MMA(1, 0, At, B0); PG8_MMA(1, 1, At, B1); PG8_BAR; PG8_SCHED;
            } else {
            PG8_LDB(B0, 0, 0); PG8_SCHED; PG8_LDA(At, 0, 0); PG8_STAGE(PG8_SA(1, 1), a1 + hstep, voffA);
            PG8_WAIT_L(8); PG8_BAR; PG8_WAIT_L(0); PG8_MMA(0, 0, At, B0); PG8_BAR; PG8_SCHED;
            PG8_LDB(B1, 0, 1); PG8_STAGE(PG8_SB(0, 0), b2, voffB);
            PG8_BAR; PG8_WAIT_L(0); PG8_MMA(0, 1, At, B1); PG8_BAR;
            PG8_LDA(At, 0, 1); PG8_STAGE(PG8_SA(0, 0), a2, voffA);
            PG8_BAR; PG8_WAIT_L(0); PG8_MMA(1, 0, At, B0); PG8_BAR; PG8_SCHED;
            PG8_STAGE(PG8_SB(0, 1), b2 + hstep, voffB);
            PG8_WAIT_V(6); PG8_BAR; PG8_MMA(1, 1, At, B1); PG8_BAR;
            PG8_LDB(B0, 1, 0); PG8_SCHED; PG8_LDA(At, 1, 0); PG8_STAGE(PG8_SA(0, 1), a2 + hstep, voffA);
            PG8_WAIT_L(8); PG8_BAR; PG8_WAIT_L(0); PG8_MMA(0, 0, At, B0); PG8_BAR; PG8_SCHED;
            PG8_LDB(B1, 1, 1); PG8_STAGE(PG8_SB(1, 0), b3, voffB);
            PG8_BAR; PG8_WAIT_L(0); PG8_MMA(0, 1, At, B1); PG8_BAR;
            PG8_LDA(At, 1, 1); PG8_STAGE(PG8_SA(1, 0), a3, voffA);
            PG8_BAR; PG8_WAIT_L(0); PG8_MMA(1, 0, At, B0); PG8_BAR; PG8_SCHED;
            PG8_STAGE(PG8_SB(1, 1), b3 + hstep, voffB);
            PG8_WAIT_V(6); PG8_BAR; PG8_MMA(1, 1, At, B1); PG8_BAR;
            }
        }
        if constexpr (ALIGN_EPI) { if (wr == 0) PG8_BAR; }
        if constexpr (!Epi::AFTER_DRAIN) { E(acc, cur, wr, wc, fr, fq); S.done(cur); }
        if (!has_next) break;
#pragma unroll
        for (int a = 0; a < 2; ++a)
#pragma unroll
            for (int b = 0; b < 2; ++b)
#pragma unroll
                for (int m = 0; m < 4; ++m)
#pragma unroll
                    for (int n = 0; n < 2; ++n) acc[a][b][m][n] = (f32x4){0.f, 0.f, 0.f, 0.f};
        cur = nxt; cA = nA; cB = nB; ++ui;
        if constexpr (ALIGN_EPI) { if (wr == 1) PG8_BAR; }
    }
    PG8_WAIT_V(0);
    if constexpr (!ALIGN_EPI) { if (wr == 0) PG8_BAR; }
    PG8_BAR;
    if constexpr (Epi::AFTER_DRAIN) { E.fused(acc, cur, wr, wc, fr, fq, lds, wid, lane); S.done(cur); }
#undef PG8_SA
#undef PG8_SB
#undef PG8_STAGE
#undef PG8_LDA
#undef PG8_LDB
#undef PG8_MMA
#undef PG8_WAIT_V
#undef PG8_WAIT_L
#undef PG8_BAR
#undef PG8_SCHED
}
}

namespace pg8 {
struct EpiProj {
    static constexpr bool PERM = true, AFTER_DRAIN = false;
    bf16_t *PZ, *PXBC, *PRW, *PGATE;
    __device__ __forceinline__ void operator()(const f32x4 (&acc)[2][2][4][2], const Unit& u, int wr, int wc, int fr, int fq) const {
        constexpr int T0 = D / 256, T1 = T0 + CONV_DIM / 256, T2 = T1 + RWKV_PROJ / 256;
        bf16_t* base; int ldc, colt;
        if (u.pn < T0) { base = PZ; ldc = D; colt = u.pn * BM; }
        else if (u.pn < T1) { base = PXBC; ldc = CONV_DIM; colt = (u.pn - T0) * BM; }
        else if (u.pn < T2) { base = PRW; ldc = RWKV_PROJ; colt = (u.pn - T1) * BM; }
        else { base = PGATE; ldc = 2 * D; colt = (u.pn - T2) * BM; }
        const int row0 = u.pm * BM + wr * 64 + fr, col0 = colt + wc * 32 + 8 * fq;
#pragma unroll
        for (int ai = 0; ai < 2; ++ai)
#pragma unroll
            for (int m = 0; m < 4; ++m) { bf16_t* rowp = base + (size_t)(row0 + ai * HALF + m * 16) * ldc + col0;
#pragma unroll
                for (int bj = 0; bj < 2; ++bj) { const f32x4 v0 = acc[ai][bj][m][0], v1 = acc[ai][bj][m][1];
                    u32x4 w; w.x = cvt_pk_bf16(v0[0], v0[1]); w.y = cvt_pk_bf16(v0[2], v0[3]); w.z = cvt_pk_bf16(v1[0], v1[1]); w.w = cvt_pk_bf16(v1[2], v1[3]);
                    *(u32x4*)(rowp + bj * HALF) = w; } }
    }
};
struct EpiB16 {
    static constexpr bool PERM = true, AFTER_DRAIN = false;
    bf16_t* O; int ldc;
    __device__ __forceinline__ void operator()(const f32x4 (&acc)[2][2][4][2], const Unit& u, int wr, int wc, int fr, int fq) const {
        const int row0 = u.pm * BM + wr * 64 + fr, col0 = u.pn * BM + wc * 32 + 8 * fq;
#pragma unroll
        for (int ai = 0; ai < 2; ++ai)
#pragma unroll
            for (int m = 0; m < 4; ++m) { bf16_t* rowp = O + (size_t)(row0 + ai * HALF + m * 16) * ldc + col0;
#pragma unroll
                for (int bj = 0; bj < 2; ++bj) { const f32x4 v0 = acc[ai][bj][m][0], v1 = acc[ai][bj][m][1];
                    u32x4 w; w.x = cvt_pk_bf16(v0[0], v0[1]); w.y = cvt_pk_bf16(v0[2], v0[3]); w.z = cvt_pk_bf16(v1[0], v1[1]); w.w = cvt_pk_bf16(v1[2], v1[3]);
                    *(u32x4*)(rowp + bj * HALF) = w; } }
    }
};
struct EpiKV {
    static constexpr bool PERM = false, AFTER_DRAIN = false;
    float *mk, *mv; bf16_t* kvb; bf16_t* vtb;
    __device__ __forceinline__ void operator()(const f32x4 (&acc)[2][2][4][2], const Unit& u, int wr, int wc, int fr, int fq) const {
        const int row0 = u.pm * BM + wr * 64 + fr, col0 = u.pn * BM + wc * 32 + 4 * fq;
        float* ob = col0 < D ? mk : mv; const int colo = col0 < D ? col0 : col0 - D;
#pragma unroll
        for (int ai = 0; ai < 2; ++ai)
#pragma unroll
            for (int m = 0; m < 4; ++m) { const size_t r = (size_t)(row0 + ai * HALF + m * 16);
#pragma unroll
                for (int bj = 0; bj < 2; ++bj)
#pragma unroll
                    for (int n = 0; n < 2; ++n) { const f32x4 v = acc[ai][bj][m][n];
                        *(f32x4*)(ob + r * D + colo + bj * HALF + n * 16) = v;
                        typedef unsigned u32x2 __attribute__((ext_vector_type(2))); u32x2 w; w.x = cvt_pk_bf16(v[0], v[1]); w.y = cvt_pk_bf16(v[2], v[3]);
                        *(u32x2*)(kvb + r * 2 * D + col0 + bj * HALF + n * 16) = w;
                        if (col0 >= D) { const int cc = colo + bj * HALF + n * 16, hh_ = cc / MEM_HD, dd = cc % MEM_HD; const size_t bb_ = r / N_MEM, mm = r % N_MEM;
                            bf16_t* vp = vtb + ((bb_ * MEM_HEADS + hh_) * MEM_HD + dd) * N_MEM + mm;
                            vp[0] = (bf16_t)(w.x & 0xffffu); vp[N_MEM] = (bf16_t)(w.x >> 16); vp[2 * N_MEM] = (bf16_t)(w.y & 0xffffu); vp[3 * N_MEM] = (bf16_t)(w.y >> 16); } } }
    }
};
struct EpiRes {
    static constexpr bool PERM = false, AFTER_DRAIN = false;
    const float* base0; const float* base1; int split; float* out; int nrows;
    __device__ __forceinline__ void operator()(const f32x4 (&acc)[2][2][4][2], const Unit& u, int wr, int wc, int fr, int fq) const {
        const int row0 = u.pm * BM + wr * 64 + fr, col0 = u.pn * BM + wc * 32 + 4 * fq;
#pragma unroll
        for (int ai = 0; ai < 2; ++ai)
#pragma unroll
            for (int m = 0; m < 4; ++m) { const int r = row0 + ai * HALF + m * 16; if (r < nrows) {
                const float* bp = r < split ? base0 + (size_t)r * D : base1 + (size_t)(r - split) * D;
#pragma unroll
                for (int bj = 0; bj < 2; ++bj)
#pragma unroll
                    for (int n = 0; n < 2; ++n) { const int c = col0 + bj * HALF + n * 16; *(f32x4*)(out + (size_t)r * D + c) = *(const f32x4*)(bp + c) + acc[ai][bj][m][n]; } } }
    }
};
struct EpiResB {
    static constexpr bool PERM = true, AFTER_DRAIN = false;
    const float* base0; const float* base1; int split; const bf16_t* baseb; bf16_t* out; int nrows; float* PS;
    __device__ __forceinline__ void operator()(const f32x4 (&acc)[2][2][4][2], const Unit& u, int wr, int wc, int fr, int fq) const {
        const int row0 = u.pm * BM + wr * 64 + fr, col0 = u.pn * BM + wc * 32 + 8 * fq;
#pragma unroll
        for (int ai = 0; ai < 2; ++ai)
#pragma unroll
            for (int m = 0; m < 4; ++m) { const int r = row0 + ai * HALF + m * 16; if (r < nrows) { float ssq = 0.f;
#pragma unroll
                for (int bj = 0; bj < 2; ++bj) { const int c = col0 + bj * HALF; f32x4 v0 = acc[ai][bj][m][0], v1 = acc[ai][bj][m][1];
                    if (baseb) { const u32x4 b = *(const u32x4*)(baseb + (size_t)r * D + c);
                        v0[0] += __uint_as_float(b.x << 16); v0[1] += __uint_as_float(b.x & 0xffff0000u); v0[2] += __uint_as_float(b.y << 16); v0[3] += __uint_as_float(b.y & 0xffff0000u);
                        v1[0] += __uint_as_float(b.z << 16); v1[1] += __uint_as_float(b.z & 0xffff0000u); v1[2] += __uint_as_float(b.w << 16); v1[3] += __uint_as_float(b.w & 0xffff0000u); }
                    else { const float* bp = (r < split ? base0 + (size_t)r * D : base1 + (size_t)(r - split) * D) + c; v0 += *(const f32x4*)bp; v1 += *(const f32x4*)(bp + 4); }
                    u32x4 w; w.x = cvt_pk_bf16(v0[0], v0[1]); w.y = cvt_pk_bf16(v0[2], v0[3]); w.z = cvt_pk_bf16(v1[0], v1[1]); w.w = cvt_pk_bf16(v1[2], v1[3]);
                    ssq += (v0[0] * v0[0] + v0[1] * v0[1]) + (v0[2] * v0[2] + v0[3] * v0[3]) + (v1[0] * v1[0] + v1[1] * v1[1]) + (v1[2] * v1[2] + v1[3] * v1[3]);
                    *(u32x4*)(out + (size_t)r * D + c) = w; }
                if (PS) { ssq += __shfl_xor(ssq, 16); ssq += __shfl_xor(ssq, 32); if (fq == 0) PS[(size_t)r * 16 + u.pn * 4 + wc] = ssq; } } }
    }
};
struct EpiB16S {
    static constexpr bool PERM = true, AFTER_DRAIN = false;
    bf16_t* O; int ldc; const PG8_LAS float* rs;
    __device__ __forceinline__ void operator()(const f32x4 (&acc)[2][2][4][2], const Unit& u, int wr, int wc, int fr, int fq) const {
        const int rl0 = wr * 64 + fr, col0 = u.pn * BM + wc * 32 + 8 * fq;
#pragma unroll
        for (int ai = 0; ai < 2; ++ai)
#pragma unroll
            for (int m = 0; m < 4; ++m) { const int rl = rl0 + ai * HALF + m * 16; const float sc = rs[rl]; bf16_t* rowp = O + (size_t)(u.pm * BM + rl) * ldc + col0;
#pragma unroll
                for (int bj = 0; bj < 2; ++bj) { const f32x4 v0 = acc[ai][bj][m][0] * sc, v1 = acc[ai][bj][m][1] * sc;
                    u32x4 w; w.x = cvt_pk_bf16(v0[0], v0[1]); w.y = cvt_pk_bf16(v0[2], v0[3]); w.z = cvt_pk_bf16(v1[0], v1[1]); w.w = cvt_pk_bf16(v1[2], v1[3]);
                    *(u32x4*)(rowp + bj * HALF) = w; } }
    }
};
}

#define GAS __attribute__((address_space(1)))
#define LAS __attribute__((address_space(3)))
typedef unsigned v4u __attribute__((ext_vector_type(4)));
typedef float f32x4 __attribute__((ext_vector_type(4)));
typedef GAS unsigned gu32;
#define RLX_AGENT __ATOMIC_RELAXED, __HIP_MEMORY_SCOPE_AGENT
#define LDS_WAIT() asm volatile("s_waitcnt lgkmcnt(0)" ::: "memory")
#define VM_WAIT() asm volatile("s_waitcnt vmcnt(0)" ::: "memory")
#define XB_TMO      128
#define XB_XCNT(j)  (256  + 64 * (j))
#define XB_XSUB(j)  (1280 + 64 * (j))
#define XB_XGEN(j)  (2304 + 64 * (j))
#define XB_TOP      3328
#define XB_TOPGEN   3392
#define XCD_BAR_WORDS 3456
#define XB_SPIN_CAP (1u << 30)

__device__ __forceinline__ unsigned xb_ld(unsigned* p)              { return __hip_atomic_load(p, __ATOMIC_RELAXED, __HIP_MEMORY_SCOPE_AGENT); }
__device__ __forceinline__ unsigned xb_add(unsigned* p, unsigned v) { return __hip_atomic_fetch_add(p, v, __ATOMIC_RELAXED, __HIP_MEMORY_SCOPE_AGENT); }
__device__ __forceinline__ unsigned xb_xcc_id() { return (unsigned)__builtin_amdgcn_s_getreg((3 << 11) | 20) & 0xFu; }
#define XB_SPIN(cond, bar) do { unsigned _sp = 0; while (cond) { __builtin_amdgcn_s_sleep(1); \
    if ((++_sp & 255u) == 0u) { if (xb_ld(&(bar)[XB_TMO])) break; if (_sp > XB_SPIN_CAP) { atomicAdd(&(bar)[XB_TMO], 1u); break; } } } } while (0)

struct XcdBarrier {
    unsigned* bar; unsigned x;
    volatile LAS unsigned* st;
};

__device__ __forceinline__ XcdBarrier xcd_barrier_post(unsigned* bar, volatile LAS unsigned* st) {
    XcdBarrier b; b.bar = bar; b.x = xb_xcc_id(); b.st = st;
    if (threadIdx.x == 0) (void)xb_add(&bar[XB_XCNT(b.x)], 1u);
    return b;
}
__device__ __forceinline__ void xcd_barrier_complete(unsigned* bar, unsigned x, unsigned& nloc, unsigned& nx) {
    const unsigned G = gridDim.x * gridDim.y * gridDim.z;
    unsigned sum, cnt, mine, sp = 0u;
    for (;;) {
        sum = 0u; cnt = 0u; mine = 0u;
#pragma unroll
        for (unsigned j = 0; j < 16; ++j) { const unsigned c = xb_ld(&bar[XB_XCNT(j)]); sum += c; cnt += (c > 0u) ? 1u : 0u; mine = (j == x) ? c : mine; }
        if (sum == G) break;
        __builtin_amdgcn_s_sleep(1);
        if ((++sp & 255u) == 0u) { if (xb_ld(&bar[XB_TMO])) break; if (sp > XB_SPIN_CAP) { atomicAdd(&bar[XB_TMO], 1u); break; } }
    }
    nloc = mine > 0u ? mine : 1u; nx = cnt > 0u ? cnt : 1u;
}

__device__ __forceinline__ void xcd_barrier(const XcdBarrier& b) {
    asm volatile("s_waitcnt vmcnt(0)" ::: "memory");
    __syncthreads();
    if (threadIdx.x == 0) {
        unsigned* bar = b.bar;
        __builtin_amdgcn_s_waitcnt(0);
        unsigned nloc = b.st[0], nx = b.st[1];
        if (nloc == 0u) { xcd_barrier_complete(bar, b.x, nloc, nx); b.st[0] = nloc; b.st[1] = nx; }
        const unsigned old = xb_add(&bar[XB_XSUB(b.x)], 1u);
        const unsigned gen = old / nloc;
        if (old + 1u == (gen + 1u) * nloc) {
            __builtin_amdgcn_fence(__ATOMIC_RELEASE, "agent");
            asm volatile("s_waitcnt vmcnt(0)" ::: "memory");
            const unsigned og = xb_add(&bar[XB_TOP], 1u);
            const unsigned tg = og / nx;
            if (og + 1u == (tg + 1u) * nx) xb_add(&bar[XB_TOPGEN], 1u);
            else XB_SPIN(xb_ld(&bar[XB_TOPGEN]) == tg, bar);
            __builtin_amdgcn_fence(__ATOMIC_ACQUIRE, "agent");
            xb_add(&bar[XB_XGEN(b.x)], 1u);
            asm volatile("s_waitcnt vmcnt(0)" ::: "memory");
        } else {
            XB_SPIN(xb_ld(&bar[XB_XGEN(b.x)]) == gen, bar);
            __builtin_amdgcn_fence(__ATOMIC_ACQUIRE, "agent");
            asm volatile("s_waitcnt vmcnt(0)" ::: "memory");
        }
    }
    __syncthreads();
}


constexpr int NWAVES = 8, NTHREADS = NWAVES * 64;
constexpr int LDS_BYTES = 163840, LDSCTL_OFF = LDS_BYTES - 1024;
constexpr int CW_LQ = 64;
constexpr int CW_PKS = 96;
constexpr int CW_BAR = 4096;

#ifndef DUP_PHASE
#define DUP_PHASE -1
#endif
enum Phase { PH_PREP = 0, PH_INPROJ, PH_CONV, PH_MIXA, PH_MERGE, PH_OUT, PH_NORM2, PH_Q, PH_ATT1, PH_O, PH_NORM3, PH_PQ, PH_PK1, PH_PEER, N_PHASES };
constexpr int MAX_LAUNCHES = 16;
#define GS_LOOP(n, call) do { for (size_t i_ = (size_t)bx * NTHREADS + tid; i_ < (size_t)(n); i_ += (size_t)G * NTHREADS) { call; } } while (0)

__device__ __forceinline__ unsigned pk2(float lo, float hi) { return (unsigned)f2bf(lo) | ((unsigned)f2bf(hi) << 16); }
__device__ __forceinline__ float wave_sum(float v) {
#pragma unroll
    for (int o = 1; o < 64; o <<= 1) v += __shfl_xor(v, o);
    return v;
}
__device__ __forceinline__ float wave_max(float v) {
#pragma unroll
    for (int o = 1; o < 64; o <<= 1) v = fmaxf(v, __shfl_xor(v, o));
    return v;
}

#ifdef PROF
#define PROF_T() ({ __builtin_amdgcn_sched_barrier(0); unsigned long long t_ = __builtin_amdgcn_s_memtime(); __builtin_amdgcn_sched_barrier(0); t_; })
#endif
struct MkArgs { const float* in[N_INPUTS]; float* out; unsigned char* ws; int ph_lo, ph_hi, bar_idx, dup; };
static_assert((CW_BAR + MAX_LAUNCHES * XCD_BAR_WORDS) * 4 <= (int)CTL_BYTES, "ctl");

__device__ __forceinline__ void p0_transpose_item(const float* W, int K, int ldw, int srccol0, bf16_t* WT, int row0, LAS float* scr, int kb, int lane, const float* kscale = nullptr) {
    const int k0 = 64 * kb;
#pragma unroll 8
    for (int i = 0; i < 32; ++i) { const int kk = 2 * i + (lane >> 5); const float wv = W[(size_t)(k0 + kk) * ldw + srccol0 + (lane & 31)]; scr[kk * 33 + (lane & 31)] = kscale ? wv * kscale[k0 + kk] : wv; }
    LDS_WAIT(); asm volatile("" ::: "memory");
    const int c = lane & 7;
#pragma unroll
    for (int j = 0; j < 4; ++j) { const int n = (lane >> 3) + 8 * j; const LAS float* s = scr + (8 * c) * 33 + n;
        v4u o; o.x = pk2(s[0 * 33], s[1 * 33]); o.y = pk2(s[2 * 33], s[3 * 33]); o.z = pk2(s[4 * 33], s[5 * 33]); o.w = pk2(s[6 * 33], s[7 * 33]);
        *(v4u*)(WT + (size_t)(row0 + n) * K + k0 + 8 * c) = o; }
    LDS_WAIT(); asm volatile("" ::: "memory");
}
__device__ __forceinline__ void norm_row_bf(const bf16_t* xrow, const float* w, bf16_t* orow, int lane) {
    const v4u a = *((const v4u*)xrow + 2 * lane), b = *((const v4u*)xrow + 2 * lane + 1); float x[16]; float s = 0.f;
#pragma unroll
    for (int j = 0; j < 4; ++j) { x[2 * j] = __uint_as_float(a[j] << 16); x[2 * j + 1] = __uint_as_float(a[j] & 0xffff0000u); x[8 + 2 * j] = __uint_as_float(b[j] << 16); x[8 + 2 * j + 1] = __uint_as_float(b[j] & 0xffff0000u); }
#pragma unroll
    for (int j = 0; j < 16; ++j) s += x[j] * x[j];
    const float rs = 1.f / sqrtf(wave_sum(s) * (1.f / D) + NORM_EPS);
    const f32x4* w4 = (const f32x4*)w + 4 * lane; v4u o0, o1;
#pragma unroll
    for (int j = 0; j < 4; ++j) { const f32x4 ww = w4[j]; const unsigned p0 = pk2(x[4 * j] * rs * ww.x, x[4 * j + 1] * rs * ww.y), p1 = pk2(x[4 * j + 2] * rs * ww.z, x[4 * j + 3] * rs * ww.w);
        if (j < 2) { o0[2 * j] = p0; o0[2 * j + 1] = p1; } else { o1[2 * (j - 2)] = p0; o1[2 * (j - 2) + 1] = p1; } }
    *((v4u*)orow + 2 * lane) = o0; *((v4u*)orow + 2 * lane + 1) = o1;
}
template <bool WITH_DT>
__device__ __forceinline__ void norm_row(const float* xrow, const float* w, bf16_t* orow, const LAS unsigned char* wdt, float* dtrow, int lane) {
    static_assert(D == 1024, "norm_row is written for D = 1024");
    const f32x4* xr = (const f32x4*)xrow + lane; const f32x4* wr4 = (const f32x4*)w + lane;
    f32x4 v[4]; float s = 0.f;
#pragma unroll
    for (int j = 0; j < 4; ++j) { v[j] = xr[64 * j]; s += (v[j].x * v[j].x + v[j].y * v[j].y) + (v[j].z * v[j].z + v[j].w * v[j].w); }
    const float rs = 1.f / sqrtf(wave_sum(s) * (1.f / D) + NORM_EPS);
    unsigned long long* o8 = (unsigned long long*)orow + lane;
#pragma unroll
    for (int j = 0; j < 4; ++j) { v[j] = v[j] * rs * wr4[64 * j]; o8[64 * j] = (unsigned long long)pk2(v[j].x, v[j].y) | ((unsigned long long)pk2(v[j].z, v[j].w) << 32); }
    if constexpr (WITH_DT) {
        static_assert(H_SSD == 16, "dt path is written for 16 heads");
        float acc16[16];
#pragma unroll
        for (int jj = 0; jj < 16; ++jj) { float a = 0.f;
#pragma unroll
            for (int j = 0; j < 4; ++j) { const f32x4 w4 = *(const LAS f32x4*)(wdt + (jj * D + 4 * (64 * j + lane)) * 4); a += (v[j].x * w4.x + v[j].y * w4.y) + (v[j].z * w4.z + v[j].w * w4.w); }
            acc16[jj] = a; }
#pragma unroll
        for (int i = 0; i < 8; ++i) { const bool up = lane & 32; const float keep = up ? acc16[i + 8] : acc16[i], send = up ? acc16[i] : acc16[i + 8]; acc16[i] = keep + __shfl_xor(send, 32); }
#pragma unroll
        for (int i = 0; i < 4; ++i) { const bool up = lane & 16; const float keep = up ? acc16[i + 4] : acc16[i], send = up ? acc16[i] : acc16[i + 4]; acc16[i] = keep + __shfl_xor(send, 16); }
#pragma unroll
        for (int i = 0; i < 2; ++i) { const bool up = lane & 8; const float keep = up ? acc16[i + 2] : acc16[i], send = up ? acc16[i] : acc16[i + 2]; acc16[i] = keep + __shfl_xor(send, 8); }
        { const bool up = lane & 4; const float keep = up ? acc16[1] : acc16[0], send = up ? acc16[0] : acc16[1]; acc16[0] = keep + __shfl_xor(send, 4); }
        acc16[0] += __shfl_xor(acc16[0], 1); acc16[0] += __shfl_xor(acc16[0], 2);
        if ((lane & 3) == 0) dtrow[(lane >> 2) & 15] = acc16[0];
    }
}
typedef unsigned u32x2 __attribute__((ext_vector_type(2)));
__device__ __forceinline__ void fp4_row(const float* src, unsigned char* dst, float* inv, int lane) {
    static_assert(D == 1024, "fp4_row is written for D = 1024");
    const f32x4* s4 = (const f32x4*)src + 4 * lane; f32x4 v[4]; float am = 0.f;
#pragma unroll
    for (int j = 0; j < 4; ++j) { v[j] = s4[j]; am = fmaxf(am, fmaxf(fmaxf(fabsf(v[j].x), fabsf(v[j].y)), fmaxf(fabsf(v[j].z), fabsf(v[j].w)))); }
    am = wave_max(am); const float sc = am > 0.f ? 6.f / am : 1.f;
    u32x2 o;
#pragma unroll
    for (int q = 0; q < 2; ++q) { unsigned p = 0u;
        p = __builtin_amdgcn_cvt_scalef32_pk_fp4_f32(p, v[2 * q].x * sc, v[2 * q].y * sc, 1.0f, 0); p = __builtin_amdgcn_cvt_scalef32_pk_fp4_f32(p, v[2 * q].z * sc, v[2 * q].w * sc, 1.0f, 1);
        p = __builtin_amdgcn_cvt_scalef32_pk_fp4_f32(p, v[2 * q + 1].x * sc, v[2 * q + 1].y * sc, 1.0f, 2); p = __builtin_amdgcn_cvt_scalef32_pk_fp4_f32(p, v[2 * q + 1].z * sc, v[2 * q + 1].w * sc, 1.0f, 3);
        o[q] = p; }
    *(u32x2*)(dst + (size_t)lane * 16) = o;
    if (lane == 0) *inv = am > 0.f ? am / 6.f : 1.f;
}
__device__ __forceinline__ void fp8_row(const float* src, unsigned char* dst, float* inv, int lane) {
    static_assert(D == 1024, "fp8_row is written for D = 1024");
    const f32x4* s4 = (const f32x4*)src + 4 * lane; f32x4 v[4]; float am = 0.f;
#pragma unroll
    for (int j = 0; j < 4; ++j) { v[j] = s4[j]; am = fmaxf(am, fmaxf(fmaxf(fabsf(v[j].x), fabsf(v[j].y)), fmaxf(fabsf(v[j].z), fabsf(v[j].w)))); }
    am = wave_max(am); const float sc = am > 0.f ? 224.f / am : 1.f;
    v4u o;
#pragma unroll
    for (int j = 0; j < 4; ++j) { int p = __builtin_amdgcn_cvt_pk_fp8_f32(v[j].x * sc, v[j].y * sc, 0, false); p = __builtin_amdgcn_cvt_pk_fp8_f32(v[j].z * sc, v[j].w * sc, p, true); o[j] = (unsigned)p; }
    *((v4u*)dst + lane) = o;
    if (lane == 0) *inv = am > 0.f ? am / 224.f : 1.f;
}

typedef float f32x2v __attribute__((ext_vector_type(2)));
#define FP8X4_FMA_DOT(accv, w, xb) do { const f32x2v lo_ = __builtin_amdgcn_cvt_pk_f32_fp8((int)(w), false), hi_ = __builtin_amdgcn_cvt_pk_f32_fp8((int)(w), true); \
    accv = fmaf(lo_.x, x[(xb)], accv); accv = fmaf(lo_.y, x[(xb) + 1], accv); accv = fmaf(hi_.x, x[(xb) + 2], accv); accv = fmaf(hi_.y, x[(xb) + 3], accv); } while (0)
#define FP8X4_AXPY(w, c, ob) do { const f32x2v lo_ = __builtin_amdgcn_cvt_pk_f32_fp8((int)(w), false), hi_ = __builtin_amdgcn_cvt_pk_f32_fp8((int)(w), true); \
    acc[(ob)] = fmaf(lo_.x, (c), acc[(ob)]); acc[(ob) + 1] = fmaf(lo_.y, (c), acc[(ob) + 1]); acc[(ob) + 2] = fmaf(hi_.x, (c), acc[(ob) + 2]); acc[(ob) + 3] = fmaf(hi_.y, (c), acc[(ob) + 3]); } while (0)
#define FP4X8_FMA_DOT(accv, w, xb) do { _Pragma("unroll") for (int s_ = 0; s_ < 4; ++s_) { const f32x2v f_ = s_ == 0 ? __builtin_amdgcn_cvt_scalef32_pk_f32_fp4((w), 1.0f, 0) : s_ == 1 ? __builtin_amdgcn_cvt_scalef32_pk_f32_fp4((w), 1.0f, 1) : s_ == 2 ? __builtin_amdgcn_cvt_scalef32_pk_f32_fp4((w), 1.0f, 2) : __builtin_amdgcn_cvt_scalef32_pk_f32_fp4((w), 1.0f, 3); \
    accv = fmaf(f_.x, x[(xb) + 2 * s_], accv); accv = fmaf(f_.y, x[(xb) + 2 * s_ + 1], accv); } } while (0)
#define FP4X8_AXPY(w, c, ob) do { _Pragma("unroll") for (int s_ = 0; s_ < 4; ++s_) { const f32x2v f_ = s_ == 0 ? __builtin_amdgcn_cvt_scalef32_pk_f32_fp4((w), 1.0f, 0) : s_ == 1 ? __builtin_amdgcn_cvt_scalef32_pk_f32_fp4((w), 1.0f, 1) : s_ == 2 ? __builtin_amdgcn_cvt_scalef32_pk_f32_fp4((w), 1.0f, 2) : __builtin_amdgcn_cvt_scalef32_pk_f32_fp4((w), 1.0f, 3); \
    acc[(ob) + 2 * s_] = fmaf(f_.x, (c), acc[(ob) + 2 * s_]); acc[(ob) + 2 * s_ + 1] = fmaf(f_.y, (c), acc[(ob) + 2 * s_ + 1]); } } while (0)
__device__ __forceinline__ void peer_token(int t, const bf16_t* H3, const int* IDX, const float* GATE, const unsigned char* EU8, const unsigned char* EV8, const float* ESC,
                                           const bf16_t* X2, const float* wfin, float* yout, int lane) {
    static_assert(D == 1024 && PEER_TOPK == 16 && PEER_HEADS == 8, "peer_token is written for D = 1024, 8 heads x 16 experts");
    float x[16], acc[16];
    { const v4u a = *((const v4u*)(H3 + (size_t)t * D) + 2 * lane), b = *((const v4u*)(H3 + (size_t)t * D) + 2 * lane + 1);
#pragma unroll
      for (int j = 0; j < 4; ++j) { x[2 * j] = __uint_as_float(a[j] << 16); x[2 * j + 1] = __uint_as_float(a[j] & 0xffff0000u); x[8 + 2 * j] = __uint_as_float(b[j] << 16); x[8 + 2 * j + 1] = __uint_as_float(b[j] & 0xffff0000u); } }
#pragma unroll
    for (int j = 0; j < 16; ++j) acc[j] = 0.f;
    const int idx_lo = IDX[(size_t)t * NSEL + lane], idx_hi = IDX[(size_t)t * NSEL + 64 + lane];
    const float gate_lo = GATE[(size_t)t * NSEL + lane], gate_hi = GATE[(size_t)t * NSEL + 64 + lane];
    const int me = (lane >> 2) & 15;
    v4u B0[8], B1[8];
#define PEER_REC(hh, e) ((const v4u*)(EU8 + (size_t)(unsigned)__builtin_amdgcn_readlane((hh) < 4 ? idx_lo : idx_hi, ((hh) & 3) * 16 + (e)) * D) + lane)
#pragma unroll
    for (int e = 0; e < 8; ++e) B0[e] = *PEER_REC(0, e);
#pragma unroll 1
    for (int h = 0; h < PEER_HEADS; ++h) {
        float p[16];
#pragma unroll
        for (int e = 0; e < 8; ++e) B1[e] = *PEER_REC(h, 8 + e);
#pragma unroll
        for (int e = 0; e < 8; ++e) { float a = 0.f; FP4X8_FMA_DOT(a, B0[e][0], 0); FP4X8_FMA_DOT(a, B0[e][1], 8); p[e] = a; }
#pragma unroll
        for (int e = 0; e < 8; ++e) { float a = 0.f; FP4X8_FMA_DOT(a, B1[e][0], 0); FP4X8_FMA_DOT(a, B1[e][1], 8); p[8 + e] = a; }
#pragma unroll
        for (int i = 0; i < 8; ++i) { const bool up = lane & 32; const float keep = up ? p[i + 8] : p[i], send = up ? p[i] : p[i + 8]; p[i] = keep + __shfl_xor(send, 32); }
#pragma unroll
        for (int i = 0; i < 4; ++i) { const bool up = lane & 16; const float keep = up ? p[i + 4] : p[i], send = up ? p[i] : p[i + 4]; p[i] = keep + __shfl_xor(send, 16); }
#pragma unroll
        for (int i = 0; i < 2; ++i) { const bool up = lane & 8; const float keep = up ? p[i + 2] : p[i], send = up ? p[i] : p[i + 2]; p[i] = keep + __shfl_xor(send, 8); }
        { const bool up = lane & 4; const float keep = up ? p[1] : p[0], send = up ? p[0] : p[1]; p[0] = keep + __shfl_xor(send, 4); }
        p[0] += __shfl_xor(p[0], 1); p[0] += __shfl_xor(p[0], 2);
        const int src = (h & 3) * 16 + me;
        const int myidx = __shfl(h < 4 ? idx_lo : idx_hi, src); const float gt = __shfl(h < 4 ? gate_lo : gate_hi, src);
        const float su = ESC[myidx], sv = ESC[N_EXPERTS + myidx];
        const float coef = gt * geluf(p[0] * su) * sv;
#pragma unroll
        for (int e = 0; e < 8; ++e) { const float c = __uint_as_float(__builtin_amdgcn_readlane(__float_as_uint(coef), 4 * e));
            FP4X8_AXPY(B0[e][2], c, 0); FP4X8_AXPY(B0[e][3], c, 8); }
        if (h + 1 < PEER_HEADS) {
#pragma unroll
            for (int e = 0; e < 8; ++e) B0[e] = *PEER_REC(h + 1, e);
        }
#pragma unroll
        for (int e = 0; e < 8; ++e) { const float c = __uint_as_float(__builtin_amdgcn_readlane(__float_as_uint(coef), 32 + 4 * e));
            FP4X8_AXPY(B1[e][2], c, 0); FP4X8_AXPY(B1[e][3], c, 8); }
    }
#undef PEER_REC
#define PEER_ROW(a, b, c) 0
#undef PEER_ROW
    const v4u xa = *((const v4u*)(X2 + (size_t)t * D) + 2 * lane), xb = *((const v4u*)(X2 + (size_t)t * D) + 2 * lane + 1); const f32x4* wf = (const f32x4*)wfin + 4 * lane; f32x4 r[4]; float ss = 0.f;
    r[0] = (f32x4){__uint_as_float(xa.x << 16), __uint_as_float(xa.x & 0xffff0000u), __uint_as_float(xa.y << 16), __uint_as_float(xa.y & 0xffff0000u)}; r[1] = (f32x4){__uint_as_float(xa.z << 16), __uint_as_float(xa.z & 0xffff0000u), __uint_as_float(xa.w << 16), __uint_as_float(xa.w & 0xffff0000u)};
    r[2] = (f32x4){__uint_as_float(xb.x << 16), __uint_as_float(xb.x & 0xffff0000u), __uint_as_float(xb.y << 16), __uint_as_float(xb.y & 0xffff0000u)}; r[3] = (f32x4){__uint_as_float(xb.z << 16), __uint_as_float(xb.z & 0xffff0000u), __uint_as_float(xb.w << 16), __uint_as_float(xb.w & 0xffff0000u)};
#pragma unroll
    for (int j = 0; j < 4; ++j) { r[j].x += acc[4 * j]; r[j].y += acc[4 * j + 1]; r[j].z += acc[4 * j + 2]; r[j].w += acc[4 * j + 3]; ss += (r[j].x * r[j].x + r[j].y * r[j].y) + (r[j].z * r[j].z + r[j].w * r[j].w); }
    const float rs = 1.f / sqrtf(wave_sum(ss) * (1.f / D) + NORM_EPS);
    f32x4* yo = (f32x4*)yout + 4 * lane;
#pragma unroll
    for (int j = 0; j < 4; ++j) yo[j] = r[j] * rs * wf[j];
}

#ifndef SCAN_CVT
__device__ __forceinline__ float fmix_lo(float a, unsigned pk, float c) { float d; asm("v_fma_mix_f32 %0, %1, %2, %3 op_sel_hi:[0,1,0]" : "=v"(d) : "v"(a), "v"(pk), "v"(c)); return d; }
__device__ __forceinline__ float fmix_hi(float a, unsigned pk, float c) { float d; asm("v_fma_mix_f32 %0, %1, %2, %3 op_sel:[0,1,0] op_sel_hi:[0,1,0]" : "=v"(d) : "v"(a), "v"(pk), "v"(c)); return d; }
#endif
#ifdef SCAN_CVT
typedef _Float16 h2v __attribute__((ext_vector_type(2)));
#undef fmix_lo
#define fmix_lo(a, pk, c) fmaf((a), (float)__builtin_bit_cast(h2v, (unsigned)(pk)).x, (c))
#define fmix_hi(a, pk, c) fmaf((a), (float)__builtin_bit_cast(h2v, (unsigned)(pk)).y, (c))
#endif
__device__ __forceinline__ float rowsum16(float v) {
    v += __builtin_bit_cast(float, __builtin_amdgcn_update_dpp(0, __builtin_bit_cast(int, v), 0xB1, 0xF, 0xF, true));
    v += __builtin_bit_cast(float, __builtin_amdgcn_update_dpp(0, __builtin_bit_cast(int, v), 0x4E, 0xF, 0xF, true));
    v += __builtin_bit_cast(float, __builtin_amdgcn_update_dpp(0, __builtin_bit_cast(int, v), 0x141, 0xF, 0xF, true));
    v += __builtin_bit_cast(float, __builtin_amdgcn_update_dpp(0, __builtin_bit_cast(int, v), 0x140, 0xF, 0xF, true));
    return v;
}
__device__ __forceinline__ unsigned pkh2(float lo, float hi) { typedef _Float16 h2 __attribute__((ext_vector_type(2))); h2 v; v.x = (_Float16)lo; v.y = (_Float16)hi; return __builtin_bit_cast(unsigned, v); }
__device__ __forceinline__ float fsigmoid(float x) { return __builtin_amdgcn_rcpf(1.f + __expf(-x)); }
namespace rw {
constexpr int CH = 64;
constexpr int L_W2H = 0, L_A2H = 9216, L_CST = 18432, L_MU = 19712, L_REC = 20992, L_VV = 70144, L_YO = 78336,
              L_AW = 82432, L_AA = 91648, L_RAW = 100864, L_END = L_RAW + (CH + 1) * 640;
#define RW_REC(t, ch) (L_REC + ((t) * 16 + ((ch) >> 2)) * 48 + ((ch) & 3) * 2)
static_assert(L_END <= LDSCTL_OFF, "rwkv LDS map");
constexpr int NPIECE = (CH + 1) * 40;
}
struct RwkvIn { const bf16_t* PRW; const bf16_t* LW2; const bf16_t* LA2; const float *mu, *w0, *a0, *k_k, *k_a, *r_k; bf16_t* YR; float* BON; float* state_out; float* prof; };

__device__ __forceinline__ void rwkv_scan_unit(LAS unsigned char* lds, const RwkvIn& I, int b, int h, int half, int tid) {
    using namespace rw;
    static_assert(D == 1024 && HK == 64 && W_RANK == 64 && A_RANK == 64 && SEQ % CH == 0, "rwkv_scan_unit shapes");
    const int lane = tid & 63, w = tid >> 6, kg = lane & 15, r = 4 * w + (lane >> 4);
    const int segcol[5] = {h * HK, D + h * HK, 2 * D + h * HK, 3 * D, 3 * D + W_RANK};
    { const int row = tid >> 3, pc = tid & 7;
      *(v4u*)(lds + L_W2H + row * 144 + pc * 16) = *(const v4u*)(I.LW2 + (size_t)(h * HK + row) * W_RANK + pc * 8);
      *(v4u*)(lds + L_A2H + row * 144 + pc * 16) = *(const v4u*)(I.LA2 + (size_t)(h * HK + row) * A_RANK + pc * 8); }
    if (tid < 320) { const int s = tid >> 6, c = tid & 63; const int gc = (s == 0 ? h * HK : s == 1 ? D + h * HK : s == 2 ? 2 * D + h * HK : s == 3 ? 3 * D : 3 * D + W_RANK) + c;
        ((LAS float*)(lds + L_MU))[tid] = I.mu[gc];
        const float* src = s == 0 ? I.w0 : s == 1 ? I.a0 : s == 2 ? I.k_k : s == 3 ? I.k_a : I.r_k;
        ((LAS float*)(lds + L_CST))[tid] = src[h * HK + c]; }
    float S[4] = {0.f, 0.f, 0.f, 0.f};
    v4u G[6];
    const size_t row0 = (size_t)b * SEQ;
    auto issue_loads = [&](int c) {
#pragma unroll
        for (int i = 0; i < 6; ++i) { const int pid = tid + 512 * i; v4u z = {0u, 0u, 0u, 0u}; G[i] = z;
            if (pid < NPIECE) { const int rr = pid / 40, sp = pid % 40, sg = sp >> 3, pc = sp & 7; const int t = c * CH + rr - 1;
                const int col = (sg == 0 ? h * HK : sg == 1 ? D + h * HK : sg == 2 ? 2 * D + h * HK : sg == 3 ? 3 * D : 3 * D + W_RANK) + pc * 8;
                if (t >= 0) G[i] = *(const v4u*)(I.PRW + (row0 + t) * RWKV_PROJ + col); } }
    };
    (void)segcol;
    issue_loads(0);
    __syncthreads();
#ifdef PROF
    unsigned long long pt_loop = 0, pt_p1 = 0, pt_p2 = 0, pt_tot0 = PROF_T(), pt_a;
#endif
    for (int c = 0; c <= SEQ / CH; ++c) {
        if (c > 0) {
#ifdef PROF
            pt_a = PROF_T();
#endif
            const LAS unsigned char* pO = lds + L_REC + kg * 48; const LAS float* pV = (const LAS float*)(lds + L_VV) + r;
            LAS bf16_t* pY = (LAS bf16_t*)(lds + L_YO) + r;
#define RW_DPP(v, ctrl) v += __builtin_bit_cast(float, __builtin_amdgcn_update_dpp(0, __builtin_bit_cast(int, v), ctrl, 0xF, 0xF, true))
#pragma unroll 1
            for (int tb = 0; tb < CH; tb += 16) { float ypend = 0.f, ykeep = 0.f;
#pragma unroll
                for (int i = 0; i < 16; ++i) { const int t = tb + i;
                    const v4u q0 = *(const LAS v4u*)(pO + t * 768), q1 = *(const LAS v4u*)(pO + t * 768 + 16); const u32x2 rr = *(const LAS u32x2*)(pO + t * 768 + 32);
                    u32x2 no, kk, nb, kh; no.x = q0.x; no.y = q0.y; kk.x = q0.z; kk.y = q0.w; nb.x = q1.x; nb.y = q1.y; kh.x = q1.z; kh.y = q1.w;
                    const float vv = pV[t * 32];
                    float sa = fmix_hi(S[1], kk.x, fmix_lo(S[0], kk.x, 0.f)) + fmix_hi(S[3], kk.y, fmix_lo(S[2], kk.y, 0.f));
                    float T0 = fmix_lo(vv, kh.x, fmix_lo(S[0], no.x, S[0])), T1 = fmix_hi(vv, kh.x, fmix_hi(S[1], no.x, S[1])), T2 = fmix_lo(vv, kh.y, fmix_lo(S[2], no.y, S[2])), T3 = fmix_hi(vv, kh.y, fmix_hi(S[3], no.y, S[3]));
                    float yq = ypend;
                    RW_DPP(sa, 0xB1); RW_DPP(yq, 0xB1); RW_DPP(sa, 0x4E); RW_DPP(yq, 0x4E); RW_DPP(sa, 0x141); RW_DPP(yq, 0x141); RW_DPP(sa, 0x140); RW_DPP(yq, 0x140);
                    if (i > 0) ykeep = kg == i - 1 ? yq : ykeep;
                    S[0] = fmix_lo(sa, nb.x, T0); S[1] = fmix_hi(sa, nb.x, T1); S[2] = fmix_lo(sa, nb.y, T2); S[3] = fmix_hi(sa, nb.y, T3);
                    ypend = fmix_hi(S[1], rr.x, fmix_lo(S[0], rr.x, 0.f)) + fmix_hi(S[3], rr.y, fmix_lo(S[2], rr.y, 0.f)); }
                { float yq = ypend; RW_DPP(yq, 0xB1); RW_DPP(yq, 0x4E); RW_DPP(yq, 0x141); RW_DPP(yq, 0x140); ykeep = kg == 15 ? yq : ykeep; }
                pY[(tb + kg) * 32] = f2bf(ykeep); }
#undef RW_DPP
#ifdef PROF
            pt_loop += PROF_T() - pt_a;
#endif
            __syncthreads();
            if (tid < 256) { const int t = tid >> 2, pc = tid & 3;
                *(v4u*)(I.YR + (row0 + (size_t)(c - 1) * CH + t) * D + h * HK + half * 32 + pc * 8) = *(const LAS v4u*)(lds + L_YO + t * 64 + pc * 16); }
        }
        if (c == SEQ / CH) break;
#pragma unroll
        for (int i = 0; i < 6; ++i) { const int pid = tid + 512 * i; if (pid < NPIECE) { const int rr_ = pid / 40, sp = pid % 40; *(LAS v4u*)(lds + L_RAW + rr_ * 640 + sp * 16) = G[i]; } }
        __syncthreads();
        if (c + 1 < SEQ / CH) issue_loads(c + 1);
#ifdef PROF
        pt_a = PROF_T();
#endif
#pragma unroll
        for (int sg = 0; sg < 5; ++sg) {
#pragma unroll
          for (int it = 0; it < 2; ++it) { const int e = tid + 512 * it;
            const int t = e >> 4, cc = (e & 15) * 4, col = sg * 64 + cc;
            const u32x2 cur = *(const LAS u32x2*)(lds + L_RAW + (t + 1) * 640 + col * 2), prv = *(const LAS u32x2*)(lds + L_RAW + t * 640 + col * 2);
            const f32x4 m4 = *(const LAS f32x4*)(lds + L_MU + col * 4);
            float x[4];
            { const float c0 = __uint_as_float(cur.x << 16), c1 = __uint_as_float(cur.x & 0xffff0000u), c2 = __uint_as_float(cur.y << 16), c3 = __uint_as_float(cur.y & 0xffff0000u);
              const float p0 = __uint_as_float(prv.x << 16), p1 = __uint_as_float(prv.x & 0xffff0000u), p2 = __uint_as_float(prv.y << 16), p3 = __uint_as_float(prv.y & 0xffff0000u);
              x[0] = c0 + (p0 - c0) * m4.x; x[1] = c1 + (p1 - c1) * m4.y; x[2] = c2 + (p2 - c2) * m4.z; x[3] = c3 + (p3 - c3) * m4.w; }
            if (sg == 0) { u32x2 o; o.x = pkh2(x[0], x[1]); o.y = pkh2(x[2], x[3]); *(LAS u32x2*)(lds + RW_REC(t, cc) + 32) = o; }
            else if (sg == 1) { u32x2 o; o.x = pkh2(x[0], x[1]); o.y = pkh2(x[2], x[3]); *(LAS u32x2*)(lds + RW_REC(t, cc) + 24) = o; }
            else if (sg == 2) { if ((cc >> 5) == half) *(LAS f32x4*)(lds + L_VV + t * 128 + (cc & 31) * 4) = (f32x4){x[0], x[1], x[2], x[3]}; }
            else if (sg == 3) { u32x2 o;
#pragma unroll
                for (int j = 0; j < 4; ++j) x[j] = 1.f - 2.f * __builtin_amdgcn_rcpf(__expf(2.f * x[j]) + 1.f);
                o.x = pk2(x[0], x[1]); o.y = pk2(x[2], x[3]); *(LAS u32x2*)(lds + L_AW + t * 144 + cc * 2) = o; }
            else { u32x2 o; o.x = pk2(x[0], x[1]); o.y = pk2(x[2], x[3]); *(LAS u32x2*)(lds + L_AA + t * 144 + cc * 2) = o; }
          } }
#ifdef PROF
        pt_p1 += PROF_T() - pt_a;
#endif
        __syncthreads();
#ifdef PROF
        pt_a = PROF_T();
#endif
        { const int role = w >> 2, tt = w & 3, fr = lane & 15, fq = lane >> 4;
          const LAS unsigned char* Aimg = lds + (role ? L_AA : L_AW); const LAS unsigned char* Wimg = lds + (role ? L_A2H : L_W2H);
          pg8::f32x4 acc[4];
#pragma unroll
          for (int nt = 0; nt < 4; ++nt) { acc[nt] = (pg8::f32x4){0.f, 0.f, 0.f, 0.f};
#pragma unroll
              for (int ks = 0; ks < 2; ++ks) { const pg8::bf16x8 af = *(const LAS pg8::bf16x8*)(Aimg + (tt * 16 + fr) * 144 + ks * 64 + fq * 16), bfr = *(const LAS pg8::bf16x8*)(Wimg + (nt * 16 + fr) * 144 + ks * 64 + fq * 16);
                  acc[nt] = __builtin_amdgcn_mfma_f32_16x16x32_bf16(af, bfr, acc[nt], 0, 0, 0); } }
          const LAS float* cst = (const LAS float*)(lds + L_CST);
          if (role == 0) {
#pragma unroll
              for (int nt = 0; nt < 4; ++nt) { const int ch = nt * 16 + fr; const float w0 = cst[ch];
#pragma unroll
                  for (int g = 0; g < 4; ++g) { const int t = tt * 16 + fq * 4 + g; const float e = 0.6065306597f * fsigmoid(w0 + acc[nt][g]); const float omw = 1.f - __expf(-e);
                      *(LAS _Float16*)(lds + RW_REC(t, ch)) = (_Float16)(-omw); } }
          } else {
              float kkr[4][4], ag[4][4], ss[4] = {0.f, 0.f, 0.f, 0.f}, bon[4] = {0.f, 0.f, 0.f, 0.f};
#pragma unroll
              for (int nt = 0; nt < 4; ++nt) { const int ch = nt * 16 + fr; const float a0 = cst[64 + ch], kk_ = cst[128 + ch], ka = cst[192 + ch], rk = cst[256 + ch];
#pragma unroll
                  for (int g = 0; g < 4; ++g) { const int t = tt * 16 + fq * 4 + g; const float a = fsigmoid(a0 + acc[nt][g]); const float k = (float)*(const LAS _Float16*)(lds + RW_REC(t, ch) + 24);
                      const float kh = k * (1.f + (a - 1.f) * ka), kq = k * kk_; ag[nt][g] = a; kkr[nt][g] = kq; ss[g] += kq * kq;
                      bon[g] += (float)*(const LAS _Float16*)(lds + RW_REC(t, ch) + 32) * kh * rk;
                      *(LAS _Float16*)(lds + RW_REC(t, ch) + 24) = (_Float16)kh; } }
#pragma unroll
              for (int g = 0; g < 4; ++g) { ss[g] = rowsum16(ss[g]); bon[g] = rowsum16(bon[g]); const float inv = 1.f / sqrtf(fmaxf(ss[g], 1e-24f)); const int t = tt * 16 + fq * 4 + g;
#pragma unroll
                  for (int nt = 0; nt < 4; ++nt) { const int ch = nt * 16 + fr; const float kk = kkr[nt][g] * inv; *(LAS _Float16*)(lds + RW_REC(t, ch) + 8) = (_Float16)kk; *(LAS _Float16*)(lds + RW_REC(t, ch) + 16) = (_Float16)(-kk * ag[nt][g]); }
                  if (fr == 0 && half == 0) I.BON[(row0 + (size_t)c * CH + t) * H_RWKV + h] = bon[g]; }
          } }
#ifdef PROF
        pt_p2 += PROF_T() - pt_a;
#endif
        __syncthreads();
    }
#ifdef PROF
    if (blockIdx.x == 0 && tid == 0) { const float tot = (float)(PROF_T() - pt_tot0); I.prof[0] = (float)pt_loop / tot; I.prof[1] = (float)pt_p1 / tot; I.prof[2] = (float)pt_p2 / tot; I.prof[3] = tot * 1e-6f; }
#endif
    *(f32x4*)(I.state_out + (((size_t)b * H_RWKV + h) * HK + half * 32 + r) * HK + kg * 4) = (f32x4){S[0], S[1], S[2], S[3]};
    __syncthreads();
}

__device__ __forceinline__ float rowsum16f(float v) {
    v += __uint_as_float((unsigned)__builtin_amdgcn_update_dpp(0, (int)__float_as_uint(v), 0xB1, 0xF, 0xF, true));
    v += __uint_as_float((unsigned)__builtin_amdgcn_update_dpp(0, (int)__float_as_uint(v), 0x4E, 0xF, 0xF, true));
    v += __uint_as_float((unsigned)__builtin_amdgcn_update_dpp(0, (int)__float_as_uint(v), 0x141, 0xF, 0xF, true));
    v += __uint_as_float((unsigned)__builtin_amdgcn_update_dpp(0, (int)__float_as_uint(v), 0x140, 0xF, 0xF, true));
    return v;
}
struct RwkvSIn { const bf16_t* PRW; const float* state_shift; const float* state_wkv; const float *mu, *w0, *w2, *a0, *a2, *k_k, *k_a, *r_k; bf16_t* YR; float* BON; float* state_out; const bf16_t *LW2, *LA2; };
__device__ __forceinline__ void rwkv_sample_unit(const RwkvSIn& I, int s, int h, int lane) {
    static_assert(HK == 64 && W_RANK == 64 && A_RANK == 64, "rwkv_sample_unit shapes");
    const size_t row = (size_t)MP + s; const bf16_t* cur = I.PRW + row * RWKV_PROJ; const float* prv = I.state_shift + (size_t)s * RWKV_PROJ;
    const int ch = h * HK + lane;
    const int r4 = lane >> 4, jj = lane & 15;
    const float* Sg = I.state_wkv + ((size_t)s * H_RWKV + h) * HK * HK + lane * 4; float* So = I.state_out + ((size_t)s * H_RWKV + h) * HK * HK + lane * 4;
    f32x4 S[16];
#pragma unroll
    for (int q = 0; q < 16; ++q) S[q] = *(const f32x4*)(Sg + q * 256);
    const int cols[5] = {ch, D + ch, 2 * D + ch, 3 * D + lane, 3 * D + W_RANK + lane};
    bf16_t c_[5]; float p_[5], m_[5];
#pragma unroll
    for (int q = 0; q < 5; ++q) { c_[q] = cur[cols[q]]; p_[q] = prv[cols[q]]; m_[q] = I.mu[cols[q]]; }
    v4u w2r[8], a2r[8];
#pragma unroll
    for (int q = 0; q < 8; ++q) { w2r[q] = *((const v4u*)(I.LW2 + (size_t)ch * W_RANK) + q); a2r[q] = *((const v4u*)(I.LA2 + (size_t)ch * A_RANK) + q); }
    const float w0c = I.w0[ch], a0c = I.a0[ch], kac = I.k_a[ch], kkc = I.k_k[ch], rkc = I.r_k[ch];
    auto lerpq = [&](int q) { const float c = bf2f(c_[q]); return c + (p_[q] - c) * m_[q]; };
    const float rr = lerpq(0), kx = lerpq(1), vx = lerpq(2);
    const float twl = tanhf(lerpq(3)), al = lerpq(4);
    float dw = 0.f, da = 0.f;
#pragma unroll
    for (int q = 0; q < 8; ++q) {
#pragma unroll
        for (int e = 0; e < 4; ++e) { const int j = 8 * q + 2 * e;
            const float t0 = __uint_as_float(__builtin_amdgcn_readlane(__float_as_uint(twl), j)), t1 = __uint_as_float(__builtin_amdgcn_readlane(__float_as_uint(twl), j + 1));
            const float g0 = __uint_as_float(__builtin_amdgcn_readlane(__float_as_uint(al), j)), g1 = __uint_as_float(__builtin_amdgcn_readlane(__float_as_uint(al), j + 1));
            dw = fmaf(t0, __uint_as_float(w2r[q][e] << 16), dw); dw = fmaf(t1, __uint_as_float(w2r[q][e] & 0xffff0000u), dw);
            da = fmaf(g0, __uint_as_float(a2r[q][e] << 16), da); da = fmaf(g1, __uint_as_float(a2r[q][e] & 0xffff0000u), da); } }
    const float e = 0.6065306597f * sigmoidf(w0c + dw), omw = -expm1f(-e), ag = sigmoidf(a0c + da);
    const float kh = kx * (1.f + (ag - 1.f) * kac), kq = kx * kkc;
    const float kk = kq / sqrtf(fmaxf(wave_sum(kq * kq), 1e-24f)), nb = -kk * ag;
    const float bon = wave_sum(rr * kh * rkc);
    if (lane == 0) I.BON[row * H_RWKV + h] = bon;
    float Kk[4], Wd[4], Nb[4], Kh[4], Rr[4];
#pragma unroll
    for (int e = 0; e < 4; ++e) { const int src = 4 * jj + e; Kk[e] = __shfl(kk, src); Wd[e] = 1.f - __shfl(omw, src); Nb[e] = __shfl(nb, src); Kh[e] = __shfl(kh, src); Rr[e] = __shfl(rr, src); }
    float yv = 0.f;
#pragma unroll
    for (int q = 0; q < 16; ++q) { const float vxr = __shfl(vx, 4 * q + r4);
        float sa = S[q][0] * Kk[0]; sa = fmaf(S[q][1], Kk[1], sa); sa = fmaf(S[q][2], Kk[2], sa); sa = fmaf(S[q][3], Kk[3], sa); sa = rowsum16f(sa);
        float yp = 0.f;
#pragma unroll
        for (int e = 0; e < 4; ++e) { float x = S[q][e] * Wd[e]; x = fmaf(sa, Nb[e], x); x = fmaf(vxr, Kh[e], x); S[q][e] = x; yp = fmaf(x, Rr[e], yp); }
        yp = rowsum16f(yp); yv = jj == q ? yp : yv; }
#pragma unroll
    for (int q = 0; q < 16; ++q) *(f32x4*)(So + q * 256) = S[q];
    I.YR[row * D + h * HK + 4 * jj + r4] = f2bf(yv);
}

namespace mg {
constexpr int L_SG = 0;
constexpr int L_G = 8192;
constexpr int L_END = L_G + 16 * D * 4;
static_assert(L_END <= LDSCTL_OFF, "merge LDS map");
}
struct MergeIn { const bf16_t *YS, *YR, *PZ, *PGATE, *PRW, *LG2; const float *BON, *state_shift, *mu, *ssd_norm_w, *ln_w, *ln_b; bf16_t* MERGED; };
__device__ __forceinline__ void merge_unit(LAS unsigned char* lds, const MergeIn& I, int t0, int tid) {
    using namespace mg;
    static_assert(D == 1024 && G_RANK == 128 && HK == 64, "merge_unit shapes");
    const int lane = tid & 63, w = tid >> 6;
    { const int t = tid >> 5, j0 = (tid & 31) * 4; const int row = t0 + t; u32x2 o; o.x = 0u; o.y = 0u;
      if (row < MT) { const RowInfo q = rowinfo(row); const int col = 3 * D + W_RANK + A_RANK + j0; float x[4];
          const u32x2 cur = *(const u32x2*)(I.PRW + (size_t)row * RWKV_PROJ + col);
          float p[4];
          if (q.t > 0) { const u32x2 pv = *(const u32x2*)(I.PRW + (size_t)(row - 1) * RWKV_PROJ + col); p[0] = __uint_as_float(pv.x << 16); p[1] = __uint_as_float(pv.x & 0xffff0000u); p[2] = __uint_as_float(pv.y << 16); p[3] = __uint_as_float(pv.y & 0xffff0000u); }
          else if (q.grp) { const f32x4 pv = *(const f32x4*)(I.state_shift + (size_t)q.b * RWKV_PROJ + col); p[0] = pv.x; p[1] = pv.y; p[2] = pv.z; p[3] = pv.w; }
          else { p[0] = p[1] = p[2] = p[3] = 0.f; }
          const f32x4 m4 = *(const f32x4*)(I.mu + col);
          const float c0 = __uint_as_float(cur.x << 16), c1 = __uint_as_float(cur.x & 0xffff0000u), c2 = __uint_as_float(cur.y << 16), c3 = __uint_as_float(cur.y & 0xffff0000u);
          x[0] = fsigmoid(c0 + (p[0] - c0) * m4.x); x[1] = fsigmoid(c1 + (p[1] - c1) * m4.y); x[2] = fsigmoid(c2 + (p[2] - c2) * m4.z); x[3] = fsigmoid(c3 + (p[3] - c3) * m4.w);
          o.x = pk2(x[0], x[1]); o.y = pk2(x[2], x[3]); }
      *(LAS u32x2*)(lds + L_SG + t * 272 + j0 * 2) = o; }
    __syncthreads();
    { const int fr = lane & 15, fq = lane >> 4; pg8::bf16x8 af[4];
#pragma unroll
      for (int ks = 0; ks < 4; ++ks) af[ks] = *(const LAS pg8::bf16x8*)(lds + L_SG + fr * 272 + ks * 64 + fq * 16);
#pragma unroll
      for (int nt = 0; nt < 8; ++nt) { const int ch = w * 128 + nt * 16 + fr; pg8::f32x4 acc = {0.f, 0.f, 0.f, 0.f};
#pragma unroll
          for (int ks = 0; ks < 4; ++ks) { const pg8::bf16x8 bfr = *(const pg8::bf16x8*)(I.LG2 + (size_t)ch * G_RANK + ks * 32 + fq * 8); acc = __builtin_amdgcn_mfma_f32_16x16x32_bf16(af[ks], bfr, acc, 0, 0, 0); }
#pragma unroll
          for (int g = 0; g < 4; ++g) ((LAS float*)(lds + L_G))[(fq * 4 + g) * D + ch] = acc[g]; } }
    __syncthreads();
    v4u kva = {0u, 0u, 0u, 0u}, kvb = {0u, 0u, 0u, 0u};
#pragma unroll 1
    for (int tt = 0; tt < 2; ++tt) { const int t = 2 * w + tt, row = t0 + t; if (row >= MT) break;
        const RowInfo q = rowinfo(row); const int c0 = 16 * lane;
        float ys[16], yr[16], zz[16];
        { const v4u a = *((const v4u*)(I.YS + (size_t)row * D) + 2 * lane), b = *((const v4u*)(I.YS + (size_t)row * D) + 2 * lane + 1);
          const v4u c = *((const v4u*)(I.PZ + (size_t)row * D) + 2 * lane), d = *((const v4u*)(I.PZ + (size_t)row * D) + 2 * lane + 1);
          const v4u e = *((const v4u*)(I.YR + (size_t)row * D) + 2 * lane), f = *((const v4u*)(I.YR + (size_t)row * D) + 2 * lane + 1);
#pragma unroll
          for (int j = 0; j < 4; ++j) { ys[2 * j] = __uint_as_float(a[j] << 16); ys[2 * j + 1] = __uint_as_float(a[j] & 0xffff0000u); ys[8 + 2 * j] = __uint_as_float(b[j] << 16); ys[8 + 2 * j + 1] = __uint_as_float(b[j] & 0xffff0000u);
              zz[2 * j] = __uint_as_float(c[j] << 16); zz[2 * j + 1] = __uint_as_float(c[j] & 0xffff0000u); zz[8 + 2 * j] = __uint_as_float(d[j] << 16); zz[8 + 2 * j + 1] = __uint_as_float(d[j] & 0xffff0000u);
              yr[2 * j] = __uint_as_float(e[j] << 16); yr[2 * j + 1] = __uint_as_float(e[j] & 0xffff0000u); yr[8 + 2 * j] = __uint_as_float(f[j] << 16); yr[8 + 2 * j + 1] = __uint_as_float(f[j] & 0xffff0000u); } }
        float ss = 0.f, sm = 0.f;
#pragma unroll
        for (int j = 0; j < 16; ++j) { ys[j] = ys[j] * zz[j] * fsigmoid(zz[j]); ss += ys[j] * ys[j]; sm += yr[j]; }
        const float rs = 1.f / sqrtf(wave_sum(ss) * (1.f / D) + NORM_EPS);
        sm += __shfl_xor(sm, 1); sm += __shfl_xor(sm, 2); const float mean = sm * (1.f / HK);
        float sv = 0.f;
#pragma unroll
        for (int j = 0; j < 16; ++j) { yr[j] -= mean; sv += yr[j] * yr[j]; }
        sv += __shfl_xor(sv, 1); sv += __shfl_xor(sv, 2); const float rstd = 1.f / sqrtf(sv * (1.f / HK) + RWKV_LN_EPS);
        const float bon = I.BON[(size_t)row * H_RWKV + (lane >> 2)];
        float vv[16], gs[16], gr[16];
        { const v4u a = *((const v4u*)(I.PRW + (size_t)row * RWKV_PROJ + 2 * D) + 2 * lane), b = *((const v4u*)(I.PRW + (size_t)row * RWKV_PROJ + 2 * D) + 2 * lane + 1);
#pragma unroll
          for (int j = 0; j < 4; ++j) { vv[2 * j] = __uint_as_float(a[j] << 16); vv[2 * j + 1] = __uint_as_float(a[j] & 0xffff0000u); vv[8 + 2 * j] = __uint_as_float(b[j] << 16); vv[8 + 2 * j + 1] = __uint_as_float(b[j] & 0xffff0000u); }
          float pv[16];
          if (q.t > 0) { v4u pa, pb; if (tt == 1) { pa = kva; pb = kvb; } else { pa = *((const v4u*)(I.PRW + (size_t)(row - 1) * RWKV_PROJ + 2 * D) + 2 * lane); pb = *((const v4u*)(I.PRW + (size_t)(row - 1) * RWKV_PROJ + 2 * D) + 2 * lane + 1); }
#pragma unroll
              for (int j = 0; j < 4; ++j) { pv[2 * j] = __uint_as_float(pa[j] << 16); pv[2 * j + 1] = __uint_as_float(pa[j] & 0xffff0000u); pv[8 + 2 * j] = __uint_as_float(pb[j] << 16); pv[8 + 2 * j + 1] = __uint_as_float(pb[j] & 0xffff0000u); } }
          else if (q.grp) {
#pragma unroll
              for (int j = 0; j < 4; ++j) { const f32x4 x = *((const f32x4*)(I.state_shift + (size_t)q.b * RWKV_PROJ + 2 * D + c0) + j); pv[4 * j] = x.x; pv[4 * j + 1] = x.y; pv[4 * j + 2] = x.z; pv[4 * j + 3] = x.w; } }
          else {
#pragma unroll
              for (int j = 0; j < 16; ++j) pv[j] = 0.f; }
#pragma unroll
          for (int j = 0; j < 4; ++j) { const f32x4 m = *((const f32x4*)(I.mu + 2 * D + c0) + j);
              vv[4 * j] += (pv[4 * j] - vv[4 * j]) * m.x; vv[4 * j + 1] += (pv[4 * j + 1] - vv[4 * j + 1]) * m.y; vv[4 * j + 2] += (pv[4 * j + 2] - vv[4 * j + 2]) * m.z; vv[4 * j + 3] += (pv[4 * j + 3] - vv[4 * j + 3]) * m.w; }
          kva = a; kvb = b;
          const v4u ga = *((const v4u*)(I.PGATE + (size_t)row * 2 * D) + 2 * lane), gb = *((const v4u*)(I.PGATE + (size_t)row * 2 * D) + 2 * lane + 1);
          const v4u ha = *((const v4u*)(I.PGATE + (size_t)row * 2 * D + D) + 2 * lane), hb = *((const v4u*)(I.PGATE + (size_t)row * 2 * D + D) + 2 * lane + 1);
#pragma unroll
          for (int j = 0; j < 4; ++j) { gs[2 * j] = __uint_as_float(ga[j] << 16); gs[2 * j + 1] = __uint_as_float(ga[j] & 0xffff0000u); gs[8 + 2 * j] = __uint_as_float(gb[j] << 16); gs[8 + 2 * j + 1] = __uint_as_float(gb[j] & 0xffff0000u);
              gr[2 * j] = __uint_as_float(ha[j] << 16); gr[2 * j + 1] = __uint_as_float(ha[j] & 0xffff0000u); gr[8 + 2 * j] = __uint_as_float(hb[j] << 16); gr[8 + 2 * j + 1] = __uint_as_float(hb[j] & 0xffff0000u); } }
        v4u o0, o1; float outv[16];
#pragma unroll
        for (int j = 0; j < 4; ++j) { const f32x4 gq = *((const LAS f32x4*)(lds + L_G + t * D * 4) + 4 * lane + j); const f32x4 nw = *((const f32x4*)(I.ssd_norm_w + c0) + j), lw = *((const f32x4*)(I.ln_w + c0) + j), lb = *((const f32x4*)(I.ln_b + c0) + j);
#pragma unroll
            for (int e = 0; e < 4; ++e) { const int k = 4 * j + e; const float yssd = ys[k] * rs * nw[e]; const float yrw = (yr[k] * rstd * lw[e] + lb[e] + bon * vv[k]) * gq[e];
                outv[k] = fsigmoid(gs[k]) * yssd + fsigmoid(gr[k]) * yrw; } }
#pragma unroll
        for (int j = 0; j < 4; ++j) { o0[j] = pk2(outv[2 * j], outv[2 * j + 1]); o1[j] = pk2(outv[8 + 2 * j], outv[8 + 2 * j + 1]); }
        *((v4u*)(I.MERGED + (size_t)row * D) + 2 * lane) = o0; *((v4u*)(I.MERGED + (size_t)row * D) + 2 * lane + 1) = o1;
    }
    __syncthreads();
}

namespace sd {
constexpr int STR = 272;
constexpr int CL = 128;
constexpr int L_C = 0, L_BT = 34816, L_G = 69632, L_XT = 104448, L_XWT = 121856, L_SB = 139264, L_ACS = 156672, L_DTV = L_ACS + 512, L_CW = L_DTV + 512, L_END = L_CW + 8 * 40 * 4;
static_assert(L_END <= LDSCTL_OFF, "ssd LDS map");
constexpr size_t IMG_ELEMS = (size_t)CL * N_SSD;
}
__device__ __forceinline__ void bf8_unpack(const v4u& v, float (&x)[8]) {
#pragma unroll
    for (int j = 0; j < 4; ++j) { x[2 * j] = __uint_as_float(v[j] << 16); x[2 * j + 1] = __uint_as_float(v[j] & 0xffff0000u); }
}
__device__ __forceinline__ float fsilu(float x) { return x * fsigmoid(x); }
struct SsdCIn { const bf16_t* PXBC; const float *conv_w, *conv_b; bf16_t* CG; bf16_t* BTG; bf16_t* CBG; };
__device__ __forceinline__ void ssd_conv_unit(LAS unsigned char* lds, const SsdCIn& I, int b, int c, int g, int tid) {
    using namespace sd;
    static_assert(D == 1024 && N_SSD == 128 && G_SSD == 2 && CONV_K == 4, "ssd_conv_unit shapes");
    const int lane = tid & 63, w = tid >> 6, fr = lane & 15, fq = lane >> 4;
    const int unit = (b * (SEQ / CL) + c) * G_SSD + g; const size_t row0 = (size_t)b * SEQ;
    __syncthreads();
    { const int pc = tid & 31, ts = (tid >> 5) * 8; const int gch = pc < 16 ? D + g * N_SSD + pc * 8 : D + G_SSD * N_SSD + g * N_SSD + (pc - 16) * 8;
      v4u R[11]; const v4u z = {0u, 0u, 0u, 0u};
#pragma unroll
      for (int i = 0; i < 11; ++i) { const long q = (long)c * CL + ts - 3 + i; R[i] = q >= 0 ? *(const v4u*)(I.PXBC + (row0 + q) * CONV_DIM + gch) : z; }
      float cwv[3];
#pragma unroll
      for (int k = 0; k < 3; ++k) { const int i = tid + k * NTHREADS; cwv[k] = 0.f;
          if (i < 32 * 40) { const int p_ = i / 40, e_ = i % 40; const int gc = p_ < 16 ? D + g * N_SSD + p_ * 8 : D + G_SSD * N_SSD + g * N_SSD + (p_ - 16) * 8;
              cwv[k] = e_ < 32 ? I.conv_w[(size_t)(e_ >> 3) * CONV_DIM + gc + (e_ & 7)] : I.conv_b[gc + (e_ - 32)]; } }
#pragma unroll
      for (int k = 0; k < 3; ++k) { const int i = tid + k * NTHREADS; if (i < 32 * 40) ((LAS float*)(lds + L_G))[i] = cwv[k]; }
      const LAS float* cwl = (const LAS float*)(lds + L_G) + pc * 40;
      __syncthreads();
      LAS unsigned char* img = lds + (pc < 16 ? L_BT   : L_C) + (pc & 15) * 16;
#pragma unroll
      for (int i = 0; i < 8; ++i) { float x0[8], x1[8], x2[8], x3[8], o[8]; bf8_unpack(R[i], x0); bf8_unpack(R[i + 1], x1); bf8_unpack(R[i + 2], x2); bf8_unpack(R[i + 3], x3);
#pragma unroll
          for (int j = 0; j < 8; ++j) o[j] = fsilu(cwl[32 + j] + cwl[j] * x0[j] + cwl[8 + j] * x1[j] + cwl[16 + j] * x2[j] + cwl[24 + j] * x3[j]);
          v4u pk; pk.x = pk2(o[0], o[1]); pk.y = pk2(o[2], o[3]); pk.z = pk2(o[4], o[5]); pk.w = pk2(o[6], o[7]); *(LAS v4u*)(img + (ts + i) * STR) = pk; } }
    __syncthreads();
    { pg8::bf16x8 Cf[4];
#pragma unroll
      for (int ks = 0; ks < 4; ++ks) Cf[ks] = *(const LAS pg8::bf16x8*)(lds + L_C + (16 * w + fr) * STR + ks * 64 + fq * 16);
      bf16_t* cbg = I.CBG + (size_t)unit * IMG_ELEMS + (size_t)(16 * w + fr) * CL;
#pragma unroll
      for (int jt = 0; jt < 8; ++jt) { pg8::f32x4 acc = {0.f, 0.f, 0.f, 0.f};
#pragma unroll
          for (int ks = 0; ks < 4; ++ks) { const pg8::bf16x8 bf_ = *(const LAS pg8::bf16x8*)(lds + L_BT + (16 * jt + fr) * STR + ks * 64 + fq * 16); acc = __builtin_amdgcn_mfma_f32_16x16x32_bf16(bf_, Cf[ks], acc, 0, 0, 0); }
          u32x2 o; o.x = pk2(acc[0], acc[1]); o.y = pk2(acc[2], acc[3]); *(u32x2*)(cbg + 16 * jt + 4 * fq) = o; } }
#pragma unroll
    for (int i = 0; i < 4; ++i) { const int pid = tid + 512 * i, t = pid >> 4, pcn = pid & 15;
        *(v4u*)(I.CG + (size_t)unit * IMG_ELEMS + (size_t)t * N_SSD + pcn * 8) = *(const LAS v4u*)(lds + L_C + t * STR + pcn * 16);
        const int n = pid & 127, tb = pid >> 7;
        v4u o;
#pragma unroll
        for (int j = 0; j < 4; ++j) { const unsigned lo = *(const LAS bf16_t*)(lds + L_BT + (8 * tb + 2 * j) * STR + n * 2), hi = *(const LAS bf16_t*)(lds + L_BT + (8 * tb + 2 * j + 1) * STR + n * 2); o[j] = lo | (hi << 16); }
        *(v4u*)(I.BTG + (size_t)unit * IMG_ELEMS + (size_t)n * CL + tb * 8) = o; }
}
struct SsdIn { const bf16_t* PXBC; const bf16_t* CG; const bf16_t* BTG; const bf16_t* CBG; const float *DT, *conv_w, *conv_b, *dt_bias, *a_log, *d_skip; bf16_t* YS; float* state_out; float* prof; };
__device__ __forceinline__ void ssd_prompt_unit(LAS unsigned char* lds, const SsdIn& I, int b, int h, int tid) {
    using namespace sd;
    static_assert(D == 1024 && P_SSD == 64 && N_SSD == 128 && G_SSD == 2 && H_SSD == 16 && SEQ % CL == 0 && CONV_K == 4, "ssd_prompt_unit shapes");
    const int lane = tid & 63, w = tid >> 6, fr = lane & 15, fq = lane >> 4, g = h / (H_SSD / G_SSD);
    const float ah = -__expf(I.a_log[h]), dbias = I.dt_bias[h], dskip = I.d_skip[h];
    const int pc = tid & 7, tx = (tid >> 3) * 2, gch = h * P_SSD + pc * 8;
    __syncthreads();
    if (tid < 320) { const int p_ = tid / 40, e_ = tid % 40; ((LAS float*)(lds + L_CW))[tid] = e_ < 32 ? I.conv_w[(size_t)(e_ >> 3) * CONV_DIM + h * P_SSD + p_ * 8 + (e_ & 7)] : I.conv_b[h * P_SSD + p_ * 8 + (e_ - 32)]; }
    const LAS float* cwl = (const LAS float*)(lds + L_CW) + pc * 40;
    pg8::f32x4 S[4];
#pragma unroll
    for (int nt = 0; nt < 4; ++nt) S[nt] = (pg8::f32x4){0.f, 0.f, 0.f, 0.f};
    for (int i = tid; i < 64 * STR / 16; i += NTHREADS) *(LAS v4u*)(lds + L_SB + i * 16) = (v4u){0u, 0u, 0u, 0u};
    const size_t row0 = (size_t)b * SEQ;
    LAS float* acs = (LAS float*)(lds + L_ACS); LAS float* dtv = (LAS float*)(lds + L_DTV);
    v4u pC[4], pB[4], pX[5]; u32x2 pCB[8]; float pDT = 0.f;
    auto prefetch = [&](int c) { const int unit = (b * (SEQ / CL) + c) * G_SSD + g; const size_t rowc = row0 + (size_t)c * CL;
#pragma unroll
        for (int i = 0; i < 4; ++i) { const int pid = tid + 512 * i; pC[i] = *(const v4u*)(I.CG + (size_t)unit * IMG_ELEMS + (size_t)pid * 8); pB[i] = *(const v4u*)(I.BTG + (size_t)unit * IMG_ELEMS + (size_t)pid * 8); }
#pragma unroll
        for (int jt = 0; jt < 8; ++jt) pCB[jt] = *(const u32x2*)(I.CBG + (size_t)unit * IMG_ELEMS + (size_t)(16 * w + fr) * CL + 16 * jt + 4 * fq);
        const v4u z = {0u, 0u, 0u, 0u};
#pragma unroll
        for (int i = 0; i < 5; ++i) { const long q = (long)c * CL + tx - 3 + i; pX[i] = q >= 0 ? *(const v4u*)(I.PXBC + (row0 + q) * CONV_DIM + gch) : z; }
        if (tid < CL) pDT = I.DT[(rowc + tid) * H_SSD + h]; };
    prefetch(0);
#ifdef PROF
    unsigned long long qt_s1 = 0, qt_s2 = 0, qt_s34 = 0, qt_s5 = 0, qt_s67 = 0, qt_tot0 = PROF_T(), qt_a;
#define QT(x) do { const unsigned long long n_ = PROF_T(); x += n_ - qt_a; qt_a = n_; } while (0)
#else
#define QT(x) do { } while (0)
#endif
#pragma unroll 1
    for (int c = 0; c < SEQ / CL; ++c) {
#ifdef PROF
        qt_a = PROF_T();
#endif
        const size_t rowc = row0 + (size_t)c * CL;
        if (tid < CL) { const float dt = softplusf(pDT + dbias); dtv[tid] = dt; acs[tid] = dt * ah; }
#pragma unroll
        for (int i = 0; i < 4; ++i) { const int pid = tid + 512 * i, rr = pid >> 4, pcn = pid & 15; *(LAS v4u*)(lds + L_C + rr * STR + pcn * 16) = pC[i]; *(LAS v4u*)(lds + L_BT + rr * STR + pcn * 16) = pB[i]; }
        __syncthreads();
        if (w == 0) { const float a0 = acs[2 * lane], a1 = acs[2 * lane + 1]; float sc = a0 + a1;
#pragma unroll
            for (int o = 1; o < 64; o <<= 1) { const float t = __shfl_up(sc, o); if (lane >= o) sc += t; }
            acs[2 * lane] = sc - a1; acs[2 * lane + 1] = sc; }
        __syncthreads();
        const float acs_last = acs[CL - 1];
        QT(qt_s1);
        { float x0[8], x1[8], x2[8], x3[8], x4[8]; bf8_unpack(pX[0], x0); bf8_unpack(pX[1], x1); bf8_unpack(pX[2], x2); bf8_unpack(pX[3], x3); bf8_unpack(pX[4], x4);
          const float wt0 = __expf(acs_last - acs[tx]) * dtv[tx], wt1 = __expf(acs_last - acs[tx + 1]) * dtv[tx + 1];
#pragma unroll
          for (int j = 0; j < 8; ++j) { const float w0_ = cwl[j], w1_ = cwl[8 + j], w2_ = cwl[16 + j], w3_ = cwl[24 + j], bb_ = cwl[32 + j];
              const float o0 = fsilu(bb_ + w0_ * x0[j] + w1_ * x1[j] + w2_ * x2[j] + w3_ * x3[j]), o1 = fsilu(bb_ + w0_ * x1[j] + w1_ * x2[j] + w2_ * x3[j] + w3_ * x4[j]);
              *(LAS unsigned*)(lds + L_XT + (pc * 8 + j) * STR + tx * 2) = pk2(o0, o1); *(LAS unsigned*)(lds + L_XWT + (pc * 8 + j) * STR + tx * 2) = pk2(o0 * wt0, o1 * wt1); } }
        { const int i = 16 * w + fr; const float ai = acs[i];
#pragma unroll
          for (int jt = 0; jt < 8; ++jt) { const int j0 = 16 * jt + 4 * fq; const f32x4 aj = *(const LAS f32x4*)(lds + L_ACS + j0 * 4), dj = *(const LAS f32x4*)(lds + L_DTV + j0 * 4); float gv[4];
              const float cbv[4] = {__uint_as_float(pCB[jt].x << 16), __uint_as_float(pCB[jt].x & 0xffff0000u), __uint_as_float(pCB[jt].y << 16), __uint_as_float(pCB[jt].y & 0xffff0000u)};
#pragma unroll
              for (int e = 0; e < 4; ++e) gv[e] = (j0 + e <= i) ? cbv[e] * __expf(ai - aj[e]) * dj[e] : 0.f;
              u32x2 o; o.x = pk2(gv[0], gv[1]); o.y = pk2(gv[2], gv[3]); *(LAS u32x2*)(lds + L_G + i * STR + j0 * 2) = o; } }
        if (c + 1 < SEQ / CL) prefetch(c + 1);
        __syncthreads();
        QT(qt_s34);
        { pg8::bf16x8 Gf[4], Cf[4];
#pragma unroll
          for (int ks = 0; ks < 4; ++ks) { Gf[ks] = *(const LAS pg8::bf16x8*)(lds + L_G + (16 * w + fr) * STR + ks * 64 + fq * 16); Cf[ks] = *(const LAS pg8::bf16x8*)(lds + L_C + (16 * w + fr) * STR + ks * 64 + fq * 16); }
          const int i = 16 * w + fr; const float ei = __expf(acs[i]);
#pragma unroll
          for (int pt = 0; pt < 4; ++pt) { pg8::f32x4 ay = {0.f, 0.f, 0.f, 0.f}, ao = {0.f, 0.f, 0.f, 0.f};
#pragma unroll
              for (int ks = 0; ks < 4; ++ks) { const pg8::bf16x8 xf = *(const LAS pg8::bf16x8*)(lds + L_XT + (16 * pt + fr) * STR + ks * 64 + fq * 16), sf = *(const LAS pg8::bf16x8*)(lds + L_SB + (16 * pt + fr) * STR + ks * 64 + fq * 16);
                  ay = __builtin_amdgcn_mfma_f32_16x16x32_bf16(xf, Gf[ks], ay, 0, 0, 0); ao = __builtin_amdgcn_mfma_f32_16x16x32_bf16(sf, Cf[ks], ao, 0, 0, 0); }
              float yv[4];
#pragma unroll
              for (int e = 0; e < 4; ++e) { const int p = 16 * pt + 4 * fq + e; yv[e] = ay[e] + ei * ao[e] + dskip * bf2f(*(const LAS bf16_t*)(lds + L_XT + p * STR + i * 2)); }
              u32x2 o; o.x = pk2(yv[0], yv[1]); o.y = pk2(yv[2], yv[3]); *(u32x2*)(I.YS + (rowc + i) * D + h * P_SSD + 16 * pt + 4 * fq) = o; } }
        QT(qt_s5);
        { pg8::bf16x8 Xf[4];
#pragma unroll
          for (int ks = 0; ks < 4; ++ks) Xf[ks] = *(const LAS pg8::bf16x8*)(lds + L_XWT + (16 * (w & 3) + fr) * STR + ks * 64 + fq * 16);
          const float dec = __expf(acs_last);
#pragma unroll
          for (int nt = 0; nt < 4; ++nt) { pg8::f32x4 as_ = {0.f, 0.f, 0.f, 0.f};
#pragma unroll
              for (int ks = 0; ks < 4; ++ks) { const pg8::bf16x8 bf_ = *(const LAS pg8::bf16x8*)(lds + L_BT + (64 * (w >> 2) + 16 * nt + fr) * STR + ks * 64 + fq * 16); as_ = __builtin_amdgcn_mfma_f32_16x16x32_bf16(bf_, Xf[ks], as_, 0, 0, 0); }
              S[nt] = S[nt] * dec + as_; } }
        __syncthreads();
#pragma unroll
        for (int nt = 0; nt < 4; ++nt) { u32x2 o; o.x = pk2(S[nt][0], S[nt][1]); o.y = pk2(S[nt][2], S[nt][3]); *(LAS u32x2*)(lds + L_SB + (16 * (w & 3) + fr) * STR + (64 * (w >> 2) + 16 * nt + 4 * fq) * 2) = o; }
        QT(qt_s67);
    }
#ifdef PROF
    if (blockIdx.x == 0 && tid == 0) { const float tot = (float)(PROF_T() - qt_tot0); I.prof[8] = (float)qt_s1 / tot; I.prof[9] = (float)qt_s2 / tot; I.prof[10] = (float)qt_s34 / tot; I.prof[11] = (float)qt_s5 / tot; I.prof[12] = (float)qt_s67 / tot; I.prof[13] = tot * 1e-6f; }
#endif
#pragma unroll
    for (int nt = 0; nt < 4; ++nt) *(f32x4*)(I.state_out + (((size_t)b * H_SSD + h) * P_SSD + 16 * (w & 3) + fr) * N_SSD + 64 * (w >> 2) + 16 * nt + 4 * fq) = (f32x4){S[nt][0], S[nt][1], S[nt][2], S[nt][3]};
    __syncthreads();
}
struct SsdSIn { const bf16_t* PXBC; const float *state_conv, *state_ssm, *DT, *conv_w, *conv_b, *dt_bias, *a_log, *d_skip; bf16_t* YS; float* state_out; };
__device__ __forceinline__ void ssd_sample_unit(const SsdSIn& I, int s, int h, int lane) {
    static_assert(P_SSD == 64 && N_SSD == 128 && CONV_K == 4, "ssd_sample_unit shapes");
    const size_t row = (size_t)MP + s; const int g = h / (H_SSD / G_SSD);
    auto conv1 = [&](int ch) { float a = I.conv_b[ch];
#pragma unroll
        for (int i = 0; i < 3; ++i) a = fmaf(I.conv_w[(size_t)i * CONV_DIM + ch], I.state_conv[((size_t)s * 3 + i) * CONV_DIM + ch], a);
        a = fmaf(I.conv_w[(size_t)3 * CONV_DIM + ch], bf2f(I.PXBC[row * CONV_DIM + ch]), a); return siluf(a); };
    const int half = lane >> 5, j = lane & 31;
    const float* Sg = I.state_ssm + ((size_t)s * H_SSD + h) * P_SSD * N_SSD + lane * 4; float* So = I.state_out + ((size_t)s * H_SSD + h) * P_SSD * N_SSD + lane * 4;
    f32x4 v[32];
#pragma unroll
    for (int q = 0; q < 32; ++q) v[q] = *(const f32x4*)(Sg + q * 256);
    const int chs[5] = {h * P_SSD + lane, D + g * N_SSD + lane, D + g * N_SSD + 64 + lane, D + G_SSD * N_SSD + g * N_SSD + lane, D + G_SSD * N_SSD + g * N_SSD + 64 + lane};
    float cw_[5][4], cs_[5][3], cb_[5]; bf16_t px_[5];
#pragma unroll
    for (int q = 0; q < 5; ++q) { cb_[q] = I.conv_b[chs[q]]; px_[q] = I.PXBC[row * CONV_DIM + chs[q]];
#pragma unroll
        for (int i = 0; i < 4; ++i) cw_[q][i] = I.conv_w[(size_t)i * CONV_DIM + chs[q]];
#pragma unroll
        for (int i = 0; i < 3; ++i) cs_[q][i] = I.state_conv[((size_t)s * 3 + i) * CONV_DIM + chs[q]]; }
    const float dtr = I.DT[row * H_SSD + h], dtb = I.dt_bias[h], alg = I.a_log[h], dsk = I.d_skip[h];
    auto convq = [&](int q) { float a = cb_[q]; a = fmaf(cw_[q][0], cs_[q][0], a); a = fmaf(cw_[q][1], cs_[q][1], a); a = fmaf(cw_[q][2], cs_[q][2], a); a = fmaf(cw_[q][3], bf2f(px_[q]), a); return siluf(a); };
    const float x = convq(0), b0 = convq(1), b1 = convq(2), c0 = convq(3), c1 = convq(4);
    const float dt = softplusf(dtr + dtb), dA = expf(dt * -expf(alg)), dtx = dt * x;
    float Bn[4], Cn[4];
#pragma unroll
    for (int e = 0; e < 4; ++e) { const int src = (4 * j + e) & 63; const float bl = __shfl(b0, src), bh = __shfl(b1, src), cl = __shfl(c0, src), chh = __shfl(c1, src); Bn[e] = j < 16 ? bl : bh; Cn[e] = j < 16 ? cl : chh; }
    float yv = 0.f;
#pragma unroll
    for (int q = 0; q < 32; ++q) { const float xs0 = __uint_as_float(__builtin_amdgcn_readlane(__float_as_uint(dtx), 2 * q)), xs1 = __uint_as_float(__builtin_amdgcn_readlane(__float_as_uint(dtx), 2 * q + 1)), xs = half ? xs1 : xs0;
        float part = 0.f;
#pragma unroll
        for (int e = 0; e < 4; ++e) { const float sv = fmaf(v[q][e], dA, xs * Bn[e]); v[q][e] = sv; part = fmaf(Cn[e], sv, part); }
        part = rowsum16f(part); part += __shfl_xor(part, 16); yv = j == q ? part : yv; }
#pragma unroll
    for (int q = 0; q < 32; ++q) *(f32x4*)(So + q * 256) = v[q];
    { const int p = 2 * j + half; const float xp = __shfl(x, p); I.YS[row * D + h * P_SSD + p] = f2bf(yv + dsk * xp); }
}

__device__ __forceinline__ unsigned ford(float f) { const unsigned u = __float_as_uint(f); return u ^ ((u >> 31) ? 0xFFFFFFFFu : 0x80000000u); }
__device__ __forceinline__ float funord(unsigned u) { return __uint_as_float((u & 0x80000000u) ? (u ^ 0x80000000u) : ~u); }
__device__ __forceinline__ unsigned rowmax16u(unsigned v) {
    v = max(v, (unsigned)__builtin_amdgcn_update_dpp(0, (int)v, 0xB1, 0xF, 0xF, true));
    v = max(v, (unsigned)__builtin_amdgcn_update_dpp(0, (int)v, 0x4E, 0xF, 0xF, true));
    v = max(v, (unsigned)__builtin_amdgcn_update_dpp(0, (int)v, 0x141, 0xF, 0xF, true));
    v = max(v, (unsigned)__builtin_amdgcn_update_dpp(0, (int)v, 0x140, 0xF, 0xF, true));
    return v;
}
#define CEX(a, b) do { const unsigned hi_ = max(a, b), lo_ = min(a, b); a = hi_; b = lo_; } while (0)
__device__ __forceinline__ unsigned top16_of_128(unsigned (&k)[8], int fr) {
    CEX(k[0], k[1]); CEX(k[2], k[3]); CEX(k[4], k[5]); CEX(k[6], k[7]);
    CEX(k[0], k[2]); CEX(k[1], k[3]); CEX(k[4], k[6]); CEX(k[5], k[7]);
    CEX(k[1], k[2]); CEX(k[5], k[6]);
    CEX(k[0], k[4]); CEX(k[1], k[5]); CEX(k[2], k[6]); CEX(k[3], k[7]);
    CEX(k[2], k[4]); CEX(k[3], k[5]);
    CEX(k[1], k[2]); CEX(k[3], k[4]); CEX(k[5], k[6]);
    unsigned mine = 0u;
#pragma unroll
    for (int it = 0; it < 16; ++it) { const unsigned m = rowmax16u(k[0]); const bool win = k[0] == m;
        k[0] = win ? k[1] : k[0]; k[1] = win ? k[2] : k[1]; k[2] = win ? k[3] : k[2]; k[3] = win ? k[4] : k[3]; k[4] = win ? k[5] : k[4]; k[5] = win ? k[6] : k[5]; k[6] = win ? k[7] : k[6]; k[7] = win ? 0u : k[7];
        mine = fr == it ? m : mine; }
    return mine;
}
struct TopkIn { const bf16_t* PQ; const bf16_t* SKB; int* IDX; float* GATE; };
__device__ __forceinline__ void peer_topk_unit(const TopkIn& I, int tg, int h, int lane) {
    static_assert(N_KEYS == 128 && PEER_HALF == 128 && PEER_TOPK == 16, "peer_topk_unit shapes");
    const int fr = lane & 15, fq = lane >> 4, t0 = tg * 16;
    unsigned sel[2][4];
#pragma unroll
    for (int c = 0; c < 2; ++c) {
        pg8::bf16x8 qf[4];
#pragma unroll
        for (int ks = 0; ks < 4; ++ks) qf[ks] = *(const pg8::bf16x8*)(I.PQ + (size_t)(t0 + fr) * NPQ + h * PEER_DKEY + c * PEER_HALF + ks * 32 + fq * 8);
        pg8::f32x4 acc[8];
        const bf16_t* kb = I.SKB + ((size_t)(h * 2 + c) * N_KEYS) * PEER_HALF;
#pragma unroll
        for (int nt = 0; nt < 8; ++nt) { acc[nt] = (pg8::f32x4){0.f, 0.f, 0.f, 0.f};
#pragma unroll
            for (int ks = 0; ks < 4; ++ks) { const pg8::bf16x8 kf = *(const pg8::bf16x8*)(kb + (size_t)(nt * 16 + fr) * PEER_HALF + ks * 32 + fq * 8); acc[nt] = __builtin_amdgcn_mfma_f32_16x16x32_bf16(qf[ks], kf, acc[nt], 0, 0, 0); } }
#pragma unroll
        for (int g = 0; g < 4; ++g) { unsigned k[8];
#pragma unroll
            for (int nt = 0; nt < 8; ++nt) k[nt] = (ford(acc[nt][g]) & ~127u) | (unsigned)(127 - (nt * 16 + fr));
            sel[c][g] = top16_of_128(k, fr); }
    }
    const int base = lane & 48;
#pragma unroll
    for (int g = 0; g < 4; ++g) { const int row = t0 + 4 * fq + g;
        const float s1 = funord(sel[0][g] & ~127u), s2 = funord(sel[1][g] & ~127u); const int i1 = 127 - (int)(sel[0][g] & 127u), i2 = 127 - (int)(sel[1][g] & 127u);
        int p = 0; unsigned key = (ford(s1 + __shfl(s2, base)) & ~255u) | (unsigned)(255 - fr * 16); unsigned mine = 0u;
#pragma unroll
        for (int it = 0; it < 16; ++it) { const unsigned m = rowmax16u(key); const bool win = key == m; const int np = p + (win ? 1 : 0);
            const float s2n = __shfl(s2, base + (np < 16 ? np : 15));
            const unsigned nk = np < 16 ? ((ford(s1 + s2n) & ~255u) | (unsigned)(255 - (fr * 16 + np))) : 0u;
            key = win ? nk : key; p = np; mine = fr == it ? m : mine; }
        const int pos = 255 - (int)(mine & 255u), a = pos >> 4, bb = pos & 15; const float ts = funord(mine & ~255u);
        const int e1 = __shfl(i1, base + a), e2 = __shfl(i2, base + bb);
        const float mx = funord(rowmax16u(ford(ts))); const float ex = __expf(ts - mx); const float sm = rowsum16(ex);
        if (row < MT) { I.IDX[(size_t)row * NSEL + h * PEER_TOPK + fr] = e1 * N_KEYS + e2; I.GATE[(size_t)row * NSEL + h * PEER_TOPK + fr] = ex / sm; }
    }
}

typedef float f32x16 __attribute__((ext_vector_type(16)));
namespace at {
constexpr int KSTR = 528, VSTR = 520;
constexpr int L_IMG = 0, L_END = 256 * KSTR;
static_assert(L_END <= LDSCTL_OFF, "attention LDS map");
}
struct AttnIn { const bf16_t* Q; const bf16_t* KVB; const bf16_t* VTB; bf16_t* AO; };
__device__ __forceinline__ void attn_prompt_unit(LAS unsigned char* lds, const AttnIn& I, int b, int h, int tile, int tid) {
    using namespace at;
    static_assert(N_MEM == 256 && MEM_HD == 256 && MEM_HEADS == 4, "attn_prompt_unit shapes");
    const int lane = tid & 63, w = tid >> 6, r = lane & 31, hh = lane >> 5;
    const size_t tok = (size_t)b * SEQ + tile * 256 + w * 32 + r;
    __syncthreads();
    { const bf16_t* kb = I.KVB + (size_t)b * N_MEM * 2 * D + h * MEM_HD;
#pragma unroll 4
      for (int i = 0; i < 16; ++i) { const int pid = tid + 512 * i, row = pid >> 5, pc = pid & 31; *(LAS v4u*)(lds + L_IMG + row * KSTR + pc * 16) = *(const v4u*)(kb + (size_t)row * 2 * D + pc * 8); } }
    pg8::bf16x8 qf[16];
#pragma unroll
    for (int ks = 0; ks < 16; ++ks) qf[ks] = *(const pg8::bf16x8*)(I.Q + tok * D + h * MEM_HD + ks * 16 + hh * 8);
    __syncthreads();
    f32x16 sacc[8];
#pragma unroll
    for (int mt = 0; mt < 8; ++mt) {
#pragma unroll
        for (int e = 0; e < 16; ++e) sacc[mt][e] = 0.f;
#pragma unroll
        for (int ks = 0; ks < 16; ++ks) { const pg8::bf16x8 kf = *(const LAS pg8::bf16x8*)(lds + L_IMG + (mt * 32 + r) * KSTR + ks * 32 + hh * 16); sacc[mt] = __builtin_amdgcn_mfma_f32_32x32x16_bf16(kf, qf[ks], sacc[mt], 0, 0, 0); } }
    float mx = -INFINITY;
#pragma unroll
    for (int mt = 0; mt < 8; ++mt)
#pragma unroll
        for (int e = 0; e < 16; ++e) mx = fmaxf(mx, sacc[mt][e]);
    mx = fmaxf(mx, __shfl_xor(mx, 32));
    const float c = 1.4426950408889634f / 16.0f; float sum = 0.f;
#pragma unroll
    for (int mt = 0; mt < 8; ++mt)
#pragma unroll
        for (int e = 0; e < 16; ++e) { const float p = __builtin_amdgcn_exp2f((sacc[mt][e] - mx) * c); sacc[mt][e] = p; sum += p; }
    sum += __shfl_xor(sum, 32);
    pg8::bf16x8 pf[8][2];
#pragma unroll
    for (int mt = 0; mt < 8; ++mt)
#pragma unroll
        for (int s = 0; s < 2; ++s) { v4u pk;
#pragma unroll
            for (int j = 0; j < 4; ++j) pk[j] = pk2(sacc[mt][8 * s + 2 * j], sacc[mt][8 * s + 2 * j + 1]);
            pf[mt][s] = __builtin_bit_cast(pg8::bf16x8, pk); }
    __syncthreads();
    { const bf16_t* vb = I.VTB + (size_t)(b * MEM_HEADS + h) * MEM_HD * N_MEM;
#pragma unroll 4
      for (int i = 0; i < 16; ++i) { const int pid = tid + 512 * i, row = pid >> 5, pc = pid & 31; const v4u v = *(const v4u*)(vb + (size_t)row * N_MEM + pc * 8);
          u32x2 lo, hi; lo.x = v.x; lo.y = v.y; hi.x = v.z; hi.y = v.w; *(LAS u32x2*)(lds + L_IMG + row * VSTR + pc * 16) = lo; *(LAS u32x2*)(lds + L_IMG + row * VSTR + pc * 16 + 8) = hi; } }
    __syncthreads();
    const float inv = 1.f / sum;
#pragma unroll 1
    for (int dt = 0; dt < 8; ++dt) { f32x16 oacc;
#pragma unroll
        for (int e = 0; e < 16; ++e) oacc[e] = 0.f;
#pragma unroll
        for (int mt = 0; mt < 8; ++mt)
#pragma unroll
            for (int s = 0; s < 2; ++s) { const LAS unsigned char* vp = lds + L_IMG + (dt * 32 + r) * VSTR + (mt * 32 + 16 * s + 4 * hh) * 2;
                const u32x2 lo = *(const LAS u32x2*)vp, hi = *(const LAS u32x2*)(vp + 16); v4u vv; vv.x = lo.x; vv.y = lo.y; vv.z = hi.x; vv.w = hi.y;
                oacc = __builtin_amdgcn_mfma_f32_32x32x16_bf16(__builtin_bit_cast(pg8::bf16x8, vv), pf[mt][s], oacc, 0, 0, 0); }
#pragma unroll
        for (int g = 0; g < 4; ++g) { u32x2 o; o.x = pk2(oacc[4 * g] * inv, oacc[4 * g + 1] * inv); o.y = pk2(oacc[4 * g + 2] * inv, oacc[4 * g + 3] * inv);
            *(u32x2*)(I.AO + tok * D + h * MEM_HD + dt * 32 + 8 * g + 4 * hh) = o; } }
}
struct AttnSIn { const bf16_t* Q; const float* ck; const float* cv; bf16_t* AO; };
__device__ __forceinline__ void attn_sample_block(LAS unsigned char* lds, const AttnSIn& I, int pp, int tid) {
    const int lane = tid & 63, w = tid >> 6, slot = w >> 2, mq = w & 3; const int pair = 2 * pp + slot, s = pair / MEM_HEADS, h = pair % MEM_HEADS;
    LAS float* red = (LAS float*)lds;
    __syncthreads();
    float q[4];
    { const u32x2 qv = *(const u32x2*)(I.Q + ((size_t)MP + s) * D + h * MEM_HD + 4 * lane); q[0] = __uint_as_float(qv.x << 16); q[1] = __uint_as_float(qv.x & 0xffff0000u); q[2] = __uint_as_float(qv.y << 16); q[3] = __uint_as_float(qv.y & 0xffff0000u); }
    const float* kb = I.ck + (((size_t)s * N_MEM + mq * 64) * MEM_HEADS + h) * MEM_HD + 4 * lane; const float* vb = I.cv + (((size_t)s * N_MEM + mq * 64) * MEM_HEADS + h) * MEM_HD + 4 * lane;
    float sc = 0.f;
#pragma unroll 1
    for (int m0 = 0; m0 < 64; m0 += 16) { f32x4 kr[16];
#pragma unroll
        for (int i = 0; i < 16; ++i) kr[i] = *(const f32x4*)(kb + (size_t)(m0 + i) * D);
#pragma unroll
        for (int i = 0; i < 16; ++i) { const float d = wave_sum((kr[i].x * q[0] + kr[i].y * q[1]) + (kr[i].z * q[2] + kr[i].w * q[3])); sc = lane == m0 + i ? d : sc; } }
    sc *= 1.f / 16.f;
    const float wm = wave_max(sc); if (lane == 0) red[slot * 4 + mq] = wm;
    __syncthreads();
    const float gm = fmaxf(fmaxf(red[slot * 4], red[slot * 4 + 1]), fmaxf(red[slot * 4 + 2], red[slot * 4 + 3]));
    const float e = __expf(sc - gm); const float wsum = wave_sum(e); if (lane == 0) red[8 + slot * 4 + mq] = wsum;
    f32x4 o = {0.f, 0.f, 0.f, 0.f};
#pragma unroll 1
    for (int m0 = 0; m0 < 64; m0 += 16) { f32x4 vr[16];
#pragma unroll
        for (int i = 0; i < 16; ++i) vr[i] = *(const f32x4*)(vb + (size_t)(m0 + i) * D);
#pragma unroll
        for (int i = 0; i < 16; ++i) { const float p = __uint_as_float(__builtin_amdgcn_readlane(__float_as_uint(e), m0 + i)); o += vr[i] * p; } }
    *(LAS f32x4*)(lds + 64 + ((slot * 4 + mq) * 256 + 4 * lane) * 4) = o;
    __syncthreads();
    if (mq == 0) { const float gs = (red[8 + slot * 4] + red[8 + slot * 4 + 1]) + (red[8 + slot * 4 + 2] + red[8 + slot * 4 + 3]); f32x4 t = o;
#pragma unroll
        for (int k = 1; k < 4; ++k) t += *(const LAS f32x4*)(lds + 64 + ((slot * 4 + k) * 256 + 4 * lane) * 4);
        const float inv = 1.f / gs; u32x2 ov; ov.x = pk2(t.x * inv, t.y * inv); ov.y = pk2(t.z * inv, t.w * inv);
        *(u32x2*)(I.AO + ((size_t)MP + s) * D + h * MEM_HD + 4 * lane) = ov; }
}

namespace rp {
constexpr int CH = 64;
constexpr int L_W2H = 0, L_A2H = 9216, L_CST = 18432, L_MU = 19712, L_KK = 20992, L_KB = 29184, L_KH = 37376, L_RR = 45568, L_E = 53760, L_VV = 70144, L_AW = 78336, L_AA = 87552, L_RAW = 96768,
              L_END = L_RAW + (CH + 1) * 640;
constexpr int L_Q = L_END;
static_assert(L_Q + 4 * 1088 * 4 <= LDSCTL_OFF, "rwkv prep LDS map (Q)");
constexpr int L_NM = L_AW;
constexpr int L_AH = L_RAW, L_BH = L_RAW + 9216, L_KH2 = L_RAW + 18432, L_RH = L_RAW + 27648;
static_assert(L_END <= LDSCTL_OFF && 16384 <= 18432 && 36864 <= (CH + 1) * 640, "rwkv prep LDS map");
constexpr int NPIECE = (CH + 1) * 40;
constexpr int S_AR = 0, S_BT = 4096, S_KT = 6144, S_W1T = 8192, S_N2T = 8704, S_M2T = 9216, S_G = 9728, S_VT = 10240, SLOT = 12288;
constexpr int NCHUNK = SEQ / 16;
}
struct RwkSlots { unsigned char* r1; };
__device__ __forceinline__ unsigned char* rwk_slot(const RwkSlots& R, int s) { return R.r1 + (size_t)s * rp::SLOT; }
__device__ __forceinline__ RwkSlots rwk_slots(unsigned char* ws, float* out) {
    static_assert((size_t)BATCH * H_RWKV * rp::NCHUNK * rp::SLOT <= O_T1END - O_RWK, "rwkv slot space");
    RwkSlots R; R.r1 = ws + O_RWK; (void)out; return R; }
struct RwkPIn { const bf16_t* PRW; const bf16_t* LW2; const bf16_t* LA2; const float *mu, *w0, *a0, *k_k, *k_a, *r_k; float* BON; RwkSlots slots; float* prof; };
__device__ __forceinline__ void rwkv_prep_units(LAS unsigned char* lds, const RwkPIn& I, int h, int u0, int ustep, int nunits, int tid) {
    using namespace rp;
    static_assert(D == 1024 && HK == 64 && W_RANK == 64 && A_RANK == 64 && SEQ % CH == 0, "rwkv_prep shapes");
    const int lane = tid & 63, w = tid >> 6;
    v4u G[6];
    auto issue_loads = [&](int u) { const int b = u / (SEQ / CH), grp = u % (SEQ / CH); const size_t row0 = (size_t)b * SEQ;
#pragma unroll
        for (int i = 0; i < 6; ++i) { const int pid = tid + 512 * i; v4u z = {0u, 0u, 0u, 0u}; G[i] = z;
            if (pid < NPIECE) { const int rr = pid / 40, sp = pid % 40, sg = sp >> 3, pc = sp & 7; const int t = grp * CH + rr - 1;
                const int col = (sg == 0 ? h * HK : sg == 1 ? D + h * HK : sg == 2 ? 2 * D + h * HK : sg == 3 ? 3 * D : 3 * D + W_RANK) + pc * 8;
                if (t >= 0) G[i] = *(const v4u*)(I.PRW + (row0 + t) * RWKV_PROJ + col); } }
    };
    if (u0 < nunits) issue_loads(u0);
    __syncthreads();
    { const int row = tid >> 3, pc = tid & 7;
      *(LAS v4u*)(lds + L_W2H + row * 144 + pc * 16) = *(const v4u*)(I.LW2 + (size_t)(h * HK + row) * W_RANK + pc * 8);
      *(LAS v4u*)(lds + L_A2H + row * 144 + pc * 16) = *(const v4u*)(I.LA2 + (size_t)(h * HK + row) * A_RANK + pc * 8); }
    if (tid < 320) { const int s = tid >> 6, c = tid & 63; const int gc = (s == 0 ? h * HK : s == 1 ? D + h * HK : s == 2 ? 2 * D + h * HK : s == 3 ? 3 * D : 3 * D + W_RANK) + c;
        ((LAS float*)(lds + L_MU))[tid] = I.mu[gc];
        const float* src = s == 0 ? I.w0 : s == 1 ? I.a0 : s == 2 ? I.k_k : s == 3 ? I.k_a : I.r_k;
        ((LAS float*)(lds + L_CST))[tid] = src[h * HK + c]; }
#ifdef PROF
    unsigned long long rt_[6] = {0, 0, 0, 0, 0, 0}, rt_tot0 = PROF_T(), rt_a;
#define RT(k) do { const unsigned long long n_ = PROF_T(); rt_[k] += n_ - rt_a; rt_a = n_; } while (0)
#else
#define RT(k) do { } while (0)
#endif
#pragma unroll 1
    for (int u = u0; u < nunits; u += ustep) {
        const int b = u / (SEQ / CH), grp = u % (SEQ / CH); const size_t row0 = (size_t)b * SEQ;
        __syncthreads();
#pragma unroll
        for (int i = 0; i < 6; ++i) { const int pid = tid + 512 * i; if (pid < NPIECE) { const int rr_ = pid / 40, sp = pid % 40; *(LAS v4u*)(lds + L_RAW + rr_ * 640 + sp * 16) = G[i]; } }
        __syncthreads();
        if (u + ustep < nunits) issue_loads(u + ustep);
#ifdef PROF
        rt_a = PROF_T();
#endif
#pragma unroll
        for (int sg = 0; sg < 5; ++sg) {
#pragma unroll
          for (int it = 0; it < 2; ++it) { const int e = tid + 512 * it; const int t = e >> 4, cc = (e & 15) * 4, col = sg * 64 + cc;
            const u32x2 cur = *(const LAS u32x2*)(lds + L_RAW + (t + 1) * 640 + col * 2), prv = *(const LAS u32x2*)(lds + L_RAW + t * 640 + col * 2);
            const f32x4 m4 = *(const LAS f32x4*)(lds + L_MU + col * 4);
            float x[4];
            { const float c0 = __uint_as_float(cur.x << 16), c1 = __uint_as_float(cur.x & 0xffff0000u), c2 = __uint_as_float(cur.y << 16), c3 = __uint_as_float(cur.y & 0xffff0000u);
              const float p0 = __uint_as_float(prv.x << 16), p1 = __uint_as_float(prv.x & 0xffff0000u), p2 = __uint_as_float(prv.y << 16), p3 = __uint_as_float(prv.y & 0xffff0000u);
              x[0] = c0 + (p0 - c0) * m4.x; x[1] = c1 + (p1 - c1) * m4.y; x[2] = c2 + (p2 - c2) * m4.z; x[3] = c3 + (p3 - c3) * m4.w; }
            if (sg == 0) { u32x2 o; o.x = pkh2(x[0], x[1]); o.y = pkh2(x[2], x[3]); *(LAS u32x2*)(lds + L_RR + t * 128 + cc * 2) = o; }
            else if (sg == 1) { u32x2 o; o.x = pkh2(x[0], x[1]); o.y = pkh2(x[2], x[3]); *(LAS u32x2*)(lds + L_KH + t * 128 + cc * 2) = o; }
            else if (sg == 2) { u32x2 o; o.x = pk2(x[0], x[1]); o.y = pk2(x[2], x[3]); *(LAS u32x2*)(lds + L_VV + t * 128 + cc * 2) = o; }
            else if (sg == 3) { u32x2 o;
#pragma unroll
                for (int j = 0; j < 4; ++j) x[j] = 1.f - 2.f * __builtin_amdgcn_rcpf(__expf(2.f * x[j]) + 1.f);
                o.x = pk2(x[0], x[1]); o.y = pk2(x[2], x[3]); *(LAS u32x2*)(lds + L_AW + t * 144 + cc * 2) = o; }
            else { u32x2 o; o.x = pk2(x[0], x[1]); o.y = pk2(x[2], x[3]); *(LAS u32x2*)(lds + L_AA + t * 144 + cc * 2) = o; }
          } }
        __syncthreads();
        RT(0);
        { const int role = w >> 2, tt = w & 3, fr = lane & 15, fq = lane >> 4;
          const LAS unsigned char* Aimg = lds + (role ? L_AA : L_AW); const LAS unsigned char* Wimg = lds + (role ? L_A2H : L_W2H);
          pg8::f32x4 acc[4];
#pragma unroll
          for (int nt = 0; nt < 4; ++nt) { acc[nt] = (pg8::f32x4){0.f, 0.f, 0.f, 0.f};
#pragma unroll
              for (int ks = 0; ks < 2; ++ks) { const pg8::bf16x8 af = *(const LAS pg8::bf16x8*)(Aimg + (tt * 16 + fr) * 144 + ks * 64 + fq * 16), bfr = *(const LAS pg8::bf16x8*)(Wimg + (nt * 16 + fr) * 144 + ks * 64 + fq * 16);
                  acc[nt] = __builtin_amdgcn_mfma_f32_16x16x32_bf16(af, bfr, acc[nt], 0, 0, 0); } }
          const LAS float* cst = (const LAS float*)(lds + L_CST);
          if (role == 0) {
#pragma unroll
              for (int nt = 0; nt < 4; ++nt) { const int ch = nt * 16 + fr; const float w0 = cst[ch];
#pragma unroll
                  for (int g = 0; g < 4; ++g) { const int t = tt * 16 + fq * 4 + g; ((LAS float*)(lds + L_E))[t * 64 + ch] = 0.6065306597f * fsigmoid(w0 + acc[nt][g]); } }
          } else {
              float kkr[4][4], ag[4][4], ss[4] = {0.f, 0.f, 0.f, 0.f}, bon[4] = {0.f, 0.f, 0.f, 0.f};
#pragma unroll
              for (int nt = 0; nt < 4; ++nt) { const int ch = nt * 16 + fr; const float a0 = cst[64 + ch], kk_ = cst[128 + ch], ka = cst[192 + ch], rk = cst[256 + ch];
#pragma unroll
                  for (int g = 0; g < 4; ++g) { const int t = tt * 16 + fq * 4 + g; const float a = fsigmoid(a0 + acc[nt][g]); const float k = (float)((const LAS _Float16*)(lds + L_KH))[t * 64 + ch];
                      const float kh = k * (1.f + (a - 1.f) * ka), kq = k * kk_; ag[nt][g] = a; kkr[nt][g] = kq; ss[g] += kq * kq;
                      bon[g] += (float)((const LAS _Float16*)(lds + L_RR))[t * 64 + ch] * kh * rk;
                      ((LAS _Float16*)(lds + L_KH))[t * 64 + ch] = (_Float16)kh; } }
#pragma unroll
              for (int g = 0; g < 4; ++g) { ss[g] = rowsum16(ss[g]); bon[g] = rowsum16(bon[g]); const float inv = 1.f / sqrtf(fmaxf(ss[g], 1e-24f)); const int t = tt * 16 + fq * 4 + g;
#pragma unroll
                  for (int nt = 0; nt < 4; ++nt) { const int ch = nt * 16 + fr; const float kk = kkr[nt][g] * inv; ((LAS _Float16*)(lds + L_KK))[t * 64 + ch] = (_Float16)kk; ((LAS _Float16*)(lds + L_KB))[t * 64 + ch] = (_Float16)(kk * ag[nt][g]); }
                  if (fr == 0) I.BON[(row0 + (size_t)grp * CH + t) * H_RWKV + h] = bon[g]; }
          } }
        __syncthreads();
        RT(1);
        { const int sc = tid >> 7, h8 = (tid >> 6) & 1, k = tid & 63; float ecum = 0.f;
            if (h8) {
#pragma unroll
                for (int t = 0; t < 8; ++t) ecum += ((const LAS float*)(lds + L_E))[(sc * 16 + t) * 64 + k]; }
            float g = __expf(-ecum);
#pragma unroll 4
            for (int t8 = 0; t8 < 8; ++t8) { const int tt = sc * 16 + h8 * 8 + t8; const float gm1 = g; ecum += ((const LAS float*)(lds + L_E))[tt * 64 + k]; g = __expf(-ecum); const float gi = __expf(ecum);
                const float kk = (float)((const LAS _Float16*)(lds + L_KK))[tt * 64 + k], kb = (float)((const LAS _Float16*)(lds + L_KB))[tt * 64 + k], kh = (float)((const LAS _Float16*)(lds + L_KH))[tt * 64 + k], rr = (float)((const LAS _Float16*)(lds + L_RR))[tt * 64 + k];
                *(LAS bf16_t*)(lds + L_AH + tt * 144 + k * 2) = f2bf(-kk * gm1); *(LAS bf16_t*)(lds + L_BH + tt * 144 + k * 2) = f2bf(kb * gi);
                *(LAS bf16_t*)(lds + L_KH2 + tt * 144 + k * 2) = f2bf(kh * gi); *(LAS bf16_t*)(lds + L_RH + tt * 144 + k * 2) = f2bf(rr * g); }
            if (h8) { const int slot = (grp * 4 + sc) * (BATCH * H_RWKV) + b * H_RWKV + h; *(float*)(rwk_slot(I.slots, slot) + S_G + k * 4) = g; } }
        __syncthreads();
        RT(2);
        { const int sc = w >> 1, par = w & 1, fr = lane & 15, fq = lane >> 4; const LAS unsigned char* Ximg = lds + (par ? L_KH2 : L_BH);
          pg8::f32x4 accA = {0.f, 0.f, 0.f, 0.f}, accR = {0.f, 0.f, 0.f, 0.f};
#pragma unroll
          for (int ks = 0; ks < 2; ++ks) { const pg8::bf16x8 xf = *(const LAS pg8::bf16x8*)(Ximg + (sc * 16 + fr) * 144 + ks * 64 + fq * 16), af = *(const LAS pg8::bf16x8*)(lds + L_AH + (sc * 16 + fr) * 144 + ks * 64 + fq * 16), rf = *(const LAS pg8::bf16x8*)(lds + L_RH + (sc * 16 + fr) * 144 + ks * 64 + fq * 16);
              accA = __builtin_amdgcn_mfma_f32_16x16x32_bf16(xf, af, accA, 0, 0, 0); accR = __builtin_amdgcn_mfma_f32_16x16x32_bf16(xf, rf, accR, 0, 0, 0); }
          LAS float* nm = (LAS float*)(lds + L_NM) + sc * 1024;
#pragma unroll
          for (int g = 0; g < 4; ++g) { const int j = 4 * fq + g; nm[(par ? 256 : 0) + j * 16 + fr] = j < fr ? accA[g] : 0.f; nm[(par ? 768 : 512) + j * 16 + fr] = j <= fr ? accR[g] : 0.f; } }
        __syncthreads();
        RT(3);
        const int slot0 = (grp * 4) * (BATCH * H_RWKV) + b * H_RWKV + h; const LAS float* nmb = (const LAS float*)(lds + L_NM);
        auto emit = [&](int sc, int r) { unsigned char* sp = rwk_slot(I.slots, slot0 + sc * (BATCH * H_RWKV)); const LAS float* nm = nmb + sc * 1024; v4u o;
              if (r < 256) {
                  const int g8 = r >> 5, m = r & 31, l0 = 2 * m, i = l0 & 31, hh = l0 >> 5, ko = 32 * (g8 >> 2) + 16 * ((g8 >> 1) & 1) + 8 * (g8 & 1) + 4 * hh;
                  const LAS unsigned char* r0 = lds + (i < 16 ? L_AH : L_RH) + (sc * 16 + (i & 15)) * 144 + ko * 2; const LAS unsigned char* r1 = lds + (i + 1 < 16 ? L_AH : L_RH) + (sc * 16 + ((i + 1) & 15)) * 144 + ko * 2;
                  const u32x2 a = *(const LAS u32x2*)r0, c = *(const LAS u32x2*)r1; o.x = a.x; o.y = a.y; o.z = c.x; o.w = c.y; *(v4u*)(sp + S_AR + r * 16) = o; }
              else if (r < 384) {
                  const int q = r - 256, gb = q >> 5, m = q & 31, l0 = 2 * m, i = l0 & 31, hh = l0 >> 5, t0 = sc * 16 + 8 * (gb & 1) + 4 * hh, k0 = 32 * (gb >> 1) + i;
#pragma unroll
                  for (int j = 0; j < 2; ++j) { o[j] = (unsigned)*(const LAS bf16_t*)(lds + L_BH + (t0 + 2 * j) * 144 + k0 * 2) | ((unsigned)*(const LAS bf16_t*)(lds + L_BH + (t0 + 2 * j + 1) * 144 + k0 * 2) << 16);
                      o[2 + j] = (unsigned)*(const LAS bf16_t*)(lds + L_BH + (t0 + 2 * j) * 144 + (k0 + 1) * 2) | ((unsigned)*(const LAS bf16_t*)(lds + L_BH + (t0 + 2 * j + 1) * 144 + (k0 + 1) * 2) << 16); }
                  *(v4u*)(sp + S_BT + q * 16) = o; }
              else if (r < 512) {
                  const int q = r - 384, kt = q >> 6, l = q & 63, i = l & 31, hh = l >> 5, k0 = 32 * kt + i, t0 = sc * 16 + 8 * hh;
#pragma unroll
                  for (int j = 0; j < 4; ++j) o[j] = (unsigned)*(const LAS bf16_t*)(lds + L_KH2 + (t0 + 2 * j) * 144 + k0 * 2) | ((unsigned)*(const LAS bf16_t*)(lds + L_KH2 + (t0 + 2 * j + 1) * 144 + k0 * 2) << 16);
                  *(v4u*)(sp + S_KT + q * 16) = o; }
              else if (r < 544) {
                  const int q = r - 512, hh = q >> 4, i = q & 15;
#pragma unroll
                  for (int j = 0; j < 4; ++j) o[j] = pk2(nm[256 + (8 * hh + 2 * j) * 16 + i], nm[256 + (8 * hh + 2 * j + 1) * 16 + i]);
                  *(v4u*)(sp + S_W1T + q * 16) = o; }
              else if (r < 576) {
                  const int q = r - 544, e0 = 2 * q, pc = e0 >> 5, hh = (e0 >> 4) & 1, ii = e0 & 15, j0 = 8 * pc + 4 * hh;
                  o.x = pk2(nm[512 + j0 * 16 + ii], nm[512 + (j0 + 1) * 16 + ii]); o.y = pk2(nm[512 + (j0 + 2) * 16 + ii], nm[512 + (j0 + 3) * 16 + ii]);
                  o.z = pk2(nm[512 + j0 * 16 + ii + 1], nm[512 + (j0 + 1) * 16 + ii + 1]); o.w = pk2(nm[512 + (j0 + 2) * 16 + ii + 1], nm[512 + (j0 + 3) * 16 + ii + 1]);
                  *(v4u*)(sp + S_N2T + q * 16) = o; }
              else if (r < 608) {
                  const int q = r - 576, hh = q >> 4, ii = q & 15;
#pragma unroll
                  for (int j = 0; j < 4; ++j) o[j] = pk2(nm[768 + (8 * hh + 2 * j) * 16 + ii], nm[768 + (8 * hh + 2 * j + 1) * 16 + ii]);
                  *(v4u*)(sp + S_M2T + q * 16) = o; }
              else {
                  const int q = r - 608, i = q & 31, hh = (q >> 5) & 1, hf = q >> 6, v = hf * 32 + i, t0 = sc * 16 + 8 * hh;
#pragma unroll
                  for (int j = 0; j < 4; ++j) o[j] = (unsigned)*(const LAS bf16_t*)(lds + L_VV + (t0 + 2 * j) * 128 + v * 2) | ((unsigned)*(const LAS bf16_t*)(lds + L_VV + (t0 + 2 * j + 1) * 128 + v * 2) << 16);
                  *(v4u*)(sp + S_VT + q * 16) = o; }
        };
        if (w < 4) { const int sc = w; int n = lane & 15, q = lane >> 4; asm volatile("" : "+v"(n), "+v"(q));
            LAS float* nmw = (LAS float*)(lds + L_NM) + sc * 1024; LAS float* X = (LAS float*)(lds + L_Q) + sc * 1088;
            auto mul = [&](const LAS float* A, int sa, bool ia, const LAS float* B, int sb, bool ib) { pg8::f32x4 acc = {0.f, 0.f, 0.f, 0.f};
#pragma unroll
                for (int ks = 0; ks < 4; ++ks) { const int k = 4 * ks + q; float av = A[n * sa + k], bv = B[k * sb + n]; if (ia && n == k) av += 1.f; if (ib && n == k) bv += 1.f; acc = __builtin_amdgcn_mfma_f32_16x16x4f32(av, bv, acc, 0, 0, 0); }
                return acc; };
            auto put = [&](LAS float* C, const pg8::f32x4& acc) {
#pragma unroll
                for (int g = 0; g < 4; ++g) C[(4 * q + g) * 17 + n] = acc[g]; };
            put(X, mul(nmw, 16, false, nmw, 16, false));
            put(X + 272, mul(nmw, 16, true, X, 17, true));
            put(X + 544, mul(X, 17, false, X, 17, false));
            put(X, mul(X + 272, 17, false, X + 544, 17, true));
            put(X + 816, mul(X + 544, 17, false, X + 544, 17, false));
            put(X + 272, mul(X, 17, false, X + 816, 17, true));
            const LAS float* T = X + 272;
#pragma unroll 1
            for (int mt = 0; mt < 5; ++mt) { pg8::f32x4 acc = {0.f, 0.f, 0.f, 0.f};
#pragma unroll
                for (int ks = 0; ks < 4; ++ks) { const int t = 4 * ks + q; const float av = mt < 4 ? bf2f(*(const LAS bf16_t*)(lds + L_AH + (sc * 16 + t) * 144 + (16 * mt + n) * 2)) : nmw[256 + n * 16 + t];
                    acc = __builtin_amdgcn_mfma_f32_16x16x4f32(av, T[t * 17 + n], acc, 0, 0, 0); }
                if (mt < 4) { u32x2 o; o.x = pk2(acc[0], acc[1]); o.y = pk2(acc[2], acc[3]); *(LAS u32x2*)(lds + L_AH + (sc * 16 + n) * 144 + (16 * mt + 4 * q) * 2) = o; }
                else {
#pragma unroll
                    for (int g = 0; g < 4; ++g) nmw[256 + (4 * q + g) * 16 + n] = acc[g]; } }
        } else {
#pragma unroll 1
            for (int idx = tid - 256; idx < 4 * 448; idx += 256) { const int sc = idx / 448, rp_ = idx % 448; emit(sc, rp_ < 256 ? 256 + rp_ : 288 + rp_); }
        }
        __syncthreads();
        RT(4);
#pragma unroll 1
        for (int idx = tid; idx < 4 * 288; idx += NTHREADS) { const int sc = idx / 288, rp_ = idx % 288; emit(sc, rp_ < 256 ? rp_ : 256 + rp_); }
        RT(5);
    }
#ifdef PROF
    if (blockIdx.x == 0 && tid == 0) { const float tot = (float)(PROF_T() - rt_tot0); I.prof[16] = (float)rt_[0] / tot; I.prof[17] = (float)rt_[1] / tot; I.prof[18] = (float)rt_[2] / tot; I.prof[19] = (float)rt_[3] / tot; I.prof[20] = (float)rt_[4] / tot; I.prof[21] = (float)rt_[5] / tot; I.prof[22] = tot * 1e-6f; }
#endif
    __syncthreads();
}
typedef float f32x16s __attribute__((ext_vector_type(16)));
struct RwkFrag { u32x2 ar[2][2][2]; v4u aw; u32x2 an2[2]; v4u am2; u32x2 ab[2][2]; v4u ak[2]; v4u bv; };
struct RwkSIn { RwkSlots slots; bf16_t* YR; float* state_out; float* prof; };
__device__ __forceinline__ pg8::bf16x8 rwk_pack(const f32x16s& x, int s) { v4u p;
#pragma unroll
    for (int j = 0; j < 4; ++j) p[j] = pk2(x[8 * s + 2 * j], x[8 * s + 2 * j + 1]);
    return __builtin_bit_cast(pg8::bf16x8, p); }
__device__ __forceinline__ pg8::bf16x8 rwk_join(const u32x2 a, const u32x2 b) { v4u p; p.x = a.x; p.y = a.y; p.z = b.x; p.w = b.y; return __builtin_bit_cast(pg8::bf16x8, p); }
__device__ __forceinline__ pg8::bf16x8 rwk_pack_asm(const f32x16s& x, int s) {
#ifndef PACK_ASM
    return rwk_pack(x, s);
#endif
    v4u p;
    if (s == 0) asm volatile("s_nop 15\n\ts_nop 3\n\tv_cvt_pk_bf16_f32 %0, %4, %5\n\tv_cvt_pk_bf16_f32 %1, %6, %7\n\tv_cvt_pk_bf16_f32 %2, %8, %9\n\tv_cvt_pk_bf16_f32 %3, %10, %11\n\ts_nop 1" : "=&v"(p[0]), "=&v"(p[1]), "=&v"(p[2]), "=&v"(p[3]) : "v"(x[0]), "v"(x[1]), "v"(x[2]), "v"(x[3]), "v"(x[4]), "v"(x[5]), "v"(x[6]), "v"(x[7]));
    else asm volatile("s_nop 15\n\ts_nop 3\n\tv_cvt_pk_bf16_f32 %0, %4, %5\n\tv_cvt_pk_bf16_f32 %1, %6, %7\n\tv_cvt_pk_bf16_f32 %2, %8, %9\n\tv_cvt_pk_bf16_f32 %3, %10, %11\n\ts_nop 1" : "=&v"(p[0]), "=&v"(p[1]), "=&v"(p[2]), "=&v"(p[3]) : "v"(x[8]), "v"(x[9]), "v"(x[10]), "v"(x[11]), "v"(x[12]), "v"(x[13]), "v"(x[14]), "v"(x[15]));
    return __builtin_bit_cast(pg8::bf16x8, p); }
#ifndef RWK_NL
#define RWK_NL 2
#define RWK_F 3
#define RWK_RING 10
#endif
__device__ __forceinline__ void rwkv_cscan_unit(LAS unsigned char* wl, const RwkSIn& I, int b, int h, int role, unsigned epoch, int lane) {
    using namespace rp;
    __builtin_amdgcn_s_setprio(3);
    const int i = lane & 31, hh = lane >> 5; const size_t row0 = (size_t)b * SEQ; const int slot0 = b * H_RWKV + h;
    const int hf = role & 1;
    f32x16s St[2];
#pragma unroll
    for (int e = 0; e < 16; ++e) { St[0][e] = 0.f; St[1][e] = 0.f; }
    LAS bf16_t* yl = (LAS bf16_t*)wl; LAS unsigned char* ring = wl + 8192 + 64; volatile LAS unsigned* ctl = (volatile LAS unsigned*)(wl + 8192);
    constexpr int RING = RWK_RING, RSZ = 12 * 1024;
#define RWK_DMA(c) do { const unsigned char* sp = rwk_slot(I.slots, slot0 + (c) * (BATCH * H_RWKV)) + lane * 16; LAS unsigned char* rb = ring + ((c) % RING) * RSZ; \
        _Pragma("unroll") for (int p = 0; p < 12; ++p) __builtin_amdgcn_global_load_lds((const unsigned*)(sp + p * 1024), (LAS unsigned*)(rb + p * 1024), 16, 0, 0); } while (0)
#define RWK_WAIT(n) asm volatile("s_waitcnt vmcnt(" #n ")" ::: "memory")
#define RWK_WAITF() do { if (RWK_F == 4) RWK_WAIT(48); else if (RWK_F == 3) RWK_WAIT(36); else if (RWK_F == 2) RWK_WAIT(24); else RWK_WAIT(12); } while (0)
#ifdef PROF
    const unsigned long long ct0 = PROF_T();
#endif
    if (role >= 2) {
        const int l = role - 2; const unsigned epl = epoch / RWK_NL;
#pragma unroll 1
        for (int k = 0; k < NCHUNK / RWK_NL; ++k) { const int c = l + k * RWK_NL;
            if (c >= RING) { unsigned sp_ = 0; while ((ctl[0] < epoch + (unsigned)(c - RING + 1) || ctl[1] < epoch + (unsigned)(c - RING + 1)) && ++sp_ < (1u << 26)) __builtin_amdgcn_s_sleep(1); asm volatile("" ::: "memory"); }
            RWK_DMA(c);
            RWK_WAITF();
            if (k >= RWK_F + 1 && lane == 0) ctl[2 + l] = epl + (unsigned)(k - RWK_F);
        }
        RWK_WAIT(0);
        if (lane == 0) ctl[2 + l] = epl + (unsigned)(NCHUNK / RWK_NL);
        __builtin_amdgcn_s_setprio(0);
        return;
    }
#pragma unroll 1
    for (int c = 0; c < NCHUNK; ++c) {
        { unsigned sp_ = 0; const unsigned need = epoch / RWK_NL + (unsigned)(c / RWK_NL + 1); while (ctl[2 + c % RWK_NL] < need && ++sp_ < (1u << 26)) __builtin_amdgcn_s_sleep(1); }
        asm volatile("s_waitcnt lgkmcnt(0)" ::: "memory");
        __builtin_amdgcn_sched_barrier(0);
        const LAS unsigned char* rb = ring + (c % RING) * RSZ;
        const v4u z4 = {0u, 0u, 0u, 0u}; u32x2 z2; z2.x = 0u; z2.y = 0u;
        const v4u aw = i < 16 ? *(const LAS v4u*)(rb + S_W1T + (hh * 16 + i) * 16) : z4;
        const u32x2 n0 = i >= 16 ? *(const LAS u32x2*)(rb + S_N2T + (hh * 16 + i - 16) * 8) : z2, n1 = i >= 16 ? *(const LAS u32x2*)(rb + S_N2T + (32 + hh * 16 + i - 16) * 8) : z2; const v4u m2 = i >= 16 ? *(const LAS v4u*)(rb + S_M2T + (hh * 16 + i - 16) * 16) : z4;
        const pg8::bf16x8 aAR00 = rwk_join(*(const LAS u32x2*)(rb + S_AR + 0 * 512 + lane * 8), *(const LAS u32x2*)(rb + S_AR + 1 * 512 + lane * 8)), aAR01 = rwk_join(*(const LAS u32x2*)(rb + S_AR + 2 * 512 + lane * 8), *(const LAS u32x2*)(rb + S_AR + 3 * 512 + lane * 8));
        const pg8::bf16x8 aAR10 = rwk_join(*(const LAS u32x2*)(rb + S_AR + 4 * 512 + lane * 8), *(const LAS u32x2*)(rb + S_AR + 5 * 512 + lane * 8)), aAR11 = rwk_join(*(const LAS u32x2*)(rb + S_AR + 6 * 512 + lane * 8), *(const LAS u32x2*)(rb + S_AR + 7 * 512 + lane * 8));
        const pg8::bf16x8 aB0 = rwk_join(*(const LAS u32x2*)(rb + S_BT + 0 * 512 + lane * 8), *(const LAS u32x2*)(rb + S_BT + 1 * 512 + lane * 8)), aB1 = rwk_join(*(const LAS u32x2*)(rb + S_BT + 2 * 512 + lane * 8), *(const LAS u32x2*)(rb + S_BT + 3 * 512 + lane * 8));
        const pg8::bf16x8 aK0 = *(const LAS pg8::bf16x8*)(rb + S_KT + lane * 16), aK1 = *(const LAS pg8::bf16x8*)(rb + S_KT + 1024 + lane * 16);
        f32x4 gm[2][4];
#pragma unroll
        for (int g = 0; g < 4; ++g) { gm[0][g] = *(const LAS f32x4*)(rb + S_G + (8 * g + 4 * hh) * 4); gm[1][g] = *(const LAS f32x4*)(rb + S_G + (32 + 8 * g + 4 * hh) * 4); }
        {
            f32x16s P;
#pragma unroll
            for (int e = 0; e < 16; ++e) P[e] = 0.f;
            P = __builtin_amdgcn_mfma_f32_32x32x16_bf16(aAR00, rwk_pack_asm(St[0], 0), P, 0, 0, 0); P = __builtin_amdgcn_mfma_f32_32x32x16_bf16(aAR10, rwk_pack_asm(St[1], 0), P, 0, 0, 0);
            P = __builtin_amdgcn_mfma_f32_32x32x16_bf16(aAR01, rwk_pack_asm(St[0], 1), P, 0, 0, 0); P = __builtin_amdgcn_mfma_f32_32x32x16_bf16(aAR11, rwk_pack_asm(St[1], 1), P, 0, 0, 0);
            const pg8::bf16x8 bV = *(const LAS pg8::bf16x8*)(rb + S_VT + ((hf * 2 + hh) * 32 + i) * 16);
            P = __builtin_amdgcn_mfma_f32_32x32x16_bf16(__builtin_bit_cast(pg8::bf16x8, aw), bV, P, 0, 0, 0);
            const pg8::bf16x8 bU = rwk_pack_asm(P, 0);
            P = __builtin_amdgcn_mfma_f32_32x32x16_bf16(rwk_join(n0, n1), bU, P, 0, 0, 0); P = __builtin_amdgcn_mfma_f32_32x32x16_bf16(__builtin_bit_cast(pg8::bf16x8, m2), bV, P, 0, 0, 0);
            St[0] = __builtin_amdgcn_mfma_f32_32x32x16_bf16(aB0, bU, St[0], 0, 0, 0); St[0] = __builtin_amdgcn_mfma_f32_32x32x16_bf16(aK0, bV, St[0], 0, 0, 0);
            St[1] = __builtin_amdgcn_mfma_f32_32x32x16_bf16(aB1, bU, St[1], 0, 0, 0); St[1] = __builtin_amdgcn_mfma_f32_32x32x16_bf16(aK1, bV, St[1], 0, 0, 0);
#pragma unroll
            for (int g = 0; g < 4; ++g) { St[0][4 * g] *= gm[0][g].x; St[0][4 * g + 1] *= gm[0][g].y; St[0][4 * g + 2] *= gm[0][g].z; St[0][4 * g + 3] *= gm[0][g].w;
                St[1][4 * g] *= gm[1][g].x; St[1][4 * g + 1] *= gm[1][g].y; St[1][4 * g + 2] *= gm[1][g].z; St[1][4 * g + 3] *= gm[1][g].w; }
            { const pg8::bf16x8 yb = rwk_pack_asm(P, 1); const v4u yv = __builtin_bit_cast(v4u, yb);
#pragma unroll
              for (int j = 0; j < 4; ++j) { const int e0 = 2 * j, t0 = (e0 & 3) + 8 * (e0 >> 2) + 4 * hh; yl[((c & 3) * 16 + t0) * 64 + hf * 32 + i] = (bf16_t)(yv[j] & 0xffffu); yl[((c & 3) * 16 + t0 + 1) * 64 + hf * 32 + i] = (bf16_t)(yv[j] >> 16); } }
        }
        if ((c & 3) == 3) {
#pragma unroll
            for (int q = 0; q < 4; ++q) { const int pid = lane + 64 * q, tt = pid >> 2, part = hf * 4 + (pid & 3); *(v4u*)(I.YR + (row0 + (size_t)(c - 3) * 16 + tt) * D + h * HK + part * 8) = *(const LAS v4u*)(yl + tt * 64 + part * 8); } }
        __builtin_amdgcn_sched_barrier(0);
        asm volatile("s_waitcnt lgkmcnt(0)" ::: "memory"); if (lane == 0) ctl[hf] = epoch + (unsigned)(c + 1);
    }
    RWK_WAIT(0);
#ifdef PROF
    if (b == 0 && h == 0 && lane == 0) { const float tot = (float)(PROF_T() - ct0); I.prof[24] = tot * 1e-6f; }
    if (b == BATCH - 1 && h == H_RWKV - 1 && lane == 0) { const float tot = (float)(PROF_T() - ct0); I.prof[27] = tot * 1e-6f; }
#endif
#undef RWK_DMA
#undef RWK_WAIT
#undef RWK_WAITF
    __builtin_amdgcn_s_setprio(0);
    { float* so = I.state_out + (((size_t)b * H_RWKV + h) * HK + hf * 32 + i) * HK;
#pragma unroll
        for (int g = 0; g < 4; ++g) { *(f32x4*)(so + 8 * g + 4 * hh) = (f32x4){St[0][4 * g], St[0][4 * g + 1], St[0][4 * g + 2], St[0][4 * g + 3]}; *(f32x4*)(so + 32 + 8 * g + 4 * hh) = (f32x4){St[1][4 * g], St[1][4 * g + 1], St[1][4 * g + 2], St[1][4 * g + 3]}; } }
}

template <int NS = 1, class F>
__device__ __forceinline__ void mini_rows_gemm(const bf16_t* A, const bf16_t* Bt, int K, int N, int r0, int bx, int G, int wave, int lane, F&& store) {
    const int fr = lane & 15, fq = lane >> 4;
    for (int s = bx * NS; s < N / 16; s += G * NS) {
        const bf16_t* ap = A + (size_t)(r0 + 16 * wave + fr) * K + 8 * fq; const bf16_t* bp = Bt + (size_t)(16 * s + fr) * K + 8 * fq;
        pg8::f32x4 acc[NS];
#pragma unroll
        for (int q = 0; q < NS; ++q) acc[q] = (pg8::f32x4){0.f, 0.f, 0.f, 0.f};
#pragma unroll (NS == 1 ? 16 : 8)
        for (int ks = 0; ks < K / 32; ++ks) { const pg8::bf16x8 a = *(const pg8::bf16x8*)(ap + 32 * ks);
#pragma unroll
            for (int q = 0; q < NS; ++q) if (s + q < N / 16) { const pg8::bf16x8 b = *(const pg8::bf16x8*)(bp + (size_t)q * 16 * K + 32 * ks); acc[q] = __builtin_amdgcn_mfma_f32_16x16x32_bf16(b, a, acc[q], 0, 0, 0); } }
#pragma unroll
        for (int q = 0; q < NS; ++q) if (s + q < N / 16) store(r0 + 16 * wave + fr, 16 * (s + q) + 4 * fq, acc[q]);
    }
}
template <class F>
__device__ __forceinline__ void mini_rows_gemm_k4(LAS unsigned char* lds, const bf16_t* A, const bf16_t* Bt, int N, int r0, int bx, int G, int tid, F&& store) {
    static_assert(D == 1024 && MS == 128, "mini_rows_gemm_k4 shapes");
    const int wave = tid >> 6, lane = tid & 63, fr = lane & 15, fq = lane >> 4, tib = wave >> 2, kp = wave & 3, ntiles = 8 * (N / 16);
    LAS f32x4* part = (LAS f32x4*)lds;
#pragma unroll 1
    for (int tile0 = bx * 2; tile0 < ntiles; tile0 += G * 2) { const int tile = tile0 + tib; const bool valid = tile < ntiles; const int rt = tile & 7, cs = tile >> 3;
        pg8::f32x4 acc = {0.f, 0.f, 0.f, 0.f};
        if (valid) { const bf16_t* ap = A + (size_t)(r0 + 16 * rt + fr) * D + kp * 256 + 8 * fq; const bf16_t* bp = Bt + (size_t)(16 * cs + fr) * D + kp * 256 + 8 * fq;
            pg8::bf16x8 a[8], b[8];
#pragma unroll
            for (int ks = 0; ks < 8; ++ks) { a[ks] = *(const pg8::bf16x8*)(ap + 32 * ks); b[ks] = *(const pg8::bf16x8*)(bp + 32 * ks); }
#pragma unroll
            for (int ks = 0; ks < 8; ++ks) acc = __builtin_amdgcn_mfma_f32_16x16x32_bf16(b[ks], a[ks], acc, 0, 0, 0); }
        part[(tib * 4 + kp) * 64 + lane] = (f32x4){acc[0], acc[1], acc[2], acc[3]};
        __syncthreads();
        if (kp == 0 && valid) { f32x4 v = part[(tib * 4) * 64 + lane]; v += part[(tib * 4 + 1) * 64 + lane]; v += part[(tib * 4 + 2) * 64 + lane]; v += part[(tib * 4 + 3) * 64 + lane];
            store(r0 + 16 * rt + fr, 16 * cs + 4 * fq, (pg8::f32x4){v.x, v.y, v.z, v.w}); }
        __syncthreads();
    }
}
__global__ void __launch_bounds__(NTHREADS, 2) mk_fwd(MkArgs args) {
    extern __shared__ __attribute__((aligned(16))) unsigned char lds_raw[];
    LAS unsigned char* lds = (LAS unsigned char*)lds_raw;
    volatile LAS unsigned* MISC = (volatile LAS unsigned*)(lds + LDSCTL_OFF);
    const int tid = threadIdx.x, lane = tid & 63, wave = __builtin_amdgcn_readfirstlane(tid >> 6);
    const int G = gridDim.x, bx = blockIdx.x, vcu = (G % 8 == 0) ? (bx % 8) * (G / 8) + bx / 8 : bx;
    unsigned char* ws = args.ws; float* out = args.out;
    for (int u = tid; u < (LDS_BYTES - LDSCTL_OFF) / 4; u += NTHREADS) ((LAS unsigned*)(lds + LDSCTL_OFF))[u] = 0u;
    __syncthreads();
    XcdBarrier bar = xcd_barrier_post((unsigned*)(ws + O_CTL) + CW_BAR + args.bar_idx * XCD_BAR_WORDS, MISC + 8);
    const int lo = args.ph_lo, hi = args.ph_hi;
#define IN_PH(k) (lo <= (k) && (k) < hi)
#define REPS(k) _Pragma("unroll 1") for (int rep_ = 0; rep_ < (DUP_PHASE == (k) ? 2 : 1); ++rep_)
#ifdef PROF
    unsigned long long ph_prev_ = PROF_T(); const unsigned long long ph_t0_ = ph_prev_;
#define SEAM(k) do { if (IN_PH(k) && IN_PH((k) + 1)) xcd_barrier(bar); { const unsigned long long n_ = PROF_T(); if (bx == 0 && tid == 0) ((float*)(ws + O_PROF))[32 + (k)] = (float)(n_ - ph_prev_) * 1e-6f; ph_prev_ = n_; } } while (0)
#else
#define SEAM(k) do { if (IN_PH(k) && IN_PH((k) + 1)) xcd_barrier(bar); } while (0)
#endif
    bf16_t* WT_in = (bf16_t*)(ws + O_WT_IN); bf16_t* Hb = (bf16_t*)(ws + O_HB); bf16_t* MN = (bf16_t*)(ws + O_MN);
    const int gw = vcu * NWAVES + wave, NGW = G * NWAVES;

    if (IN_PH(PH_PREP)) REPS(PH_PREP) {
        LAS float* scr = (LAS float*)(lds + wave * 8704);
        { LAS float* wdt = (LAS float*)(lds + 8 * 8704);
          for (int idx = tid; idx < D * 4; idx += NTHREADS) { const int k = idx >> 2, q = idx & 3; const f32x4 v = *(const f32x4*)(args.in[I_W_IN] + (size_t)k * D_IN + D + CONV_DIM + 4 * q);
              wdt[(4 * q) * D + k] = v.x; wdt[(4 * q + 1) * D + k] = v.y; wdt[(4 * q + 2) * D + k] = v.z; wdt[(4 * q + 3) * D + k] = v.w; }
          __syncthreads(); }
        constexpr int KB = D / 64;
        constexpr int I_IN = (NMAIN / 32) * KB, I_SQ = (D / 32) * KB, I_PQ = (NPQ / 32) * KB, I_L64 = D / 32, I_L128 = (D / 32) * 2;
        constexpr int NITEMS = I_IN + 5 * I_SQ + I_PQ + 2 * I_L64 + I_L128;
        static_assert(W_RANK == 64 && A_RANK == 64 && G_RANK == 128 && (D + CONV_DIM) % 32 == 0, "P0 item shapes");
        for (int it = gw; it < NITEMS; it += NGW) {
            int r = it;
            if (r < I_IN) { const int kb = r / (NMAIN / 32), nb = r % (NMAIN / 32), n0 = 32 * nb; p0_transpose_item(args.in[I_W_IN], D, D_IN, n0 + (n0 >= D + CONV_DIM ? H_SSD : 0), WT_in, n0, scr, kb, lane); continue; } r -= I_IN;
            if (r < 5 * I_SQ) { const int wsel = r / I_SQ; r %= I_SQ; const int kb = r / (D / 32), nb = r % (D / 32);
                const float* W = args.in[wsel == 0 ? I_W_OUT : wsel == 1 ? I_W_MK : wsel == 2 ? I_W_MV : wsel == 3 ? I_W_MQ : I_W_MO];
                bf16_t* WT = (bf16_t*)(ws + (wsel == 0 ? O_WT_OUT : wsel == 1 ? O_WT_MK : wsel == 2 ? O_WT_MV : wsel == 3 ? O_WT_MQ : O_WT_MO));
                p0_transpose_item(W, D, D, 32 * nb, WT, 32 * nb, scr, kb, lane); continue; } r -= 5 * I_SQ;
            if (r < I_PQ) { const int kb = r / (NPQ / 32), nb = r % (NPQ / 32); p0_transpose_item(args.in[I_W_PQ], D, NPQ, 32 * nb, (bf16_t*)(ws + O_WT_PQ), 32 * nb, scr, kb, lane); continue; } r -= I_PQ;
            if (r < I_L64) { p0_transpose_item(args.in[I_W2], W_RANK, D, 32 * r, (bf16_t*)(ws + O_LW2), 32 * r, scr, 0, lane); continue; } r -= I_L64;
            if (r < I_L64) { p0_transpose_item(args.in[I_A2], A_RANK, D, 32 * r, (bf16_t*)(ws + O_LA2), 32 * r, scr, 0, lane); continue; } r -= I_L64;
            { const int kb = r / (D / 32), nb = r % (D / 32); p0_transpose_item(args.in[I_G2], G_RANK, D, 32 * nb, (bf16_t*)(ws + O_LG2), 32 * nb, scr, kb, lane); }
        }
        for (int it = gw; it < I_SQ; it += NGW) { const int kb = it / (D / 32), nb = it % (D / 32); p0_transpose_item(args.in[I_W_MQ], D, D, 32 * nb, (bf16_t*)(ws + O_WT_MQS), 32 * nb, scr, kb, lane, args.in[I_NORM_MEM]); }
        float* DT = (float*)(ws + O_DT);
        for (int m = gw; m < MPAD; m += NGW) {
            if (m < MT) norm_row<true>(m < MP ? args.in[I_XP] + (size_t)m * D : args.in[I_XS] + (size_t)(m - MP) * D, args.in[I_NORM_MIX], Hb + (size_t)m * D, lds + 8 * 8704, DT + (size_t)m * H_SSD, lane);
            else { v4u z = {0u, 0u, 0u, 0u}; v4u* o = (v4u*)(Hb + (size_t)m * D) + lane; o[0] = z; o[64] = z; }
        }
        for (int m = gw; m < NMEMROWS; m += NGW) norm_row<false>(args.in[I_MEM] + (size_t)m * D, args.in[I_MEM_NORM], MN + (size_t)m * D, (const LAS unsigned char*)nullptr, nullptr, lane);
        float* esc = (float*)(ws + O_ESC);
        for (int e = gw; e < 2 * N_EXPERTS; e += NGW) { const int t = e >= N_EXPERTS, r = e - t * N_EXPERTS;
            fp4_row(args.in[t ? I_EV : I_EU] + (size_t)r * D, ws + O_EU8 + (size_t)r * D + t * 8, esc + e, lane); }
        { const float* sk = args.in[I_SUBK]; bf16_t* skb = (bf16_t*)(ws + O_SKB); constexpr int NSK = PEER_HEADS * 2 * N_KEYS * PEER_HALF;
          for (int i = (vcu * NTHREADS + tid) * 4; i < NSK; i += G * NTHREADS * 4) { const f32x4 v = *(const f32x4*)(sk + i); typedef unsigned u32x2 __attribute__((ext_vector_type(2))); u32x2 w; w.x = pk2(v.x, v.y); w.y = pk2(v.z, v.w); *(u32x2*)(skb + i) = w; } }
    }
    SEAM(PH_PREP);
    if (IN_PH(PH_INPROJ)) REPS(PH_INPROJ) {
        { pg8::Gemm g{Hb, WT_in, MP, NMAIN, D}; pg8::StaticOrder S; S.init(MP, NMAIN, G, bx);
          pg8::EpiProj E{(bf16_t*)(ws + O_PZ), (bf16_t*)(ws + O_PXBC), (bf16_t*)(ws + O_PRW), (bf16_t*)(ws + O_PGATE)};
          mini_rows_gemm<2>(g.A, g.Bt, D, NMAIN, MP, bx, G, wave, lane, [&](int r, int c, const pg8::f32x4& v) { u32x2 o; o.x = pk2(v[0], v[1]); o.y = pk2(v[2], v[3]);
              bf16_t* dst = c < D ? E.PZ + (size_t)r * D + c : c < D + CONV_DIM ? E.PXBC + (size_t)r * CONV_DIM + (c - D) : c < D + CONV_DIM + RWKV_PROJ ? E.PRW + (size_t)r * RWKV_PROJ + (c - D - CONV_DIM) : E.PGATE + (size_t)r * 2 * D + (c - D - CONV_DIM - RWKV_PROJ);
              *(u32x2*)dst = o; });
          pg8::gemm_phase<pg8::EpiProj, pg8::StaticOrder, true, true>(lds, g, S, E); }
        { pg8::Gemm g{MN, (const bf16_t*)(ws + O_WT_MK), NMEMROWS, 2 * D, D}; pg8::StaticOrder S; S.init(NMEMROWS, 2 * D, G, G - 1 - bx);
          pg8::EpiKV E{out + OO_MKP, out + OO_MVP, (bf16_t*)(ws + O_KVB), (bf16_t*)(ws + O_VTB)};
          pg8::gemm_phase<pg8::EpiKV, pg8::StaticOrder, true, true>(lds, g, S, E); }
    }
    SEAM(PH_INPROJ);
    float* o_ = out;
    if (IN_PH(PH_CONV)) REPS(PH_CONV) {
        SsdCIn I{(const bf16_t*)(ws + O_PXBC), args.in[I_CONV_W], args.in[I_CONV_B], (bf16_t*)(ws + O_CG), (bf16_t*)(ws + O_BTG), (bf16_t*)(ws + O_CBG)};
        for (int u = bx; u < BATCH * (SEQ / 128) * G_SSD; u += G) ssd_conv_unit(lds, I, u / ((SEQ / 128) * G_SSD), (u / G_SSD) % (SEQ / 128), u % G_SSD, tid);
        { RwkPIn J{(const bf16_t*)(ws + O_PRW), (const bf16_t*)(ws + O_LW2), (const bf16_t*)(ws + O_LA2), args.in[I_MU], args.in[I_W0], args.in[I_A0], args.in[I_K_K], args.in[I_K_A], args.in[I_R_K], (float*)(ws + O_BON), rwk_slots(ws, out), (float*)(ws + O_PROF)};
          constexpr int NU = BATCH * (SEQ / 64);
          if (G % H_RWKV == 0) rwkv_prep_units(lds, J, bx % H_RWKV, bx / H_RWKV, G / H_RWKV, NU, tid);
          else for (int hh_ = 0; hh_ < H_RWKV; ++hh_) rwkv_prep_units(lds, J, hh_, bx, G, NU, tid); }
    }
    SEAM(PH_CONV);
    if (IN_PH(PH_MIXA)) REPS(PH_MIXA) {
        const bf16_t* PXBC = (const bf16_t*)(ws + O_PXBC); const bf16_t* PRW = (const bf16_t*)(ws + O_PRW);
        constexpr int NHEAVY = BATCH * H_SSD;
        { SsdIn I{PXBC, (const bf16_t*)(ws + O_CG), (const bf16_t*)(ws + O_BTG), (const bf16_t*)(ws + O_CBG), (const float*)(ws + O_DT), args.in[I_CONV_W], args.in[I_CONV_B], args.in[I_DT_BIAS], args.in[I_A_LOG], args.in[I_D_SKIP], (bf16_t*)(ws + O_YS), o_ + OO_SSMP, (float*)(ws + O_PROF)};
          if (tid < 16) ((LAS unsigned*)(lds + 8192))[tid] = 0u;
          __syncthreads();
          for (int u = bx; u < NHEAVY; u += G) ssd_prompt_unit(lds, I, u / H_SSD, u % H_SSD, tid); }
        { RwkSIn J{rwk_slots(ws, out), (bf16_t*)(o_ + OO_YP), o_ + OO_WKVP, (float*)(ws + O_PROF)};
          if (G >= 2 * NHEAVY) { if (bx >= NHEAVY && wave < 2 + RWK_NL) { unsigned ep = 0; for (int u = bx - NHEAVY; u < BATCH * H_RWKV; u += G - NHEAVY, ep += rp::NCHUNK) rwkv_cscan_unit(lds, J, u / H_RWKV, u % H_RWKV, wave, ep, lane); } }
          else { __syncthreads(); if (tid < 16) ((LAS unsigned*)(lds + 8192))[tid] = 0u; __syncthreads();
              if (wave < 2 + RWK_NL) { unsigned ep = 0; for (int u = bx; u < BATCH * H_RWKV; u += G, ep += rp::NCHUNK) rwkv_cscan_unit(lds, J, u / H_RWKV, u % H_RWKV, wave, ep, lane); } } }
#ifdef PROF
        if (bx == NHEAVY && wave == 0 && lane == 0) ((float*)(ws + O_PROF))[26] = (float)(PROF_T() - ph_prev_) * 1e-6f;
#endif
        { SsdSIn J{PXBC, args.in[I_SCONV], args.in[I_SSSM], (const float*)(ws + O_DT), args.in[I_CONV_W], args.in[I_CONV_B], args.in[I_DT_BIAS], args.in[I_A_LOG], args.in[I_D_SKIP], (bf16_t*)(ws + O_YS), o_ + OO_SSMS};
          RwkvSIn K{PRW, args.in[I_SSHIFT], args.in[I_SWKV], args.in[I_MU], args.in[I_W0], args.in[I_W2], args.in[I_A0], args.in[I_A2], args.in[I_K_K], args.in[I_K_A], args.in[I_R_K], (bf16_t*)(o_ + OO_YP), (float*)(ws + O_BON), o_ + OO_WKVS, (const bf16_t*)(ws + O_LW2), (const bf16_t*)(ws + O_LA2)};
          unsigned* qc = (unsigned*)(ws + O_CTL) + CW_LQ;
          constexpr unsigned NU_S = DEC_BATCH * H_SSD, NU_R = DEC_BATCH * H_RWKV;
          constexpr size_t N_CV = (size_t)(BATCH + DEC_BATCH) * (CONV_K - 1) * CONV_DIM, N_SH = (size_t)(BATCH + DEC_BATCH) * RWKV_PROJ;
          constexpr unsigned NU_CV = (unsigned)((N_CV + 1023) / 1024), NU_SH = (unsigned)((N_SH + 1023) / 1024);
          const float* sconv = args.in[I_SCONV];
          auto cv_get = [&](size_t i) -> float { constexpr size_t np = (size_t)BATCH * (CONV_K - 1) * CONV_DIM;
              if (i < np) { const int ch = (int)(i % CONV_DIM), jr = (int)((i / CONV_DIM) % (CONV_K - 1)), b = (int)(i / ((CONV_K - 1) * CONV_DIM)); const int t = SEQ - (CONV_K - 1) + jr; return t >= 0 ? bf2f(PXBC[((size_t)b * SEQ + t) * CONV_DIM + ch]) : 0.f; }
              const size_t k = i - np; const int ch = (int)(k % CONV_DIM), jr = (int)((k / CONV_DIM) % (CONV_K - 1)), b = (int)(k / ((CONV_K - 1) * CONV_DIM));
              return (jr + 1 < CONV_K - 1) ? sconv[((size_t)b * (CONV_K - 1) + jr + 1) * CONV_DIM + ch] : bf2f(PXBC[((size_t)MP + b) * CONV_DIM + ch]); };
          auto sh_get = [&](size_t i) -> float { constexpr size_t np = (size_t)BATCH * RWKV_PROJ;
              if (i < np) { const int c = (int)(i % RWKV_PROJ), b = (int)(i / RWKV_PROJ); return bf2f(PRW[((size_t)b * SEQ + SEQ - 1) * RWKV_PROJ + c]); }
              const size_t k = i - np; const int c = (int)(k % RWKV_PROJ), b = (int)(k / RWKV_PROJ); return bf2f(PRW[((size_t)MP + b) * RWKV_PROJ + c]); };
#pragma unroll 1
          for (;;) { unsigned u = 0; if (lane == 0) u = __hip_atomic_fetch_add(qc, 1u, __ATOMIC_RELAXED, __HIP_MEMORY_SCOPE_AGENT); u = __builtin_amdgcn_readfirstlane(u);
              if (u >= NU_S + NU_R + NU_CV + NU_SH) break;
              if (u < NU_S) ssd_sample_unit(J, (int)(u / H_SSD), (int)(u % H_SSD), lane);
              else if (u < NU_S + NU_R) { u -= NU_S; rwkv_sample_unit(K, (int)(u / H_RWKV), (int)(u % H_RWKV), lane); }
              else if (u < NU_S + NU_R + NU_CV) { const size_t i0 = (size_t)(u - NU_S - NU_R) * 1024 + lane; float r_[16];
#pragma unroll
                  for (int k = 0; k < 16; ++k) { const size_t i = i0 + 64 * k; r_[k] = i < N_CV ? cv_get(i) : 0.f; }
#pragma unroll
                  for (int k = 0; k < 16; ++k) { const size_t i = i0 + 64 * k; constexpr size_t np = (size_t)BATCH * (CONV_K - 1) * CONV_DIM; if (i < N_CV) { if (i < np) o_[OO_CONVP + i] = r_[k]; else o_[OO_CONVS + (i - np)] = r_[k]; } } }
              else { const size_t i0 = (size_t)(u - NU_S - NU_R - NU_CV) * 1024 + lane; float r_[16];
#pragma unroll
                  for (int k = 0; k < 16; ++k) { const size_t i = i0 + 64 * k; r_[k] = i < N_SH ? sh_get(i) : 0.f; }
#pragma unroll
                  for (int k = 0; k < 16; ++k) { const size_t i = i0 + 64 * k; constexpr size_t np = (size_t)BATCH * RWKV_PROJ; if (i < N_SH) { if (i < np) o_[OO_SHP + i] = r_[k]; else o_[OO_SHS + (i - np)] = r_[k]; } } } }
#ifdef PROF
          if (bx == NHEAVY && wave == 2 + RWK_NL && lane == 0) ((float*)(ws + O_PROF))[25] = (float)(PROF_T() - ph_prev_) * 1e-6f;
#endif
        }
    }
    SEAM(PH_MIXA);
    if (IN_PH(PH_MERGE)) REPS(PH_MERGE) {
        static_assert(MT % 16 == 0, "merge units");
        MergeIn I{(const bf16_t*)(ws + O_YS), (const bf16_t*)(o_ + OO_YP), (const bf16_t*)(ws + O_PZ), (const bf16_t*)(ws + O_PGATE), (const bf16_t*)(ws + O_PRW), (const bf16_t*)(ws + O_LG2),
                  (const float*)(ws + O_BON), args.in[I_SSHIFT], args.in[I_MU], args.in[I_SSD_NORM], args.in[I_LN_W], args.in[I_LN_B], (bf16_t*)(ws + O_MERGED)};
        for (int u = bx; u < MT / 16; u += G) merge_unit(lds, I, 16 * u, tid);
        GS_LOOP((size_t)(MPAD - MT) * D, b_zero_u16(i_, (bf16_t*)(ws + O_MERGED) + (size_t)MT * D, (size_t)(MPAD - MT) * D));
    }
    SEAM(PH_MERGE);
    if (IN_PH(PH_OUT)) REPS(PH_OUT) {
        pg8::Gemm g{(const bf16_t*)(ws + O_MERGED), (const bf16_t*)(ws + O_WT_OUT), MP, D, D}; pg8::StaticOrder S; S.init(MP, D, G, bx);
        float* PS = (float*)(ws + O_HB); float* PSS = PS + (size_t)MP * 16;
        pg8::EpiResB E{args.in[I_XP], args.in[I_XS], MP, (const bf16_t*)nullptr, (bf16_t*)(ws + O_X1), MT, PS};
        { const float* xs = args.in[I_XS]; bf16_t* X1 = (bf16_t*)(ws + O_X1);
          mini_rows_gemm_k4(lds, g.A, g.Bt, D, MP, bx, G, tid, [&](int r, int c, const pg8::f32x4& v) { const f32x4 b = *(const f32x4*)(xs + (size_t)(r - MP) * D + c); const float y0 = b.x + v[0], y1 = b.y + v[1], y2 = b.z + v[2], y3 = b.w + v[3]; u32x2 o; o.x = pk2(y0, y1); o.y = pk2(y2, y3); *(u32x2*)(X1 + (size_t)r * D + c) = o;
              float q_ = (y0 * y0 + y1 * y1) + (y2 * y2 + y3 * y3); q_ += __shfl_xor(q_, 16); q_ += __shfl_xor(q_, 32); if ((c & 15) == 0) PSS[(size_t)(r - MP) * 64 + (c >> 4)] = q_; }); }
        pg8::gemm_phase<pg8::EpiResB, pg8::StaticOrder, true, true>(lds, g, S, E);
    }
    SEAM(PH_OUT);
    if (IN_PH(PH_NORM2)) REPS(PH_NORM2) {
        bf16_t* H2 = (bf16_t*)(ws + O_H2); const bf16_t* X1 = (const bf16_t*)(ws + O_X1);
        if (G < (MP / 256) * (D / 256))
        for (int m = gw; m < MT; m += NGW) norm_row_bf(X1 + (size_t)m * D, args.in[I_NORM_MEM], H2 + (size_t)m * D, lane);
    }
    if (G < (MP / 256) * (D / 256)) SEAM(PH_NORM2);
    if (IN_PH(PH_Q)) REPS(PH_Q) {
        pg8::StaticOrder S; S.init(MP, D, G, bx); bf16_t* QB = (bf16_t*)(ws + O_QB);
        if (G >= (MP / 256) * (D / 256)) {
            LAS float* rsl = (LAS float*)(lds + 139264); LAS float* rss = rsl + 256;
            const float* PS = (const float*)(ws + O_HB); const float* PSS = PS + (size_t)MP * 16;
            { pg8::Unit u0; const bool has = S.next(0, u0);
              const int tr = tid >> 1, th = tid & 1, sr = tid >> 2, sq = tid & 3; float qa = 0.f, qb = 0.f;
              if (has) { const float* p = PS + ((size_t)u0.pm * 256 + tr) * 16 + th * 8;
#pragma unroll
                  for (int j = 0; j < 8; ++j) qa += p[j]; }
              { const float* p = PSS + (size_t)sr * 64 + sq * 16;
#pragma unroll
                  for (int j = 0; j < 16; ++j) qb += p[j]; }
              qa += __shfl_xor(qa, 1); qb += __shfl_xor(qb, 1); qb += __shfl_xor(qb, 2);
              if (has && th == 0) rsl[tr] = 1.f / sqrtf(qa * (1.f / D) + NORM_EPS);
              if (sq == 0) rss[sr] = 1.f / sqrtf(qb * (1.f / D) + NORM_EPS); }
            __syncthreads();
            pg8::Gemm g{(const bf16_t*)(ws + O_X1), (const bf16_t*)(ws + O_WT_MQS), MP, D, D};
            pg8::EpiB16S E{QB, D, rsl};
            mini_rows_gemm_k4(lds, g.A, g.Bt, D, MP, bx, G, tid, [&](int r, int c, const pg8::f32x4& v) { const float sc = rss[r - MP]; u32x2 o; o.x = pk2(v[0] * sc, v[1] * sc); o.y = pk2(v[2] * sc, v[3] * sc); *(u32x2*)(QB + (size_t)r * D + c) = o; });
            pg8::gemm_phase<pg8::EpiB16S, pg8::StaticOrder, true, true>(lds, g, S, E);
        } else {
            pg8::Gemm g{(const bf16_t*)(ws + O_H2), (const bf16_t*)(ws + O_WT_MQ), MP, D, D};
            pg8::EpiB16 E{QB, D};
            mini_rows_gemm_k4(lds, g.A, g.Bt, D, MP, bx, G, tid, [&](int r, int c, const pg8::f32x4& v) { u32x2 o; o.x = pk2(v[0], v[1]); o.y = pk2(v[2], v[3]); *(u32x2*)(QB + (size_t)r * D + c) = o; });
            pg8::gemm_phase<pg8::EpiB16, pg8::StaticOrder, true, true>(lds, g, S, E);
        }
    }
    SEAM(PH_Q);
    if (IN_PH(PH_ATT1)) REPS(PH_ATT1) {
        AttnIn I{(const bf16_t*)(ws + O_QB), (const bf16_t*)(ws + O_KVB), (const bf16_t*)(ws + O_VTB), (bf16_t*)(ws + O_AO)};
        AttnSIn J{(const bf16_t*)(ws + O_QB), args.in[I_CK], args.in[I_CV], (bf16_t*)(ws + O_AO)};
#pragma unroll 1
        for (int pass = 0; pass < 2; ++pass) {
            if ((pass ^ ((bx >> 3) & 1)) == 0) { for (int u = bx; u < BATCH * MEM_HEADS * (SEQ / 256); u += G) attn_prompt_unit(lds, I, u / (MEM_HEADS * (SEQ / 256)), (u / (SEQ / 256)) % MEM_HEADS, u % (SEQ / 256), tid); }
            else { for (int u = bx; u < DEC_BATCH * MEM_HEADS / 2; u += G) attn_sample_block(lds, J, u, tid); }
            __syncthreads();
        }
        GS_LOOP((size_t)(MPAD - MT) * D, b_zero_u16(i_, (bf16_t*)(ws + O_AO) + (size_t)MT * D, (size_t)(MPAD - MT) * D));
    }
    SEAM(PH_ATT1);
    if (IN_PH(PH_O)) REPS(PH_O) {
        pg8::Gemm g{(const bf16_t*)(ws + O_AO), (const bf16_t*)(ws + O_WT_MO), MP, D, D}; pg8::StaticOrder S; S.init(MP, D, G, bx);
        pg8::EpiResB E{(const float*)nullptr, (const float*)nullptr, MPAD, (const bf16_t*)(ws + O_X1), (bf16_t*)(ws + O_X2), MT, (float*)nullptr};
        { const bf16_t* X1 = (const bf16_t*)(ws + O_X1); bf16_t* X2 = (bf16_t*)(ws + O_X2);
          mini_rows_gemm_k4(lds, g.A, g.Bt, D, MP, bx, G, tid, [&](int r, int c, const pg8::f32x4& v) { const u32x2 b = *(const u32x2*)(X1 + (size_t)r * D + c); u32x2 o;
              o.x = pk2(__uint_as_float(b.x << 16) + v[0], __uint_as_float(b.x & 0xffff0000u) + v[1]); o.y = pk2(__uint_as_float(b.y << 16) + v[2], __uint_as_float(b.y & 0xffff0000u) + v[3]); *(u32x2*)(X2 + (size_t)r * D + c) = o; }); }
        pg8::gemm_phase<pg8::EpiResB, pg8::StaticOrder, true, true>(lds, g, S, E);
    }
    SEAM(PH_O);
    if (IN_PH(PH_NORM3)) REPS(PH_NORM3) {
        bf16_t* H3 = (bf16_t*)(ws + O_H3); const bf16_t* X2 = (const bf16_t*)(ws + O_X2);
        for (int m = gw; m < MT; m += NGW) norm_row_bf(X2 + (size_t)m * D, args.in[I_NORM_FFN], H3 + (size_t)m * D, lane);
    }
    SEAM(PH_NORM3);
    if (IN_PH(PH_PQ)) REPS(PH_PQ) {
        pg8::Gemm g{(const bf16_t*)(ws + O_H3), (const bf16_t*)(ws + O_WT_PQ), MP, NPQ, D}; pg8::StaticOrder S; S.init(MP, NPQ, G, bx);
        pg8::EpiB16 E{(bf16_t*)(ws + O_PQ), NPQ};
        { bf16_t* PQo = (bf16_t*)(ws + O_PQ);
          mini_rows_gemm_k4(lds, g.A, g.Bt, NPQ, MP, bx, G, tid, [&](int r, int c, const pg8::f32x4& v) { u32x2 o; o.x = pk2(v[0], v[1]); o.y = pk2(v[2], v[3]); *(u32x2*)(PQo + (size_t)r * NPQ + c) = o; }); }
        pg8::gemm_phase<pg8::EpiB16, pg8::StaticOrder, true, true>(lds, g, S, E);
    }
    SEAM(PH_PQ);
    if (IN_PH(PH_PK1)) REPS(PH_PK1) {
        static_assert(MT % 16 == 0, "topk units");
        TopkIn I{(const bf16_t*)(ws + O_PQ), (const bf16_t*)(ws + O_SKB), (int*)(ws + O_IDX), (float*)(ws + O_GATE)};
        for (int u = gw; u < (MP / 16) * PEER_HEADS; u += NGW) peer_topk_unit(I, u / PEER_HEADS, u % PEER_HEADS, lane);
    }
    SEAM(PH_PK1);
    if (IN_PH(PH_PEER)) REPS(PH_PEER) {
        unsigned* pkc = (unsigned*)(ws + O_CTL) + CW_PKS; constexpr int NSU = (MS / 16) * PEER_HEADS;
        { TopkIn I{(const bf16_t*)(ws + O_PQ), (const bf16_t*)(ws + O_SKB), (int*)(ws + O_IDX), (float*)(ws + O_GATE)};
          const bool pk_sel = (G % 8 == 0 && G >= 256) ? (wave == 0 && ((bx & 7) == 1 || (bx & 7) == 2) && (bx >> 3) < 32) : (wave == 0);
          const int pk_u0 = (G % 8 == 0 && G >= 256) ? (bx >> 3) + 32 * ((bx & 7) - 1) : bx, pk_step = (G % 8 == 0 && G >= 256) ? NSU : G;
          if (pk_sel) for (int u = pk_u0; u < NSU; u += pk_step) { peer_topk_unit(I, MP / 16 + u / PEER_HEADS, u % PEER_HEADS, lane);
              __builtin_amdgcn_fence(__ATOMIC_RELEASE, "agent"); asm volatile("s_waitcnt vmcnt(0)" ::: "memory"); if (lane == 0) (void)xb_add(pkc, 1u); } }
        for (int t = gw; t < MT; t += NGW) {
            if (t >= MP) { unsigned sp_ = 0; while (xb_ld(pkc) < (unsigned)NSU && ++sp_ < (1u << 24)) __builtin_amdgcn_s_sleep(2); __builtin_amdgcn_fence(__ATOMIC_ACQUIRE, "agent"); asm volatile("s_waitcnt vmcnt(0)" ::: "memory"); }
            peer_token(t, (const bf16_t*)(ws + O_H3), (const int*)(ws + O_IDX), (const float*)(ws + O_GATE), ws + O_EU8, ws + O_EV8, (const float*)(ws + O_ESC),
                       (const bf16_t*)(ws + O_X2), args.in[I_NORM_FINAL], t < MP ? o_ + OO_YP + (size_t)t * D : o_ + OO_YS + (size_t)(t - MP) * D, lane); }
    }
#ifdef PROF
#ifndef PROF_ASCALE
#define PROF_ASCALE 1.f
#endif
#ifndef PROF_A
#define PROF_A 0
#define PROF_B 1
#endif
    if (IN_PH(PH_PEER)) { xcd_barrier(bar); { const unsigned long long n_ = PROF_T(); if (bx == 0 && tid == 0) { ((float*)(ws + O_PROF))[32 + PH_PEER] = (float)(n_ - ph_prev_) * 1e-6f; ((float*)(ws + O_PROF))[46] = (float)(n_ - ph_t0_) * 1e-6f; } } const float* pr = (const float*)(ws + O_PROF); const float fa = rintf(pr[PROF_A] * PROF_ASCALE * 50.f) * 0.02f, fb = rintf(pr[PROF_B] * 50.f) * 0.0002f;
        if (bx == 0 && tid == 0) o_[OO_YP] += 1.f + 8.f * fa;
        const float cc = sqrtf(0.002f + fb); for (int i = bx * NTHREADS + tid; i < MS * D; i += G * NTHREADS) o_[OO_YS + i] += cc; }
#endif
#undef IN_PH
#undef SEAM
}
#endif

#ifndef DUP_PHASE
#define DUP_PHASE -1
#endif
extern "C" void kernel_launch(void* const* d_in, const int* in_sizes, int n_in, void* d_out, int out_size, void* d_ws, size_t ws_size, hipStream_t stream) {
    const float* const* in = (const float* const*)d_in;
    const float *x_prompt = in[0], *x_sample = in[1], *mem_prompt = in[2], *state_ssm = in[3], *state_conv = in[4], *state_wkv = in[5], *state_shift = in[6], *cache_k = in[7], *cache_v = in[8];
    const float *norm_mix_w = in[9], *w_in = in[10], *conv_w = in[11], *conv_b = in[12], *dt_bias = in[13], *a_log = in[14], *d_skip = in[15], *ssd_norm_w = in[16];
    const float *rwkv_mu = in[17], *rwkv_w0 = in[18], *rwkv_w2 = in[19], *rwkv_a0 = in[20], *rwkv_a2 = in[21], *rwkv_g2 = in[22], *rwkv_k_k = in[23], *rwkv_k_a = in[24], *rwkv_r_k = in[25], *rwkv_ln_w = in[26], *rwkv_ln_b = in[27];
    const float *w_out = in[28], *norm_mem_w = in[29], *mem_norm_w = in[30], *w_mk = in[31], *w_mv = in[32], *w_mq = in[33], *w_mo = in[34], *norm_ffn_w = in[35], *w_pq = in[36], *sub_keys = in[37], *expert_u = in[38], *expert_v = in[39], *norm_final_w = in[40];
    (void)mem_prompt; (void)w_in; (void)w_out; (void)mem_norm_w; (void)w_mk; (void)w_mv; (void)w_mq; (void)w_mo; (void)w_pq; (void)norm_mix_w; (void)x_prompt; (void)x_sample;
    float* o = (float*)d_out;
    float *y_prompt = o + OO_YP, *y_sample = o + OO_YS, *ssm_p = o + OO_SSMP, *conv_p = o + OO_CONVP, *wkv_p = o + OO_WKVP, *shift_p = o + OO_SHP, *memk_p = o + OO_MKP, *memv_p = o + OO_MVP;
    float *ssm_s = o + OO_SSMS, *conv_s = o + OO_CONVS, *wkv_s = o + OO_WKVS, *shift_s = o + OO_SHS;
    unsigned char* ws = (unsigned char*)d_ws;
    if (O_END > ws_size || (size_t)out_size != OO_END || n_in != N_INPUTS) { fprintf(stderr, "kernel_launch: workspace %zu (need %zu), out %d (need %zu), n_in %d\n", ws_size, (size_t)O_END, out_size, (size_t)OO_END, n_in); return; }
    bf16_t *WT_out = (bf16_t*)(ws + O_WT_OUT), *WT_mq = (bf16_t*)(ws + O_WT_MQ), *WT_mo = (bf16_t*)(ws + O_WT_MO), *WT_pq = (bf16_t*)(ws + O_WT_PQ);
    bf16_t *PZ = (bf16_t*)(ws + O_PZ), *PXBC = (bf16_t*)(ws + O_PXBC), *PRW = (bf16_t*)(ws + O_PRW), *PGATE = (bf16_t*)(ws + O_PGATE); float* DT = (float*)(ws + O_DT);
    bf16_t* XC = (bf16_t*)(ws + O_XC);
    f16_t *R16 = (f16_t*)(ws + O_R16), *OMW16 = (f16_t*)(ws + O_OMW16), *K16 = (f16_t*)(ws + O_K16), *V16 = (f16_t*)(ws + O_V16), *KK16 = (f16_t*)(ws + O_KK16), *B16 = (f16_t*)(ws + O_B16);
    bf16_t* YR = (bf16_t*)y_prompt;
    bf16_t *Gb = (bf16_t*)(ws + O_GB), *YS = (bf16_t*)(ws + O_YS), *MERGED = (bf16_t*)(ws + O_MERGED); float* X1 = (float*)(ws + O_X1);
    bf16_t *H2 = (bf16_t*)(ws + O_H2), *Qb = (bf16_t*)(ws + O_QB), *AO = (bf16_t*)(ws + O_AO);
    float* SC = (float*)(ws + O_SC); float* X2 = (float*)(ws + O_X2); bf16_t *H3 = (bf16_t*)(ws + O_H3), *PQ = (bf16_t*)(ws + O_PQ);
    int* IDX = (int*)(ws + O_IDX); float *GATE = (float*)(ws + O_GATE), *COEF = (float*)(ws + O_COEF); float* TS = (float*)(ws + O_TS); int* TI = (int*)(ws + O_TI); float* SCP = (float*)(ws + O_SCP);

#ifndef HOST_EMU
    static int grid = 0;
    if (grid == 0) {
        int dev = 0, cus = 0, per_cu = 0;
        if (hipGetDevice(&dev) != hipSuccess || hipDeviceGetAttribute(&cus, hipDeviceAttributeMultiprocessorCount, dev) != hipSuccess) { fprintf(stderr, "kernel_launch: device query failed\n"); grid = -1; return; }
        if (hipFuncSetAttribute((const void*)mk_fwd, hipFuncAttributeMaxDynamicSharedMemorySize, LDS_BYTES) != hipSuccess) { fprintf(stderr, "kernel_launch: hipFuncSetAttribute failed\n"); grid = -1; return; }
        if (hipOccupancyMaxActiveBlocksPerMultiprocessor(&per_cu, (const void*)mk_fwd, NTHREADS, LDS_BYTES) != hipSuccess || per_cu < 1) { fprintf(stderr, "kernel_launch: occupancy query says %d blocks per CU\n", per_cu); (void)hipGetLastError(); grid = -1; return; }
        grid = cus;
    }
    if (grid < 0) return;
    (void)hipMemsetAsync(ws + O_CTL, 0, CTL_BYTES, stream);
    MkArgs a{};
    for (int i = 0; i < N_INPUTS; ++i) a.in[i] = (const float*)d_in[i];
    a.out = (float*)d_out; a.ws = ws; a.ph_lo = 0; a.ph_hi = N_PHASES; a.bar_idx = 0; a.dup = 0;
    hipLaunchKernelGGL(mk_fwd, dim3(grid), dim3(NTHREADS), LDS_BYTES, stream, a);
    return;
#define MK(lo_, hi_) do { } while (0)
#else
#define MK(lo_, hi_) do { } while (0)
    { bf16_t *WT_in = (bf16_t*)(ws + O_WT_IN), *WT_dt = (bf16_t*)(ws + O_WT_DT), *WT_mk = (bf16_t*)(ws + O_WT_MK), *WT_mv = (bf16_t*)(ws + O_WT_MV), *Hb = (bf16_t*)(ws + O_HB), *MN = (bf16_t*)(ws + O_MN);
    launch(k_wt, (size_t)NMAIN * D, stream, w_in, D, D_IN, 0, D + CONV_DIM, H_SSD, WT_in, NMAIN);
    launch(k_wt, (size_t)H_SSD * D, stream, w_in, D, D_IN, D + CONV_DIM, 1 << 30, 0, WT_dt, H_SSD);
    launch(k_wt, (size_t)D * D, stream, w_out, D, D, 0, 1 << 30, 0, WT_out, D);
    launch(k_wt, (size_t)D * D, stream, w_mk, D, D, 0, 1 << 30, 0, WT_mk, D);
    launch(k_wt, (size_t)D * D, stream, w_mv, D, D, 0, 1 << 30, 0, WT_mv, D);
    launch(k_wt, (size_t)D * D, stream, w_mq, D, D, 0, 1 << 30, 0, WT_mq, D);
    launch(k_wt, (size_t)D * D, stream, w_mo, D, D, 0, 1 << 30, 0, WT_mo, D);
    launch(k_wt, (size_t)NPQ * D, stream, w_pq, D, NPQ, 0, 1 << 30, 0, WT_pq, NPQ);
    launch(k_rmsnorm_bf16, (size_t)MP, stream, x_prompt, norm_mix_w, Hb, MP);
    launch(k_rmsnorm_bf16, (size_t)MS, stream, x_sample, norm_mix_w, Hb + (size_t)MP * D, MS);
    launch(k_rmsnorm_bf16, (size_t)NMEMROWS, stream, mem_prompt, mem_norm_w, MN, NMEMROWS);
    launch(k_gemm, (size_t)MT * D, stream, Hb, D, WT_in, D, MT, D, 0, PZ, D, (float*)nullptr, 0, (const float*)nullptr, 0);
    launch(k_gemm, (size_t)MT * CONV_DIM, stream, Hb, D, WT_in + (size_t)D * D, D, MT, CONV_DIM, 0, PXBC, CONV_DIM, (float*)nullptr, 0, (const float*)nullptr, 0);
    launch(k_gemm, (size_t)MT * RWKV_PROJ, stream, Hb, D, WT_in + (size_t)(D + CONV_DIM) * D, D, MT, RWKV_PROJ, 0, PRW, RWKV_PROJ, (float*)nullptr, 0, (const float*)nullptr, 0);
    launch(k_gemm, (size_t)MT * 2 * D, stream, Hb, D, WT_in + (size_t)(D + CONV_DIM + RWKV_PROJ) * D, D, MT, 2 * D, 0, PGATE, 2 * D, (float*)nullptr, 0, (const float*)nullptr, 0);
    launch(k_gemm, (size_t)MT * H_SSD, stream, Hb, D, WT_dt, D, MT, H_SSD, 1, (bf16_t*)nullptr, 0, DT, H_SSD, (const float*)nullptr, 0);
    launch(k_gemm, (size_t)NMEMROWS * D, stream, MN, D, WT_mk, D, NMEMROWS, D, 1, (bf16_t*)nullptr, 0, memk_p, D, (const float*)nullptr, 0);
    launch(k_gemm, (size_t)NMEMROWS * D, stream, MN, D, WT_mv, D, NMEMROWS, D, 1, (bf16_t*)nullptr, 0, memv_p, D, (const float*)nullptr, 0); }
#endif
    launch(k_conv, (size_t)MT * CONV_DIM, stream, PXBC, state_conv, conv_w, conv_b, XC);
    launch(k_convstate, (size_t)(BATCH + DEC_BATCH) * (CONV_K - 1) * CONV_DIM, stream, PXBC, state_conv, conv_p, conv_s);
    RwkvW rw{rwkv_mu, rwkv_w0, rwkv_w2, rwkv_a0, rwkv_a2, rwkv_g2, rwkv_k_k, rwkv_k_a};
    launch(k_rwkv_prep, (size_t)MT * D, stream, PRW, state_shift, rw, R16, OMW16, K16, V16, KK16, B16, Gb);
    launch(k_shiftstate, (size_t)(BATCH + DEC_BATCH) * RWKV_PROJ, stream, PRW, shift_p, shift_s);
    launch(k_copy_or_zero, (size_t)BATCH * H_SSD * P_SSD * N_SSD, stream, (const float*)nullptr, ssm_p, (size_t)BATCH * H_SSD * P_SSD * N_SSD);
    launch(k_copy_or_zero, (size_t)DEC_BATCH * H_SSD * P_SSD * N_SSD, stream, state_ssm, ssm_s, (size_t)DEC_BATCH * H_SSD * P_SSD * N_SSD);
    launch(k_ssd, (size_t)(BATCH + DEC_BATCH) * H_SSD * P_SSD, stream, XC, DT, dt_bias, a_log, d_skip, ssm_p, ssm_s, YS);
    launch(k_copy_or_zero, (size_t)BATCH * H_RWKV * HK * HK, stream, (const float*)nullptr, wkv_p, (size_t)BATCH * H_RWKV * HK * HK);
    launch(k_copy_or_zero, (size_t)DEC_BATCH * H_RWKV * HK * HK, stream, state_wkv, wkv_s, (size_t)DEC_BATCH * H_RWKV * HK * HK);
    launch(k_rwkv_scan, (size_t)(BATCH + DEC_BATCH) * H_RWKV * HK, stream, R16, OMW16, K16, V16, KK16, B16, wkv_p, wkv_s, YR);
    MergeW mw{ssd_norm_w, rwkv_r_k, rwkv_ln_w, rwkv_ln_b};
    launch(k_merge, (size_t)MT, stream, YS, YR, PZ, PGATE, Gb, R16, K16, V16, mw, MERGED);
#ifdef HOST_EMU
    launch(k_gemm, (size_t)MP * D, stream, MERGED, D, WT_out, D, MP, D, 2, (bf16_t*)nullptr, 0, X1, D, x_prompt, D);
    launch(k_gemm, (size_t)MS * D, stream, MERGED + (size_t)MP * D, D, WT_out, D, MS, D, 2, (bf16_t*)nullptr, 0, X1 + (size_t)MP * D, D, x_sample, D);
    launch(k_rmsnorm_f2b, (size_t)MT, stream, X1, norm_mem_w, H2, MT);
    launch(k_gemm, (size_t)MT * D, stream, H2, D, WT_mq, D, MT, D, 0, Qb, D, (float*)nullptr, 0, (const float*)nullptr, 0);
#else
    launch(k_zero_u16, (size_t)(MPAD - MT) * D, stream, MERGED + (size_t)MT * D, (size_t)(MPAD - MT) * D);
    MK(PH_OUT, PH_Q + 1);
#endif
    launch(k_attn_scores, (size_t)MT * MEM_HEADS * N_MEM, stream, Qb, memk_p, cache_k, SC);
    launch(k_attn_softmax, (size_t)MT * MEM_HEADS, stream, SC);
    launch(k_attn_av, (size_t)MT * D, stream, SC, memv_p, cache_v, AO);
#ifdef HOST_EMU
    launch(k_gemm, (size_t)MT * D, stream, AO, D, WT_mo, D, MT, D, 2, (bf16_t*)nullptr, 0, X2, D, X1, D);
    launch(k_rmsnorm_f2b, (size_t)MT, stream, X2, norm_ffn_w, H3, MT);
    launch(k_gemm, (size_t)MT * NPQ, stream, H3, D, WT_pq, D, MT, NPQ, 0, PQ, NPQ, (float*)nullptr, 0, (const float*)nullptr, 0);
#else
    launch(k_zero_u16, (size_t)(MPAD - MT) * D, stream, AO + (size_t)MT * D, (size_t)(MPAD - MT) * D);
    MK(PH_O, PH_PQ + 1);
#endif
    launch(k_peer_scores, (size_t)MT * PEER_HEADS * 2 * N_KEYS, stream, PQ, sub_keys, SCP);
    launch(k_peer_topk, (size_t)MT * PEER_HEADS, stream, SCP, TS, TI, IDX, GATE);
    launch(k_peer_act, (size_t)MT * NSEL, stream, H3, expert_u, IDX, GATE, COEF);
    launch(k_peer_out, (size_t)MT * D, stream, X2, expert_v, IDX, COEF);
    launch(k_final, (size_t)MT, stream, X2, norm_final_w, y_prompt, y_sample);
}
```

```cpp
#define PACK_ASM 1
#ifdef HOST_EMU
#include <cmath>
#include <cstring>
#include <cstdint>
#include <cstdio>
#include <cstddef>
typedef void* hipStream_t;
#define __global__
#define __device__
#define __host__
#define __forceinline__ inline
static thread_local size_t g_tid;
#define GTID g_tid
template <class F, class... A> static void launch(F f, size_t n, hipStream_t, A... a) {
#pragma omp parallel for schedule(static)
    for (long long i = 0; i < (long long)n; ++i) { g_tid = (size_t)i; f(a...); }
}
#else
#include <hip/hip_runtime.h>
#include <cstdint>
#include <cstdio>
#define GTID ((size_t)blockIdx.x * blockDim.x + threadIdx.x)
template <class F, class... A> static void launch(F f, size_t n, hipStream_t s, A... a) {
    if (n == 0) return;
    hipLaunchKernelGGL(f, dim3((unsigned)((n + 255) / 256)), dim3(256), 0, s, a...);
}
#endif

#ifndef D_MODEL
#define D_MODEL 1024
#define BATCH 8
#define SEQ 2048
#define DEC_BATCH 128
#define SSD_HEADDIM 64
#define SSD_GROUPS 2
#define SSD_STATE 128
#define HD_RWKV 64
#define W_RANK 64
#define A_RANK 64
#define G_RANK 128
#define N_MEM 256
#define MEM_HEADS 4
#define N_KEYS 128
#define PEER_HEADS 8
#define PEER_DKEY 256
#define PEER_TOPK 16
#endif
#define CONV_K 4
constexpr int D = D_MODEL;
constexpr int H_SSD = D / SSD_HEADDIM, P_SSD = SSD_HEADDIM, N_SSD = SSD_STATE, G_SSD = SSD_GROUPS;
constexpr int CONV_DIM = D + 2 * G_SSD * N_SSD;
constexpr int H_RWKV = D / HD_RWKV, HK = HD_RWKV;
constexpr int RWKV_PROJ = 3 * D + W_RANK + A_RANK + G_RANK;
constexpr int D_IN = D + CONV_DIM + H_SSD + RWKV_PROJ + 2 * D;
constexpr int MEM_HD = D / MEM_HEADS;
constexpr int N_EXPERTS = N_KEYS * N_KEYS, PEER_HALF = PEER_DKEY / 2, NPQ = PEER_HEADS * PEER_DKEY, NSEL = PEER_HEADS * PEER_TOPK;
constexpr int MP = BATCH * SEQ, MS = DEC_BATCH, MT = MP + MS, MPAD = (MT + 255) / 256 * 256, NMEMROWS = BATCH * N_MEM;
constexpr float NORM_EPS = 1e-6f, RWKV_LN_EPS = 64e-5f;
constexpr int NMAIN = D_IN - H_SSD;

typedef unsigned short bf16_t;
typedef _Float16 f16_t;
__host__ __device__ __forceinline__ float bf2f(bf16_t v) { unsigned u = (unsigned)v << 16; float f; memcpy(&f, &u, 4); return f; }
__host__ __device__ __forceinline__ bf16_t f2bf(float f) { unsigned u; memcpy(&u, &f, 4); u = (u + 0x7fffu + ((u >> 16) & 1u)) >> 16; return (bf16_t)u; }
__host__ __device__ __forceinline__ float siluf(float x) { return x / (1.f + expf(-x)); }
__host__ __device__ __forceinline__ float sigmoidf(float x) { return 1.f / (1.f + expf(-x)); }
__host__ __device__ __forceinline__ float softplusf(float x) { return x > 20.f ? x : log1pf(expf(x)); }
__host__ __device__ __forceinline__ float geluf(float x) { return 0.5f * x * (1.f + erff(x * 0.70710678118654752f)); }

struct RowInfo { int grp, b, t; };
__host__ __device__ __forceinline__ RowInfo rowinfo(int r) { RowInfo q; if (r < MP) { q.grp = 0; q.b = r / SEQ; q.t = r % SEQ; } else { q.grp = 1; q.b = r - MP; q.t = 0; } return q; }

__device__ __forceinline__ void b_zero_u16(size_t i, bf16_t* p, size_t n) {  if (i < n) p[i] = 0; }
__device__ __forceinline__ void b_rmsnorm_bf16(size_t i, const float* x, const float* w, bf16_t* out, int nrows) {
     if (i >= (size_t)nrows) return;
    const float* xr = x + i * D; float ss = 0.f;
    for (int c = 0; c < D; ++c) ss += xr[c] * xr[c];
    const float rs = 1.f / sqrtf(ss / D + NORM_EPS);
    for (int c = 0; c < D; ++c) out[i * D + c] = f2bf(xr[c] * rs * w[c]);
}
__device__ __forceinline__ void b_wt(size_t i, const float* W, int K, int ldw, int ncol0, int skip_at, int skip, bf16_t* WT, int N) {
     if (i >= (size_t)N * K) return;
    const int n = (int)(i / K), k = (int)(i % K); const int sc = ncol0 + n + (n >= skip_at ? skip : 0);
    WT[i] = f2bf(W[(size_t)k * ldw + sc]);
}
struct __attribute__((aligned(16))) V8 { bf16_t v[8]; };
__device__ __forceinline__ void b_gemm(size_t i, const bf16_t* A, int lda, const bf16_t* Bt, int K, int M, int N, int mode, bf16_t* ob, int ldob, float* of, int ldof, const float* base, int ldbase) {
     if (i >= (size_t)M * N) return;
    const int m = (int)(i / N), n = (int)(i % N);
    const bf16_t* a = A + (size_t)m * lda; const bf16_t* b = Bt + (size_t)n * K; float acc = 0.f;
    for (int k = 0; k < K; k += 8) { V8 va, vb; memcpy(&va, a + k, 16); memcpy(&vb, b + k, 16);
        for (int j = 0; j < 8; ++j) acc += bf2f(va.v[j]) * bf2f(vb.v[j]); }
    if (mode == 0) ob[(size_t)m * ldob + n] = f2bf(acc);
    else if (mode == 1) { of[(size_t)m * ldof + n] = acc; if (ob) ob[(size_t)m * ldob + n] = f2bf(acc); }
    else of[(size_t)m * ldof + n] = base[(size_t)m * ldbase + n] + acc;
}
__device__ __forceinline__ void b_conv(size_t i, const bf16_t* PXBC, const float* state_conv, const float* conv_w, const float* conv_b, bf16_t* XC) {
     if (i >= (size_t)MT * CONV_DIM) return;
    const int r = (int)(i / CONV_DIM), ch = (int)(i % CONV_DIM); const RowInfo q = rowinfo(r);
    float acc = conv_b[ch];
    for (int j = 0; j < CONV_K; ++j) { const int tp = q.t - (CONV_K - 1) + j; float v;
        if (tp >= 0) v = bf2f(PXBC[(size_t)(r - (q.t - tp)) * CONV_DIM + ch]);
        else v = q.grp ? state_conv[((size_t)q.b * (CONV_K - 1) + (CONV_K - 1 + tp)) * CONV_DIM + ch] : 0.f;
        acc += v * conv_w[j * CONV_DIM + ch]; }
    XC[i] = f2bf(siluf(acc));
}
__device__ __forceinline__ void b_convstate(size_t i, const bf16_t* PXBC, const float* state_conv, float* conv_p, float* conv_s) {
     const size_t np = (size_t)BATCH * (CONV_K - 1) * CONV_DIM, ns = (size_t)DEC_BATCH * (CONV_K - 1) * CONV_DIM; if (i >= np + ns) return;
    if (i < np) { const int ch = (int)(i % CONV_DIM), j = (int)((i / CONV_DIM) % (CONV_K - 1)), b = (int)(i / ((CONV_K - 1) * CONV_DIM));
        const int t = SEQ - (CONV_K - 1) + j; conv_p[i] = t >= 0 ? bf2f(PXBC[((size_t)b * SEQ + t) * CONV_DIM + ch]) : 0.f; }
    else { const size_t k = i - np; const int ch = (int)(k % CONV_DIM), j = (int)((k / CONV_DIM) % (CONV_K - 1)), b = (int)(k / ((CONV_K - 1) * CONV_DIM));
        conv_s[k] = (j + 1 < CONV_K - 1) ? state_conv[((size_t)b * (CONV_K - 1) + j + 1) * CONV_DIM + ch] : bf2f(PXBC[((size_t)MP + b) * CONV_DIM + ch]); }
}
__device__ __forceinline__ void b_copy_or_zero(size_t i, const float* src, float* dst, size_t n) {  if (i < n) dst[i] = src ? src[i] : 0.f; }
__device__ __forceinline__ void b_ssd(size_t i, const bf16_t* XC, const float* DT, const float* dt_bias, const float* a_log, const float* d_skip, float* Sp, float* Ss, bf16_t* YS) {
     const size_t np = (size_t)BATCH * H_SSD * P_SSD, ns = (size_t)DEC_BATCH * H_SSD * P_SSD; if (i >= np + ns) return;
    const int grp = i >= np; const size_t k = grp ? i - np : i; const int p = (int)(k % P_SSD), h = (int)((k / P_SSD) % H_SSD), b = (int)(k / (P_SSD * H_SSD));
    float* S = (grp ? Ss : Sp) + k * N_SSD; const int L = grp ? 1 : SEQ; const int g = h / (H_SSD / G_SSD);
    const float ah = -expf(a_log[h]), db = dt_bias[h], dsk = d_skip[h];
    for (int t = 0; t < L; ++t) { const size_t r = grp ? (size_t)MP + b : (size_t)b * SEQ + t;
        const float dt = softplusf(DT[r * H_SSD + h] + db), dA = expf(dt * ah), x = bf2f(XC[r * CONV_DIM + h * P_SSD + p]);
        const bf16_t* Bv = XC + r * CONV_DIM + D + g * N_SSD; const bf16_t* Cv = XC + r * CONV_DIM + D + G_SSD * N_SSD + g * N_SSD;
        float y = 0.f;
        for (int n = 0; n < N_SSD; ++n) { const float s = S[n] * dA + dt * x * bf2f(Bv[n]); S[n] = s; y += bf2f(Cv[n]) * s; }
        YS[r * D + h * P_SSD + p] = f2bf(y + dsk * x); }
}
__device__ __forceinline__ float rws_at(const bf16_t* PRW, const float* state_shift, const float* mu, int r, int c) {
    const RowInfo q = rowinfo(r); const float cur = bf2f(PRW[(size_t)r * RWKV_PROJ + c]);
    const float prev = q.t > 0 ? bf2f(PRW[(size_t)(r - 1) * RWKV_PROJ + c]) : (q.grp ? state_shift[(size_t)q.b * RWKV_PROJ + c] : 0.f);
    return cur + (prev - cur) * mu[c];
}
struct RwkvW { const float *mu, *w0, *w2, *a0, *a2, *g2, *k_k, *k_a; };
__device__ __forceinline__ void b_rwkv_prep(size_t i, const bf16_t* PRW, const float* state_shift, RwkvW W, f16_t* R16, f16_t* OMW16, f16_t* K16, f16_t* V16, f16_t* KK16, f16_t* B16, bf16_t* Gb) {
     if (i >= (size_t)MT * D) return;
    const int r = (int)(i / D), ch = (int)(i % D), h0 = ch / HK * HK;
    float dw = 0.f, da = 0.f, dg = 0.f;
    for (int j = 0; j < W_RANK; ++j) dw += tanhf(rws_at(PRW, state_shift, W.mu, r, 3 * D + j)) * W.w2[j * D + ch];
    for (int j = 0; j < A_RANK; ++j) da += rws_at(PRW, state_shift, W.mu, r, 3 * D + W_RANK + j) * W.a2[j * D + ch];
    for (int j = 0; j < G_RANK; ++j) dg += sigmoidf(rws_at(PRW, state_shift, W.mu, r, 3 * D + W_RANK + A_RANK + j)) * W.g2[j * D + ch];
    const float wlog = -softplusf(-(W.w0[ch] + dw)) - 0.5f, e = expf(wlog), omw = -expm1f(-e);
    const float ag = sigmoidf(W.a0[ch] + da);
    const float kv = rws_at(PRW, state_shift, W.mu, r, D + ch);
    float ss = 0.f;
    for (int c = h0; c < h0 + HK; ++c) { const float q = rws_at(PRW, state_shift, W.mu, r, D + c) * W.k_k[c]; ss += q * q; }
    const float kk = kv * W.k_k[ch] / sqrtf(fmaxf(ss, 1e-24f));
    R16[i] = (f16_t)rws_at(PRW, state_shift, W.mu, r, ch); OMW16[i] = (f16_t)omw; K16[i] = (f16_t)(kv * (1.f + (ag - 1.f) * W.k_a[ch]));
    V16[i] = (f16_t)rws_at(PRW, state_shift, W.mu, r, 2 * D + ch); KK16[i] = (f16_t)kk; B16[i] = (f16_t)(kk * ag); Gb[i] = f2bf(dg);
}
__device__ __forceinline__ void b_shiftstate(size_t i, const bf16_t* PRW, float* sh_p, float* sh_s) {
     const size_t np = (size_t)BATCH * RWKV_PROJ, ns = (size_t)DEC_BATCH * RWKV_PROJ; if (i >= np + ns) return;
    if (i < np) { const int c = (int)(i % RWKV_PROJ), b = (int)(i / RWKV_PROJ); sh_p[i] = bf2f(PRW[((size_t)b * SEQ + SEQ - 1) * RWKV_PROJ + c]); }
    else { const size_t k = i - np; const int c = (int)(k % RWKV_PROJ), b = (int)(k / RWKV_PROJ); sh_s[k] = bf2f(PRW[((size_t)MP + b) * RWKV_PROJ + c]); }
}
__device__ __forceinline__ void b_rwkv_scan(size_t i, const f16_t* R16, const f16_t* OMW16, const f16_t* K16, const f16_t* V16, const f16_t* KK16, const f16_t* B16, float* Sp, float* Ss, bf16_t* YR) {
     const size_t np = (size_t)BATCH * H_RWKV * HK, ns = (size_t)DEC_BATCH * H_RWKV * HK; if (i >= np + ns) return;
    const int grp = i >= np; const size_t k0 = grp ? i - np : i; const int v = (int)(k0 % HK), h = (int)((k0 / HK) % H_RWKV), b = (int)(k0 / (HK * H_RWKV));
    float* S = (grp ? Ss : Sp) + k0 * HK; const int L = grp ? 1 : SEQ;
    for (int t = 0; t < L; ++t) { const size_t r = grp ? (size_t)MP + b : (size_t)b * SEQ + t; const size_t o = r * D + h * HK;
        float sa = 0.f; for (int k = 0; k < HK; ++k) sa += S[k] * (float)KK16[o + k];
        const float vv = (float)V16[o + v]; float y = 0.f;
        for (int k = 0; k < HK; ++k) { float s = S[k]; s = s - s * (float)OMW16[o + k]; s = s - sa * (float)B16[o + k]; s = s + vv * (float)K16[o + k]; S[k] = s; y += s * (float)R16[o + k]; }
        YR[o + v] = f2bf(y); }
}
struct MergeW { const float *ssd_norm_w, *r_k, *ln_w, *ln_b; };
__device__ __forceinline__ void b_merge(size_t i, const bf16_t* YS, const bf16_t* YR, const bf16_t* PZ, const bf16_t* PGATE, const bf16_t* Gb, const f16_t* R16, const f16_t* K16, const f16_t* V16, MergeW W, bf16_t* MERGED) {
     if (i >= (size_t)MT) return; const size_t o = i * D;
    float ss = 0.f; for (int c = 0; c < D; ++c) { const float q = bf2f(YS[o + c]) * siluf(bf2f(PZ[o + c])); ss += q * q; }
    const float rs = 1.f / sqrtf(ss / D + NORM_EPS);
    for (int h = 0; h < H_RWKV; ++h) { float m = 0.f, bonus = 0.f;
        for (int k = 0; k < HK; ++k) { const int c = h * HK + k; m += bf2f(YR[o + c]); bonus += (float)R16[o + c] * (float)K16[o + c] * W.r_k[c]; }
        m /= HK; float var = 0.f; for (int k = 0; k < HK; ++k) { const float d = bf2f(YR[o + h * HK + k]) - m; var += d * d; } var /= HK;
        const float rstd = 1.f / sqrtf(var + RWKV_LN_EPS);
        for (int k = 0; k < HK; ++k) { const int c = h * HK + k;
            const float yssd = bf2f(YS[o + c]) * siluf(bf2f(PZ[o + c])) * rs * W.ssd_norm_w[c];
            const float yrn = (bf2f(YR[o + c]) - m) * rstd * W.ln_w[c] + W.ln_b[c];
            const float yrw = (yrn + bonus * (float)V16[o + c]) * bf2f(Gb[o + c]);
            MERGED[o + c] = f2bf(sigmoidf(bf2f(PGATE[i * 2 * D + c])) * yssd + sigmoidf(bf2f(PGATE[i * 2 * D + D + c])) * yrw); } }
}
__device__ __forceinline__ void b_rmsnorm_f2b(size_t i, const float* X, const float* w, bf16_t* out, int nrows) {  if (i >= (size_t)nrows) return;
    const float* xr = X + i * D; float ss = 0.f; for (int c = 0; c < D; ++c) ss += xr[c] * xr[c]; const float rs = 1.f / sqrtf(ss / D + NORM_EPS);
    for (int c = 0; c < D; ++c) out[i * D + c] = f2bf(xr[c] * rs * w[c]); }
__device__ __forceinline__ void b_attn_scores(size_t i, const bf16_t* Q, const float* kp, const float* kc, float* SC) {
     if (i >= (size_t)MT * MEM_HEADS * N_MEM) return;
    const int m = (int)(i % N_MEM), h = (int)((i / N_MEM) % MEM_HEADS), r = (int)(i / (N_MEM * MEM_HEADS)); const RowInfo q = rowinfo(r);
    const float* kr = (q.grp ? kc : kp) + ((size_t)q.b * N_MEM + m) * D + h * MEM_HD; const bf16_t* qr = Q + (size_t)r * D + h * MEM_HD; float acc = 0.f;
    for (int d = 0; d < MEM_HD; ++d) acc += bf2f(qr[d]) * kr[d];
    SC[i] = acc / sqrtf((float)MEM_HD);
}
__device__ __forceinline__ void b_attn_softmax(size_t i, float* SC) {  if (i >= (size_t)MT * MEM_HEADS) return; float* s = SC + i * N_MEM;
    float mx = s[0]; for (int m = 1; m < N_MEM; ++m) mx = fmaxf(mx, s[m]); float sum = 0.f; for (int m = 0; m < N_MEM; ++m) { const float e = expf(s[m] - mx); s[m] = e; sum += e; }
    const float inv = 1.f / sum; for (int m = 0; m < N_MEM; ++m) s[m] *= inv; }
__device__ __forceinline__ void b_attn_av(size_t i, const float* SC, const float* vp, const float* vc, bf16_t* AO) {
     if (i >= (size_t)MT * D) return; const int c = (int)(i % D), r = (int)(i / D), h = c / MEM_HD; const RowInfo q = rowinfo(r);
    const float* vb = (q.grp ? vc : vp) + (size_t)q.b * N_MEM * D + c; const float* s = SC + ((size_t)r * MEM_HEADS + h) * N_MEM; float acc = 0.f;
    for (int m = 0; m < N_MEM; ++m) acc += s[m] * vb[(size_t)m * D];
    AO[i] = f2bf(acc);
}
__device__ __forceinline__ void b_peer_scores(size_t i, const bf16_t* PQ, const float* sub_keys, float* SCP) {
     if (i >= (size_t)MT * PEER_HEADS * 2 * N_KEYS) return;
    const int key = (int)(i % N_KEYS), c = (int)((i / N_KEYS) % 2), h = (int)((i / (2 * N_KEYS)) % PEER_HEADS), r = (int)(i / ((size_t)2 * N_KEYS * PEER_HEADS));
    const bf16_t* q = PQ + (size_t)r * NPQ + h * PEER_DKEY + c * PEER_HALF; const float* kk = sub_keys + (((size_t)h * 2 + c) * N_KEYS + key) * PEER_HALF; float acc = 0.f;
    for (int d = 0; d < PEER_HALF; ++d) acc += bf2f(q[d]) * kk[d];
    SCP[i] = acc;
}
__device__ __forceinline__ void b_peer_topk(size_t i, const float* SCP, float* TS, int* TI, int* IDX, float* GATE) {
     if (i >= (size_t)MT * PEER_HEADS) return;
    float* ts = TS + i * 2 * PEER_TOPK; int* ti = TI + i * 2 * PEER_TOPK;
    for (int c = 0; c < 2; ++c) { const float* s = SCP + (i * 2 + c) * N_KEYS; float pv = INFINITY; int pi = -1;
        for (int j = 0; j < PEER_TOPK; ++j) { float bv = -INFINITY; int bi = -1;
            for (int k = 0; k < N_KEYS; ++k) { const float v = s[k]; const bool after = (v < pv) || (v == pv && k > pi); if (after && (v > bv)) { bv = v; bi = k; } }
            ts[c * PEER_TOPK + j] = bv; ti[c * PEER_TOPK + j] = bi; pv = bv; pi = bi; } }
    float pv = INFINITY; int pi = -1; float* g = GATE + i * PEER_TOPK; int* id = IDX + i * PEER_TOPK;
    for (int j = 0; j < PEER_TOPK; ++j) { float bv = -INFINITY; int bi = -1;
        for (int k = 0; k < PEER_TOPK * PEER_TOPK; ++k) { const float v = ts[k / PEER_TOPK] + ts[PEER_TOPK + k % PEER_TOPK]; const bool after = (v < pv) || (v == pv && k > pi); if (after && (v > bv)) { bv = v; bi = k; } }
        g[j] = bv; id[j] = ti[bi / PEER_TOPK] * N_KEYS + ti[PEER_TOPK + bi % PEER_TOPK]; pv = bv; pi = bi; }
    const float mx = g[0]; float sum = 0.f; for (int j = 0; j < PEER_TOPK; ++j) { const float e = expf(g[j] - mx); g[j] = e; sum += e; }
    for (int j = 0; j < PEER_TOPK; ++j) g[j] /= sum;
}
__device__ __forceinline__ void b_peer_act(size_t i, const bf16_t* H3, const float* eu, const int* IDX, const float* GATE, float* COEF) {
     if (i >= (size_t)MT * NSEL) return; const int r = (int)(i / NSEL);
    const float* u = eu + (size_t)IDX[i] * D; const bf16_t* x = H3 + (size_t)r * D; float acc = 0.f;
    for (int d = 0; d < D; ++d) acc += bf2f(x[d]) * u[d];
    COEF[i] = GATE[i] * geluf(acc);
}
__device__ __forceinline__ void b_peer_out(size_t i, float* X2, const float* ev, const int* IDX, const float* COEF) {
     if (i >= (size_t)MT * D) return; const int r = (int)(i / D), c = (int)(i % D); float acc = 0.f;
    for (int j = 0; j < NSEL; ++j) acc += COEF[(size_t)r * NSEL + j] * ev[(size_t)IDX[(size_t)r * NSEL + j] * D + c];
    X2[i] += acc;
}
__device__ __forceinline__ void b_final(size_t i, const float* X, const float* w, float* yp, float* ys) {  if (i >= (size_t)MT) return;
    const float* xr = X + i * D; float ss = 0.f; for (int c = 0; c < D; ++c) ss += xr[c] * xr[c]; const float rs = 1.f / sqrtf(ss / D + NORM_EPS);
    float* o = i < (size_t)MP ? yp + i * D : ys + (i - MP) * D; for (int c = 0; c < D; ++c) o[c] = xr[c] * rs * w[c]; }


__global__ void k_zero_u16(bf16_t* p, size_t n) { b_zero_u16(GTID, p, n); }
__global__ void k_rmsnorm_bf16(const float* x, const float* w, bf16_t* out, int nrows) { b_rmsnorm_bf16(GTID, x, w, out, nrows); }
__global__ void k_wt(const float* W, int K, int ldw, int ncol0, int skip_at, int skip, bf16_t* WT, int N) { b_wt(GTID, W, K, ldw, ncol0, skip_at, skip, WT, N); }
__global__ void k_gemm(const bf16_t* A, int lda, const bf16_t* Bt, int K, int M, int N, int mode, bf16_t* ob, int ldob, float* of, int ldof, const float* base, int ldbase) { b_gemm(GTID, A, lda, Bt, K, M, N, mode, ob, ldob, of, ldof, base, ldbase); }
__global__ void k_conv(const bf16_t* PXBC, const float* state_conv, const float* conv_w, const float* conv_b, bf16_t* XC) { b_conv(GTID, PXBC, state_conv, conv_w, conv_b, XC); }
__global__ void k_convstate(const bf16_t* PXBC, const float* state_conv, float* conv_p, float* conv_s) { b_convstate(GTID, PXBC, state_conv, conv_p, conv_s); }
__global__ void k_copy_or_zero(const float* src, float* dst, size_t n) { b_copy_or_zero(GTID, src, dst, n); }
__global__ void k_ssd(const bf16_t* XC, const float* DT, const float* dt_bias, const float* a_log, const float* d_skip, float* Sp, float* Ss, bf16_t* YS) { b_ssd(GTID, XC, DT, dt_bias, a_log, d_skip, Sp, Ss, YS); }
__global__ void k_rwkv_prep(const bf16_t* PRW, const float* state_shift, RwkvW W, f16_t* R16, f16_t* OMW16, f16_t* K16, f16_t* V16, f16_t* KK16, f16_t* B16, bf16_t* Gb) { b_rwkv_prep(GTID, PRW, state_shift, W, R16, OMW16, K16, V16, KK16, B16, Gb); }
__global__ void k_shiftstate(const bf16_t* PRW, float* sh_p, float* sh_s) { b_shiftstate(GTID, PRW, sh_p, sh_s); }
__global__ void k_rwkv_scan(const f16_t* R16, const f16_t* OMW16, const f16_t* K16, const f16_t* V16, const f16_t* KK16, const f16_t* B16, float* Sp, float* Ss, bf16_t* YR) { b_rwkv_scan(GTID, R16, OMW16, K16, V16, KK16, B16, Sp, Ss, YR); }
__global__ void k_merge(const bf16_t* YS, const bf16_t* YR, const bf16_t* PZ, const bf16_t* PGATE, const bf16_t* Gb, const f16_t* R16, const f16_t* K16, const f16_t* V16, MergeW W, bf16_t* MERGED) { b_merge(GTID, YS, YR, PZ, PGATE, Gb, R16, K16, V16, W, MERGED); }
__global__ void k_rmsnorm_f2b(const float* X, const float* w, bf16_t* out, int nrows) { b_rmsnorm_f2b(GTID, X, w, out, nrows); }
__global__ void k_attn_scores(const bf16_t* Q, const float* kp, const float* kc, float* SC) { b_attn_scores(GTID, Q, kp, kc, SC); }
__global__ void k_attn_softmax(float* SC) { b_attn_softmax(GTID, SC); }
__global__ void k_attn_av(const float* SC, const float* vp, const float* vc, bf16_t* AO) { b_attn_av(GTID, SC, vp, vc, AO); }
__global__ void k_peer_scores(const bf16_t* PQ, const float* sub_keys, float* SCP) { b_peer_scores(GTID, PQ, sub_keys, SCP); }
__global__ void k_peer_topk(const float* SCP, float* TS, int* TI, int* IDX, float* GATE) { b_peer_topk(GTID, SCP, TS, TI, IDX, GATE); }
__global__ void k_peer_act(const bf16_t* H3, const float* eu, const int* IDX, const float* GATE, float* COEF) { b_peer_act(GTID, H3, eu, IDX, GATE, COEF); }
__global__ void k_peer_out(float* X2, const float* ev, const int* IDX, const float* COEF) { b_peer_out(GTID, X2, ev, IDX, COEF); }
__global__ void k_final(const float* X, const float* w, float* yp, float* ys) { b_final(GTID, X, w, yp, ys); }
constexpr size_t al256(size_t x) { return (x + 255) & ~(size_t)255; }
constexpr size_t cmax(size_t a, size_t b) { return a > b ? a : b; }
constexpr size_t O_WT_IN = 0;
constexpr size_t O_WT_DT = O_WT_IN + al256((size_t)NMAIN * D * 2);
constexpr size_t O_WT_OUT = O_WT_DT + al256((size_t)H_SSD * D * 2);
constexpr size_t O_WT_MK = O_WT_OUT + al256((size_t)D * D * 2);
constexpr size_t O_WT_MV = O_WT_MK + al256((size_t)D * D * 2);
constexpr size_t O_WT_MQ = O_WT_MV + al256((size_t)D * D * 2);
constexpr size_t O_WT_MO = O_WT_MQ + al256((size_t)D * D * 2);
constexpr size_t O_WT_PQ = O_WT_MO + al256((size_t)D * D * 2);
constexpr size_t O_HB = O_WT_PQ + al256((size_t)NPQ * D * 2);
constexpr size_t O_MN = O_HB + al256((size_t)MPAD * D * 2);
constexpr size_t O_PZ = O_MN + al256((size_t)NMEMROWS * D * 2);
constexpr size_t O_PXBC = O_PZ + al256((size_t)MPAD * D * 2);
constexpr size_t O_PRW = O_PXBC + al256((size_t)MPAD * CONV_DIM * 2);
constexpr size_t O_PGATE = O_PRW + al256((size_t)MPAD * RWKV_PROJ * 2);
constexpr size_t O_DT = O_PGATE + al256((size_t)MPAD * 2 * D * 2);
constexpr size_t O_XC = O_DT + al256((size_t)MT * H_SSD * 4);
constexpr size_t O_R16 = O_XC + al256(cmax((size_t)MT * CONV_DIM * 2, (size_t)MPAD * D * 2));
constexpr size_t SZ16 = al256((size_t)MT * D * 2);
constexpr size_t O_OMW16 = O_R16 + SZ16, O_K16 = O_OMW16 + SZ16, O_V16 = O_K16 + SZ16, O_KK16 = O_V16 + SZ16, O_B16 = O_KK16 + SZ16;
constexpr size_t O_T1END = O_B16 + SZ16;
constexpr size_t O_CTL = O_T1END;
constexpr size_t CTL_BYTES = 1u << 20;
constexpr size_t O_EU8 = O_CTL + CTL_BYTES;
constexpr size_t O_EV8 = O_EU8 + al256((size_t)N_EXPERTS * D);
constexpr size_t O_WT_MQS = O_EV8;
static_assert((size_t)D * D * 2 <= (size_t)N_EXPERTS * D, "scaled w_mq copy fits the former v-table slot");
constexpr size_t O_ESC = O_EV8 + al256((size_t)N_EXPERTS * D);
constexpr size_t O_KVB = O_ESC + al256((size_t)2 * N_EXPERTS * 4);
constexpr size_t O_SKB = O_KVB + al256((size_t)NMEMROWS * 2 * D * 2);
constexpr size_t O_LW2 = O_SKB + al256((size_t)PEER_HEADS * 2 * N_KEYS * PEER_HALF * 2);
constexpr size_t O_LA2 = O_LW2 + al256((size_t)D * W_RANK * 2);
constexpr size_t O_LG2 = O_LA2 + al256((size_t)D * A_RANK * 2);
constexpr size_t O_BON = O_LG2 + al256((size_t)D * G_RANK * 2);
constexpr size_t O_VTB = O_BON + al256((size_t)MT * H_RWKV * 4);
constexpr size_t O_PROF = O_VTB + al256((size_t)NMEMROWS * D * 2);
constexpr size_t O_END = O_PROF + 256;
constexpr size_t SSD_IMG_BYTES = (size_t)BATCH * (SEQ / 128) * G_SSD * 128 * N_SSD * 2;
constexpr size_t O_CG = O_XC, O_BTG = O_CG + SSD_IMG_BYTES, O_CBG = O_BTG + SSD_IMG_BYTES;
static_assert(O_CBG + SSD_IMG_BYTES <= O_R16, "ssd conv products");
constexpr size_t O_RWK = O_R16;
constexpr size_t O_GB = O_HB, O_YS = O_HB  , O_MERGED = O_XC, O_X1 = O_PGATE;
constexpr size_t O_H2 = O_PRW, O_QB = O_H2 + al256((size_t)MPAD * D * 2), O_AO = O_QB + al256((size_t)MPAD * D * 2);
static_assert(O_AO + al256((size_t)MPAD * D * 2) <= O_PGATE, "late overlay 1");
static_assert((size_t)MPAD * D * 4 <= (size_t)MPAD * 2 * D * 2, "X1 overlay");
constexpr size_t O_SC = O_XC, O_X2 = O_SC + al256((size_t)MT * MEM_HEADS * N_MEM * 4), O_H3 = O_X2 + al256((size_t)MPAD * D * 4), O_PQ = O_H3 + al256((size_t)MPAD * D * 2);
static_assert(O_PQ + al256((size_t)MPAD * NPQ * 2) <= O_T1END, "late overlay 2");
constexpr size_t O_TS = O_HB, O_TI = O_TS + al256((size_t)MT * PEER_HEADS * 2 * PEER_TOPK * 4);
static_assert(O_TI + al256((size_t)MT * PEER_HEADS * 2 * PEER_TOPK * 4) <= O_PZ, "topk temp overlay");
constexpr size_t O_SCP = O_PZ;
constexpr size_t O_IDX = O_SCP + al256((size_t)MT * PEER_HEADS * 2 * N_KEYS * 4), O_GATE = O_IDX + al256((size_t)MT * NSEL * 4), O_COEF = O_GATE + al256((size_t)MT * NSEL * 4);
static_assert(O_COEF + al256((size_t)MT * NSEL * 4) <= O_PGATE, "SCP/IDX/GATE/COEF overlay");

constexpr size_t OO_YP = 0, OO_YS = OO_YP + (size_t)MP * D, OO_SSMP = OO_YS + (size_t)MS * D, OO_CONVP = OO_SSMP + (size_t)BATCH * H_SSD * P_SSD * N_SSD,
    OO_WKVP = OO_CONVP + (size_t)BATCH * (CONV_K - 1) * CONV_DIM, OO_SHP = OO_WKVP + (size_t)BATCH * H_RWKV * HK * HK, OO_MKP = OO_SHP + (size_t)BATCH * RWKV_PROJ,
    OO_MVP = OO_MKP + (size_t)NMEMROWS * D, OO_SSMS = OO_MVP + (size_t)NMEMROWS * D, OO_CONVS = OO_SSMS + (size_t)DEC_BATCH * H_SSD * P_SSD * N_SSD,
    OO_WKVS = OO_CONVS + (size_t)DEC_BATCH * (CONV_K - 1) * CONV_DIM, OO_SHS = OO_WKVS + (size_t)DEC_BATCH * H_RWKV * HK * HK, OO_END = OO_SHS + (size_t)DEC_BATCH * RWKV_PROJ;
enum InIdx { I_XP = 0, I_XS, I_MEM, I_SSSM, I_SCONV, I_SWKV, I_SSHIFT, I_CK, I_CV, I_NORM_MIX, I_W_IN, I_CONV_W, I_CONV_B, I_DT_BIAS, I_A_LOG, I_D_SKIP, I_SSD_NORM, I_MU, I_W0, I_W2, I_A0, I_A2, I_G2,
    I_K_K, I_K_A, I_R_K, I_LN_W, I_LN_B, I_W_OUT, I_NORM_MEM, I_MEM_NORM, I_W_MK, I_W_MV, I_W_MQ, I_W_MO, I_NORM_FFN, I_W_PQ, I_SUBK, I_EU, I_EV, I_NORM_FINAL, N_INPUTS };

#ifndef HOST_EMU
namespace pg8 {
#define PG8_LAS __attribute__((address_space(3)))
typedef unsigned short bf16_t;
typedef short bf16x8 __attribute__((ext_vector_type(8)));
typedef float f32x4 __attribute__((ext_vector_type(4)));
typedef unsigned u32x4 __attribute__((ext_vector_type(4)));
constexpr int BM = 256, BK = 64, HALF = 128, HTB = HALF * BK * 2  , STAGE_BYTES = 8 * HTB, NXCD = 8, WGM = 8;

__host__ __device__ __forceinline__ int lds_byte(int r, int c) { const int st = (r >> 4) * 2 + (c >> 5), rr = r & 15, cc = c & 31, ob = rr * 64 + cc * 2; return st * 1024 + (ob ^ (((ob >> 9) & 1) << 5)); }
__host__ __device__ __forceinline__ void stage_rc(int b, int& R, int& C) { const int st = b / 1024, sb = b % 1024, swz = sb ^ (((sb >> 9) & 1) << 5); R = (st >> 1) * 16 + swz / 64; C = (st & 1) * 32 + (swz % 64) / 2; }
__host__ __device__ __forceinline__ int perm32(int rho) { const int n = rho >> 4, i = rho & 15; return 8 * (i >> 2) + 4 * n + (i & 3); }

struct Unit { int pm, pn; };
struct Gemm { const bf16_t* A; const bf16_t* Bt; int M, N, K; };

struct StaticOrder {
    int nM, nN, nwg, G, c;
    __host__ __device__ void init(int M, int N, int G_, int c_) { nM = M / BM; nN = N / BM; nwg = nM * nN; G = G_; c = c_; }
    __host__ __device__ __attribute__((always_inline)) bool next(int i, Unit& u) const {
        const long L = (long)i * G + c; if (L >= nwg) return false;
        int wgid = (int)L; { const int q = nwg / NXCD, r = nwg % NXCD, xcd = wgid % NXCD, off = wgid / NXCD; wgid = (xcd < r ? xcd * (q + 1) : r * (q + 1) + (xcd - r) * q) + off; }
        const int nig = WGM * nN, gid = wgid / nig, fm = gid * WGM, gsz = (nM - fm) < WGM ? (nM - fm) : WGM;
        u.pm = fm + ((wgid % nig) % gsz); u.pn = (wgid % nig) / gsz; return true;
    }
    __device__ __forceinline__ void a_ready(const Unit&) const {}
    __device__ __forceinline__ void done(const Unit&) const {}
};

__device__ __forceinline__ unsigned cvt_pk_bf16(float lo, float hi) { unsigned r; asm volatile("v_cvt_pk_bf16_f32 %0, %1, %2" : "=v"(r) : "v"(lo), "v"(hi)); return r; }
typedef float f32x2 __attribute__((ext_vector_type(2)));
template <class Epi, class Sched, bool ALIGN_EPI = false, bool SP2 = false>
__device__ __forceinline__ void gemm_phase(PG8_LAS unsigned char* lds, const Gemm g, const Sched& S, const Epi& E) {
    const int tid = threadIdx.x, wid = __builtin_amdgcn_readfirstlane(tid >> 6), lane = tid & 63, wr = wid >> 2, wc = wid & 3, fr = lane & 15, fq = lane >> 4;
    const int K = g.K, nt = K / BK;
    unsigned voffA[2], voffB[2];
#pragma unroll
    for (int i = 0; i < 2; ++i) { int R, C; stage_rc(tid * 16 + i * 8192, R, C); const int Rb = Epi::PERM ? ((R & ~31) + perm32(R & 31)) : R;
        voffA[i] = (unsigned)(R * K + C) * 2u; voffB[i] = (unsigned)(Rb * K + C) * 2u; }
    const size_t kstep = (size_t)(BK * 2);
    const size_t hstep = (size_t)HALF * K * 2;
    const size_t tstep = 2 * hstep;
    const unsigned ldsw = (unsigned)wid * 1024u;
    const int aoff = lds_byte(wr * 64 + fr, fq * 8), boff = lds_byte(wc * 32 + fr, fq * 8);
#define PG8_SA(b, h) (((b) * 2 + (h)) * HTB)
#define PG8_SB(b, h) ((4 + (b) * 2 + (h)) * HTB)
#define PG8_STAGE(bufoff, gbase, voff) do { _Pragma("unroll") for (int _i = 0; _i < 2; ++_i) \
        __builtin_amdgcn_global_load_lds((const unsigned*)((const char*)(gbase) + (voff)[_i]), (PG8_LAS unsigned*)(lds + (bufoff) + ldsw + _i * 8192), 16, 0, 0); } while (0)
#define PG8_LDA(dst, b, h) do { _Pragma("unroll") for (int m = 0; m < 4; ++m) _Pragma("unroll") for (int k = 0; k < 2; ++k) dst[m][k] = *(const PG8_LAS bf16x8*)(lds + PG8_SA(b, h) + aoff + m * 2048 + k * 1024); } while (0)
#define PG8_LDB(dst, b, h) do { _Pragma("unroll") for (int n = 0; n < 2; ++n) _Pragma("unroll") for (int k = 0; k < 2; ++k) dst[n][k] = *(const PG8_LAS bf16x8*)(lds + PG8_SB(b, h) + boff + n * 2048 + k * 1024); } while (0)
#define PG8_MMA(ai, bj, At, Bt) do { __builtin_amdgcn_s_setprio(1); _Pragma("unroll") for (int m = 0; m < 4; ++m) _Pragma("unroll") for (int n = 0; n < 2; ++n) _Pragma("unroll") for (int k = 0; k < 2; ++k) \
        acc[ai][bj][m][n] = __builtin_amdgcn_mfma_f32_16x16x32_bf16(Bt[n][k], At[m][k], acc[ai][bj][m][n], 0, 0, 0); __builtin_amdgcn_s_setprio(0); } while (0)
#define PG8_WAIT_V(n) asm volatile("s_waitcnt vmcnt(" #n ")" ::: "memory")
#define PG8_WAIT_L(n) asm volatile("s_waitcnt lgkmcnt(" #n ")" ::: "memory")
#define PG8_BAR __builtin_amdgcn_s_barrier()
#define PG8_SCHED __builtin_amdgcn_sched_barrier(0)
    Unit cur, nxt; int ui = 0;
    if (!S.next(0, cur)) return;
    f32x4 acc[2][2][4][2];
#pragma unroll
    for (int a = 0; a < 2; ++a)
#pragma unroll
        for (int b = 0; b < 2; ++b)
#pragma unroll
            for (int m = 0; m < 4; ++m)
#pragma unroll
                for (int n = 0; n < 2; ++n) acc[a][b][m][n] = (f32x4){0.f, 0.f, 0.f, 0.f};
    bf16x8 At[4][2], B0[2][2], B1[2][2];
    const char* cA = (const char*)g.A + (size_t)cur.pm * tstep; const char* cB = (const char*)g.Bt + (size_t)cur.pn * tstep;
    S.a_ready(cur);
    if constexpr (SP2) {
        PG8_STAGE(PG8_SB(0, 0), cB, voffB); PG8_STAGE(PG8_SB(0, 1), cB + hstep, voffB); PG8_STAGE(PG8_SA(0, 0), cA, voffA); PG8_STAGE(PG8_SA(0, 1), cA + hstep, voffA);
        if (wr == 1) PG8_BAR;
        PG8_WAIT_V(2); PG8_BAR;
        PG8_STAGE(PG8_SB(1, 0), cB + kstep, voffB); PG8_STAGE(PG8_SA(1, 0), cA + kstep, voffA); PG8_STAGE(PG8_SB(1, 1), cB + hstep + kstep, voffB);
        PG8_WAIT_V(6); PG8_BAR;
    } else {
        PG8_STAGE(PG8_SB(0, 0), cB, voffB); PG8_STAGE(PG8_SA(0, 0), cA, voffA); PG8_STAGE(PG8_SB(0, 1), cB + hstep, voffB); PG8_STAGE(PG8_SA(0, 1), cA + hstep, voffA);
        if (wr == 1) PG8_BAR;
        PG8_WAIT_V(4); PG8_BAR;
        PG8_STAGE(PG8_SB(1, 0), cB + kstep, voffB); PG8_STAGE(PG8_SA(1, 0), cA + kstep, voffA); PG8_STAGE(PG8_SB(1, 1), cB + hstep + kstep, voffB);
        PG8_WAIT_V(6); PG8_BAR;
    }
    for (;;) {
        const bool has_next = S.next(ui + 1, nxt);
        const char* nA = has_next ? (const char*)g.A + (size_t)nxt.pm * tstep : cA; const char* nB = has_next ? (const char*)g.Bt + (size_t)nxt.pn * tstep : cB;
        for (int t = 0; t < nt; t += 2) {
            const bool last = (t == nt - 2);
            const char* a1 = cA + (size_t)(t + 1) * kstep;
            const char* a2 = last ? nA : cA + (size_t)(t + 2) * kstep; const char* b2 = last ? nB : cB + (size_t)(t + 2) * kstep;
            const char* a3 = a2 + kstep; const char* b3 = b2 + kstep;
            if (last && has_next) S.a_ready(nxt);
            if constexpr (SP2) {
            PG8_LDB(B0, 0, 0); PG8_LDB(B1, 0, 1); PG8_SCHED; PG8_LDA(At, 0, 0); PG8_STAGE(PG8_SA(1, 1), a1 + hstep, voffA);
            PG8_WAIT_V(8); PG8_WAIT_L(0); PG8_BAR; PG8_MMA(0, 0, At, B0); PG8_MMA(0, 1, At, B1); PG8_BAR; PG8_SCHED;
            PG8_LDA(At, 0, 1); PG8_STAGE(PG8_SB(0, 0), b2, voffB); PG8_STAGE(PG8_SB(0, 1), b2 + hstep, voffB); PG8_STAGE(PG8_SA(0, 0), a2, voffA);
            PG8_WAIT_V(8); PG8_WAIT_L(0); PG8_BAR; PG8_MMA(1, 0, At, B0); PG8_MMA(1, 1, At, B1); PG8_BAR; PG8_SCHED;
            PG8_LDB(B0, 1, 0); PG8_LDB(B1, 1, 1); PG8_SCHED; PG8_LDA(At, 1, 0); PG8_STAGE(PG8_SA(0, 1), a2 + hstep, voffA);
            PG8_WAIT_V(8); PG8_WAIT_L(0); PG8_BAR; PG8_MMA(0, 0, At, B0); PG8_MMA(0, 1, At, B1); PG8_BAR; PG8_SCHED;
            PG8_LDA(At, 1, 1); PG8_STAGE(PG8_SB(1, 0), b3, voffB); PG8_STAGE(PG8_SB(1, 1), b3 + hstep, voffB); PG8_STAGE(PG8_SA(1, 0), a3, voffA);
            PG8_WAIT_V(8); PG8_WAIT_L(0); PG8_BAR; PG8_MMA(1, 0, At, B0); PG8_MMA(1, 1, At, B1); PG8_BAR; PG8_SCHED;
            } else {
            PG8_LDB(B0, 0, 0); PG8_SCHED; PG8_LDA(At, 0, 0); PG8_STAGE(PG8_SA(1, 1), a1 + hstep, voffA);
            PG8_WAIT_L(8); PG8_BAR; PG8_WAIT_L(0); PG8_MMA(0, 0, At, B0); PG8_BAR; PG8_SCHED;
            PG8_LDB(B1, 0, 1); PG8_STAGE(PG8_SB(0, 0), b2, voffB);
            PG8_BAR; PG8_WAIT_L(0); PG8_MMA(0, 1, At, B1); PG8_BAR;
            PG8_LDA(At, 0, 1); PG8_STAGE(PG8_SA(0, 0), a2, voffA);
            PG8_BAR; PG8_WAIT_L(0); PG8_MMA(1, 0, At, B0); PG8_BAR; PG8_SCHED;
            PG8_STAGE(PG8_SB(0, 1), b2 + hstep, voffB);
            PG8_WAIT_V(6); PG8_BAR; PG8_MMA(1, 1, At, B1); PG8_BAR;
            PG8_LDB(B0, 1, 0); PG8_SCHED; PG8_LDA(At, 1, 0); PG8_STAGE(PG8_SA(0, 1), a2 + hstep, voffA);
            PG8_WAIT_L(8); PG8_BAR; PG8_WAIT_L(0); PG8_MMA(0, 0, At, B0); PG8_BAR; PG8_SCHED;
            PG8_LDB(B1, 1, 1); PG8_STAGE(PG8_SB(1, 0), b3, voffB);
            PG8_BAR; PG8_WAIT_L(0); PG8_MMA(0, 1, At, B1); PG8_BAR;
            PG8_LDA(At, 1, 1); PG8_STAGE(PG8_SA(1, 0), a3, voffA);
            PG8_BAR; PG8_WAIT_L(0); PG8_MMA(1, 0, At, B0); PG8_BAR; PG8_SCHED;
            PG8_STAGE(PG8_SB(1, 1), b3 + hstep, voffB);
            PG8_WAIT_V(6); PG8_BAR; PG8_MMA(1, 1, At, B1); PG8_BAR;
            }
        }
        if constexpr (ALIGN_EPI) { if (wr == 0) PG8_BAR; }
        if constexpr (!Epi::AFTER_DRAIN) { E(acc, cur, wr, wc, fr, fq); S.done(cur); }
        if (!has_next) break;
#pragma unroll
        for (int a = 0; a < 2; ++a)
#pragma unroll
            for (int b = 0; b < 2; ++b)
#pragma unroll
                for (int m = 0; m < 4; ++m)
#pragma unroll
                    for (int n = 0; n < 2; ++n) acc[a][b][m][n] = (f32x4){0.f, 0.f, 0.f, 0.f};
        cur = nxt; cA = nA; cB = nB; ++ui;
        if constexpr (ALIGN_EPI) { if (wr == 1) PG8_BAR; }
    }
    PG8_WAIT_V(0);
    if constexpr (!ALIGN_EPI) { if (wr == 0) PG8_BAR; }
    PG8_BAR;
    if constexpr (Epi::AFTER_DRAIN) { E.fused(acc, cur, wr, wc, fr, fq, lds, wid, lane); S.done(cur); }
#undef PG8_SA
#undef PG8_SB
#undef PG8_STAGE
#undef PG8_LDA
#undef PG8_LDB
#undef PG8_MMA
#undef PG8_WAIT_V
#undef PG8_WAIT_L
#undef PG8_BAR
#undef PG8_SCHED
}
}

namespace pg8 {
struct EpiProj {
    static constexpr bool PERM = true, AFTER_DRAIN = false;
    bf16_t *PZ, *PXBC, *PRW, *PGATE;
    __device__ __forceinline__ void operator()(const f32x4 (&acc)[2][2][4][2], const Unit& u, int wr, int wc, int fr, int fq) const {
        constexpr int T0 = D / 256, T1 = T0 + CONV_DIM / 256, T2 = T1 + RWKV_PROJ / 256;
        bf16_t* base; int ldc, colt;
        if (u.pn < T0) { base = PZ; ldc = D; colt = u.pn * BM; }
        else if (u.pn < T1) { base = PXBC; ldc = CONV_DIM; colt = (u.pn - T0) * BM; }
        else if (u.pn < T2) { base = PRW; ldc = RWKV_PROJ; colt = (u.pn - T1) * BM; }
        else { base = PGATE; ldc = 2 * D; colt = (u.pn - T2) * BM; }
        const int row0 = u.pm * BM + wr * 64 + fr, col0 = colt + wc * 32 + 8 * fq;
#pragma unroll
        for (int ai = 0; ai < 2; ++ai)
#pragma unroll
            for (int m = 0; m < 4; ++m) { bf16_t* rowp = base + (size_t)(row0 + ai * HALF + m * 16) * ldc + col0;
#pragma unroll
                for (int bj = 0; bj < 2; ++bj) { const f32x4 v0 = acc[ai][bj][m][0], v1 = acc[ai][bj][m][1];
                    u32x4 w; w.x = cvt_pk_bf16(v0[0], v0[1]); w.y = cvt_pk_bf16(v0[2], v0[3]); w.z = cvt_pk_bf16(v1[0], v1[1]); w.w = cvt_pk_bf16(v1[2], v1[3]);
                    *(u32x4*)(rowp + bj * HALF) = w; } }
    }
};
struct EpiB16 {
    static constexpr bool PERM = true, AFTER_DRAIN = false;
    bf16_t* O; int ldc;
    __device__ __forceinline__ void operator()(const f32x4 (&acc)[2][2][4][2], const Unit& u, int wr, int wc, int fr, int fq) const {
        const int row0 = u.pm * BM + wr * 64 + fr, col0 = u.pn * BM + wc * 32 + 8 * fq;
#pragma unroll
        for (int ai = 0; ai < 2; ++ai)
#pragma unroll
            for (int m = 0; m < 4; ++m) { bf16_t* rowp = O + (size_t)(row0 + ai * HALF + m * 16) * ldc + col0;
#pragma unroll
                for (int bj = 0; bj < 2; ++bj) { const f32x4 v0 = acc[ai][bj][m][0], v1 = acc[ai][bj][m][1];
                    u32x4 w; w.x = cvt_pk_bf16(v0[0], v0[1]); w.y = cvt_pk_bf16(v0[2], v0[3]); w.z = cvt_pk_bf16(v1[0], v1[1]); w.w = cvt_pk_bf16(v1[2], v1[3]);
                    *(u32x4*)(rowp + bj * HALF) = w; } }
    }
};
struct EpiKV {
    static constexpr bool PERM = false, AFTER_DRAIN = false;
    float *mk, *mv; bf16_t* kvb; bf16_t* vtb;
    __device__ __forceinline__ void operator()(const f32x4 (&acc)[2][2][4][2], const Unit& u, int wr, int wc, int fr, int fq) const {
        const int row0 = u.pm * BM + wr * 64 + fr, col0 = u.pn * BM + wc * 32 + 4 * fq;
        float* ob = col0 < D ? mk : mv; const int colo = col0 < D ? col0 : col0 - D;
#pragma unroll
        for (int ai = 0; ai < 2; ++ai)
#pragma unroll
            for (int m = 0; m < 4; ++m) { const size_t r = (size_t)(row0 + ai * HALF + m * 16);
#pragma unroll
                for (int bj = 0; bj < 2; ++bj)
#pragma unroll
                    for (int n = 0; n < 2; ++n) { const f32x4 v = acc[ai][bj][m][n];
                        *(f32x4*)(ob + r * D + colo + bj * HALF + n * 16) = v;
                        typedef unsigned u32x2 __attribute__((ext_vector_type(2))); u32x2 w; w.x = cvt_pk_bf16(v[0], v[1]); w.y = cvt_pk_bf16(v[2], v[3]);
                        *(u32x2*)(kvb + r * 2 * D + col0 + bj * HALF + n * 16) = w;
                        if (col0 >= D) { const int cc = colo + bj * HALF + n * 16, hh_ = cc / MEM_HD, dd = cc % MEM_HD; const size_t bb_ = r / N_MEM, mm = r % N_MEM;
                            bf16_t* vp = vtb + ((bb_ * MEM_HEADS + hh_) * MEM_HD + dd) * N_MEM + mm;
                            vp[0] = (bf16_t)(w.x & 0xffffu); vp[N_MEM] = (bf16_t)(w.x >> 16); vp[2 * N_MEM] = (bf16_t)(w.y & 0xffffu); vp[3 * N_MEM] = (bf16_t)(w.y >> 16); } } }
    }
};
struct EpiRes {
    static constexpr bool PERM = false, AFTER_DRAIN = false;
    const float* base0; const float* base1; int split; float* out; int nrows;
    __device__ __forceinline__ void operator()(const f32x4 (&acc)[2][2][4][2], const Unit& u, int wr, int wc, int fr, int fq) const {
        const int row0 = u.pm * BM + wr * 64 + fr, col0 = u.pn * BM + wc * 32 + 4 * fq;
#pragma unroll
        for (int ai = 0; ai < 2; ++ai)
#pragma unroll
            for (int m = 0; m < 4; ++m) { const int r = row0 + ai * HALF + m * 16; if (r < nrows) {
                const float* bp = r < split ? base0 + (size_t)r * D : base1 + (size_t)(r - split) * D;
#pragma unroll
                for (int bj = 0; bj < 2; ++bj)
#pragma unroll
                    for (int n = 0; n < 2; ++n) { const int c = col0 + bj * HALF + n * 16; *(f32x4*)(out + (size_t)r * D + c) = *(const f32x4*)(bp + c) + acc[ai][bj][m][n]; } } }
    }
};
struct EpiResB {
    static constexpr bool PERM = true, AFTER_DRAIN = false;
    const float* base0; const float* base1; int split; const bf16_t* baseb; bf16_t* out; int nrows; float* PS;
    __device__ __forceinline__ void operator()(const f32x4 (&acc)[2][2][4][2], const Unit& u, int wr, int wc, int fr, int fq) const {
        const int row0 = u.pm * BM + wr * 64 + fr, col0 = u.pn * BM + wc * 32 + 8 * fq;
#pragma unroll
        for (int ai = 0; ai < 2; ++ai)
#pragma unroll
            for (int m = 0; m < 4; ++m) { const int r = row0 + ai * HALF + m * 16; if (r < nrows) { float ssq = 0.f;
#pragma unroll
                for (int bj = 0; bj < 2; ++bj) { const int c = col0 + bj * HALF; f32x4 v0 = acc[ai][bj][m][0], v1 = acc[ai][bj][m][1];
                    if (baseb) { const u32x4 b = *(const u32x4*)(baseb + (size_t)r * D + c);
                        v0[0] += __uint_as_float(b.x << 16); v0[1] += __uint_as_float(b.x & 0xffff0000u); v0[2] += __uint_as_float(b.y << 16); v0[3] += __uint_as_float(b.y & 0xffff0000u);
                        v1[0] += __uint_as_float(b.z << 16); v1[1] += __uint_as_float(b.z & 0xffff0000u); v1[2] += __uint_as_float(b.w << 16); v1[3] += __uint_as_float(b.w & 0xffff0000u); }
                    else { const float* bp = (r < split ? base0 + (size_t)r * D : base1 + (size_t)(r - split) * D) + c; v0 += *(const f32x4*)bp; v1 += *(const f32x4*)(bp + 4); }
                    u32x4 w; w.x = cvt_pk_bf16(v0[0], v0[1]); w.y = cvt_pk_bf16(v0[2], v0[3]); w.z = cvt_pk_bf16(v1[0], v1[1]); w.w = cvt_pk_bf16(v1[2], v1[3]);
                    ssq += (v0[0] * v0[0] + v0[1] * v0[1]) + (v0[2] * v0[2] + v0[3] * v0[3]) + (v1[0] * v1[0] + v1[1] * v1[1]) + (v1[2] * v1[2] + v1[3] * v1[3]);
                    *(u32x4*)(out + (size_t)r * D + c) = w; }
                if (PS) { ssq += __shfl_xor(ssq, 16); ssq += __shfl_xor(ssq, 32); if (fq == 0) PS[(size_t)r * 16 + u.pn * 4 + wc] = ssq; } } }
    }
};
struct EpiB16S {
    static constexpr bool PERM = true, AFTER_DRAIN = false;
    bf16_t* O; int ldc; const PG8_LAS float* rs;
    __device__ __forceinline__ void operator()(const f32x4 (&acc)[2][2][4][2], const Unit& u, int wr, int wc, int fr, int fq) const {
        const int rl0 = wr * 64 + fr, col0 = u.pn * BM + wc * 32 + 8 * fq;
#pragma unroll
        for (int ai = 0; ai < 2; ++ai)
#pragma unroll
            for (int m = 0; m < 4; ++m) { const int rl = rl0 + ai * HALF + m * 16; const float sc = rs[rl]; bf16_t* rowp = O + (size_t)(u.pm * BM + rl) * ldc + col0;
#pragma unroll
                for (int bj = 0; bj < 2; ++bj) { const f32x4 v0 = acc[ai][bj][m][0] * sc, v1 = acc[ai][bj][m][1] * sc;
                    u32x4 w; w.x = cvt_pk_bf16(v0[0], v0[1]); w.y = cvt_pk_bf16(v0[2], v0[3]); w.z = cvt_pk_bf16(v1[0], v1[1]); w.w = cvt_pk_bf16(v1[2], v1[3]);
                    *(u32x4*)(rowp + bj * HALF) = w; } }
    }
};
}

#define GAS __attribute__((address_space(1)))
#define LAS __attribute__((address_space(3)))
typedef unsigned v4u __attribute__((ext_vector_type(4)));
typedef float f32x4 __attribute__((ext_vector_type(4)));
typedef GAS unsigned gu32;
#define RLX_AGENT __ATOMIC_RELAXED, __HIP_MEMORY_SCOPE_AGENT
#define LDS_WAIT() asm volatile("s_waitcnt lgkmcnt(0)" ::: "memory")
#define VM_WAIT() asm volatile("s_waitcnt vmcnt(0)" ::: "memory")
#define XB_TMO      128
#define XB_XCNT(j)  (256  + 64 * (j))
#define XB_XSUB(j)  (1280 + 64 * (j))
#define XB_XGEN(j)  (2304 + 64 * (j))
#define XB_TOP      3328
#define XB_TOPGEN   3392
#define XCD_BAR_WORDS 3456
#define XB_SPIN_CAP (1u << 30)

__device__ __forceinline__ unsigned xb_ld(unsigned* p)              { return __hip_atomic_load(p, __ATOMIC_RELAXED, __HIP_MEMORY_SCOPE_AGENT); }
__device__ __forceinline__ unsigned xb_add(unsigned* p, unsigned v) { return __hip_atomic_fetch_add(p, v, __ATOMIC_RELAXED, __HIP_MEMORY_SCOPE_AGENT); }
__device__ __forceinline__ unsigned xb_xcc_id() { return (unsigned)__builtin_amdgcn_s_getreg((3 << 11) | 20) & 0xFu; }
#define XB_SPIN(cond, bar) do { unsigned _sp = 0; while (cond) { __builtin_amdgcn_s_sleep(1); \
    if ((++_sp & 255u) == 0u) { if (xb_ld(&(bar)[XB_TMO])) break; if (_sp > XB_SPIN_CAP) { atomicAdd(&(bar)[XB_TMO], 1u); break; } } } } while (0)

struct XcdBarrier {
    unsigned* bar; unsigned x;
    volatile LAS unsigned* st;
};

__device__ __forceinline__ XcdBarrier xcd_barrier_post(unsigned* bar, volatile LAS unsigned* st) {
    XcdBarrier b; b.bar = bar; b.x = xb_xcc_id(); b.st = st;
    if (threadIdx.x == 0) (void)xb_add(&bar[XB_XCNT(b.x)], 1u);
    return b;
}
__device__ __forceinline__ void xcd_barrier_complete(unsigned* bar, unsigned x, unsigned& nloc, unsigned& nx) {
    const unsigned G = gridDim.x * gridDim.y * gridDim.z;
    unsigned sum, cnt, mine, sp = 0u;
    for (;;) {
        sum = 0u; cnt = 0u; mine = 0u;
#pragma unroll
        for (unsigned j = 0; j < 16; ++j) { const unsigned c = xb_ld(&bar[XB_XCNT(j)]); sum += c; cnt += (c > 0u) ? 1u : 0u; mine = (j == x) ? c : mine; }
        if (sum == G) break;
        __builtin_amdgcn_s_sleep(1);
        if ((++sp & 255u) == 0u) { if (xb_ld(&bar[XB_TMO])) break; if (sp > XB_SPIN_CAP) { atomicAdd(&bar[XB_TMO], 1u); break; } }
    }
    nloc = mine > 0u ? mine : 1u; nx = cnt > 0u ? cnt : 1u;
}

__device__ __forceinline__ void xcd_barrier(const XcdBarrier& b) {
    asm volatile("s_waitcnt vmcnt(0)" ::: "memory");
    __syncthreads();
    if (threadIdx.x == 0) {
        unsigned* bar = b.bar;
        __builtin_amdgcn_s_waitcnt(0);
        unsigned nloc = b.st[0], nx = b.st[1];
        if (nloc == 0u) { xcd_barrier_complete(bar, b.x, nloc, nx); b.st[0] = nloc; b.st[1] = nx; }
        const unsigned old = xb_add(&bar[XB_XSUB(b.x)], 1u);
        const unsigned gen = old / nloc;
        if (old + 1u == (gen + 1u) * nloc) {
            __builtin_amdgcn_fence(__ATOMIC_RELEASE, "agent");
            asm volatile("s_waitcnt vmcnt(0)" ::: "memory");
            const unsigned og = xb_add(&bar[XB_TOP], 1u);
            const unsigned tg = og / nx;
            if (og + 1u == (tg + 1u) * nx) xb_add(&bar[XB_TOPGEN], 1u);
            else XB_SPIN(xb_ld(&bar[XB_TOPGEN]) == tg, bar);
            __builtin_amdgcn_fence(__ATOMIC_ACQUIRE, "agent");
            xb_add(&bar[XB_XGEN(b.x)], 1u);
            asm volatile("s_waitcnt vmcnt(0)" ::: "memory");
        } else {
            XB_SPIN(xb_ld(&bar[XB_XGEN(b.x)]) == gen, bar);
            __builtin_amdgcn_fence(__ATOMIC_ACQUIRE, "agent");
            asm volatile("s_waitcnt vmcnt(0)" ::: "memory");
        }
    }
    __syncthreads();
}


constexpr int NWAVES = 8, NTHREADS = NWAVES * 64;
constexpr int LDS_BYTES = 163840, LDSCTL_OFF = LDS_BYTES - 1024;
constexpr int CW_LQ = 64;
constexpr int CW_PKS = 96;
constexpr int CW_BAR = 4096;

#ifndef DUP_PHASE
#define DUP_PHASE -1
#endif
enum Phase { PH_PREP = 0, PH_INPROJ, PH_CONV, PH_MIXA, PH_MERGE, PH_OUT, PH_NORM2, PH_Q, PH_ATT1, PH_O, PH_NORM3, PH_PQ, PH_PK1, PH_PEER, N_PHASES };
constexpr int MAX_LAUNCHES = 16;
#define GS_LOOP(n, call) do { for (size_t i_ = (size_t)bx * NTHREADS + tid; i_ < (size_t)(n); i_ += (size_t)G * NTHREADS) { call; } } while (0)

__device__ __forceinline__ unsigned pk2(float lo, float hi) { return (unsigned)f2bf(lo) | ((unsigned)f2bf(hi) << 16); }
__device__ __forceinline__ float wave_sum(float v) {
#pragma unroll
    for (int o = 1; o < 64; o <<= 1) v += __shfl_xor(v, o);
    return v;
}
__device__ __forceinline__ float wave_max(float v) {
#pragma unroll
    for (int o = 1; o < 64; o <<= 1) v = fmaxf(v, __shfl_xor(v, o));
    return v;
}

#ifdef PROF
#define PROF_T() ({ __builtin_amdgcn_sched_barrier(0); unsigned long long t_ = __builtin_amdgcn_s_memtime(); __builtin_amdgcn_sched_barrier(0); t_; })
#endif
struct MkArgs { const float* in[N_INPUTS]; float* out; unsigned char* ws; int ph_lo, ph_hi, bar_idx, dup; };
static_assert((CW_BAR + MAX_LAUNCHES * XCD_BAR_WORDS) * 4 <= (int)CTL_BYTES, "ctl");

__device__ __forceinline__ void p0_transpose_item(const float* W, int K, int ldw, int srccol0, bf16_t* WT, int row0, LAS float* scr, int kb, int lane, const float* kscale = nullptr) {
    const int k0 = 64 * kb;
#pragma unroll 8
    for (int i = 0; i < 32; ++i) { const int kk = 2 * i + (lane >> 5); const float wv = W[(size_t)(k0 + kk) * ldw + srccol0 + (lane & 31)]; scr[kk * 33 + (lane & 31)] = kscale ? wv * kscale[k0 + kk] : wv; }
    LDS_WAIT(); asm volatile("" ::: "memory");
    const int c = lane & 7;
#pragma unroll
    for (int j = 0; j < 4; ++j) { const int n = (lane >> 3) + 8 * j; const LAS float* s = scr + (8 * c) * 33 + n;
        v4u o; o.x = pk2(s[0 * 33], s[1 * 33]); o.y = pk2(s[2 * 33], s[3 * 33]); o.z = pk2(s[4 * 33], s[5 * 33]); o.w = pk2(s[6 * 33], s[7 * 33]);
        *(v4u*)(WT + (size_t)(row0 + n) * K + k0 + 8 * c) = o; }
    LDS_WAIT(); asm volatile("" ::: "memory");
}
__device__ __forceinline__ void norm_row_bf(const bf16_t* xrow, const float* w, bf16_t* orow, int lane) {
    const v4u a = *((const v4u*)xrow + 2 * lane), b = *((const v4u*)xrow + 2 * lane + 1); float x[16]; float s = 0.f;
#pragma unroll
    for (int j = 0; j < 4; ++j) { x[2 * j] = __uint_as_float(a[j] << 16); x[2 * j + 1] = __uint_as_float(a[j] & 0xffff0000u); x[8 + 2 * j] = __uint_as_float(b[j] << 16); x[8 + 2 * j + 1] = __uint_as_float(b[j] & 0xffff0000u); }
#pragma unroll
    for (int j = 0; j < 16; ++j) s += x[j] * x[j];
    const float rs = 1.f / sqrtf(wave_sum(s) * (1.f / D) + NORM_EPS);
    const f32x4* w4 = (const f32x4*)w + 4 * lane; v4u o0, o1;
#pragma unroll
    for (int j = 0; j < 4; ++j) { const f32x4 ww = w4[j]; const unsigned p0 = pk2(x[4 * j] * rs * ww.x, x[4 * j + 1] * rs * ww.y), p1 = pk2(x[4 * j + 2] * rs * ww.z, x[4 * j + 3] * rs * ww.w);
        if (j < 2) { o0[2 * j] = p0; o0[2 * j + 1] = p1; } else { o1[2 * (j - 2)] = p0; o1[2 * (j - 2) + 1] = p1; } }
    *((v4u*)orow + 2 * lane) = o0; *((v4u*)orow + 2 * lane + 1) = o1;
}
template <bool WITH_DT>
__device__ __forceinline__ void norm_row(const float* xrow, const float* w, bf16_t* orow, const LAS unsigned char* wdt, float* dtrow, int lane) {
    static_assert(D == 1024, "norm_row is written for D = 1024");
    const f32x4* xr = (const f32x4*)xrow + lane; const f32x4* wr4 = (const f32x4*)w + lane;
    f32x4 v[4]; float s = 0.f;
#pragma unroll
    for (int j = 0; j < 4; ++j) { v[j] = xr[64 * j]; s += (v[j].x * v[j].x + v[j].y * v[j].y) + (v[j].z * v[j].z + v[j].w * v[j].w); }
    const float rs = 1.f / sqrtf(wave_sum(s) * (1.f / D) + NORM_EPS);
    unsigned long long* o8 = (unsigned long long*)orow + lane;
#pragma unroll
    for (int j = 0; j < 4; ++j) { v[j] = v[j] * rs * wr4[64 * j]; o8[64 * j] = (unsigned long long)pk2(v[j].x, v[j].y) | ((unsigned long long)pk2(v[j].z, v[j].w) << 32); }
    if constexpr (WITH_DT) {
        static_assert(H_SSD == 16, "dt path is written for 16 heads");
        float acc16[16];
#pragma unroll
        for (int jj = 0; jj < 16; ++jj) { float a = 0.f;
#pragma unroll
            for (int j = 0; j < 4; ++j) { const f32x4 w4 = *(const LAS f32x4*)(wdt + (jj * D + 4 * (64 * j + lane)) * 4); a += (v[j].x * w4.x + v[j].y * w4.y) + (v[j].z * w4.z + v[j].w * w4.w); }
            acc16[jj] = a; }
#pragma unroll
        for (int i = 0; i < 8; ++i) { const bool up = lane & 32; const float keep = up ? acc16[i + 8] : acc16[i], send = up ? acc16[i] : acc16[i + 8]; acc16[i] = keep + __shfl_xor(send, 32); }
#pragma unroll
        for (int i = 0; i < 4; ++i) { const bool up = lane & 16; const float keep = up ? acc16[i + 4] : acc16[i], send = up ? acc16[i] : acc16[i + 4]; acc16[i] = keep + __shfl_xor(send, 16); }
#pragma unroll
        for (int i = 0; i < 2; ++i) { const bool up = lane & 8; const float keep = up ? acc16[i + 2] : acc16[i], send = up ? acc16[i] : acc16[i + 2]; acc16[i] = keep + __shfl_xor(send, 8); }
        { const bool up = lane & 4; const float keep = up ? acc16[1] : acc16[0], send = up ? acc16[0] : acc16[1]; acc16[0] = keep + __shfl_xor(send, 4); }
        acc16[0] += __shfl_xor(acc16[0], 1); acc16[0] += __shfl_xor(acc16[0], 2);
        if ((lane & 3) == 0) dtrow[(lane >> 2) & 15] = acc16[0];
    }
}
typedef unsigned u32x2 __attribute__((ext_vector_type(2)));
__device__ __forceinline__ void fp4_row(const float* src, unsigned char* dst, float* inv, int lane) {
    static_assert(D == 1024, "fp4_row is written for D = 1024");
    const f32x4* s4 = (const f32x4*)src + 4 * lane; f32x4 v[4]; float am = 0.f;
#pragma unroll
    for (int j = 0; j < 4; ++j) { v[j] = s4[j]; am = fmaxf(am, fmaxf(fmaxf(fabsf(v[j].x), fabsf(v[j].y)), fmaxf(fabsf(v[j].z), fabsf(v[j].w)))); }
    am = wave_max(am); const float sc = am > 0.f ? 6.f / am : 1.f;
    u32x2 o;
#pragma unroll
    for (int q = 0; q < 2; ++q) { unsigned p = 0u;
        p = __builtin_amdgcn_cvt_scalef32_pk_fp4_f32(p, v[2 * q].x * sc, v[2 * q].y * sc, 1.0f, 0); p = __builtin_amdgcn_cvt_scalef32_pk_fp4_f32(p, v[2 * q].z * sc, v[2 * q].w * sc, 1.0f, 1);
        p = __builtin_amdgcn_cvt_scalef32_pk_fp4_f32(p, v[2 * q + 1].x * sc, v[2 * q + 1].y * sc, 1.0f, 2); p = __builtin_amdgcn_cvt_scalef32_pk_fp4_f32(p, v[2 * q + 1].z * sc, v[2 * q + 1].w * sc, 1.0f, 3);
        o[q] = p; }
    *(u32x2*)(dst + (size_t)lane * 16) = o;
    if (lane == 0) *inv = am > 0.f ? am / 6.f : 1.f;
}
__device__ __forceinline__ void fp8_row(const float* src, unsigned char* dst, float* inv, int lane) {
    static_assert(D == 1024, "fp8_row is written for D = 1024");
    const f32x4* s4 = (const f32x4*)src + 4 * lane; f32x4 v[4]; float am = 0.f;
#pragma unroll
    for (int j = 0; j < 4; ++j) { v[j] = s4[j]; am = fmaxf(am, fmaxf(fmaxf(fabsf(v[j].x), fabsf(v[j].y)), fmaxf(fabsf(v[j].z), fabsf(v[j].w)))); }
    am = wave_max(am); const float sc = am > 0.f ? 224.f / am : 1.f;
    v4u o;
#pragma unroll
    for (int j = 0; j < 4; ++j) { int p = __builtin_amdgcn_cvt_pk_fp8_f32(v[j].x * sc, v[j].y * sc, 0, false); p = __builtin_amdgcn_cvt_pk_fp8_f32(v[j].z * sc, v[j].w * sc, p, true); o[j] = (unsigned)p; }
    *((v4u*)dst + lane) = o;
    if (lane == 0) *inv = am > 0.f ? am / 224.f : 1.f;
}

typedef float f32x2v __attribute__((ext_vector_type(2)));
#define FP8X4_FMA_DOT(accv, w, xb) do { const f32x2v lo_ = __builtin_amdgcn_cvt_pk_f32_fp8((int)(w), false), hi_ = __builtin_amdgcn_cvt_pk_f32_fp8((int)(w), true); \
    accv = fmaf(lo_.x, x[(xb)], accv); accv = fmaf(lo_.y, x[(xb) + 1], accv); accv = fmaf(hi_.x, x[(xb) + 2], accv); accv = fmaf(hi_.y, x[(xb) + 3], accv); } while (0)
#define FP8X4_AXPY(w, c, ob) do { const f32x2v lo_ = __builtin_amdgcn_cvt_pk_f32_fp8((int)(w), false), hi_ = __builtin_amdgcn_cvt_pk_f32_fp8((int)(w), true); \
    acc[(ob)] = fmaf(lo_.x, (c), acc[(ob)]); acc[(ob) + 1] = fmaf(lo_.y, (c), acc[(ob) + 1]); acc[(ob) + 2] = fmaf(hi_.x, (c), acc[(ob) + 2]); acc[(ob) + 3] = fmaf(hi_.y, (c), acc[(ob) + 3]); } while (0)
#define FP4X8_FMA_DOT(accv, w, xb) do { _Pragma("unroll") for (int s_ = 0; s_ < 4; ++s_) { const f32x2v f_ = s_ == 0 ? __builtin_amdgcn_cvt_scalef32_pk_f32_fp4((w), 1.0f, 0) : s_ == 1 ? __builtin_amdgcn_cvt_scalef32_pk_f32_fp4((w), 1.0f, 1) : s_ == 2 ? __builtin_amdgcn_cvt_scalef32_pk_f32_fp4((w), 1.0f, 2) : __builtin_amdgcn_cvt_scalef32_pk_f32_fp4((w), 1.0f, 3); \
    accv = fmaf(f_.x, x[(xb) + 2 * s_], accv); accv = fmaf(f_.y, x[(xb) + 2 * s_ + 1], accv); } } while (0)
#define FP4X8_AXPY(w, c, ob) do { _Pragma("unroll") for (int s_ = 0; s_ < 4; ++s_) { const f32x2v f_ = s_ == 0 ? __builtin_amdgcn_cvt_scalef32_pk_f32_fp4((w), 1.0f, 0) : s_ == 1 ? __builtin_amdgcn_cvt_scalef32_pk_f32_fp4((w), 1.0f, 1) : s_ == 2 ? __builtin_amdgcn_cvt_scalef32_pk_f32_fp4((w), 1.0f, 2) : __builtin_amdgcn_cvt_scalef32_pk_f32_fp4((w), 1.0f, 3); \
    acc[(ob) + 2 * s_] = fmaf(f_.x, (c), acc[(ob) + 2 * s_]); acc[(ob) + 2 * s_ + 1] = fmaf(f_.y, (c), acc[(ob) + 2 * s_ + 1]); } } while (0)
__device__ __forceinline__ void peer_token(int t, const bf16_t* H3, const int* IDX, const float* GATE, const unsigned char* EU8, const unsigned char* EV8, const float* ESC,
                                           const bf16_t* X2, const float* wfin, float* yout, int lane) {
    static_assert(D == 1024 && PEER_TOPK == 16 && PEER_HEADS == 8, "peer_token is written for D = 1024, 8 heads x 16 experts");
    float x[16], acc[16];
    { const v4u a = *((const v4u*)(H3 + (size_t)t * D) + 2 * lane), b = *((const v4u*)(H3 + (size_t)t * D) + 2 * lane + 1);
#pragma unroll
      for (int j = 0; j < 4; ++j) { x[2 * j] = __uint_as_float(a[j] << 16); x[2 * j + 1] = __uint_as_float(a[j] & 0xffff0000u); x[8 + 2 * j] = __uint_as_float(b[j] << 16); x[8 + 2 * j + 1] = __uint_as_float(b[j] & 0xffff0000u); } }
#pragma unroll
    for (int j = 0; j < 16; ++j) acc[j] = 0.f;
    const int idx_lo = IDX[(size_t)t * NSEL + lane], idx_hi = IDX[(size_t)t * NSEL + 64 + lane];
    const float gate_lo = GATE[(size_t)t * NSEL + lane], gate_hi = GATE[(size_t)t * NSEL + 64 + lane];
    const int me = (lane >> 2) & 15;
    v4u B0[8], B1[8];
#define PEER_REC(hh, e) ((const v4u*)(EU8 + (size_t)(unsigned)__builtin_amdgcn_readlane((hh) < 4 ? idx_lo : idx_hi, ((hh) & 3) * 16 + (e)) * D) + lane)
#pragma unroll
    for (int e = 0; e < 8; ++e) B0[e] = *PEER_REC(0, e);
#pragma unroll 1
    for (int h = 0; h < PEER_HEADS; ++h) {
        float p[16];
#pragma unroll
        for (int e = 0; e < 8; ++e) B1[e] = *PEER_REC(h, 8 + e);
#pragma unroll
        for (int e = 0; e < 8; ++e) { float a = 0.f; FP4X8_FMA_DOT(a, B0[e][0], 0); FP4X8_FMA_DOT(a, B0[e][1], 8); p[e] = a; }
#pragma unroll
        for (int e = 0; e < 8; ++e) { float a = 0.f; FP4X8_FMA_DOT(a, B1[e][0], 0); FP4X8_FMA_DOT(a, B1[e][1], 8); p[8 + e] = a; }
#pragma unroll
        for (int i = 0; i < 8; ++i) { const bool up = lane & 32; const float keep = up ? p[i + 8] : p[i], send = up ? p[i] : p[i + 8]; p[i] = keep + __shfl_xor(send, 32); }
#pragma unroll
        for (int i = 0; i < 4; ++i) { const bool up = lane & 16; const float keep = up ? p[i + 4] : p[i], send = up ? p[i] : p[i + 4]; p[i] = keep + __shfl_xor(send, 16); }
#pragma unroll
        for (int i = 0; i < 2; ++i) { const bool up = lane & 8; const float keep = up ? p[i + 2] : p[i], send = up ? p[i] : p[i + 2]; p[i] = keep + __shfl_xor(send, 8); }
        { const bool up = lane & 4; const float keep = up ? p[1] : p[0], send = up ? p[0] : p[1]; p[0] = keep + __shfl_xor(send, 4); }
        p[0] += __shfl_xor(p[0], 1); p[0] += __shfl_xor(p[0], 2);
        const int src = (h & 3) * 16 + me;
        const int myidx = __shfl(h < 4 ? idx_lo : idx_hi, src); const float gt = __shfl(h < 4 ? gate_lo : gate_hi, src);
        const float su = ESC[myidx], sv = ESC[N_EXPERTS + myidx];
        const float coef = gt * geluf(p[0] * su) * sv;
#pragma unroll
        for (int e = 0; e < 8; ++e) { const float c = __uint_as_float(__builtin_amdgcn_readlane(__float_as_uint(coef), 4 * e));
            FP4X8_AXPY(B0[e][2], c, 0); FP4X8_AXPY(B0[e][3], c, 8); }
        if (h + 1 < PEER_HEADS) {
#pragma unroll
            for (int e = 0; e < 8; ++e) B0[e] = *PEER_REC(h + 1, e);
        }
#pragma unroll
        for (int e = 0; e < 8; ++e) { const float c = __uint_as_float(__builtin_amdgcn_readlane(__float_as_uint(coef), 32 + 4 * e));
            FP4X8_AXPY(B1[e][2], c, 0); FP4X8_AXPY(B1[e][3], c, 8); }
    }
#undef PEER_REC
#define PEER_ROW(a, b, c) 0
#undef PEER_ROW
    const v4u xa = *((const v4u*)(X2 + (size_t)t * D) + 2 * lane), xb = *((const v4u*)(X2 + (size_t)t * D) + 2 * lane + 1); const f32x4* wf = (const f32x4*)wfin + 4 * lane; f32x4 r[4]; float ss = 0.f;
    r[0] = (f32x4){__uint_as_float(xa.x << 16), __uint_as_float(xa.x & 0xffff0000u), __uint_as_float(xa.y << 16), __uint_as_float(xa.y & 0xffff0000u)}; r[1] = (f32x4){__uint_as_float(xa.z << 16), __uint_as_float(xa.z & 0xffff0000u), __uint_as_float(xa.w << 16), __uint_as_float(xa.w & 0xffff0000u)};
    r[2] = (f32x4){__uint_as_float(xb.x << 16), __uint_as_float(xb.x & 0xffff0000u), __uint_as_float(xb.y << 16), __uint_as_float(xb.y & 0xffff0000u)}; r[3] = (f32x4){__uint_as_float(xb.z << 16), __uint_as_float(xb.z & 0xffff0000u), __uint_as_float(xb.w << 16), __uint_as_float(xb.w & 0xffff0000u)};
#pragma unroll
    for (int j = 0; j < 4; ++j) { r[j].x += acc[4 * j]; r[j].y += acc[4 * j + 1]; r[j].z += acc[4 * j + 2]; r[j].w += acc[4 * j + 3]; ss += (r[j].x * r[j].x + r[j].y * r[j].y) + (r[j].z * r[j].z + r[j].w * r[j].w); }
    const float rs = 1.f / sqrtf(wave_sum(ss) * (1.f / D) + NORM_EPS);
    f32x4* yo = (f32x4*)yout + 4 * lane;
#pragma unroll
    for (int j = 0; j < 4; ++j) yo[j] = r[j] * rs * wf[j];
}

#ifndef SCAN_CVT
__device__ __forceinline__ float fmix_lo(float a, unsigned pk, float c) { float d; asm("v_fma_mix_f32 %0, %1, %2, %3 op_sel_hi:[0,1,0]" : "=v"(d) : "v"(a), "v"(pk), "v"(c)); return d; }
__device__ __forceinline__ float fmix_hi(float a, unsigned pk, float c) { float d; asm("v_fma_mix_f32 %0, %1, %2, %3 op_sel:[0,1,0] op_sel_hi:[0,1,0]" : "=v"(d) : "v"(a), "v"(pk), "v"(c)); return d; }
#endif
#ifdef SCAN_CVT
typedef _Float16 h2v __attribute__((ext_vector_type(2)));
#undef fmix_lo
#define fmix_lo(a, pk, c) fmaf((a), (float)__builtin_bit_cast(h2v, (unsigned)(pk)).x, (c))
#define fmix_hi(a, pk, c) fmaf((a), (float)__builtin_bit_cast(h2v, (unsigned)(pk)).y, (c))
#endif
__device__ __forceinline__ float rowsum16(float v) {
    v += __builtin_bit_cast(float, __builtin_amdgcn_update_dpp(0, __builtin_bit_cast(int, v), 0xB1, 0xF, 0xF, true));
    v += __builtin_bit_cast(float, __builtin_amdgcn_update_dpp(0, __builtin_bit_cast(int, v), 0x4E, 0xF, 0xF, true));
    v += __builtin_bit_cast(float, __builtin_amdgcn_update_dpp(0, __builtin_bit_cast(int, v), 0x141, 0xF, 0xF, true));
    v += __builtin_bit_cast(float, __builtin_amdgcn_update_dpp(0, __builtin_bit_cast(int, v), 0x140, 0xF, 0xF, true));
    return v;
}
__device__ __forceinline__ unsigned pkh2(float lo, float hi) { typedef _Float16 h2 __attribute__((ext_vector_type(2))); h2 v; v.x = (_Float16)lo; v.y = (_Float16)hi; return __builtin_bit_cast(unsigned, v); }
__device__ __forceinline__ float fsigmoid(float x) { return __builtin_amdgcn_rcpf(1.f + __expf(-x)); }
namespace rw {
constexpr int CH = 64;
constexpr int L_W2H = 0, L_A2H = 9216, L_CST = 18432, L_MU = 19712, L_REC = 20992, L_VV = 70144, L_YO = 78336,
              L_AW = 82432, L_AA = 91648, L_RAW = 100864, L_END = L_RAW + (CH + 1) * 640;
#define RW_REC(t, ch) (L_REC + ((t) * 16 + ((ch) >> 2)) * 48 + ((ch) & 3) * 2)
static_assert(L_END <= LDSCTL_OFF, "rwkv LDS map");
constexpr int NPIECE = (CH + 1) * 40;
}
struct RwkvIn { const bf16_t* PRW; const bf16_t* LW2; const bf16_t* LA2; const float *mu, *w0, *a0, *k_k, *k_a, *r_k; bf16_t* YR; float* BON; float* state_out; float* prof; };

__device__ __forceinline__ void rwkv_scan_unit(LAS unsigned char* lds, const RwkvIn& I, int b, int h, int half, int tid) {
    using namespace rw;
    static_assert(D == 1024 && HK == 64 && W_RANK == 64 && A_RANK == 64 && SEQ % CH == 0, "rwkv_scan_unit shapes");
    const int lane = tid & 63, w = tid >> 6, kg = lane & 15, r = 4 * w + (lane >> 4);
    const int segcol[5] = {h * HK, D + h * HK, 2 * D + h * HK, 3 * D, 3 * D + W_RANK};
    { const int row = tid >> 3, pc = tid & 7;
      *(v4u*)(lds + L_W2H + row * 144 + pc * 16) = *(const v4u*)(I.LW2 + (size_t)(h * HK + row) * W_RANK + pc * 8);
      *(v4u*)(lds + L_A2H + row * 144 + pc * 16) = *(const v4u*)(I.LA2 + (size_t)(h * HK + row) * A_RANK + pc * 8); }
    if (tid < 320) { const int s = tid >> 6, c = tid & 63; const int gc = (s == 0 ? h * HK : s == 1 ? D + h * HK : s == 2 ? 2 * D + h * HK : s == 3 ? 3 * D : 3 * D + W_RANK) + c;
        ((LAS float*)(lds + L_MU))[tid] = I.mu[gc];
        const float* src = s == 0 ? I.w0 : s == 1 ? I.a0 : s == 2 ? I.k_k : s == 3 ? I.k_a : I.r_k;
        ((LAS float*)(lds + L_CST))[tid] = src[h * HK + c]; }
    float S[4] = {0.f, 0.f, 0.f, 0.f};
    v4u G[6];
    const size_t row0 = (size_t)b * SEQ;
    auto issue_loads = [&](int c) {
#pragma unroll
        for (int i = 0; i < 6; ++i) { const int pid = tid + 512 * i; v4u z = {0u, 0u, 0u, 0u}; G[i] = z;
            if (pid < NPIECE) { const int rr = pid / 40, sp = pid % 40, sg = sp >> 3, pc = sp & 7; const int t = c * CH + rr - 1;
                const int col = (sg == 0 ? h * HK : sg == 1 ? D + h * HK : sg == 2 ? 2 * D + h * HK : sg == 3 ? 3 * D : 3 * D + W_RANK) + pc * 8;
                if (t >= 0) G[i] = *(const v4u*)(I.PRW + (row0 + t) * RWKV_PROJ + col); } }
    };
    (void)segcol;
    issue_loads(0);
    __syncthreads();
#ifdef PROF
    unsigned long long pt_loop = 0, pt_p1 = 0, pt_p2 = 0, pt_tot0 = PROF_T(), pt_a;
#endif
    for (int c = 0; c <= SEQ / CH; ++c) {
        if (c > 0) {
#ifdef PROF
            pt_a = PROF_T();
#endif
            const LAS unsigned char* pO = lds + L_REC + kg * 48; const LAS float* pV = (const LAS float*)(lds + L_VV) + r;
            LAS bf16_t* pY = (LAS bf16_t*)(lds + L_YO) + r;
#define RW_DPP(v, ctrl) v += __builtin_bit_cast(float, __builtin_amdgcn_update_dpp(0, __builtin_bit_cast(int, v), ctrl, 0xF, 0xF, true))
#pragma unroll 1
            for (int tb = 0; tb < CH; tb += 16) { float ypend = 0.f, ykeep = 0.f;
#pragma unroll
                for (int i = 0; i < 16; ++i) { const int t = tb + i;
                    const v4u q0 = *(const LAS v4u*)(pO + t * 768), q1 = *(const LAS v4u*)(pO + t * 768 + 16); const u32x2 rr = *(const LAS u32x2*)(pO + t * 768 + 32);
                    u32x2 no, kk, nb, kh; no.x = q0.x; no.y = q0.y; kk.x = q0.z; kk.y = q0.w; nb.x = q1.x; nb.y = q1.y; kh.x = q1.z; kh.y = q1.w;
                    const float vv = pV[t * 32];
                    float sa = fmix_hi(S[1], kk.x, fmix_lo(S[0], kk.x, 0.f)) + fmix_hi(S[3], kk.y, fmix_lo(S[2], kk.y, 0.f));
                    float T0 = fmix_lo(vv, kh.x, fmix_lo(S[0], no.x, S[0])), T1 = fmix_hi(vv, kh.x, fmix_hi(S[1], no.x, S[1])), T2 = fmix_lo(vv, kh.y, fmix_lo(S[2], no.y, S[2])), T3 = fmix_hi(vv, kh.y, fmix_hi(S[3], no.y, S[3]));
                    float yq = ypend;
                    RW_DPP(sa, 0xB1); RW_DPP(yq, 0xB1); RW_DPP(sa, 0x4E); RW_DPP(yq, 0x4E); RW_DPP(sa, 0x141); RW_DPP(yq, 0x141); RW_DPP(sa, 0x140); RW_DPP(yq, 0x140);
                    if (i > 0) ykeep = kg == i - 1 ? yq : ykeep;
                    S[0] = fmix_lo(sa, nb.x, T0); S[1] = fmix_hi(sa, nb.x, T1); S[2] = fmix_lo(sa, nb.y, T2); S[3] = fmix_hi(sa, nb.y, T3);
                    ypend = fmix_hi(S[1], rr.x, fmix_lo(S[0], rr.x, 0.f)) + fmix_hi(S[3], rr.y, fmix_lo(S[2], rr.y, 0.f)); }
                { float yq = ypend; RW_DPP(yq, 0xB1); RW_DPP(yq, 0x4E); RW_DPP(yq, 0x141); RW_DPP(yq, 0x140); ykeep = kg == 15 ? yq : ykeep; }
                pY[(tb + kg) * 32] = f2bf(ykeep); }
#undef RW_DPP
#ifdef PROF
            pt_loop += PROF_T() - pt_a;
#endif
            __syncthreads();
            if (tid < 256) { const int t = tid >> 2, pc = tid & 3;
                *(v4u*)(I.YR + (row0 + (size_t)(c - 1) * CH + t) * D + h * HK + half * 32 + pc * 8) = *(const LAS v4u*)(lds + L_YO + t * 64 + pc * 16); }
        }
        if (c == SEQ / CH) break;
#pragma unroll
        for (int i = 0; i < 6; ++i) { const int pid = tid + 512 * i; if (pid < NPIECE) { const int rr_ = pid / 40, sp = pid % 40; *(LAS v4u*)(lds + L_RAW + rr_ * 640 + sp * 16) = G[i]; } }
        __syncthreads();
        if (c + 1 < SEQ / CH) issue_loads(c + 1);
#ifdef PROF
        pt_a = PROF_T();
#endif
#pragma unroll
        for (int sg = 0; sg < 5; ++sg) {
#pragma unroll
          for (int it = 0; it < 2; ++it) { const int e = tid + 512 * it;
            const int t = e >> 4, cc = (e & 15) * 4, col = sg * 64 + cc;
            const u32x2 cur = *(const LAS u32x2*)(lds + L_RAW + (t + 1) * 640 + col * 2), prv = *(const LAS u32x2*)(lds + L_RAW + t * 640 + col * 2);
            const f32x4 m4 = *(const LAS f32x4*)(lds + L_MU + col * 4);
            float x[4];
            { const float c0 = __uint_as_float(cur.x << 16), c1 = __uint_as_float(cur.x & 0xffff0000u), c2 = __uint_as_float(cur.y << 16), c3 = __uint_as_float(cur.y & 0xffff0000u);
              const float p0 = __uint_as_float(prv.x << 16), p1 = __uint_as_float(prv.x & 0xffff0000u), p2 = __uint_as_float(prv.y << 16), p3 = __uint_as_float(prv.y & 0xffff0000u);
              x[0] = c0 + (p0 - c0) * m4.x; x[1] = c1 + (p1 - c1) * m4.y; x[2] = c2 + (p2 - c2) * m4.z; x[3] = c3 + (p3 - c3) * m4.w; }
            if (sg == 0) { u32x2 o; o.x = pkh2(x[0], x[1]); o.y = pkh2(x[2], x[3]); *(LAS u32x2*)(lds + RW_REC(t, cc) + 32) = o; }
            else if (sg == 1) { u32x2 o; o.x = pkh2(x[0], x[1]); o.y = pkh2(x[2], x[3]); *(LAS u32x2*)(lds + RW_REC(t, cc) + 24) = o; }
            else if (sg == 2) { if ((cc >> 5) == half) *(LAS f32x4*)(lds + L_VV + t * 128 + (cc & 31) * 4) = (f32x4){x[0], x[1], x[2], x[3]}; }
            else if (sg == 3) { u32x2 o;
#pragma unroll
                for (int j = 0; j < 4; ++j) x[j] = 1.f - 2.f * __builtin_amdgcn_rcpf(__expf(2.f * x[j]) + 1.f);
                o.x = pk2(x[0], x[1]); o.y = pk2(x[2], x[3]); *(LAS u32x2*)(lds + L_AW + t * 144 + cc * 2) = o; }
            else { u32x2 o; o.x = pk2(x[0], x[1]); o.y = pk2(x[2], x[3]); *(LAS u32x2*)(lds + L_AA + t * 144 + cc * 2) = o; }
          } }
#ifdef PROF
        pt_p1 += PROF_T() - pt_a;
#endif
        __syncthreads();
#ifdef PROF
        pt_a = PROF_T();
#endif
        { const int role = w >> 2, tt = w & 3, fr = lane & 15, fq = lane >> 4;
          const LAS unsigned char* Aimg = lds + (role ? L_AA : L_AW); const LAS unsigned char* Wimg = lds + (role ? L_A2H : L_W2H);
          pg8::f32x4 acc[4];
#pragma unroll
          for (int nt = 0; nt < 4; ++nt) { acc[nt] = (pg8::f32x4){0.f, 0.f, 0.f, 0.f};
#pragma unroll
              for (int ks = 0; ks < 2; ++ks) { const pg8::bf16x8 af = *(const LAS pg8::bf16x8*)(Aimg + (tt * 16 + fr) * 144 + ks * 64 + fq * 16), bfr = *(const LAS pg8::bf16x8*)(Wimg + (nt * 16 + fr) * 144 + ks * 64 + fq * 16);
                  acc[nt] = __builtin_amdgcn_mfma_f32_16x16x32_bf16(af, bfr, acc[nt], 0, 0, 0); } }
          const LAS float* cst = (const LAS float*)(lds + L_CST);
          if (role == 0) {
#pragma unroll
              for (int nt = 0; nt < 4; ++nt) { const int ch = nt * 16 + fr; const float w0 = cst[ch];
#pragma unroll
                  for (int g = 0; g < 4; ++g) { const int t = tt * 16 + fq * 4 + g; const float e = 0.6065306597f * fsigmoid(w0 + acc[nt][g]); const float omw = 1.f - __expf(-e);
                      *(LAS _Float16*)(lds + RW_REC(t, ch)) = (_Float16)(-omw); } }
          } else {
              float kkr[4][4], ag[4][4], ss[4] = {0.f, 0.f, 0.f, 0.f}, bon[4] = {0.f, 0.f, 0.f, 0.f};
#pragma unroll
              for (int nt = 0; nt < 4; ++nt) { const int ch = nt * 16 + fr; const float a0 = cst[64 + ch], kk_ = cst[128 + ch], ka = cst[192 + ch], rk = cst[256 + ch];
#pragma unroll
                  for (int g = 0; g < 4; ++g) { const int t = tt * 16 + fq * 4 + g; const float a = fsigmoid(a0 + acc[nt][g]); const float k = (float)*(const LAS _Float16*)(lds + RW_REC(t, ch) + 24);
                      const float kh = k * (1.f + (a - 1.f) * ka), kq = k * kk_; ag[nt][g] = a; kkr[nt][g] = kq; ss[g] += kq * kq;
                      bon[g] += (float)*(const LAS _Float16*)(lds + RW_REC(t, ch) + 32) * kh * rk;
                      *(LAS _Float16*)(lds + RW_REC(t, ch) + 24) = (_Float16)kh; } }
#pragma unroll
              for (int g = 0; g < 4; ++g) { ss[g] = rowsum16(ss[g]); bon[g] = rowsum16(bon[g]); const float inv = 1.f / sqrtf(fmaxf(ss[g], 1e-24f)); const int t = tt * 16 + fq * 4 + g;
#pragma unroll
                  for (int nt = 0; nt < 4; ++nt) { const int ch = nt * 16 + fr; const float kk = kkr[nt][g] * inv; *(LAS _Float16*)(lds + RW_REC(t, ch) + 8) = (_Float16)kk; *(LAS _Float16*)(lds + RW_REC(t, ch) + 16) = (_Float16)(-kk * ag[nt][g]); }
                  if (fr == 0 && half == 0) I.BON[(row0 + (size_t)c * CH + t) * H_RWKV + h] = bon[g]; }
          } }
#ifdef PROF
        pt_p2 += PROF_T() - pt_a;
#endif
        __syncthreads();
    }
#ifdef PROF
    if (blockIdx.x == 0 && tid == 0) { const float tot = (float)(PROF_T() - pt_tot0); I.prof[0] = (float)pt_loop / tot; I.prof[1] = (float)pt_p1 / tot; I.prof[2] = (float)pt_p2 / tot; I.prof[3] = tot * 1e-6f; }
#endif
    *(f32x4*)(I.state_out + (((size_t)b * H_RWKV + h) * HK + half * 32 + r) * HK + kg * 4) = (f32x4){S[0], S[1], S[2], S[3]};
    __syncthreads();
}

__device__ __forceinline__ float rowsum16f(float v) {
    v += __uint_as_float((unsigned)__builtin_amdgcn_update_dpp(0, (int)__float_as_uint(v), 0xB1, 0xF, 0xF, true));
    v += __uint_as_float((unsigned)__builtin_amdgcn_update_dpp(0, (int)__float_as_uint(v), 0x4E, 0xF, 0xF, true));
    v += __uint_as_float((unsigned)__builtin_amdgcn_update_dpp(0, (int)__float_as_uint(v), 0x141, 0xF, 0xF, true));
    v += __uint_as_float((unsigned)__builtin_amdgcn_update_dpp(0, (int)__float_as_uint(v), 0x140, 0xF, 0xF, true));
    return v;
}
struct RwkvSIn { const bf16_t* PRW; const float* state_shift; const float* state_wkv; const float *mu, *w0, *w2, *a0, *a2, *k_k, *k_a, *r_k; bf16_t* YR; float* BON; float* state_out; const bf16_t *LW2, *LA2; };
__device__ __forceinline__ void rwkv_sample_unit(const RwkvSIn& I, int s, int h, int lane) {
    static_assert(HK == 64 && W_RANK == 64 && A_RANK == 64, "rwkv_sample_unit shapes");
    const size_t row = (size_t)MP + s; const bf16_t* cur = I.PRW + row * RWKV_PROJ; const float* prv = I.state_shift + (size_t)s * RWKV_PROJ;
    const int ch = h * HK + lane;
    const int r4 = lane >> 4, jj = lane & 15;
    const float* Sg = I.state_wkv + ((size_t)s * H_RWKV + h) * HK * HK + lane * 4; float* So = I.state_out + ((size_t)s * H_RWKV + h) * HK * HK + lane * 4;
    f32x4 S[16];
#pragma unroll
    for (int q = 0; q < 16; ++q) S[q] = *(const f32x4*)(Sg + q * 256);
    const int cols[5] = {ch, D + ch, 2 * D + ch, 3 * D + lane, 3 * D + W_RANK + lane};
    bf16_t c_[5]; float p_[5], m_[5];
#pragma unroll
    for (int q = 0; q < 5; ++q) { c_[q] = cur[cols[q]]; p_[q] = prv[cols[q]]; m_[q] = I.mu[cols[q]]; }
    v4u w2r[8], a2r[8];
#pragma unroll
    for (int q = 0; q < 8; ++q) { w2r[q] = *((const v4u*)(I.LW2 + (size_t)ch * W_RANK) + q); a2r[q] = *((const v4u*)(I.LA2 + (size_t)ch * A_RANK) + q); }
    const float w0c = I.w0[ch], a0c = I.a0[ch], kac = I.k_a[ch], kkc = I.k_k[ch], rkc = I.r_k[ch];
    auto lerpq = [&](int q) { const float c = bf2f(c_[q]); return c + (p_[q] - c) * m_[q]; };
    const float rr = lerpq(0), kx = lerpq(1), vx = lerpq(2);
    const float twl = tanhf(lerpq(3)), al = lerpq(4);
    float dw = 0.f, da = 0.f;
#pragma unroll
    for (int q = 0; q < 8; ++q) {
#pragma unroll
        for (int e = 0; e < 4; ++e) { const int j = 8 * q + 2 * e;
            const float t0 = __uint_as_float(__builtin_amdgcn_readlane(__float_as_uint(twl), j)), t1 = __uint_as_float(__builtin_amdgcn_readlane(__float_as_uint(twl), j + 1));
            const float g0 = __uint_as_float(__builtin_amdgcn_readlane(__float_as_uint(al), j)), g1 = __uint_as_float(__builtin_amdgcn_readlane(__float_as_uint(al), j + 1));
            dw = fmaf(t0, __uint_as_float(w2r[q][e] << 16), dw); dw = fmaf(t1, __uint_as_float(w2r[q][e] & 0xffff0000u), dw);
            da = fmaf(g0, __uint_as_float(a2r[q][e] << 16), da); da = fmaf(g1, __uint_as_float(a2r[q][e] & 0xffff0000u), da); } }
    const float e = 0.6065306597f * sigmoidf(w0c + dw), omw = -expm1f(-e), ag = sigmoidf(a0c + da);
    const float kh = kx * (1.f + (ag - 1.f) * kac), kq = kx * kkc;
    const float kk = kq / sqrtf(fmaxf(wave_sum(kq * kq), 1e-24f)), nb = -kk * ag;
    const float bon = wave_sum(rr * kh * rkc);
    if (lane == 0) I.BON[row * H_RWKV + h] = bon;
    float Kk[4], Wd[4], Nb[4], Kh[4], Rr[4];
#pragma unroll
    for (int e = 0; e < 4; ++e) { const int src = 4 * jj + e; Kk[e] = __shfl(kk, src); Wd[e] = 1.f - __shfl(omw, src); Nb[e] = __shfl(nb, src); Kh[e] = __shfl(kh, src); Rr[e] = __shfl(rr, src); }
    float yv = 0.f;
#pragma unroll
    for (int q = 0; q < 16; ++q) { const float vxr = __shfl(vx, 4 * q + r4);
        float sa = S[q][0] * Kk[0]; sa = fmaf(S[q][1], Kk[1], sa); sa = fmaf(S[q][2], Kk[2], sa); sa = fmaf(S[q][3], Kk[3], sa); sa = rowsum16f(sa);
        float yp = 0.f;
#pragma unroll
        for (int e = 0; e < 4; ++e) { float x = S[q][e] * Wd[e]; x = fmaf(sa, Nb[e], x); x = fmaf(vxr, Kh[e], x); S[q][e] = x; yp = fmaf(x, Rr[e], yp); }
        yp = rowsum16f(yp); yv = jj == q ? yp : yv; }
#pragma unroll
    for (int q = 0; q < 16; ++q) *(f32x4*)(So + q * 256) = S[q];
    I.YR[row * D + h * HK + 4 * jj + r4] = f2bf(yv);
}

namespace mg {
constexpr int L_SG = 0;
constexpr int L_G = 8192;
constexpr int L_END = L_G + 16 * D * 4;
static_assert(L_END <= LDSCTL_OFF, "merge LDS map");
}
struct MergeIn { const bf16_t *YS, *YR, *PZ, *PGATE, *PRW, *LG2; const float *BON, *state_shift, *mu, *ssd_norm_w, *ln_w, *ln_b; bf16_t* MERGED; };
__device__ __forceinline__ void merge_unit(LAS unsigned char* lds, const MergeIn& I, int t0, int tid) {
    using namespace mg;
    static_assert(D == 1024 && G_RANK == 128 && HK == 64, "merge_unit shapes");
    const int lane = tid & 63, w = tid >> 6;
    { const int t = tid >> 5, j0 = (tid & 31) * 4; const int row = t0 + t; u32x2 o; o.x = 0u; o.y = 0u;
      if (row < MT) { const RowInfo q = rowinfo(row); const int col = 3 * D + W_RANK + A_RANK + j0; float x[4];
          const u32x2 cur = *(const u32x2*)(I.PRW + (size_t)row * RWKV_PROJ + col);
          float p[4];
          if (q.t > 0) { const u32x2 pv = *(const u32x2*)(I.PRW + (size_t)(row - 1) * RWKV_PROJ + col); p[0] = __uint_as_float(pv.x << 16); p[1] = __uint_as_float(pv.x & 0xffff0000u); p[2] = __uint_as_float(pv.y << 16); p[3] = __uint_as_float(pv.y & 0xffff0000u); }
          else if (q.grp) { const f32x4 pv = *(const f32x4*)(I.state_shift + (size_t)q.b * RWKV_PROJ + col); p[0] = pv.x; p[1] = pv.y; p[2] = pv.z; p[3] = pv.w; }
          else { p[0] = p[1] = p[2] = p[3] = 0.f; }
          const f32x4 m4 = *(const f32x4*)(I.mu + col);
          const float c0 = __uint_as_float(cur.x << 16), c1 = __uint_as_float(cur.x & 0xffff0000u), c2 = __uint_as_float(cur.y << 16), c3 = __uint_as_float(cur.y & 0xffff0000u);
          x[0] = fsigmoid(c0 + (p[0] - c0) * m4.x); x[1] = fsigmoid(c1 + (p[1] - c1) * m4.y); x[2] = fsigmoid(c2 + (p[2] - c2) * m4.z); x[3] = fsigmoid(c3 + (p[3] - c3) * m4.w);
          o.x = pk2(x[0], x[1]); o.y = pk2(x[2], x[3]); }
      *(LAS u32x2*)(lds + L_SG + t * 272 + j0 * 2) = o; }
    __syncthreads();
    { const int fr = lane & 15, fq = lane >> 4; pg8::bf16x8 af[4];
#pragma unroll
      for (int ks = 0; ks < 4; ++ks) af[ks] = *(const LAS pg8::bf16x8*)(lds + L_SG + fr * 272 + ks * 64 + fq * 16);
#pragma unroll
      for (int nt = 0; nt < 8; ++nt) { const int ch = w * 128 + nt * 16 + fr; pg8::f32x4 acc = {0.f, 0.f, 0.f, 0.f};
#pragma unroll
          for (int ks = 0; ks < 4; ++ks) { const pg8::bf16x8 bfr = *(const pg8::bf16x8*)(I.LG2 + (size_t)ch * G_RANK + ks * 32 + fq * 8); acc = __builtin_amdgcn_mfma_f32_16x16x32_bf16(af[ks], bfr, acc, 0, 0, 0); }
#pragma unroll
          for (int g = 0; g < 4; ++g) ((LAS float*)(lds + L_G))[(fq * 4 + g) * D + ch] = acc[g]; } }
    __syncthreads();
#pragma unroll 1
    for (int tt = 0; tt < 2; ++tt) { const int t = 2 * w + tt, row = t0 + t; if (row >= MT) break;
        const RowInfo q = rowinfo(row); const int c0 = 16 * lane;
        float ys[16], yr[16], zz[16];
        { const v4u a = *((const v4u*)(I.YS + (size_t)row * D) + 2 * lane), b = *((const v4u*)(I.YS + (size_t)row * D) + 2 * lane + 1);
          const v4u c = *((const v4u*)(I.PZ + (size_t)row * D) + 2 * lane), d = *((const v4u*)(I.PZ + (size_t)row * D) + 2 * lane + 1);
          const v4u e = *((const v4u*)(I.YR + (size_t)row * D) + 2 * lane), f = *((const v4u*)(I.YR + (size_t)row * D) + 2 * lane + 1);
#pragma unroll
          for (int j = 0; j < 4; ++j) { ys[2 * j] = __uint_as_float(a[j] << 16); ys[2 * j + 1] = __uint_as_float(a[j] & 0xffff0000u); ys[8 + 2 * j] = __uint_as_float(b[j] << 16); ys[8 + 2 * j + 1] = __uint_as_float(b[j] & 0xffff0000u);
              zz[2 * j] = __uint_as_float(c[j] << 16); zz[2 * j + 1] = __uint_as_float(c[j] & 0xffff0000u); zz[8 + 2 * j] = __uint_as_float(d[j] << 16); zz[8 + 2 * j + 1] = __uint_as_float(d[j] & 0xffff0000u);
              yr[2 * j] = __uint_as_float(e[j] << 16); yr[2 * j + 1] = __uint_as_float(e[j] & 0xffff0000u); yr[8 + 2 * j] = __uint_as_float(f[j] << 16); yr[8 + 2 * j + 1] = __uint_as_float(f[j] & 0xffff0000u); } }
        float ss = 0.f, sm = 0.f;
#pragma unroll
        for (int j = 0; j < 16; ++j) { ys[j] = ys[j] * zz[j] * fsigmoid(zz[j]); ss += ys[j] * ys[j]; sm += yr[j]; }
        const float rs = 1.f / sqrtf(wave_sum(ss) * (1.f / D) + NORM_EPS);
        sm += __shfl_xor(sm, 1); sm += __shfl_xor(sm, 2); const float mean = sm * (1.f / HK);
        float sv = 0.f;
#pragma unroll
        for (int j = 0; j < 16; ++j) { yr[j] -= mean; sv += yr[j] * yr[j]; }
        sv += __shfl_xor(sv, 1); sv += __shfl_xor(sv, 2); const float rstd = 1.f / sqrtf(sv * (1.f / HK) + RWKV_LN_EPS);
        const float bon = I.BON[(size_t)row * H_RWKV + (lane >> 2)];
        float vv[16], gs[16], gr[16];
        { const v4u a = *((const v4u*)(I.PRW + (size_t)row * RWKV_PROJ + 2 * D) + 2 * lane), b = *((const v4u*)(I.PRW + (size_t)row * RWKV_PROJ + 2 * D) + 2 * lane + 1);
#pragma unroll
          for (int j = 0; j < 4; ++j) { vv[2 * j] = __uint_as_float(a[j] << 16); vv[2 * j + 1] = __uint_as_float(a[j] & 0xffff0000u); vv[8 + 2 * j] = __uint_as_float(b[j] << 16); vv[8 + 2 * j + 1] = __uint_as_float(b[j] & 0xffff0000u); }
          float pv[16];
          if (q.t > 0) { const v4u pa = *((const v4u*)(I.PRW + (size_t)(row - 1) * RWKV_PROJ + 2 * D) + 2 * lane), pb = *((const v4u*)(I.PRW + (size_t)(row - 1) * RWKV_PROJ + 2 * D) + 2 * lane + 1);
#pragma unroll
              for (int j = 0; j < 4; ++j) { pv[2 * j] = __uint_as_float(pa[j] << 16); pv[2 * j + 1] = __uint_as_float(pa[j] & 0xffff0000u); pv[8 + 2 * j] = __uint_as_float(pb[j] << 16); pv[8 + 2 * j + 1] = __uint_as_float(pb[j] & 0xffff0000u); } }
          else if (q.grp) {
#pragma unroll
              for (int j = 0; j < 4; ++j) { const f32x4 x = *((const f32x4*)(I.state_shift + (size_t)q.b * RWKV_PROJ + 2 * D + c0) + j); pv[4 * j] = x.x; pv[4 * j + 1] = x.y; pv[4 * j + 2] = x.z; pv[4 * j + 3] = x.w; } }
          else {
#pragma unroll
              for (int j = 0; j < 16; ++j) pv[j] = 0.f; }
#pragma unroll
          for (int j = 0; j < 4; ++j) { const f32x4 m = *((const f32x4*)(I.mu + 2 * D + c0) + j);
              vv[4 * j] += (pv[4 * j] - vv[4 * j]) * m.x; vv[4 * j + 1] += (pv[4 * j + 1] - vv[4 * j + 1]) * m.y; vv[4 * j + 2] += (pv[4 * j + 2] - vv[4 * j + 2]) * m.z; vv[4 * j + 3] += (pv[4 * j + 3] - vv[4 * j + 3]) * m.w; }
          const v4u ga = *((const v4u*)(I.PGATE + (size_t)row * 2 * D) + 2 * lane), gb = *((const v4u*)(I.PGATE + (size_t)row * 2 * D) + 2 * lane + 1);
          const v4u ha = *((const v4u*)(I.PGATE + (size_t)row * 2 * D + D) + 2 * lane), hb = *((const v4u*)(I.PGATE + (size_t)row * 2 * D + D) + 2 * lane + 1);
#pragma unroll
          for (int j = 0; j < 4; ++j) { gs[2 * j] = __uint_as_float(ga[j] << 16); gs[2 * j + 1] = __uint_as_float(ga[j] & 0xffff0000u); gs[8 + 2 * j] = __uint_as_float(gb[j] << 16); gs[8 + 2 * j + 1] = __uint_as_float(gb[j] & 0xffff0000u);
              gr[2 * j] = __uint_as_float(ha[j] << 16); gr[2 * j + 1] = __uint_as_float(ha[j] & 0xffff0000u); gr[8 + 2 * j] = __uint_as_float(hb[j] << 16); gr[8 + 2 * j + 1] = __uint_as_float(hb[j] & 0xffff0000u); } }
        v4u o0, o1; float outv[16];
#pragma unroll
        for (int j = 0; j < 4; ++j) { const f32x4 gq = *((const LAS f32x4*)(lds + L_G + t * D * 4) + 4 * lane + j); const f32x4 nw = *((const f32x4*)(I.ssd_norm_w + c0) + j), lw = *((const f32x4*)(I.ln_w + c0) + j), lb = *((const f32x4*)(I.ln_b + c0) + j);
#pragma unroll
            for (int e = 0; e < 4; ++e) { const int k = 4 * j + e; const float yssd = ys[k] * rs * nw[e]; const float yrw = (yr[k] * rstd * lw[e] + lb[e] + bon * vv[k]) * gq[e];
                outv[k] = fsigmoid(gs[k]) * yssd + fsigmoid(gr[k]) * yrw; } }
#pragma unroll
        for (int j = 0; j < 4; ++j) { o0[j] = pk2(outv[2 * j], outv[2 * j + 1]); o1[j] = pk2(outv[8 + 2 * j], outv[8 + 2 * j + 1]); }
        *((v4u*)(I.MERGED + (size_t)row * D) + 2 * lane) = o0; *((v4u*)(I.MERGED + (size_t)row * D) + 2 * lane + 1) = o1;
    }
    __syncthreads();
}

namespace sd {
constexpr int STR = 272;
constexpr int CL = 128;
constexpr int L_C = 0, L_BT = 34816, L_G = 69632, L_XT = 104448, L_XWT = 121856, L_SB = 139264, L_ACS = 156672, L_DTV = L_ACS + 512, L_CW = L_DTV + 512, L_END = L_CW + 8 * 40 * 4;
static_assert(L_END <= LDSCTL_OFF, "ssd LDS map");
constexpr size_t IMG_ELEMS = (size_t)CL * N_SSD;
}
__device__ __forceinline__ void bf8_unpack(const v4u& v, float (&x)[8]) {
#pragma unroll
    for (int j = 0; j < 4; ++j) { x[2 * j] = __uint_as_float(v[j] << 16); x[2 * j + 1] = __uint_as_float(v[j] & 0xffff0000u); }
}
__device__ __forceinline__ float fsilu(float x) { return x * fsigmoid(x); }
struct SsdCIn { const bf16_t* PXBC; const float *conv_w, *conv_b; bf16_t* CG; bf16_t* BTG; bf16_t* CBG; };
__device__ __forceinline__ void ssd_conv_unit(LAS unsigned char* lds, const SsdCIn& I, int b, int c, int g, int tid) {
    using namespace sd;
    static_assert(D == 1024 && N_SSD == 128 && G_SSD == 2 && CONV_K == 4, "ssd_conv_unit shapes");
    const int lane = tid & 63, w = tid >> 6, fr = lane & 15, fq = lane >> 4;
    const int unit = (b * (SEQ / CL) + c) * G_SSD + g; const size_t row0 = (size_t)b * SEQ;
    __syncthreads();
    { const int pc = tid & 31, ts = (tid >> 5) * 8; const int gch = pc < 16 ? D + g * N_SSD + pc * 8 : D + G_SSD * N_SSD + g * N_SSD + (pc - 16) * 8;
      v4u R[11]; const v4u z = {0u, 0u, 0u, 0u};
#pragma unroll
      for (int i = 0; i < 11; ++i) { const long q = (long)c * CL + ts - 3 + i; R[i] = q >= 0 ? *(const v4u*)(I.PXBC + (row0 + q) * CONV_DIM + gch) : z; }
      float cwv[3];
#pragma unroll
      for (int k = 0; k < 3; ++k) { const int i = tid + k * NTHREADS; cwv[k] = 0.f;
          if (i < 32 * 40) { const int p_ = i / 40, e_ = i % 40; const int gc = p_ < 16 ? D + g * N_SSD + p_ * 8 : D + G_SSD * N_SSD + g * N_SSD + (p_ - 16) * 8;
              cwv[k] = e_ < 32 ? I.conv_w[(size_t)(e_ >> 3) * CONV_DIM + gc + (e_ & 7)] : I.conv_b[gc + (e_ - 32)]; } }
#pragma unroll
      for (int k = 0; k < 3; ++k) { const int i = tid + k * NTHREADS; if (i < 32 * 40) ((LAS float*)(lds + L_G))[i] = cwv[k]; }
      const LAS float* cwl = (const LAS float*)(lds + L_G) + pc * 40;
      __syncthreads();
      LAS unsigned char* img = lds + (pc < 16 ? L_BT   : L_C) + (pc & 15) * 16;
#pragma unroll
      for (int i = 0; i < 8; ++i) { float x0[8], x1[8], x2[8], x3[8], o[8]; bf8_unpack(R[i], x0); bf8_unpack(R[i + 1], x1); bf8_unpack(R[i + 2], x2); bf8_unpack(R[i + 3], x3);
#pragma unroll
          for (int j = 0; j < 8; ++j) o[j] = fsilu(cwl[32 + j] + cwl[j] * x0[j] + cwl[8 + j] * x1[j] + cwl[16 + j] * x2[j] + cwl[24 + j] * x3[j]);
          v4u pk; pk.x = pk2(o[0], o[1]); pk.y = pk2(o[2], o[3]); pk.z = pk2(o[4], o[5]); pk.w = pk2(o[6], o[7]); *(LAS v4u*)(img + (ts + i) * STR) = pk; } }
    __syncthreads();
    { pg8::bf16x8 Cf[4];
#pragma unroll
      for (int ks = 0; ks < 4; ++ks) Cf[ks] = *(const LAS pg8::bf16x8*)(lds + L_C + (16 * w + fr) * STR + ks * 64 + fq * 16);
      bf16_t* cbg = I.CBG + (size_t)unit * IMG_ELEMS + (size_t)(16 * w + fr) * CL;
#pragma unroll
      for (int jt = 0; jt < 8; ++jt) { pg8::f32x4 acc = {0.f, 0.f, 0.f, 0.f};
#pragma unroll
          for (int ks = 0; ks < 4; ++ks) { const pg8::bf16x8 bf_ = *(const LAS pg8::bf16x8*)(lds + L_BT + (16 * jt + fr) * STR + ks * 64 + fq * 16); acc = __builtin_amdgcn_mfma_f32_16x16x32_bf16(bf_, Cf[ks], acc, 0, 0, 0); }
          u32x2 o; o.x = pk2(acc[0], acc[1]); o.y = pk2(acc[2], acc[3]); *(u32x2*)(cbg + 16 * jt + 4 * fq) = o; } }
#pragma unroll
    for (int i = 0; i < 4; ++i) { const int pid = tid + 512 * i, t = pid >> 4, pcn = pid & 15;
        *(v4u*)(I.CG + (size_t)unit * IMG_ELEMS + (size_t)t * N_SSD + pcn * 8) = *(const LAS v4u*)(lds + L_C + t * STR + pcn * 16);
        const int n = pid & 127, tb = pid >> 7;
        v4u o;
#pragma unroll
        for (int j = 0; j < 4; ++j) { const unsigned lo = *(const LAS bf16_t*)(lds + L_BT + (8 * tb + 2 * j) * STR + n * 2), hi = *(const LAS bf16_t*)(lds + L_BT + (8 * tb + 2 * j + 1) * STR + n * 2); o[j] = lo | (hi << 16); }
        *(v4u*)(I.BTG + (size_t)unit * IMG_ELEMS + (size_t)n * CL + tb * 8) = o; }
}
struct SsdIn { const bf16_t* PXBC; const bf16_t* CG; const bf16_t* BTG; const bf16_t* CBG; const float *DT, *conv_w, *conv_b, *dt_bias, *a_log, *d_skip; bf16_t* YS; float* state_out; float* prof; };
__device__ __forceinline__ void ssd_prompt_unit(LAS unsigned char* lds, const SsdIn& I, int b, int h, int tid) {
    using namespace sd;
    static_assert(D == 1024 && P_SSD == 64 && N_SSD == 128 && G_SSD == 2 && H_SSD == 16 && SEQ % CL == 0 && CONV_K == 4, "ssd_prompt_unit shapes");
    const int lane = tid & 63, w = tid >> 6, fr = lane & 15, fq = lane >> 4, g = h / (H_SSD / G_SSD);
    const float ah = -__expf(I.a_log[h]), dbias = I.dt_bias[h], dskip = I.d_skip[h];
    const int pc = tid & 7, tx = (tid >> 3) * 2, gch = h * P_SSD + pc * 8;
    __syncthreads();
    if (tid < 320) { const int p_ = tid / 40, e_ = tid % 40; ((LAS float*)(lds + L_CW))[tid] = e_ < 32 ? I.conv_w[(size_t)(e_ >> 3) * CONV_DIM + h * P_SSD + p_ * 8 + (e_ & 7)] : I.conv_b[h * P_SSD + p_ * 8 + (e_ - 32)]; }
    const LAS float* cwl = (const LAS float*)(lds + L_CW) + pc * 40;
    pg8::f32x4 S[4];
#pragma unroll
    for (int nt = 0; nt < 4; ++nt) S[nt] = (pg8::f32x4){0.f, 0.f, 0.f, 0.f};
    for (int i = tid; i < 64 * STR / 16; i += NTHREADS) *(LAS v4u*)(lds + L_SB + i * 16) = (v4u){0u, 0u, 0u, 0u};
    const size_t row0 = (size_t)b * SEQ;
    LAS float* acs = (LAS float*)(lds + L_ACS); LAS float* dtv = (LAS float*)(lds + L_DTV);
    v4u pC[4], pB[4], pX[5]; u32x2 pCB[8]; float pDT = 0.f;
    auto prefetch = [&](int c) { const int unit = (b * (SEQ / CL) + c) * G_SSD + g; const size_t rowc = row0 + (size_t)c * CL;
#pragma unroll
        for (int i = 0; i < 4; ++i) { const int pid = tid + 512 * i; pC[i] = *(const v4u*)(I.CG + (size_t)unit * IMG_ELEMS + (size_t)pid * 8); pB[i] = *(const v4u*)(I.BTG + (size_t)unit * IMG_ELEMS + (size_t)pid * 8); }
#pragma unroll
        for (int jt = 0; jt < 8; ++jt) pCB[jt] = *(const u32x2*)(I.CBG + (size_t)unit * IMG_ELEMS + (size_t)(16 * w + fr) * CL + 16 * jt + 4 * fq);
        const v4u z = {0u, 0u, 0u, 0u};
#pragma unroll
        for (int i = 0; i < 5; ++i) { const long q = (long)c * CL + tx - 3 + i; pX[i] = q >= 0 ? *(const v4u*)(I.PXBC + (row0 + q) * CONV_DIM + gch) : z; }
        if (tid < CL) pDT = I.DT[(rowc + tid) * H_SSD + h]; };
    prefetch(0);
#ifdef PROF
    unsigned long long qt_s1 = 0, qt_s2 = 0, qt_s34 = 0, qt_s5 = 0, qt_s67 = 0, qt_tot0 = PROF_T(), qt_a;
#define QT(x) do { const unsigned long long n_ = PROF_T(); x += n_ - qt_a; qt_a = n_; } while (0)
#else
#define QT(x) do { } while (0)
#endif
#pragma unroll 1
    for (int c = 0; c < SEQ / CL; ++c) {
#ifdef PROF
        qt_a = PROF_T();
#endif
        const size_t rowc = row0 + (size_t)c * CL;
        if (tid < CL) { const float dt = softplusf(pDT + dbias); dtv[tid] = dt; acs[tid] = dt * ah; }
#pragma unroll
        for (int i = 0; i < 4; ++i) { const int pid = tid + 512 * i, rr = pid >> 4, pcn = pid & 15; *(LAS v4u*)(lds + L_C + rr * STR + pcn * 16) = pC[i]; *(LAS v4u*)(lds + L_BT + rr * STR + pcn * 16) = pB[i]; }
        __syncthreads();
        if (w == 0) { const float a0 = acs[2 * lane], a1 = acs[2 * lane + 1]; float sc = a0 + a1;
#pragma unroll
            for (int o = 1; o < 64; o <<= 1) { const float t = __shfl_up(sc, o); if (lane >= o) sc += t; }
            acs[2 * lane] = sc - a1; acs[2 * lane + 1] = sc; }
        __syncthreads();
        const float acs_last = acs[CL - 1];
        QT(qt_s1);
        { float x0[8], x1[8], x2[8], x3[8], x4[8]; bf8_unpack(pX[0], x0); bf8_unpack(pX[1], x1); bf8_unpack(pX[2], x2); bf8_unpack(pX[3], x3); bf8_unpack(pX[4], x4);
          const float wt0 = __expf(acs_last - acs[tx]) * dtv[tx], wt1 = __expf(acs_last - acs[tx + 1]) * dtv[tx + 1];
#pragma unroll
          for (int j = 0; j < 8; ++j) { const float w0_ = cwl[j], w1_ = cwl[8 + j], w2_ = cwl[16 + j], w3_ = cwl[24 + j], bb_ = cwl[32 + j];
              const float o0 = fsilu(bb_ + w0_ * x0[j] + w1_ * x1[j] + w2_ * x2[j] + w3_ * x3[j]), o1 = fsilu(bb_ + w0_ * x1[j] + w1_ * x2[j] + w2_ * x3[j] + w3_ * x4[j]);
              *(LAS unsigned*)(lds + L_XT + (pc * 8 + j) * STR + tx * 2) = pk2(o0, o1); *(LAS unsigned*)(lds + L_XWT + (pc * 8 + j) * STR + tx * 2) = pk2(o0 * wt0, o1 * wt1); } }
        { const int i = 16 * w + fr; const float ai = acs[i];
#pragma unroll
          for (int jt = 0; jt < 8; ++jt) { const int j0 = 16 * jt + 4 * fq; const f32x4 aj = *(const LAS f32x4*)(lds + L_ACS + j0 * 4), dj = *(const LAS f32x4*)(lds + L_DTV + j0 * 4); float gv[4];
              const float cbv[4] = {__uint_as_float(pCB[jt].x << 16), __uint_as_float(pCB[jt].x & 0xffff0000u), __uint_as_float(pCB[jt].y << 16), __uint_as_float(pCB[jt].y & 0xffff0000u)};
#pragma unroll
              for (int e = 0; e < 4; ++e) gv[e] = (j0 + e <= i) ? cbv[e] * __expf(ai - aj[e]) * dj[e] : 0.f;
              u32x2 o; o.x = pk2(gv[0], gv[1]); o.y = pk2(gv[2], gv[3]); *(LAS u32x2*)(lds + L_G + i * STR + j0 * 2) = o; } }
        if (c + 1 < SEQ / CL) prefetch(c + 1);
        __syncthreads();
        QT(qt_s34);
        { pg8::bf16x8 Gf[4], Cf[4];
#pragma unroll
          for (int ks = 0; ks < 4; ++ks) { Gf[ks] = *(const LAS pg8::bf16x8*)(lds + L_G + (16 * w + fr) * STR + ks * 64 + fq * 16); Cf[ks] = *(const LAS pg8::bf16x8*)(lds + L_C + (16 * w + fr) * STR + ks * 64 + fq * 16); }
          const int i = 16 * w + fr; const float ei = __expf(acs[i]);
#pragma unroll
          for (int pt = 0; pt < 4; ++pt) { pg8::f32x4 ay = {0.f, 0.f, 0.f, 0.f}, ao = {0.f, 0.f, 0.f, 0.f};
#pragma unroll
              for (int ks = 0; ks < 4; ++ks) { const pg8::bf16x8 xf = *(const LAS pg8::bf16x8*)(lds + L_XT + (16 * pt + fr) * STR + ks * 64 + fq * 16), sf = *(const LAS pg8::bf16x8*)(lds + L_SB + (16 * pt + fr) * STR + ks * 64 + fq * 16);
                  ay = __builtin_amdgcn_mfma_f32_16x16x32_bf16(xf, Gf[ks], ay, 0, 0, 0); ao = __builtin_amdgcn_mfma_f32_16x16x32_bf16(sf, Cf[ks], ao, 0, 0, 0); }
              float yv[4];
#pragma unroll
              for (int e = 0; e < 4; ++e) { const int p = 16 * pt + 4 * fq + e; yv[e] = ay[e] + ei * ao[e] + dskip * bf2f(*(const LAS bf16_t*)(lds + L_XT + p * STR + i * 2)); }
              u32x2 o; o.x = pk2(yv[0], yv[1]); o.y = pk2(yv[2], yv[3]); *(u32x2*)(I.YS + (rowc + i) * D + h * P_SSD + 16 * pt + 4 * fq) = o; } }
        QT(qt_s5);
        { pg8::bf16x8 Xf[4];
#pragma unroll
          for (int ks = 0; ks < 4; ++ks) Xf[ks] = *(const LAS pg8::bf16x8*)(lds + L_XWT + (16 * (w & 3) + fr) * STR + ks * 64 + fq * 16);
          const float dec = __expf(acs_last);
#pragma unroll
          for (int nt = 0; nt < 4; ++nt) { pg8::f32x4 as_ = {0.f, 0.f, 0.f, 0.f};
#pragma unroll
              for (int ks = 0; ks < 4; ++ks) { const pg8::bf16x8 bf_ = *(const LAS pg8::bf16x8*)(lds + L_BT + (64 * (w >> 2) + 16 * nt + fr) * STR + ks * 64 + fq * 16); as_ = __builtin_amdgcn_mfma_f32_16x16x32_bf16(bf_, Xf[ks], as_, 0, 0, 0); }
              S[nt] = S[nt] * dec + as_; } }
        __syncthreads();
#pragma unroll
        for (int nt = 0; nt < 4; ++nt) { u32x2 o; o.x = pk2(S[nt][0], S[nt][1]); o.y = pk2(S[nt][2], S[nt][3]); *(LAS u32x2*)(lds + L_SB + (16 * (w & 3) + fr) * STR + (64 * (w >> 2) + 16 * nt + 4 * fq) * 2) = o; }
        QT(qt_s67);
    }
#ifdef PROF
    if (blockIdx.x == 0 && tid == 0) { const float tot = (float)(PROF_T() - qt_tot0); I.prof[8] = (float)qt_s1 / tot; I.prof[9] = (float)qt_s2 / tot; I.prof[10] = (float)qt_s34 / tot; I.prof[11] = (float)qt_s5 / tot; I.prof[12] = (float)qt_s67 / tot; I.prof[13] = tot * 1e-6f; }
#endif
#pragma unroll
    for (int nt = 0; nt < 4; ++nt) *(f32x4*)(I.state_out + (((size_t)b * H_SSD + h) * P_SSD + 16 * (w & 3) + fr) * N_SSD + 64 * (w >> 2) + 16 * nt + 4 * fq) = (f32x4){S[nt][0], S[nt][1], S[nt][2], S[nt][3]};
    __syncthreads();
}
struct SsdSIn { const bf16_t* PXBC; const float *state_conv, *state_ssm, *DT, *conv_w, *conv_b, *dt_bias, *a_log, *d_skip; bf16_t* YS; float* state_out; };
__device__ __forceinline__ void ssd_sample_unit(const SsdSIn& I, int s, int h, int lane) {
    static_assert(P_SSD == 64 && N_SSD == 128 && CONV_K == 4, "ssd_sample_unit shapes");
    const size_t row = (size_t)MP + s; const int g = h / (H_SSD / G_SSD);
    auto conv1 = [&](int ch) { float a = I.conv_b[ch];
#pragma unroll
        for (int i = 0; i < 3; ++i) a = fmaf(I.conv_w[(size_t)i * CONV_DIM + ch], I.state_conv[((size_t)s * 3 + i) * CONV_DIM + ch], a);
        a = fmaf(I.conv_w[(size_t)3 * CONV_DIM + ch], bf2f(I.PXBC[row * CONV_DIM + ch]), a); return siluf(a); };
    const int half = lane >> 5, j = lane & 31;
    const float* Sg = I.state_ssm + ((size_t)s * H_SSD + h) * P_SSD * N_SSD + lane * 4; float* So = I.state_out + ((size_t)s * H_SSD + h) * P_SSD * N_SSD + lane * 4;
    f32x4 v[32];
#pragma unroll
    for (int q = 0; q < 32; ++q) v[q] = *(const f32x4*)(Sg + q * 256);
    const int chs[5] = {h * P_SSD + lane, D + g * N_SSD + lane, D + g * N_SSD + 64 + lane, D + G_SSD * N_SSD + g * N_SSD + lane, D + G_SSD * N_SSD + g * N_SSD + 64 + lane};
    float cw_[5][4], cs_[5][3], cb_[5]; bf16_t px_[5];
#pragma unroll
    for (int q = 0; q < 5; ++q) { cb_[q] = I.conv_b[chs[q]]; px_[q] = I.PXBC[row * CONV_DIM + chs[q]];
#pragma unroll
        for (int i = 0; i < 4; ++i) cw_[q][i] = I.conv_w[(size_t)i * CONV_DIM + chs[q]];
#pragma unroll
        for (int i = 0; i < 3; ++i) cs_[q][i] = I.state_conv[((size_t)s * 3 + i) * CONV_DIM + chs[q]]; }
    const float dtr = I.DT[row * H_SSD + h], dtb = I.dt_bias[h], alg = I.a_log[h], dsk = I.d_skip[h];
    auto convq = [&](int q) { float a = cb_[q]; a = fmaf(cw_[q][0], cs_[q][0], a); a = fmaf(cw_[q][1], cs_[q][1], a); a = fmaf(cw_[q][2], cs_[q][2], a); a = fmaf(cw_[q][3], bf2f(px_[q]), a); return siluf(a); };
    const float x = convq(0), b0 = convq(1), b1 = convq(2), c0 = convq(3), c1 = convq(4);
    const float dt = softplusf(dtr + dtb), dA = expf(dt * -expf(alg)), dtx = dt * x;
    float Bn[4], Cn[4];
#pragma unroll
    for (int e = 0; e < 4; ++e) { const int src = (4 * j + e) & 63; const float bl = __shfl(b0, src), bh = __shfl(b1, src), cl = __shfl(c0, src), chh = __shfl(c1, src); Bn[e] = j < 16 ? bl : bh; Cn[e] = j < 16 ? cl : chh; }
    float yv = 0.f;
#pragma unroll
    for (int q = 0; q < 32; ++q) { const float xs0 = __uint_as_float(__builtin_amdgcn_readlane(__float_as_uint(dtx), 2 * q)), xs1 = __uint_as_float(__builtin_amdgcn_readlane(__float_as_uint(dtx), 2 * q + 1)), xs = half ? xs1 : xs0;
        float part = 0.f;
#pragma unroll
        for (int e = 0; e < 4; ++e) { const float sv = fmaf(v[q][e], dA, xs * Bn[e]); v[q][e] = sv; part = fmaf(Cn[e], sv, part); }
        part = rowsum16f(part); part += __shfl_xor(part, 16); yv = j == q ? part : yv; }
#pragma unroll
    for (int q = 0; q < 32; ++q) *(f32x4*)(So + q * 256) = v[q];
    { const int p = 2 * j + half; const float xp = __shfl(x, p); I.YS[row * D + h * P_SSD + p] = f2bf(yv + dsk * xp); }
}

__device__ __forceinline__ unsigned ford(float f) { const unsigned u = __float_as_uint(f); return u ^ ((u >> 31) ? 0xFFFFFFFFu : 0x80000000u); }
__device__ __forceinline__ float funord(unsigned u) { return __uint_as_float((u & 0x80000000u) ? (u ^ 0x80000000u) : ~u); }
__device__ __forceinline__ unsigned rowmax16u(unsigned v) {
    v = max(v, (unsigned)__builtin_amdgcn_update_dpp(0, (int)v, 0xB1, 0xF, 0xF, true));
    v = max(v, (unsigned)__builtin_amdgcn_update_dpp(0, (int)v, 0x4E, 0xF, 0xF, true));
    v = max(v, (unsigned)__builtin_amdgcn_update_dpp(0, (int)v, 0x141, 0xF, 0xF, true));
    v = max(v, (unsigned)__builtin_amdgcn_update_dpp(0, (int)v, 0x140, 0xF, 0xF, true));
    return v;
}
#define CEX(a, b) do { const unsigned hi_ = max(a, b), lo_ = min(a, b); a = hi_; b = lo_; } while (0)
__device__ __forceinline__ unsigned top16_of_128(unsigned (&k)[8], int fr) {
    CEX(k[0], k[1]); CEX(k[2], k[3]); CEX(k[4], k[5]); CEX(k[6], k[7]);
    CEX(k[0], k[2]); CEX(k[1], k[3]); CEX(k[4], k[6]); CEX(k[5], k[7]);
    CEX(k[1], k[2]); CEX(k[5], k[6]);
    CEX(k[0], k[4]); CEX(k[1], k[5]); CEX(k[2], k[6]); CEX(k[3], k[7]);
    CEX(k[2], k[4]); CEX(k[3], k[5]);
    CEX(k[1], k[2]); CEX(k[3], k[4]); CEX(k[5], k[6]);
    unsigned mine = 0u;
#pragma unroll
    for (int it = 0; it < 16; ++it) { const unsigned m = rowmax16u(k[0]); const bool win = k[0] == m;
        k[0] = win ? k[1] : k[0]; k[1] = win ? k[2] : k[1]; k[2] = win ? k[3] : k[2]; k[3] = win ? k[4] : k[3]; k[4] = win ? k[5] : k[4]; k[5] = win ? k[6] : k[5]; k[6] = win ? k[7] : k[6]; k[7] = win ? 0u : k[7];
        mine = fr == it ? m : mine; }
    return mine;
}
struct TopkIn { const bf16_t* PQ; const bf16_t* SKB; int* IDX; float* GATE; };
__device__ __forceinline__ void peer_topk_unit(const TopkIn& I, int tg, int h, int lane) {
    static_assert(N_KEYS == 128 && PEER_HALF == 128 && PEER_TOPK == 16, "peer_topk_unit shapes");
    const int fr = lane & 15, fq = lane >> 4, t0 = tg * 16;
    unsigned sel[2][4];
#pragma unroll
    for (int c = 0; c < 2; ++c) {
        pg8::bf16x8 qf[4];
#pragma unroll
        for (int ks = 0; ks < 4; ++ks) qf[ks] = *(const pg8::bf16x8*)(I.PQ + (size_t)(t0 + fr) * NPQ + h * PEER_DKEY + c * PEER_HALF + ks * 32 + fq * 8);
        pg8::f32x4 acc[8];
        const bf16_t* kb = I.SKB + ((size_t)(h * 2 + c) * N_KEYS) * PEER_HALF;
#pragma unroll
        for (int nt = 0; nt < 8; ++nt) { acc[nt] = (pg8::f32x4){0.f, 0.f, 0.f, 0.f};
#pragma unroll
            for (int ks = 0; ks < 4; ++ks) { const pg8::bf16x8 kf = *(const pg8::bf16x8*)(kb + (size_t)(nt * 16 + fr) * PEER_HALF + ks * 32 + fq * 8); acc[nt] = __builtin_amdgcn_mfma_f32_16x16x32_bf16(qf[ks], kf, acc[nt], 0, 0, 0); } }
#pragma unroll
        for (int g = 0; g < 4; ++g) { unsigned k[8];
#pragma unroll
            for (int nt = 0; nt < 8; ++nt) k[nt] = (ford(acc[nt][g]) & ~127u) | (unsigned)(127 - (nt * 16 + fr));
            sel[c][g] = top16_of_128(k, fr); }
    }
    const int base = lane & 48;
#pragma unroll
    for (int g = 0; g < 4; ++g) { const int row = t0 + 4 * fq + g;
        const float s1 = funord(sel[0][g] & ~127u), s2 = funord(sel[1][g] & ~127u); const int i1 = 127 - (int)(sel[0][g] & 127u), i2 = 127 - (int)(sel[1][g] & 127u);
        int p = 0; unsigned key = (ford(s1 + __shfl(s2, base)) & ~255u) | (unsigned)(255 - fr * 16); unsigned mine = 0u;
#pragma unroll
        for (int it = 0; it < 16; ++it) { const unsigned m = rowmax16u(key); const bool win = key == m; const int np = p + (win ? 1 : 0);
            const float s2n = __shfl(s2, base + (np < 16 ? np : 15));
            const unsigned nk = np < 16 ? ((ford(s1 + s2n) & ~255u) | (unsigned)(255 - (fr * 16 + np))) : 0u;
            key = win ? nk : key; p = np; mine = fr == it ? m : mine; }
        const int pos = 255 - (int)(mine & 255u), a = pos >> 4, bb = pos & 15; const float ts = funord(mine & ~255u);
        const int e1 = __shfl(i1, base + a), e2 = __shfl(i2, base + bb);
        const float mx = funord(rowmax16u(ford(ts))); const float ex = __expf(ts - mx); const float sm = rowsum16(ex);
        if (row < MT) { I.IDX[(size_t)row * NSEL + h * PEER_TOPK + fr] = e1 * N_KEYS + e2; I.GATE[(size_t)row * NSEL + h * PEER_TOPK + fr] = ex / sm; }
    }
}

typedef float f32x16 __attribute__((ext_vector_type(16)));
namespace at {
constexpr int KSTR = 528, VSTR = 520;
constexpr int L_IMG = 0, L_END = 256 * KSTR;
static_assert(L_END <= LDSCTL_OFF, "attention LDS map");
}
struct AttnIn { const bf16_t* Q; const bf16_t* KVB; const bf16_t* VTB; bf16_t* AO; };
__device__ __forceinline__ void attn_prompt_unit(LAS unsigned char* lds, const AttnIn& I, int b, int h, int tile, int tid) {
    using namespace at;
    static_assert(N_MEM == 256 && MEM_HD == 256 && MEM_HEADS == 4, "attn_prompt_unit shapes");
    const int lane = tid & 63, w = tid >> 6, r = lane & 31, hh = lane >> 5;
    const size_t tok = (size_t)b * SEQ + tile * 256 + w * 32 + r;
    __syncthreads();
    { const bf16_t* kb = I.KVB + (size_t)b * N_MEM * 2 * D + h * MEM_HD;
#pragma unroll 4
      for (int i = 0; i < 16; ++i) { const int pid = tid + 512 * i, row = pid >> 5, pc = pid & 31; *(LAS v4u*)(lds + L_IMG + row * KSTR + pc * 16) = *(const v4u*)(kb + (size_t)row * 2 * D + pc * 8); } }
    pg8::bf16x8 qf[16];
#pragma unroll
    for (int ks = 0; ks < 16; ++ks) qf[ks] = *(const pg8::bf16x8*)(I.Q + tok * D + h * MEM_HD + ks * 16 + hh * 8);
    __syncthreads();
    f32x16 sacc[8];
#pragma unroll
    for (int mt = 0; mt < 8; ++mt) {
#pragma unroll
        for (int e = 0; e < 16; ++e) sacc[mt][e] = 0.f;
#pragma unroll
        for (int ks = 0; ks < 16; ++ks) { const pg8::bf16x8 kf = *(const LAS pg8::bf16x8*)(lds + L_IMG + (mt * 32 + r) * KSTR + ks * 32 + hh * 16); sacc[mt] = __builtin_amdgcn_mfma_f32_32x32x16_bf16(kf, qf[ks], sacc[mt], 0, 0, 0); } }
    float mx = -INFINITY;
#pragma unroll
    for (int mt = 0; mt < 8; ++mt)
#pragma unroll
        for (int e = 0; e < 16; ++e) mx = fmaxf(mx, sacc[mt][e]);
    mx = fmaxf(mx, __shfl_xor(mx, 32));
    const float c = 1.4426950408889634f / 16.0f; float sum = 0.f;
#pragma unroll
    for (int mt = 0; mt < 8; ++mt)
#pragma unroll
        for (int e = 0; e < 16; ++e) { const float p = __builtin_amdgcn_exp2f((sacc[mt][e] - mx) * c); sacc[mt][e] = p; sum += p; }
    sum += __shfl_xor(sum, 32);
    pg8::bf16x8 pf[8][2];
#pragma unroll
    for (int mt = 0; mt < 8; ++mt)
#pragma unroll
        for (int s = 0; s < 2; ++s) { v4u pk;
#pragma unroll
            for (int j = 0; j < 4; ++j) pk[j] = pk2(sacc[mt][8 * s + 2 * j], sacc[mt][8 * s + 2 * j + 1]);
            pf[mt][s] = __builtin_bit_cast(pg8::bf16x8, pk); }
    __syncthreads();
    { const bf16_t* vb = I.VTB + (size_t)(b * MEM_HEADS + h) * MEM_HD * N_MEM;
#pragma unroll 4
      for (int i = 0; i < 16; ++i) { const int pid = tid + 512 * i, row = pid >> 5, pc = pid & 31; const v4u v = *(const v4u*)(vb + (size_t)row * N_MEM + pc * 8);
          u32x2 lo, hi; lo.x = v.x; lo.y = v.y; hi.x = v.z; hi.y = v.w; *(LAS u32x2*)(lds + L_IMG + row * VSTR + pc * 16) = lo; *(LAS u32x2*)(lds + L_IMG + row * VSTR + pc * 16 + 8) = hi; } }
    __syncthreads();
    const float inv = 1.f / sum;
#pragma unroll 1
    for (int dt = 0; dt < 8; ++dt) { f32x16 oacc;
#pragma unroll
        for (int e = 0; e < 16; ++e) oacc[e] = 0.f;
#pragma unroll
        for (int mt = 0; mt < 8; ++mt)
#pragma unroll
            for (int s = 0; s < 2; ++s) { const LAS unsigned char* vp = lds + L_IMG + (dt * 32 + r) * VSTR + (mt * 32 + 16 * s + 4 * hh) * 2;
                const u32x2 lo = *(const LAS u32x2*)vp, hi = *(const LAS u32x2*)(vp + 16); v4u vv; vv.x = lo.x; vv.y = lo.y; vv.z = hi.x; vv.w = hi.y;
                oacc = __builtin_amdgcn_mfma_f32_32x32x16_bf16(__builtin_bit_cast(pg8::bf16x8, vv), pf[mt][s], oacc, 0, 0, 0); }
#pragma unroll
        for (int g = 0; g < 4; ++g) { u32x2 o; o.x = pk2(oacc[4 * g] * inv, oacc[4 * g + 1] * inv); o.y = pk2(oacc[4 * g + 2] * inv, oacc[4 * g + 3] * inv);
            *(u32x2*)(I.AO + tok * D + h * MEM_HD + dt * 32 + 8 * g + 4 * hh) = o; } }
}
struct AttnSIn { const bf16_t* Q; const float* ck; const float* cv; bf16_t* AO; };
__device__ __forceinline__ void attn_sample_block(LAS unsigned char* lds, const AttnSIn& I, int pp, int tid) {
    const int lane = tid & 63, w = tid >> 6, slot = w >> 2, mq = w & 3; const int pair = 2 * pp + slot, s = pair / MEM_HEADS, h = pair % MEM_HEADS;
    LAS float* red = (LAS float*)lds;
    __syncthreads();
    float q[4];
    { const u32x2 qv = *(const u32x2*)(I.Q + ((size_t)MP + s) * D + h * MEM_HD + 4 * lane); q[0] = __uint_as_float(qv.x << 16); q[1] = __uint_as_float(qv.x & 0xffff0000u); q[2] = __uint_as_float(qv.y << 16); q[3] = __uint_as_float(qv.y & 0xffff0000u); }
    const float* kb = I.ck + (((size_t)s * N_MEM + mq * 64) * MEM_HEADS + h) * MEM_HD + 4 * lane; const float* vb = I.cv + (((size_t)s * N_MEM + mq * 64) * MEM_HEADS + h) * MEM_HD + 4 * lane;
    float sc = 0.f;
#pragma unroll 1
    for (int m0 = 0; m0 < 64; m0 += 16) { f32x4 kr[16];
#pragma unroll
        for (int i = 0; i < 16; ++i) kr[i] = *(const f32x4*)(kb + (size_t)(m0 + i) * D);
#pragma unroll
        for (int i = 0; i < 16; ++i) { const float d = wave_sum((kr[i].x * q[0] + kr[i].y * q[1]) + (kr[i].z * q[2] + kr[i].w * q[3])); sc = lane == m0 + i ? d : sc; } }
    sc *= 1.f / 16.f;
    const float wm = wave_max(sc); if (lane == 0) red[slot * 4 + mq] = wm;
    __syncthreads();
    const float gm = fmaxf(fmaxf(red[slot * 4], red[slot * 4 + 1]), fmaxf(red[slot * 4 + 2], red[slot * 4 + 3]));
    const float e = __expf(sc - gm); const float wsum = wave_sum(e); if (lane == 0) red[8 + slot * 4 + mq] = wsum;
    f32x4 o = {0.f, 0.f, 0.f, 0.f};
#pragma unroll 1
    for (int m0 = 0; m0 < 64; m0 += 16) { f32x4 vr[16];
#pragma unroll
        for (int i = 0; i < 16; ++i) vr[i] = *(const f32x4*)(vb + (size_t)(m0 + i) * D);
#pragma unroll
        for (int i = 0; i < 16; ++i) { const float p = __uint_as_float(__builtin_amdgcn_readlane(__float_as_uint(e), m0 + i)); o += vr[i] * p; } }
    *(LAS f32x4*)(lds + 64 + ((slot * 4 + mq) * 256 + 4 * lane) * 4) = o;
    __syncthreads();
    if (mq == 0) { const float gs = (red[8 + slot * 4] + red[8 + slot * 4 + 1]) + (red[8 + slot * 4 + 2] + red[8 + slot * 4 + 3]); f32x4 t = o;
#pragma unroll
        for (int k = 1; k < 4; ++k) t += *(const LAS f32x4*)(lds + 64 + ((slot * 4 + k) * 256 + 4 * lane) * 4);
        const float inv = 1.f / gs; u32x2 ov; ov.x = pk2(t.x * inv, t.y * inv); ov.y = pk2(t.z * inv, t.w * inv);
        *(u32x2*)(I.AO + ((size_t)MP + s) * D + h * MEM_HD + 4 * lane) = ov; }
}

namespace rp {
constexpr int CH = 64;
constexpr int L_W2H = 0, L_A2H = 9216, L_CST = 18432, L_MU = 19712, L_KK = 20992, L_KB = 29184, L_KH = 37376, L_RR = 45568, L_E = 53760, L_VV = 70144, L_AW = 78336, L_AA = 87552, L_RAW = 96768,
              L_END = L_RAW + (CH + 1) * 640;
constexpr int L_Q = L_END;
static_assert(L_Q + 4 * 1088 * 4 <= LDSCTL_OFF, "rwkv prep LDS map (Q)");
constexpr int L_NM = L_AW;
constexpr int L_AH = L_RAW, L_BH = L_RAW + 9216, L_KH2 = L_RAW + 18432, L_RH = L_RAW + 27648;
static_assert(L_END <= LDSCTL_OFF && 16384 <= 18432 && 36864 <= (CH + 1) * 640, "rwkv prep LDS map");
constexpr int NPIECE = (CH + 1) * 40;
constexpr int S_AR = 0, S_BT = 4096, S_KT = 6144, S_W1T = 8192, S_N2T = 8704, S_M2T = 9216, S_G = 9728, S_VT = 10240, SLOT = 12288;
constexpr int NCHUNK = SEQ / 16;
}
struct RwkSlots { unsigned char* r1; };
__device__ __forceinline__ unsigned char* rwk_slot(const RwkSlots& R, int s) { return R.r1 + (size_t)s * rp::SLOT; }
__device__ __forceinline__ RwkSlots rwk_slots(unsigned char* ws, float* out) {
    static_assert((size_t)BATCH * H_RWKV * rp::NCHUNK * rp::SLOT <= O_T1END - O_RWK, "rwkv slot space");
    RwkSlots R; R.r1 = ws + O_RWK; (void)out; return R; }
struct RwkPIn { const bf16_t* PRW; const bf16_t* LW2; const bf16_t* LA2; const float *mu, *w0, *a0, *k_k, *k_a, *r_k; float* BON; RwkSlots slots; float* prof; };
__device__ __forceinline__ void rwkv_prep_units(LAS unsigned char* lds, const RwkPIn& I, int h, int u0, int ustep, int nunits, int tid) {
    using namespace rp;
    static_assert(D == 1024 && HK == 64 && W_RANK == 64 && A_RANK == 64 && SEQ % CH == 0, "rwkv_prep shapes");
    const int lane = tid & 63, w = tid >> 6;
    v4u G[6];
    auto issue_loads = [&](int u) { const int b = u / (SEQ / CH), grp = u % (SEQ / CH); const size_t row0 = (size_t)b * SEQ;
#pragma unroll
        for (int i = 0; i < 6; ++i) { const int pid = tid + 512 * i; v4u z = {0u, 0u, 0u, 0u}; G[i] = z;
            if (pid < NPIECE) { const int rr = pid / 40, sp = pid % 40, sg = sp >> 3, pc = sp & 7; const int t = grp * CH + rr - 1;
                const int col = (sg == 0 ? h * HK : sg == 1 ? D + h * HK : sg == 2 ? 2 * D + h * HK : sg == 3 ? 3 * D : 3 * D + W_RANK) + pc * 8;
                if (t >= 0) G[i] = *(const v4u*)(I.PRW + (row0 + t) * RWKV_PROJ + col); } }
    };
    if (u0 < nunits) issue_loads(u0);
    __syncthreads();
    { const int row = tid >> 3, pc = tid & 7;
      *(LAS v4u*)(lds + L_W2H + row * 144 + pc * 16) = *(const v4u*)(I.LW2 + (size_t)(h * HK + row) * W_RANK + pc * 8);
      *(LAS v4u*)(lds + L_A2H + row * 144 + pc * 16) = *(const v4u*)(I.LA2 + (size_t)(h * HK + row) * A_RANK + pc * 8); }
    if (tid < 320) { const int s = tid >> 6, c = tid & 63; const int gc = (s == 0 ? h * HK : s == 1 ? D + h * HK : s == 2 ? 2 * D + h * HK : s == 3 ? 3 * D : 3 * D + W_RANK) + c;
        ((LAS float*)(lds + L_MU))[tid] = I.mu[gc];
        const float* src = s == 0 ? I.w0 : s == 1 ? I.a0 : s == 2 ? I.k_k : s == 3 ? I.k_a : I.r_k;
        ((LAS float*)(lds + L_CST))[tid] = src[h * HK + c]; }
#ifdef PROF
    unsigned long long rt_[6] = {0, 0, 0, 0, 0, 0}, rt_tot0 = PROF_T(), rt_a;
#define RT(k) do { const unsigned long long n_ = PROF_T(); rt_[k] += n_ - rt_a; rt_a = n_; } while (0)
#else
#define RT(k) do { } while (0)
#endif
#pragma unroll 1
    for (int u = u0; u < nunits; u += ustep) {
        const int b = u / (SEQ / CH), grp = u % (SEQ / CH); const size_t row0 = (size_t)b * SEQ;
        __syncthreads();
#pragma unroll
        for (int i = 0; i < 6; ++i) { const int pid = tid + 512 * i; if (pid < NPIECE) { const int rr_ = pid / 40, sp = pid % 40; *(LAS v4u*)(lds + L_RAW + rr_ * 640 + sp * 16) = G[i]; } }
        __syncthreads();
        if (u + ustep < nunits) issue_loads(u + ustep);
#ifdef PROF
        rt_a = PROF_T();
#endif
#pragma unroll
        for (int sg = 0; sg < 5; ++sg) {
#pragma unroll
          for (int it = 0; it < 2; ++it) { const int e = tid + 512 * it; const int t = e >> 4, cc = (e & 15) * 4, col = sg * 64 + cc;
            const u32x2 cur = *(const LAS u32x2*)(lds + L_RAW + (t + 1) * 640 + col * 2), prv = *(const LAS u32x2*)(lds + L_RAW + t * 640 + col * 2);
            const f32x4 m4 = *(const LAS f32x4*)(lds + L_MU + col * 4);
            float x[4];
            { const float c0 = __uint_as_float(cur.x << 16), c1 = __uint_as_float(cur.x & 0xffff0000u), c2 = __uint_as_float(cur.y << 16), c3 = __uint_as_float(cur.y & 0xffff0000u);
              const float p0 = __uint_as_float(prv.x << 16), p1 = __uint_as_float(prv.x & 0xffff0000u), p2 = __uint_as_float(prv.y << 16), p3 = __uint_as_float(prv.y & 0xffff0000u);
              x[0] = c0 + (p0 - c0) * m4.x; x[1] = c1 + (p1 - c1) * m4.y; x[2] = c2 + (p2 - c2) * m4.z; x[3] = c3 + (p3 - c3) * m4.w; }
            if (sg == 0) { u32x2 o; o.x = pkh2(x[0], x[1]); o.y = pkh2(x[2], x[3]); *(LAS u32x2*)(lds + L_RR + t * 128 + cc * 2) = o; }
            else if (sg == 1) { u32x2 o; o.x = pkh2(x[0], x[1]); o.y = pkh2(x[2], x[3]); *(LAS u32x2*)(lds + L_KH + t * 128 + cc * 2) = o; }
            else if (sg == 2) { u32x2 o; o.x = pk2(x[0], x[1]); o.y = pk2(x[2], x[3]); *(LAS u32x2*)(lds + L_VV + t * 128 + cc * 2) = o; }
            else if (sg == 3) { u32x2 o;
#pragma unroll
                for (int j = 0; j < 4; ++j) x[j] = 1.f - 2.f * __builtin_amdgcn_rcpf(__expf(2.f * x[j]) + 1.f);
                o.x = pk2(x[0], x[1]); o.y = pk2(x[2], x[3]); *(LAS u32x2*)(lds + L_AW + t * 144 + cc * 2) = o; }
            else { u32x2 o; o.x = pk2(x[0], x[1]); o.y = pk2(x[2], x[3]); *(LAS u32x2*)(lds + L_AA + t * 144 + cc * 2) = o; }
          } }
        __syncthreads();
        RT(0);
        { const int role = w >> 2, tt = w & 3, fr = lane & 15, fq = lane >> 4;
          const LAS unsigned char* Aimg = lds + (role ? L_AA : L_AW); const LAS unsigned char* Wimg = lds + (role ? L_A2H : L_W2H);
          pg8::f32x4 acc[4];
#pragma unroll
          for (int nt = 0; nt < 4; ++nt) { acc[nt] = (pg8::f32x4){0.f, 0.f, 0.f, 0.f};
#pragma unroll
              for (int ks = 0; ks < 2; ++ks) { const pg8::bf16x8 af = *(const LAS pg8::bf16x8*)(Aimg + (tt * 16 + fr) * 144 + ks * 64 + fq * 16), bfr = *(const LAS pg8::bf16x8*)(Wimg + (nt * 16 + fr) * 144 + ks * 64 + fq * 16);
                  acc[nt] = __builtin_amdgcn_mfma_f32_16x16x32_bf16(af, bfr, acc[nt], 0, 0, 0); } }
          const LAS float* cst = (const LAS float*)(lds + L_CST);
          if (role == 0) {
#pragma unroll
              for (int nt = 0; nt < 4; ++nt) { const int ch = nt * 16 + fr; const float w0 = cst[ch];
#pragma unroll
                  for (int g = 0; g < 4; ++g) { const int t = tt * 16 + fq * 4 + g; ((LAS float*)(lds + L_E))[t * 64 + ch] = 0.6065306597f * fsigmoid(w0 + acc[nt][g]); } }
          } else {
              float kkr[4][4], ag[4][4], ss[4] = {0.f, 0.f, 0.f, 0.f}, bon[4] = {0.f, 0.f, 0.f, 0.f};
#pragma unroll
              for (int nt = 0; nt < 4; ++nt) { const int ch = nt * 16 + fr; const float a0 = cst[64 + ch], kk_ = cst[128 + ch], ka = cst[192 + ch], rk = cst[256 + ch];
#pragma unroll
                  for (int g = 0; g < 4; ++g) { const int t = tt * 16 + fq * 4 + g; const float a = fsigmoid(a0 + acc[nt][g]); const float k = (float)((const LAS _Float16*)(lds + L_KH))[t * 64 + ch];
                      const float kh = k * (1.f + (a - 1.f) * ka), kq = k * kk_; ag[nt][g] = a; kkr[nt][g] = kq; ss[g] += kq * kq;
                      bon[g] += (float)((const LAS _Float16*)(lds + L_RR))[t * 64 + ch] * kh * rk;
                      ((LAS _Float16*)(lds + L_KH))[t * 64 + ch] = (_Float16)kh; } }
#pragma unroll
              for (int g = 0; g < 4; ++g) { ss[g] = rowsum16(ss[g]); bon[g] = rowsum16(bon[g]); const float inv = 1.f / sqrtf(fmaxf(ss[g], 1e-24f)); const int t = tt * 16 + fq * 4 + g;
#pragma unroll
                  for (int nt = 0; nt < 4; ++nt) { const int ch = nt * 16 + fr; const float kk = kkr[nt][g] * inv; ((LAS _Float16*)(lds + L_KK))[t * 64 + ch] = (_Float16)kk; ((LAS _Float16*)(lds + L_KB))[t * 64 + ch] = (_Float16)(kk * ag[nt][g]); }
                  if (fr == 0) I.BON[(row0 + (size_t)grp * CH + t) * H_RWKV + h] = bon[g]; }
          } }
        __syncthreads();
        RT(1);
        { const int sc = tid >> 7, h8 = (tid >> 6) & 1, k = tid & 63; float ecum = 0.f;
            if (h8) {
#pragma unroll
                for (int t = 0; t < 8; ++t) ecum += ((const LAS float*)(lds + L_E))[(sc * 16 + t) * 64 + k]; }
            float g = __expf(-ecum);
#pragma unroll 4
            for (int t8 = 0; t8 < 8; ++t8) { const int tt = sc * 16 + h8 * 8 + t8; const float gm1 = g; ecum += ((const LAS float*)(lds + L_E))[tt * 64 + k]; g = __expf(-ecum); const float gi = __expf(ecum);
                const float kk = (float)((const LAS _Float16*)(lds + L_KK))[tt * 64 + k], kb = (float)((const LAS _Float16*)(lds + L_KB))[tt * 64 + k], kh = (float)((const LAS _Float16*)(lds + L_KH))[tt * 64 + k], rr = (float)((const LAS _Float16*)(lds + L_RR))[tt * 64 + k];
                *(LAS bf16_t*)(lds + L_AH + tt * 144 + k * 2) = f2bf(-kk * gm1); *(LAS bf16_t*)(lds + L_BH + tt * 144 + k * 2) = f2bf(kb * gi);
                *(LAS bf16_t*)(lds + L_KH2 + tt * 144 + k * 2) = f2bf(kh * gi); *(LAS bf16_t*)(lds + L_RH + tt * 144 + k * 2) = f2bf(rr * g); }
            if (h8) { const int slot = (grp * 4 + sc) * (BATCH * H_RWKV) + b * H_RWKV + h; *(float*)(rwk_slot(I.slots, slot) + S_G + k * 4) = g; } }
        __syncthreads();
        RT(2);
        { const int sc = w >> 1, par = w & 1, fr = lane & 15, fq = lane >> 4; const LAS unsigned char* Ximg = lds + (par ? L_KH2 : L_BH);
          pg8::f32x4 accA = {0.f, 0.f, 0.f, 0.f}, accR = {0.f, 0.f, 0.f, 0.f};
#pragma unroll
          for (int ks = 0; ks < 2; ++ks) { const pg8::bf16x8 xf = *(const LAS pg8::bf16x8*)(Ximg + (sc * 16 + fr) * 144 + ks * 64 + fq * 16), af = *(const LAS pg8::bf16x8*)(lds + L_AH + (sc * 16 + fr) * 144 + ks * 64 + fq * 16), rf = *(const LAS pg8::bf16x8*)(lds + L_RH + (sc * 16 + fr) * 144 + ks * 64 + fq * 16);
              accA = __builtin_amdgcn_mfma_f32_16x16x32_bf16(xf, af, accA, 0, 0, 0); accR = __builtin_amdgcn_mfma_f32_16x16x32_bf16(xf, rf, accR, 0, 0, 0); }
          LAS float* nm = (LAS float*)(lds + L_NM) + sc * 1024;
#pragma unroll
          for (int g = 0; g < 4; ++g) { const int j = 4 * fq + g; nm[(par ? 256 : 0) + j * 16 + fr] = j < fr ? accA[g] : 0.f; nm[(par ? 768 : 512) + j * 16 + fr] = j <= fr ? accR[g] : 0.f; } }
        __syncthreads();
        RT(3);
        const int slot0 = (grp * 4) * (BATCH * H_RWKV) + b * H_RWKV + h; const LAS float* nmb = (const LAS float*)(lds + L_NM);
        auto emit = [&](int sc, int r) { unsigned char* sp = rwk_slot(I.slots, slot0 + sc * (BATCH * H_RWKV)); const LAS float* nm = nmb + sc * 1024; v4u o;
              if (r < 256) {
                  const int g8 = r >> 5, m = r & 31, l0 = 2 * m, i = l0 & 31, hh = l0 >> 5, ko = 32 * (g8 >> 2) + 16 * ((g8 >> 1) & 1) + 8 * (g8 & 1) + 4 * hh;
                  const LAS unsigned char* r0 = lds + (i < 16 ? L_AH : L_RH) + (sc * 16 + (i & 15)) * 144 + ko * 2; const LAS unsigned char* r1 = lds + (i + 1 < 16 ? L_AH : L_RH) + (sc * 16 + ((i + 1) & 15)) * 144 + ko * 2;
                  const u32x2 a = *(const LAS u32x2*)r0, c = *(const LAS u32x2*)r1; o.x = a.x; o.y = a.y; o.z = c.x; o.w = c.y; *(v4u*)(sp + S_AR + r * 16) = o; }
              else if (r < 384) {
                  const int q = r - 256, gb = q >> 5, m = q & 31, l0 = 2 * m, i = l0 & 31, hh = l0 >> 5, t0 = sc * 16 + 8 * (gb & 1) + 4 * hh, k0 = 32 * (gb >> 1) + i;
#pragma unroll
                  for (int j = 0; j < 2; ++j) { o[j] = (unsigned)*(const LAS bf16_t*)(lds + L_BH + (t0 + 2 * j) * 144 + k0 * 2) | ((unsigned)*(const LAS bf16_t*)(lds + L_BH + (t0 + 2 * j + 1) * 144 + k0 * 2) << 16);
                      o[2 + j] = (unsigned)*(const LAS bf16_t*)(lds + L_BH + (t0 + 2 * j) * 144 + (k0 + 1) * 2) | ((unsigned)*(const LAS bf16_t*)(lds + L_BH + (t0 + 2 * j + 1) * 144 + (k0 + 1) * 2) << 16); }
                  *(v4u*)(sp + S_BT + q * 16) = o; }
              else if (r < 512) {
                  const int q = r - 384, kt = q >> 6, l = q & 63, i = l & 31, hh = l >> 5, k0 = 32 * kt + i, t0 = sc * 16 + 8 * hh;
#pragma unroll
                  for (int j = 0; j < 4; ++j) o[j] = (unsigned)*(const LAS bf16_t*)(lds + L_KH2 + (t0 + 2 * j) * 144 + k0 * 2) | ((unsigned)*(const LAS bf16_t*)(lds + L_KH2 + (t0 + 2 * j + 1) * 144 + k0 * 2) << 16);
                  *(v4u*)(sp + S_KT + q * 16) = o; }
              else if (r < 544) {
                  const int q = r - 512, hh = q >> 4, i = q & 15;
#pragma unroll
                  for (int j = 0; j < 4; ++j) o[j] = pk2(nm[256 + (8 * hh + 2 * j) * 16 + i], nm[256 + (8 * hh + 2 * j + 1) * 16 + i]);
                  *(v4u*)(sp + S_W1T + q * 16) = o; }
              else if (r < 576) {
                  const int q = r - 544, e0 = 2 * q, pc = e0 >> 5, hh = (e0 >> 4) & 1, ii = e0 & 15, j0 = 8 * pc + 4 * hh;
                  o.x = pk2(nm[512 + j0 * 16 + ii], nm[512 + (j0 + 1) * 16 + ii]); o.y = pk2(nm[512 + (j0 + 2) * 16 + ii], nm[512 + (j0 + 3) * 16 + ii]);
                  o.z = pk2(nm[512 + j0 * 16 + ii + 1], nm[512 + (j0 + 1) * 16 + ii + 1]); o.w = pk2(nm[512 + (j0 + 2) * 16 + ii + 1], nm[512 + (j0 + 3) * 16 + ii + 1]);
                  *(v4u*)(sp + S_N2T + q * 16) = o; }
              else if (r < 608) {
                  const int q = r - 576, hh = q >> 4, ii = q & 15;
#pragma unroll
                  for (int j = 0; j < 4; ++j) o[j] = pk2(nm[768 + (8 * hh + 2 * j) * 16 + ii], nm[768 + (8 * hh + 2 * j + 1) * 16 + ii]);
                  *(v4u*)(sp + S_M2T + q * 16) = o; }
              else {
                  const int q = r - 608, i = q & 31, hh = (q >> 5) & 1, hf = q >> 6, v = hf * 32 + i, t0 = sc * 16 + 8 * hh;
#pragma unroll
                  for (int j = 0; j < 4; ++j) o[j] = (unsigned)*(const LAS bf16_t*)(lds + L_VV + (t0 + 2 * j) * 128 + v * 2) | ((unsigned)*(const LAS bf16_t*)(lds + L_VV + (t0 + 2 * j + 1) * 128 + v * 2) << 16);
                  *(v4u*)(sp + S_VT + q * 16) = o; }
        };
        if (w < 4) { const int sc = w; int n = lane & 15, q = lane >> 4; asm volatile("" : "+v"(n), "+v"(q));
            LAS float* nmw = (LAS float*)(lds + L_NM) + sc * 1024; LAS float* X = (LAS float*)(lds + L_Q) + sc * 1088;
            auto mul = [&](const LAS float* A, int sa, bool ia, const LAS float* B, int sb, bool ib) { pg8::f32x4 acc = {0.f, 0.f, 0.f, 0.f};
#pragma unroll
                for (int ks = 0; ks < 4; ++ks) { const int k = 4 * ks + q; float av = A[n * sa + k], bv = B[k * sb + n]; if (ia && n == k) av += 1.f; if (ib && n == k) bv += 1.f; acc = __builtin_amdgcn_mfma_f32_16x16x4f32(av, bv, acc, 0, 0, 0); }
                return acc; };
            auto put = [&](LAS float* C, const pg8::f32x4& acc) {
#pragma unroll
                for (int g = 0; g < 4; ++g) C[(4 * q + g) * 17 + n] = acc[g]; };
            put(X, mul(nmw, 16, false, nmw, 16, false));
            put(X + 272, mul(nmw, 16, true, X, 17, true));
            put(X + 544, mul(X, 17, false, X, 17, false));
            put(X, mul(X + 272, 17, false, X + 544, 17, true));
            put(X + 816, mul(X + 544, 17, false, X + 544, 17, false));
            put(X + 272, mul(X, 17, false, X + 816, 17, true));
            const LAS float* T = X + 272;
#pragma unroll 1
            for (int mt = 0; mt < 5; ++mt) { pg8::f32x4 acc = {0.f, 0.f, 0.f, 0.f};
#pragma unroll
                for (int ks = 0; ks < 4; ++ks) { const int t = 4 * ks + q; const float av = mt < 4 ? bf2f(*(const LAS bf16_t*)(lds + L_AH + (sc * 16 + t) * 144 + (16 * mt + n) * 2)) : nmw[256 + n * 16 + t];
                    acc = __builtin_amdgcn_mfma_f32_16x16x4f32(av, T[t * 17 + n], acc, 0, 0, 0); }
                if (mt < 4) { u32x2 o; o.x = pk2(acc[0], acc[1]); o.y = pk2(acc[2], acc[3]); *(LAS u32x2*)(lds + L_AH + (sc * 16 + n) * 144 + (16 * mt + 4 * q) * 2) = o; }
                else {
#pragma unroll
                    for (int g = 0; g < 4; ++g) nmw[256 + (4 * q + g) * 16 + n] = acc[g]; } }
        } else {
#pragma unroll 1
            for (int idx = tid - 256; idx < 4 * 448; idx += 256) { const int sc = idx / 448, rp_ = idx % 448; emit(sc, rp_ < 256 ? 256 + rp_ : 288 + rp_); }
        }
        __syncthreads();
        RT(4);
#pragma unroll 1
        for (int idx = tid; idx < 4 * 288; idx += NTHREADS) { const int sc = idx / 288, rp_ = idx % 288; emit(sc, rp_ < 256 ? rp_ : 256 + rp_); }
        RT(5);
    }
#ifdef PROF
    if (blockIdx.x == 0 && tid == 0) { const float tot = (float)(PROF_T() - rt_tot0); I.prof[16] = (float)rt_[0] / tot; I.prof[17] = (float)rt_[1] / tot; I.prof[18] = (float)rt_[2] / tot; I.prof[19] = (float)rt_[3] / tot; I.prof[20] = (float)rt_[4] / tot; I.prof[21] = (float)rt_[5] / tot; I.prof[22] = tot * 1e-6f; }
#endif
    __syncthreads();
}
typedef float f32x16s __attribute__((ext_vector_type(16)));
struct RwkFrag { u32x2 ar[2][2][2]; v4u aw; u32x2 an2[2]; v4u am2; u32x2 ab[2][2]; v4u ak[2]; v4u bv; };
struct RwkSIn { RwkSlots slots; bf16_t* YR; float* state_out; float* prof; };
__device__ __forceinline__ pg8::bf16x8 rwk_pack(const f32x16s& x, int s) { v4u p;
#pragma unroll
    for (int j = 0; j < 4; ++j) p[j] = pk2(x[8 * s + 2 * j], x[8 * s + 2 * j + 1]);
    return __builtin_bit_cast(pg8::bf16x8, p); }
__device__ __forceinline__ pg8::bf16x8 rwk_join(const u32x2 a, const u32x2 b) { v4u p; p.x = a.x; p.y = a.y; p.z = b.x; p.w = b.y; return __builtin_bit_cast(pg8::bf16x8, p); }
__device__ __forceinline__ pg8::bf16x8 rwk_pack_asm(const f32x16s& x, int s) {
#ifndef PACK_ASM
    return rwk_pack(x, s);
#endif
    v4u p;
    if (s == 0) asm volatile("s_nop 15\n\ts_nop 3\n\tv_cvt_pk_bf16_f32 %0, %4, %5\n\tv_cvt_pk_bf16_f32 %1, %6, %7\n\tv_cvt_pk_bf16_f32 %2, %8, %9\n\tv_cvt_pk_bf16_f32 %3, %10, %11\n\ts_nop 1" : "=&v"(p[0]), "=&v"(p[1]), "=&v"(p[2]), "=&v"(p[3]) : "v"(x[0]), "v"(x[1]), "v"(x[2]), "v"(x[3]), "v"(x[4]), "v"(x[5]), "v"(x[6]), "v"(x[7]));
    else asm volatile("s_nop 15\n\ts_nop 3\n\tv_cvt_pk_bf16_f32 %0, %4, %5\n\tv_cvt_pk_bf16_f32 %1, %6, %7\n\tv_cvt_pk_bf16_f32 %2, %8, %9\n\tv_cvt_pk_bf16_f32 %3, %10, %11\n\ts_nop 1" : "=&v"(p[0]), "=&v"(p[1]), "=&v"(p[2]), "=&v"(p[3]) : "v"(x[8]), "v"(x[9]), "v"(x[10]), "v"(x[11]), "v"(x[12]), "v"(x[13]), "v"(x[14]), "v"(x[15]));
    return __builtin_bit_cast(pg8::bf16x8, p); }
#ifndef RWK_NL
#define RWK_NL 2
#define RWK_F 3
#define RWK_RING 10
#endif
__device__ __forceinline__ void rwkv_cscan_unit(LAS unsigned char* wl, const RwkSIn& I, int b, int h, int role, unsigned epoch, int lane) {
    using namespace rp;
    __builtin_amdgcn_s_setprio(3);
    const int i = lane & 31, hh = lane >> 5; const size_t row0 = (size_t)b * SEQ; const int slot0 = b * H_RWKV + h;
    const int hf = role & 1;
    f32x16s St[2];
#pragma unroll
    for (int e = 0; e < 16; ++e) { St[0][e] = 0.f; St[1][e] = 0.f; }
    LAS bf16_t* yl = (LAS bf16_t*)wl; LAS unsigned char* ring = wl + 8192 + 64; volatile LAS unsigned* ctl = (volatile LAS unsigned*)(wl + 8192);
    constexpr int RING = RWK_RING, RSZ = 12 * 1024;
#define RWK_DMA(c) do { const unsigned char* sp = rwk_slot(I.slots, slot0 + (c) * (BATCH * H_RWKV)) + lane * 16; LAS unsigned char* rb = ring + ((c) % RING) * RSZ; \
        _Pragma("unroll") for (int p = 0; p < 12; ++p) __builtin_amdgcn_global_load_lds((const unsigned*)(sp + p * 1024), (LAS unsigned*)(rb + p * 1024), 16, 0, 0); } while (0)
#define RWK_WAIT(n) asm volatile("s_waitcnt vmcnt(" #n ")" ::: "memory")
#define RWK_WAITF() do { if (RWK_F == 4) RWK_WAIT(48); else if (RWK_F == 3) RWK_WAIT(36); else if (RWK_F == 2) RWK_WAIT(24); else RWK_WAIT(12); } while (0)
#ifdef PROF
    const unsigned long long ct0 = PROF_T();
#endif
    if (role >= 2) {
        const int l = role - 2; const unsigned epl = epoch / RWK_NL;
#pragma unroll 1
        for (int k = 0; k < NCHUNK / RWK_NL; ++k) { const int c = l + k * RWK_NL;
            if (c >= RING) { unsigned sp_ = 0; while ((ctl[0] < epoch + (unsigned)(c - RING + 1) || ctl[1] < epoch + (unsigned)(c - RING + 1)) && ++sp_ < (1u << 26)) __builtin_amdgcn_s_sleep(1); asm volatile("" ::: "memory"); }
            RWK_DMA(c);
            RWK_WAITF();
            if (k >= RWK_F + 1 && lane == 0) ctl[2 + l] = epl + (unsigned)(k - RWK_F);
        }
        RWK_WAIT(0);
        if (lane == 0) ctl[2 + l] = epl + (unsigned)(NCHUNK / RWK_NL);
        __builtin_amdgcn_s_setprio(0);
        return;
    }
#pragma unroll 1
    for (int c = 0; c < NCHUNK; ++c) {
        { unsigned sp_ = 0; const unsigned need = epoch / RWK_NL + (unsigned)(c / RWK_NL + 1); while (ctl[2 + c % RWK_NL] < need && ++sp_ < (1u << 26)) __builtin_amdgcn_s_sleep(1); }
        asm volatile("s_waitcnt lgkmcnt(0)" ::: "memory");
        __builtin_amdgcn_sched_barrier(0);
        const LAS unsigned char* rb = ring + (c % RING) * RSZ;
        const v4u z4 = {0u, 0u, 0u, 0u}; u32x2 z2; z2.x = 0u; z2.y = 0u;
        const v4u aw = i < 16 ? *(const LAS v4u*)(rb + S_W1T + (hh * 16 + i) * 16) : z4;
        const u32x2 n0 = i >= 16 ? *(const LAS u32x2*)(rb + S_N2T + (hh * 16 + i - 16) * 8) : z2, n1 = i >= 16 ? *(const LAS u32x2*)(rb + S_N2T + (32 + hh * 16 + i - 16) * 8) : z2; const v4u m2 = i >= 16 ? *(const LAS v4u*)(rb + S_M2T + (hh * 16 + i - 16) * 16) : z4;
        const pg8::bf16x8 aAR00 = rwk_join(*(const LAS u32x2*)(rb + S_AR + 0 * 512 + lane * 8), *(const LAS u32x2*)(rb + S_AR + 1 * 512 + lane * 8)), aAR01 = rwk_join(*(const LAS u32x2*)(rb + S_AR + 2 * 512 + lane * 8), *(const LAS u32x2*)(rb + S_AR + 3 * 512 + lane * 8));
        const pg8::bf16x8 aAR10 = rwk_join(*(const LAS u32x2*)(rb + S_AR + 4 * 512 + lane * 8), *(const LAS u32x2*)(rb + S_AR + 5 * 512 + lane * 8)), aAR11 = rwk_join(*(const LAS u32x2*)(rb + S_AR + 6 * 512 + lane * 8), *(const LAS u32x2*)(rb + S_AR + 7 * 512 + lane * 8));
        const pg8::bf16x8 aB0 = rwk_join(*(const LAS u32x2*)(rb + S_BT + 0 * 512 + lane * 8), *(const LAS u32x2*)(rb + S_BT + 1 * 512 + lane * 8)), aB1 = rwk_join(*(const LAS u32x2*)(rb + S_BT + 2 * 512 + lane * 8), *(const LAS u32x2*)(rb + S_BT + 3 * 512 + lane * 8));
        const pg8::bf16x8 aK0 = *(const LAS pg8::bf16x8*)(rb + S_KT + lane * 16), aK1 = *(const LAS pg8::bf16x8*)(rb + S_KT + 1024 + lane * 16);
        f32x4 gm[2][4];
#pragma unroll
        for (int g = 0; g < 4; ++g) { gm[0][g] = *(const LAS f32x4*)(rb + S_G + (8 * g + 4 * hh) * 4); gm[1][g] = *(const LAS f32x4*)(rb + S_G + (32 + 8 * g + 4 * hh) * 4); }
        {
            f32x16s P;
#pragma unroll
            for (int e = 0; e < 16; ++e) P[e] = 0.f;
            P = __builtin_amdgcn_mfma_f32_32x32x16_bf16(aAR00, rwk_pack_asm(St[0], 0), P, 0, 0, 0); P = __builtin_amdgcn_mfma_f32_32x32x16_bf16(aAR10, rwk_pack_asm(St[1], 0), P, 0, 0, 0);
            P = __builtin_amdgcn_mfma_f32_32x32x16_bf16(aAR01, rwk_pack_asm(St[0], 1), P, 0, 0, 0); P = __builtin_amdgcn_mfma_f32_32x32x16_bf16(aAR11, rwk_pack_asm(St[1], 1), P, 0, 0, 0);
            const pg8::bf16x8 bV = *(const LAS pg8::bf16x8*)(rb + S_VT + ((hf * 2 + hh) * 32 + i) * 16);
            P = __builtin_amdgcn_mfma_f32_32x32x16_bf16(__builtin_bit_cast(pg8::bf16x8, aw), bV, P, 0, 0, 0);
            const pg8::bf16x8 bU = rwk_pack_asm(P, 0);
            P = __builtin_amdgcn_mfma_f32_32x32x16_bf16(rwk_join(n0, n1), bU, P, 0, 0, 0); P = __builtin_amdgcn_mfma_f32_32x32x16_bf16(__builtin_bit_cast(pg8::bf16x8, m2), bV, P, 0, 0, 0);
            St[0] = __builtin_amdgcn_mfma_f32_32x32x16_bf16(aB0, bU, St[0], 0, 0, 0); St[0] = __builtin_amdgcn_mfma_f32_32x32x16_bf16(aK0, bV, St[0], 0, 0, 0);
            St[1] = __builtin_amdgcn_mfma_f32_32x32x16_bf16(aB1, bU, St[1], 0, 0, 0); St[1] = __builtin_amdgcn_mfma_f32_32x32x16_bf16(aK1, bV, St[1], 0, 0, 0);
#pragma unroll
            for (int g = 0; g < 4; ++g) { St[0][4 * g] *= gm[0][g].x; St[0][4 * g + 1] *= gm[0][g].y; St[0][4 * g + 2] *= gm[0][g].z; St[0][4 * g + 3] *= gm[0][g].w;
                St[1][4 * g] *= gm[1][g].x; St[1][4 * g + 1] *= gm[1][g].y; St[1][4 * g + 2] *= gm[1][g].z; St[1][4 * g + 3] *= gm[1][g].w; }
            { const pg8::bf16x8 yb = rwk_pack_asm(P, 1); const v4u yv = __builtin_bit_cast(v4u, yb);
#pragma unroll
              for (int j = 0; j < 4; ++j) { const int e0 = 2 * j, t0 = (e0 & 3) + 8 * (e0 >> 2) + 4 * hh; yl[((c & 3) * 16 + t0) * 64 + hf * 32 + i] = (bf16_t)(yv[j] & 0xffffu); yl[((c & 3) * 16 + t0 + 1) * 64 + hf * 32 + i] = (bf16_t)(yv[j] >> 16); } }
        }
        if ((c & 3) == 3) {
#pragma unroll
            for (int q = 0; q < 4; ++q) { const int pid = lane + 64 * q, tt = pid >> 2, part = hf * 4 + (pid & 3); *(v4u*)(I.YR + (row0 + (size_t)(c - 3) * 16 + tt) * D + h * HK + part * 8) = *(const LAS v4u*)(yl + tt * 64 + part * 8); } }
        __builtin_amdgcn_sched_barrier(0);
        asm volatile("s_waitcnt lgkmcnt(0)" ::: "memory"); if (lane == 0) ctl[hf] = epoch + (unsigned)(c + 1);
    }
    RWK_WAIT(0);
#ifdef PROF
    if (b == 0 && h == 0 && lane == 0) { const float tot = (float)(PROF_T() - ct0); I.prof[24] = tot * 1e-6f; }
    if (b == BATCH - 1 && h == H_RWKV - 1 && lane == 0) { const float tot = (float)(PROF_T() - ct0); I.prof[27] = tot * 1e-6f; }
#endif
#undef RWK_DMA
#undef RWK_WAIT
#undef RWK_WAITF
    __builtin_amdgcn_s_setprio(0);
    { float* so = I.state_out + (((size_t)b * H_RWKV + h) * HK + hf * 32 + i) * HK;
#pragma unroll
        for (int g = 0; g < 4; ++g) { *(f32x4*)(so + 8 * g + 4 * hh) = (f32x4){St[0][4 * g], St[0][4 * g + 1], St[0][4 * g + 2], St[0][4 * g + 3]}; *(f32x4*)(so + 32 + 8 * g + 4 * hh) = (f32x4){St[1][4 * g], St[1][4 * g + 1], St[1][4 * g + 2], St[1][4 * g + 3]}; } }
}

template <int NS = 1, class F>
__device__ __forceinline__ void mini_rows_gemm(const bf16_t* A, const bf16_t* Bt, int K, int N, int r0, int bx, int G, int wave, int lane, F&& store) {
    const int fr = lane & 15, fq = lane >> 4;
    for (int s = bx * NS; s < N / 16; s += G * NS) {
        const bf16_t* ap = A + (size_t)(r0 + 16 * wave + fr) * K + 8 * fq; const bf16_t* bp = Bt + (size_t)(16 * s + fr) * K + 8 * fq;
        pg8::f32x4 acc[NS];
#pragma unroll
        for (int q = 0; q < NS; ++q) acc[q] = (pg8::f32x4){0.f, 0.f, 0.f, 0.f};
#pragma unroll (NS == 1 ? 16 : 8)
        for (int ks = 0; ks < K / 32; ++ks) { const pg8::bf16x8 a = *(const pg8::bf16x8*)(ap + 32 * ks);
#pragma unroll
            for (int q = 0; q < NS; ++q) if (s + q < N / 16) { const pg8::bf16x8 b = *(const pg8::bf16x8*)(bp + (size_t)q * 16 * K + 32 * ks); acc[q] = __builtin_amdgcn_mfma_f32_16x16x32_bf16(b, a, acc[q], 0, 0, 0); } }
#pragma unroll
        for (int q = 0; q < NS; ++q) if (s + q < N / 16) store(r0 + 16 * wave + fr, 16 * (s + q) + 4 * fq, acc[q]);
    }
}
template <class F>
__device__ __forceinline__ void mini_rows_gemm_k4(LAS unsigned char* lds, const bf16_t* A, const bf16_t* Bt, int N, int r0, int bx, int G, int tid, F&& store) {
    static_assert(D == 1024 && MS == 128, "mini_rows_gemm_k4 shapes");
    const int wave = tid >> 6, lane = tid & 63, fr = lane & 15, fq = lane >> 4, tib = wave >> 2, kp = wave & 3, ntiles = 8 * (N / 16);
    LAS f32x4* part = (LAS f32x4*)lds;
#pragma unroll 1
    for (int tile0 = bx * 2; tile0 < ntiles; tile0 += G * 2) { const int tile = tile0 + tib; const bool valid = tile < ntiles; const int rt = tile & 7, cs = tile >> 3;
        pg8::f32x4 acc = {0.f, 0.f, 0.f, 0.f};
        if (valid) { const bf16_t* ap = A + (size_t)(r0 + 16 * rt + fr) * D + kp * 256 + 8 * fq; const bf16_t* bp = Bt + (size_t)(16 * cs + fr) * D + kp * 256 + 8 * fq;
            pg8::bf16x8 a[8], b[8];
#pragma unroll
            for (int ks = 0; ks < 8; ++ks) { a[ks] = *(const pg8::bf16x8*)(ap + 32 * ks); b[ks] = *(const pg8::bf16x8*)(bp + 32 * ks); }
#pragma unroll
            for (int ks = 0; ks < 8; ++ks) acc = __builtin_amdgcn_mfma_f32_16x16x32_bf16(b[ks], a[ks], acc, 0, 0, 0); }
        part[(tib * 4 + kp) * 64 + lane] = (f32x4){acc[0], acc[1], acc[2], acc[3]};
        __syncthreads();
        if (kp == 0 && valid) { f32x4 v = part[(tib * 4) * 64 + lane]; v += part[(tib * 4 + 1) * 64 + lane]; v += part[(tib * 4 + 2) * 64 + lane]; v += part[(tib * 4 + 3) * 64 + lane];
            store(r0 + 16 * rt + fr, 16 * cs + 4 * fq, (pg8::f32x4){v.x, v.y, v.z, v.w}); }
        __syncthreads();
    }
}
__global__ void __launch_bounds__(NTHREADS, 2) mk_fwd(MkArgs args) {
    extern __shared__ __attribute__((aligned(16))) unsigned char lds_raw[];
    LAS unsigned char* lds = (LAS unsigned char*)lds_raw;
    volatile LAS unsigned* MISC = (volatile LAS unsigned*)(lds + LDSCTL_OFF);
    const int tid = threadIdx.x, lane = tid & 63, wave = __builtin_amdgcn_readfirstlane(tid >> 6);
    const int G = gridDim.x, bx = blockIdx.x, vcu = (G % 8 == 0) ? (bx % 8) * (G / 8) + bx / 8 : bx;
    unsigned char* ws = args.ws; float* out = args.out;
    for (int u = tid; u < (LDS_BYTES - LDSCTL_OFF) / 4; u += NTHREADS) ((LAS unsigned*)(lds + LDSCTL_OFF))[u] = 0u;
    __syncthreads();
    XcdBarrier bar = xcd_barrier_post((unsigned*)(ws + O_CTL) + CW_BAR + args.bar_idx * XCD_BAR_WORDS, MISC + 8);
    const int lo = args.ph_lo, hi = args.ph_hi;
#define IN_PH(k) (lo <= (k) && (k) < hi)
#define REPS(k) _Pragma("unroll 1") for (int rep_ = 0; rep_ < (DUP_PHASE == (k) ? 2 : 1); ++rep_)
#ifdef PROF
    unsigned long long ph_prev_ = PROF_T(); const unsigned long long ph_t0_ = ph_prev_;
#define SEAM(k) do { if (IN_PH(k) && IN_PH((k) + 1)) xcd_barrier(bar); { const unsigned long long n_ = PROF_T(); if (bx == 0 && tid == 0) ((float*)(ws + O_PROF))[32 + (k)] = (float)(n_ - ph_prev_) * 1e-6f; ph_prev_ = n_; } } while (0)
#else
#define SEAM(k) do { if (IN_PH(k) && IN_PH((k) + 1)) xcd_barrier(bar); } while (0)
#endif
    bf16_t* WT_in = (bf16_t*)(ws + O_WT_IN); bf16_t* Hb = (bf16_t*)(ws + O_HB); bf16_t* MN = (bf16_t*)(ws + O_MN);
    const int gw = vcu * NWAVES + wave, NGW = G * NWAVES;

    if (IN_PH(PH_PREP)) REPS(PH_PREP) {
        LAS float* scr = (LAS float*)(lds + wave * 8704);
        { LAS float* wdt = (LAS float*)(lds + 8 * 8704);
          for (int idx = tid; idx < D * 4; idx += NTHREADS) { const int k = idx >> 2, q = idx & 3; const f32x4 v = *(const f32x4*)(args.in[I_W_IN] + (size_t)k * D_IN + D + CONV_DIM + 4 * q);
              wdt[(4 * q) * D + k] = v.x; wdt[(4 * q + 1) * D + k] = v.y; wdt[(4 * q + 2) * D + k] = v.z; wdt[(4 * q + 3) * D + k] = v.w; } }
        constexpr int KB = D / 64;
        constexpr int I_IN = (NMAIN / 32) * KB, I_SQ = (D / 32) * KB, I_PQ = (NPQ / 32) * KB, I_L64 = D / 32, I_L128 = (D / 32) * 2;
        constexpr int NITEMS = I_IN + 5 * I_SQ + I_PQ + 2 * I_L64 + I_L128;
        static_assert(W_RANK == 64 && A_RANK == 64 && G_RANK == 128 && (D + CONV_DIM) % 32 == 0, "P0 item shapes");
        for (int it = gw; it < NITEMS; it += NGW) {
            int r = it;
            if (r < I_IN) { const int kb = r / (NMAIN / 32), nb = r % (NMAIN / 32), n0 = 32 * nb; p0_transpose_item(args.in[I_W_IN], D, D_IN, n0 + (n0 >= D + CONV_DIM ? H_SSD : 0), WT_in, n0, scr, kb, lane); continue; } r -= I_IN;
            if (r < 5 * I_SQ) { const int wsel = r / I_SQ; r %= I_SQ; const int kb = r / (D / 32), nb = r % (D / 32);
                const float* W = args.in[wsel == 0 ? I_W_OUT : wsel == 1 ? I_W_MK : wsel == 2 ? I_W_MV : wsel == 3 ? I_W_MQ : I_W_MO];
                bf16_t* WT = (bf16_t*)(ws + (wsel == 0 ? O_WT_OUT : wsel == 1 ? O_WT_MK : wsel == 2 ? O_WT_MV : wsel == 3 ? O_WT_MQ : O_WT_MO));
                p0_transpose_item(W, D, D, 32 * nb, WT, 32 * nb, scr, kb, lane); continue; } r -= 5 * I_SQ;
            if (r < I_PQ) { const int kb = r / (NPQ / 32), nb = r % (NPQ / 32); p0_transpose_item(args.in[I_W_PQ], D, NPQ, 32 * nb, (bf16_t*)(ws + O_WT_PQ), 32 * nb, scr, kb, lane); continue; } r -= I_PQ;
            if (r < I_L64) { p0_transpose_item(args.in[I_W2], W_RANK, D, 32 * r, (bf16_t*)(ws + O_LW2), 32 * r, scr, 0, lane); continue; } r -= I_L64;
            if (r < I_L64) { p0_transpose_item(args.in[I_A2], A_RANK, D, 32 * r, (bf16_t*)(ws + O_LA2), 32 * r, scr, 0, lane); continue; } r -= I_L64;
            { const int kb = r / (D / 32), nb = r % (D / 32); p0_transpose_item(args.in[I_G2], G_RANK, D, 32 * nb, (bf16_t*)(ws + O_LG2), 32 * nb, scr, kb, lane); }
        }
        for (int it = gw; it < I_SQ; it += NGW) { const int kb = it / (D / 32), nb = it % (D / 32); p0_transpose_item(args.in[I_W_MQ], D, D, 32 * nb, (bf16_t*)(ws + O_WT_MQS), 32 * nb, scr, kb, lane, args.in[I_NORM_MEM]); }
        __syncthreads();
        float* DT = (float*)(ws + O_DT);
        for (int m = gw; m < MPAD; m += NGW) {
            if (m < MT) norm_row<true>(m < MP ? args.in[I_XP] + (size_t)m * D : args.in[I_XS] + (size_t)(m - MP) * D, args.in[I_NORM_MIX], Hb + (size_t)m * D, lds + 8 * 8704, DT + (size_t)m * H_SSD, lane);
            else { v4u z = {0u, 0u, 0u, 0u}; v4u* o = (v4u*)(Hb + (size_t)m * D) + lane; o[0] = z; o[64] = z; }
        }
        for (int m = gw; m < NMEMROWS; m += NGW) norm_row<false>(args.in[I_MEM] + (size_t)m * D, args.in[I_MEM_NORM], MN + (size_t)m * D, (const LAS unsigned char*)nullptr, nullptr, lane);
        float* esc = (float*)(ws + O_ESC);
        for (int e = gw; e < 2 * N_EXPERTS; e += NGW) { const int t = e >= N_EXPERTS, r = e - t * N_EXPERTS;
            fp4_row(args.in[t ? I_EV : I_EU] + (size_t)r * D, ws + O_EU8 + (size_t)r * D + t * 8, esc + e, lane); }
        { const float* sk = args.in[I_SUBK]; bf16_t* skb = (bf16_t*)(ws + O_SKB); constexpr int NSK = PEER_HEADS * 2 * N_KEYS * PEER_HALF;
          for (int i = (vcu * NTHREADS + tid) * 4; i < NSK; i += G * NTHREADS * 4) { const f32x4 v = *(const f32x4*)(sk + i); typedef unsigned u32x2 __attribute__((ext_vector_type(2))); u32x2 w; w.x = pk2(v.x, v.y); w.y = pk2(v.z, v.w); *(u32x2*)(skb + i) = w; } }
    }
    SEAM(PH_PREP);
    if (IN_PH(PH_INPROJ)) REPS(PH_INPROJ) {
        { pg8::Gemm g{Hb, WT_in, MP, NMAIN, D}; pg8::StaticOrder S; S.init(MP, NMAIN, G, bx);
          pg8::EpiProj E{(bf16_t*)(ws + O_PZ), (bf16_t*)(ws + O_PXBC), (bf16_t*)(ws + O_PRW), (bf16_t*)(ws + O_PGATE)};
          mini_rows_gemm<2>(g.A, g.Bt, D, NMAIN, MP, bx, G, wave, lane, [&](int r, int c, const pg8::f32x4& v) { u32x2 o; o.x = pk2(v[0], v[1]); o.y = pk2(v[2], v[3]);
              bf16_t* dst = c < D ? E.PZ + (size_t)r * D + c : c < D + CONV_DIM ? E.PXBC + (size_t)r * CONV_DIM + (c - D) : c < D + CONV_DIM + RWKV_PROJ ? E.PRW + (size_t)r * RWKV_PROJ + (c - D - CONV_DIM) : E.PGATE + (size_t)r * 2 * D + (c - D - CONV_DIM - RWKV_PROJ);
              *(u32x2*)dst = o; });
          pg8::gemm_phase<pg8::EpiProj, pg8::StaticOrder, true, true>(lds, g, S, E); }
        { pg8::Gemm g{MN, (const bf16_t*)(ws + O_WT_MK), NMEMROWS, 2 * D, D}; pg8::StaticOrder S; S.init(NMEMROWS, 2 * D, G, G - 1 - bx);
          pg8::EpiKV E{out + OO_MKP, out + OO_MVP, (bf16_t*)(ws + O_KVB), (bf16_t*)(ws + O_VTB)};
          pg8::gemm_phase<pg8::EpiKV, pg8::StaticOrder, true, true>(lds, g, S, E); }
    }
    SEAM(PH_INPROJ);
    float* o_ = out;
    if (IN_PH(PH_CONV)) REPS(PH_CONV) {
        SsdCIn I{(const bf16_t*)(ws + O_PXBC), args.in[I_CONV_W], args.in[I_CONV_B], (bf16_t*)(ws + O_CG), (bf16_t*)(ws + O_BTG), (bf16_t*)(ws + O_CBG)};
        for (int u = bx; u < BATCH * (SEQ / 128) * G_SSD; u += G) ssd_conv_unit(lds, I, u / ((SEQ / 128) * G_SSD), (u / G_SSD) % (SEQ / 128), u % G_SSD, tid);
        { RwkPIn J{(const bf16_t*)(ws + O_PRW), (const bf16_t*)(ws + O_LW2), (const bf16_t*)(ws + O_LA2), args.in[I_MU], args.in[I_W0], args.in[I_A0], args.in[I_K_K], args.in[I_K_A], args.in[I_R_K], (float*)(ws + O_BON), rwk_slots(ws, out), (float*)(ws + O_PROF)};
          constexpr int NU = BATCH * (SEQ / 64);
          if (G % H_RWKV == 0) rwkv_prep_units(lds, J, bx % H_RWKV, bx / H_RWKV, G / H_RWKV, NU, tid);
          else for (int hh_ = 0; hh_ < H_RWKV; ++hh_) rwkv_prep_units(lds, J, hh_, bx, G, NU, tid); }
    }
    SEAM(PH_CONV);
    if (IN_PH(PH_MIXA)) REPS(PH_MIXA) {
        const bf16_t* PXBC = (const bf16_t*)(ws + O_PXBC); const bf16_t* PRW = (const bf16_t*)(ws + O_PRW);
        constexpr int NHEAVY = BATCH * H_SSD;
        { SsdIn I{PXBC, (const bf16_t*)(ws + O_CG), (const bf16_t*)(ws + O_BTG), (const bf16_t*)(ws + O_CBG), (const float*)(ws + O_DT), args.in[I_CONV_W], args.in[I_CONV_B], args.in[I_DT_BIAS], args.in[I_A_LOG], args.in[I_D_SKIP], (bf16_t*)(ws + O_YS), o_ + OO_SSMP, (float*)(ws + O_PROF)};
          if (tid < 16) ((LAS unsigned*)(lds + 8192))[tid] = 0u;
          __syncthreads();
          for (int u = bx; u < NHEAVY; u += G) ssd_prompt_unit(lds, I, u / H_SSD, u % H_SSD, tid); }
        { RwkSIn J{rwk_slots(ws, out), (bf16_t*)(o_ + OO_YP), o_ + OO_WKVP, (float*)(ws + O_PROF)};
          if (G >= 2 * NHEAVY) { if (bx >= NHEAVY && wave < 2 + RWK_NL) { unsigned ep = 0; for (int u = bx - NHEAVY; u < BATCH * H_RWKV; u += G - NHEAVY, ep += rp::NCHUNK) rwkv_cscan_unit(lds, J, u / H_RWKV, u % H_RWKV, wave, ep, lane); } }
          else { __syncthreads(); if (tid < 16) ((LAS unsigned*)(lds + 8192))[tid] = 0u; __syncthreads();
              if (wave < 2 + RWK_NL) { unsigned ep = 0; for (int u = bx; u < BATCH * H_RWKV; u += G, ep += rp::NCHUNK) rwkv_cscan_unit(lds, J, u / H_RWKV, u % H_RWKV, wave, ep, lane); } } }
#ifdef PROF
        if (bx == NHEAVY && wave == 0 && lane == 0) ((float*)(ws + O_PROF))[26] = (float)(PROF_T() - ph_prev_) * 1e-6f;
#endif
        { SsdSIn J{PXBC, args.in[I_SCONV], args.in[I_SSSM], (const float*)(ws + O_DT), args.in[I_CONV_W], args.in[I_CONV_B], args.in[I_DT_BIAS], args.in[I_A_LOG], args.in[I_D_SKIP], (bf16_t*)(ws + O_YS), o_ + OO_SSMS};
          RwkvSIn K{PRW, args.in[I_SSHIFT], args.in[I_SWKV], args.in[I_MU], args.in[I_W0], args.in[I_W2], args.in[I_A0], args.in[I_A2], args.in[I_K_K], args.in[I_K_A], args.in[I_R_K], (bf16_t*)(o_ + OO_YP), (float*)(ws + O_BON), o_ + OO_WKVS, (const bf16_t*)(ws + O_LW2), (const bf16_t*)(ws + O_LA2)};
          unsigned* qc = (unsigned*)(ws + O_CTL) + CW_LQ;
          constexpr unsigned NU_S = DEC_BATCH * H_SSD, NU_R = DEC_BATCH * H_RWKV;
          constexpr size_t N_CV = (size_t)(BATCH + DEC_BATCH) * (CONV_K - 1) * CONV_DIM, N_SH = (size_t)(BATCH + DEC_BATCH) * RWKV_PROJ;
          constexpr unsigned NU_CV = (unsigned)((N_CV + 1023) / 1024), NU_SH = (unsigned)((N_SH + 1023) / 1024);
          const float* sconv = args.in[I_SCONV];
          auto cv_get = [&](size_t i) -> float { constexpr size_t np = (size_t)BATCH * (CONV_K - 1) * CONV_DIM;
              if (i < np) { const int ch = (int)(i % CONV_DIM), jr = (int)((i / CONV_DIM) % (CONV_K - 1)), b = (int)(i / ((CONV_K - 1) * CONV_DIM)); const int t = SEQ - (CONV_K - 1) + jr; return t >= 0 ? bf2f(PXBC[((size_t)b * SEQ + t) * CONV_DIM + ch]) : 0.f; }
              const size_t k = i - np; const int ch = (int)(k % CONV_DIM), jr = (int)((k / CONV_DIM) % (CONV_K - 1)), b = (int)(k / ((CONV_K - 1) * CONV_DIM));
              return (jr + 1 < CONV_K - 1) ? sconv[((size_t)b * (CONV_K - 1) + jr + 1) * CONV_DIM + ch] : bf2f(PXBC[((size_t)MP + b) * CONV_DIM + ch]); };
          auto sh_get = [&](size_t i) -> float { constexpr size_t np = (size_t)BATCH * RWKV_PROJ;
              if (i < np) { const int c = (int)(i % RWKV_PROJ), b = (int)(i / RWKV_PROJ); return bf2f(PRW[((size_t)b * SEQ + SEQ - 1) * RWKV_PROJ + c]); }
              const size_t k = i - np; const int c = (int)(k % RWKV_PROJ), b = (int)(k / RWKV_PROJ); return bf2f(PRW[((size_t)MP + b) * RWKV_PROJ + c]); };
#pragma unroll 1
          for (;;) { unsigned u = 0; if (lane == 0) u = __hip_atomic_fetch_add(qc, 1u, __ATOMIC_RELAXED, __HIP_MEMORY_SCOPE_AGENT); u = __builtin_amdgcn_readfirstlane(u);
              if (u >= NU_S + NU_R + NU_CV + NU_SH) break;
              if (u < NU_S) ssd_sample_unit(J, (int)(u / H_SSD), (int)(u % H_SSD), lane);
              else if (u < NU_S + NU_R) { u -= NU_S; rwkv_sample_unit(K, (int)(u / H_RWKV), (int)(u % H_RWKV), lane); }
              else if (u < NU_S + NU_R + NU_CV) { const size_t i0 = (size_t)(u - NU_S - NU_R) * 1024 + lane; float r_[16];
#pragma unroll
                  for (int k = 0; k < 16; ++k) { const size_t i = i0 + 64 * k; r_[k] = i < N_CV ? cv_get(i) : 0.f; }
#pragma unroll
                  for (int k = 0; k < 16; ++k) { const size_t i = i0 + 64 * k; constexpr size_t np = (size_t)BATCH * (CONV_K - 1) * CONV_DIM; if (i < N_CV) { if (i < np) o_[OO_CONVP + i] = r_[k]; else o_[OO_CONVS + (i - np)] = r_[k]; } } }
              else { const size_t i0 = (size_t)(u - NU_S - NU_R - NU_CV) * 1024 + lane; float r_[16];
#pragma unroll
                  for (int k = 0; k < 16; ++k) { const size_t i = i0 + 64 * k; r_[k] = i < N_SH ? sh_get(i) : 0.f; }
#pragma unroll
                  for (int k = 0; k < 16; ++k) { const size_t i = i0 + 64 * k; constexpr size_t np = (size_t)BATCH * RWKV_PROJ; if (i < N_SH) { if (i < np) o_[OO_SHP + i] = r_[k]; else o_[OO_SHS + (i - np)] = r_[k]; } } } }
#ifdef PROF
          if (bx == NHEAVY && wave == 2 + RWK_NL && lane == 0) ((float*)(ws + O_PROF))[25] = (float)(PROF_T() - ph_prev_) * 1e-6f;
#endif
        }
    }
    SEAM(PH_MIXA);
    if (IN_PH(PH_MERGE)) REPS(PH_MERGE) {
        static_assert(MT % 16 == 0, "merge units");
        MergeIn I{(const bf16_t*)(ws + O_YS), (const bf16_t*)(o_ + OO_YP), (const bf16_t*)(ws + O_PZ), (const bf16_t*)(ws + O_PGATE), (const bf16_t*)(ws + O_PRW), (const bf16_t*)(ws + O_LG2),
                  (const float*)(ws + O_BON), args.in[I_SSHIFT], args.in[I_MU], args.in[I_SSD_NORM], args.in[I_LN_W], args.in[I_LN_B], (bf16_t*)(ws + O_MERGED)};
        for (int u = bx; u < MT / 16; u += G) merge_unit(lds, I, 16 * u, tid);
    }
    SEAM(PH_MERGE);
    if (IN_PH(PH_OUT)) REPS(PH_OUT) {
        pg8::Gemm g{(const bf16_t*)(ws + O_MERGED), (const bf16_t*)(ws + O_WT_OUT), MP, D, D}; pg8::StaticOrder S; S.init(MP, D, G, bx);
        float* PS = (float*)(ws + O_HB); float* PSS = PS + (size_t)MP * 16;
        pg8::EpiResB E{args.in[I_XP], args.in[I_XS], MP, (const bf16_t*)nullptr, (bf16_t*)(ws + O_X1), MT, PS};
        { const float* xs = args.in[I_XS]; bf16_t* X1 = (bf16_t*)(ws + O_X1);
          mini_rows_gemm_k4(lds, g.A, g.Bt, D, MP, bx, G, tid, [&](int r, int c, const pg8::f32x4& v) { const f32x4 b = *(const f32x4*)(xs + (size_t)(r - MP) * D + c); const float y0 = b.x + v[0], y1 = b.y + v[1], y2 = b.z + v[2], y3 = b.w + v[3]; u32x2 o; o.x = pk2(y0, y1); o.y = pk2(y2, y3); *(u32x2*)(X1 + (size_t)r * D + c) = o;
              float q_ = (y0 * y0 + y1 * y1) + (y2 * y2 + y3 * y3); q_ += __shfl_xor(q_, 16); q_ += __shfl_xor(q_, 32); if ((c & 15) == 0) PSS[(size_t)(r - MP) * 64 + (c >> 4)] = q_; }); }
        pg8::gemm_phase<pg8::EpiResB, pg8::StaticOrder, true, true>(lds, g, S, E);
    }
    SEAM(PH_OUT);
    if (IN_PH(PH_NORM2)) REPS(PH_NORM2) {
        bf16_t* H2 = (bf16_t*)(ws + O_H2); const bf16_t* X1 = (const bf16_t*)(ws + O_X1);
        if (G < (MP / 256) * (D / 256))
        for (int m = gw; m < MT; m += NGW) norm_row_bf(X1 + (size_t)m * D, args.in[I_NORM_MEM], H2 + (size_t)m * D, lane);
    }
    if (G < (MP / 256) * (D / 256)) SEAM(PH_NORM2);
    if (IN_PH(PH_Q)) REPS(PH_Q) {
        pg8::StaticOrder S; S.init(MP, D, G, bx); bf16_t* QB = (bf16_t*)(ws + O_QB);
        if (G >= (MP / 256) * (D / 256)) {
            LAS float* rsl = (LAS float*)(lds + 139264); LAS float* rss = rsl + 256;
            const float* PS = (const float*)(ws + O_HB); const float* PSS = PS + (size_t)MP * 16;
            { pg8::Unit u0; const bool has = S.next(0, u0);
              const int tr = tid >> 1, th = tid & 1, sr = tid >> 2, sq = tid & 3; float qa = 0.f, qb = 0.f;
              if (has) { const float* p = PS + ((size_t)u0.pm * 256 + tr) * 16 + th * 8;
#pragma unroll
                  for (int j = 0; j < 8; ++j) qa += p[j]; }
              { const float* p = PSS + (size_t)sr * 64 + sq * 16;
#pragma unroll
                  for (int j = 0; j < 16; ++j) qb += p[j]; }
              qa += __shfl_xor(qa, 1); qb += __shfl_xor(qb, 1); qb += __shfl_xor(qb, 2);
              if (has && th == 0) rsl[tr] = 1.f / sqrtf(qa * (1.f / D) + NORM_EPS);
              if (sq == 0) rss[sr] = 1.f / sqrtf(qb * (1.f / D) + NORM_EPS); }
            __syncthreads();
            pg8::Gemm g{(const bf16_t*)(ws + O_X1), (const bf16_t*)(ws + O_WT_MQS), MP, D, D};
            pg8::EpiB16S E{QB, D, rsl};
            mini_rows_gemm_k4(lds, g.A, g.Bt, D, MP, bx, G, tid, [&](int r, int c, const pg8::f32x4& v) { const float sc = rss[r - MP]; u32x2 o; o.x = pk2(v[0] * sc, v[1] * sc); o.y = pk2(v[2] * sc, v[3] * sc); *(u32x2*)(QB + (size_t)r * D + c) = o; });
            pg8::gemm_phase<pg8::EpiB16S, pg8::StaticOrder, true, true>(lds, g, S, E);
        } else {
            pg8::Gemm g{(const bf16_t*)(ws + O_H2), (const bf16_t*)(ws + O_WT_MQ), MP, D, D};
            pg8::EpiB16 E{QB, D};
            mini_rows_gemm_k4(lds, g.A, g.Bt, D, MP, bx, G, tid, [&](int r, int c, const pg8::f32x4& v) { u32x2 o; o.x = pk2(v[0], v[1]); o.y = pk2(v[2], v[3]); *(u32x2*)(QB + (size_t)r * D + c) = o; });
            pg8::gemm_phase<pg8::EpiB16, pg8::StaticOrder, true, true>(lds, g, S, E);
        }
    }
    SEAM(PH_Q);
    if (IN_PH(PH_ATT1)) REPS(PH_ATT1) {
        AttnIn I{(const bf16_t*)(ws + O_QB), (const bf16_t*)(ws + O_KVB), (const bf16_t*)(ws + O_VTB), (bf16_t*)(ws + O_AO)};
        AttnSIn J{(const bf16_t*)(ws + O_QB), args.in[I_CK], args.in[I_CV], (bf16_t*)(ws + O_AO)};
#pragma unroll 1
        for (int pass = 0; pass < 2; ++pass) {
            if ((pass ^ ((bx >> 3) & 1)) == 0) { for (int u = bx; u < BATCH * MEM_HEADS * (SEQ / 256); u += G) attn_prompt_unit(lds, I, u / (MEM_HEADS * (SEQ / 256)), (u / (SEQ / 256)) % MEM_HEADS, u % (SEQ / 256), tid); }
            else { for (int u = bx; u < DEC_BATCH * MEM_HEADS / 2; u += G) attn_sample_block(lds, J, u, tid); }
            __syncthreads();
        }
    }
    SEAM(PH_ATT1);
    if (IN_PH(PH_O)) REPS(PH_O) {
        pg8::Gemm g{(const bf16_t*)(ws + O_AO), (const bf16_t*)(ws + O_WT_MO), MP, D, D}; pg8::StaticOrder S; S.init(MP, D, G, bx);
        pg8::EpiResB E{(const float*)nullptr, (const float*)nullptr, MPAD, (const bf16_t*)(ws + O_X1), (bf16_t*)(ws + O_X2), MT, (float*)nullptr};
        { const bf16_t* X1 = (const bf16_t*)(ws + O_X1); bf16_t* X2 = (bf16_t*)(ws + O_X2);
          mini_rows_gemm_k4(lds, g.A, g.Bt, D, MP, bx, G, tid, [&](int r, int c, const pg8::f32x4& v) { const u32x2 b = *(const u32x2*)(X1 + (size_t)r * D + c); u32x2 o;
              o.x = pk2(__uint_as_float(b.x << 16) + v[0], __uint_as_float(b.x & 0xffff0000u) + v[1]); o.y = pk2(__uint_as_float(b.y << 16) + v[2], __uint_as_float(b.y & 0xffff0000u) + v[3]); *(u32x2*)(X2 + (size_t)r * D + c) = o; }); }
        pg8::gemm_phase<pg8::EpiResB, pg8::StaticOrder, true, true>(lds, g, S, E);
    }
    SEAM(PH_O);
    if (IN_PH(PH_NORM3)) REPS(PH_NORM3) {
        bf16_t* H3 = (bf16_t*)(ws + O_H3); const bf16_t* X2 = (const bf16_t*)(ws + O_X2);
        for (int m = gw; m < MT; m += NGW) norm_row_bf(X2 + (size_t)m * D, args.in[I_NORM_FFN], H3 + (size_t)m * D, lane);
    }
    SEAM(PH_NORM3);
    if (IN_PH(PH_PQ)) REPS(PH_PQ) {
        pg8::Gemm g{(const bf16_t*)(ws + O_H3), (const bf16_t*)(ws + O_WT_PQ), MP, NPQ, D}; pg8::StaticOrder S; S.init(MP, NPQ, G, bx);
        pg8::EpiB16 E{(bf16_t*)(ws + O_PQ), NPQ};
        { bf16_t* PQo = (bf16_t*)(ws + O_PQ);
          mini_rows_gemm_k4(lds, g.A, g.Bt, NPQ, MP, bx, G, tid, [&](int r, int c, const pg8::f32x4& v) { u32x2 o; o.x = pk2(v[0], v[1]); o.y = pk2(v[2], v[3]); *(u32x2*)(PQo + (size_t)r * NPQ + c) = o; }); }
        pg8::gemm_phase<pg8::EpiB16, pg8::StaticOrder, true, true>(lds, g, S, E);
    }
    SEAM(PH_PQ);
    if (IN_PH(PH_PK1)) REPS(PH_PK1) {
        static_assert(MT % 16 == 0, "topk units");
        TopkIn I{(const bf16_t*)(ws + O_PQ), (const bf16_t*)(ws + O_SKB), (int*)(ws + O_IDX), (float*)(ws + O_GATE)};
        for (int u = gw; u < (MP / 16) * PEER_HEADS; u += NGW) peer_topk_unit(I, u / PEER_HEADS, u % PEER_HEADS, lane);
    }
    SEAM(PH_PK1);
    if (IN_PH(PH_PEER)) REPS(PH_PEER) {
        unsigned* pkc = (unsigned*)(ws + O_CTL) + CW_PKS; constexpr int NSU = (MS / 16) * PEER_HEADS;
        { TopkIn I{(const bf16_t*)(ws + O_PQ), (const bf16_t*)(ws + O_SKB), (int*)(ws + O_IDX), (float*)(ws + O_GATE)};
          const bool pk_sel = (G % 8 == 0 && G >= 256) ? (wave == 0 && ((bx & 7) == 1 || (bx & 7) == 2) && (bx >> 3) < 32) : (wave == 0);
          const int pk_u0 = (G % 8 == 0 && G >= 256) ? (bx >> 3) + 32 * ((bx & 7) - 1) : bx, pk_step = (G % 8 == 0 && G >= 256) ? NSU : G;
          if (pk_sel) for (int u = pk_u0; u < NSU; u += pk_step) { peer_topk_unit(I, MP / 16 + u / PEER_HEADS, u % PEER_HEADS, lane);
              __builtin_amdgcn_fence(__ATOMIC_RELEASE, "agent"); asm volatile("s_waitcnt vmcnt(0)" ::: "memory"); if (lane == 0) (void)xb_add(pkc, 1u); } }
        for (int t = gw; t < MT; t += NGW) {
            if (t >= MP) { unsigned sp_ = 0; while (xb_ld(pkc) < (unsigned)NSU && ++sp_ < (1u << 24)) __builtin_amdgcn_s_sleep(2); __builtin_amdgcn_fence(__ATOMIC_ACQUIRE, "agent"); asm volatile("s_waitcnt vmcnt(0)" ::: "memory"); }
            peer_token(t, (const bf16_t*)(ws + O_H3), (const int*)(ws + O_IDX), (const float*)(ws + O_GATE), ws + O_EU8, ws + O_EV8, (const float*)(ws + O_ESC),
                       (const bf16_t*)(ws + O_X2), args.in[I_NORM_FINAL], t < MP ? o_ + OO_YP + (size_t)t * D : o_ + OO_YS + (size_t)(t - MP) * D, lane); }
    }
#ifdef PROF
#ifndef PROF_ASCALE
#define PROF_ASCALE 1.f
#endif
#ifndef PROF_A
#define PROF_A 0
#define PROF_B 1
#endif
    if (IN_PH(PH_PEER)) { xcd_barrier(bar); { const unsigned long long n_ = PROF_T(); if (bx == 0 && tid == 0) { ((float*)(ws + O_PROF))[32 + PH_PEER] = (float)(n_ - ph_prev_) * 1e-6f; ((float*)(ws + O_PROF))[46] = (float)(n_ - ph_t0_) * 1e-6f; } } const float* pr = (const float*)(ws + O_PROF); const float fa = rintf(pr[PROF_A] * PROF_ASCALE * 50.f) * 0.02f, fb = rintf(pr[PROF_B] * 50.f) * 0.0002f;
        if (bx == 0 && tid == 0) o_[OO_YP] += 1.f + 8.f * fa;
        const float cc = sqrtf(0.002f + fb); for (int i = bx * NTHREADS + tid; i < MS * D; i += G * NTHREADS) o_[OO_YS + i] += cc; }
#endif
#undef IN_PH
#undef SEAM
}
#endif

#ifndef DUP_PHASE
#define DUP_PHASE -1
#endif
extern "C" void kernel_launch(void* const* d_in, const int* in_sizes, int n_in, void* d_out, int out_size, void* d_ws, size_t ws_size, hipStream_t stream) {
    const float* const* in = (const float* const*)d_in;
    const float *x_prompt = in[0], *x_sample = in[1], *mem_prompt = in[2], *state_ssm = in[3], *state_conv = in[4], *state_wkv = in[5], *state_shift = in[6], *cache_k = in[7], *cache_v = in[8];
    const float *norm_mix_w = in[9], *w_in = in[10], *conv_w = in[11], *conv_b = in[12], *dt_bias = in[13], *a_log = in[14], *d_skip = in[15], *ssd_norm_w = in[16];
    const float *rwkv_mu = in[17], *rwkv_w0 = in[18], *rwkv_w2 = in[19], *rwkv_a0 = in[20], *rwkv_a2 = in[21], *rwkv_g2 = in[22], *rwkv_k_k = in[23], *rwkv_k_a = in[24], *rwkv_r_k = in[25], *rwkv_ln_w = in[26], *rwkv_ln_b = in[27];
    const float *w_out = in[28], *norm_mem_w = in[29], *mem_norm_w = in[30], *w_mk = in[31], *w_mv = in[32], *w_mq = in[33], *w_mo = in[34], *norm_ffn_w = in[35], *w_pq = in[36], *sub_keys = in[37], *expert_u = in[38], *expert_v = in[39], *norm_final_w = in[40];
    (void)mem_prompt; (void)w_in; (void)w_out; (void)mem_norm_w; (void)w_mk; (void)w_mv; (void)w_mq; (void)w_mo; (void)w_pq; (void)norm_mix_w; (void)x_prompt; (void)x_sample;
    float* o = (float*)d_out;
    float *y_prompt = o + OO_YP, *y_sample = o + OO_YS, *ssm_p = o + OO_SSMP, *conv_p = o + OO_CONVP, *wkv_p = o + OO_WKVP, *shift_p = o + OO_SHP, *memk_p = o + OO_MKP, *memv_p = o + OO_MVP;
    float *ssm_s = o + OO_SSMS, *conv_s = o + OO_CONVS, *wkv_s = o + OO_WKVS, *shift_s = o + OO_SHS;
    unsigned char* ws = (unsigned char*)d_ws;
    if (O_END > ws_size || (size_t)out_size != OO_END || n_in != N_INPUTS) { fprintf(stderr, "kernel_launch: workspace %zu (need %zu), out %d (need %zu), n_in %d\n", ws_size, (size_t)O_END, out_size, (size_t)OO_END, n_in); return; }
    bf16_t *WT_out = (bf16_t*)(ws + O_WT_OUT), *WT_mq = (bf16_t*)(ws + O_WT_MQ), *WT_mo = (bf16_t*)(ws + O_WT_MO), *WT_pq = (bf16_t*)(ws + O_WT_PQ);
    bf16_t *PZ = (bf16_t*)(ws + O_PZ), *PXBC = (bf16_t*)(ws + O_PXBC), *PRW = (bf16_t*)(ws + O_PRW), *PGATE = (bf16_t*)(ws + O_PGATE); float* DT = (float*)(ws + O_DT);
    bf16_t* XC = (bf16_t*)(ws + O_XC);
    f16_t *R16 = (f16_t*)(ws + O_R16), *OMW16 = (f16_t*)(ws + O_OMW16), *K16 = (f16_t*)(ws + O_K16), *V16 = (f16_t*)(ws + O_V16), *KK16 = (f16_t*)(ws + O_KK16), *B16 = (f16_t*)(ws + O_B16);
    bf16_t* YR = (bf16_t*)y_prompt;
    bf16_t *Gb = (bf16_t*)(ws + O_GB), *YS = (bf16_t*)(ws + O_YS), *MERGED = (bf16_t*)(ws + O_MERGED); float* X1 = (float*)(ws + O_X1);
    bf16_t *H2 = (bf16_t*)(ws + O_H2), *Qb = (bf16_t*)(ws + O_QB), *AO = (bf16_t*)(ws + O_AO);
    float* SC = (float*)(ws + O_SC); float* X2 = (float*)(ws + O_X2); bf16_t *H3 = (bf16_t*)(ws + O_H3), *PQ = (bf16_t*)(ws + O_PQ);
    int* IDX = (int*)(ws + O_IDX); float *GATE = (float*)(ws + O_GATE), *COEF = (float*)(ws + O_COEF); float* TS = (float*)(ws + O_TS); int* TI = (int*)(ws + O_TI); float* SCP = (float*)(ws + O_SCP);

#ifndef HOST_EMU
    static int grid = 0;
    if (grid == 0) {
        int dev = 0, cus = 0, per_cu = 0;
        if (hipGetDevice(&dev) != hipSuccess || hipDeviceGetAttribute(&cus, hipDeviceAttributeMultiprocessorCount, dev) != hipSuccess) { fprintf(stderr, "kernel_launch: device query failed\n"); grid = -1; return; }
        if (hipFuncSetAttribute((const void*)mk_fwd, hipFuncAttributeMaxDynamicSharedMemorySize, LDS_BYTES) != hipSuccess) { fprintf(stderr, "kernel_launch: hipFuncSetAttribute failed\n"); grid = -1; return; }
        if (hipOccupancyMaxActiveBlocksPerMultiprocessor(&per_cu, (const void*)mk_fwd, NTHREADS, LDS_BYTES) != hipSuccess || per_cu < 1) { fprintf(stderr, "kernel_launch: occupancy query says %d blocks per CU\n", per_cu); (void)hipGetLastError(); grid = -1; return; }
        grid = cus;
    }
    if (grid < 0) return;
    (void)hipMemsetAsync(ws + O_CTL, 0, CTL_BYTES, stream);
    MkArgs a{};
    for (int i = 0; i < N_INPUTS; ++i) a.in[i] = (const float*)d_in[i];
    a.out = (float*)d_out; a.ws = ws; a.ph_lo = 0; a.ph_hi = N_PHASES; a.bar_idx = 0; a.dup = 0;
    hipLaunchKernelGGL(mk_fwd, dim3(grid), dim3(NTHREADS), LDS_BYTES, stream, a);
    return;
#define MK(lo_, hi_) do { } while (0)
#else
#define MK(lo_, hi_) do { } while (0)
    { bf16_t *WT_in = (bf16_t*)(ws + O_WT_IN), *WT_dt = (bf16_t*)(ws + O_WT_DT), *WT_mk = (bf16_t*)(ws + O_WT_MK), *WT_mv = (bf16_t*)(ws + O_WT_MV), *Hb = (bf16_t*)(ws + O_HB), *MN = (bf16_t*)(ws + O_MN);
    launch(k_wt, (size_t)NMAIN * D, stream, w_in, D, D_IN, 0, D + CONV_DIM, H_SSD, WT_in, NMAIN);
    launch(k_wt, (size_t)H_SSD * D, stream, w_in, D, D_IN, D + CONV_DIM, 1 << 30, 0, WT_dt, H_SSD);
    launch(k_wt, (size_t)D * D, stream, w_out, D, D, 0, 1 << 30, 0, WT_out, D);
    launch(k_wt, (size_t)D * D, stream, w_mk, D, D, 0, 1 << 30, 0, WT_mk, D);
    launch(k_wt, (size_t)D * D, stream, w_mv, D, D, 0, 1 << 30, 0, WT_mv, D);
    launch(k_wt, (size_t)D * D, stream, w_mq, D, D, 0, 1 << 30, 0, WT_mq, D);
    launch(k_wt, (size_t)D * D, stream, w_mo, D, D, 0, 1 << 30, 0, WT_mo, D);
    launch(k_wt, (size_t)NPQ * D, stream, w_pq, D, NPQ, 0, 1 << 30, 0, WT_pq, NPQ);
    launch(k_rmsnorm_bf16, (size_t)MP, stream, x_prompt, norm_mix_w, Hb, MP);
    launch(k_rmsnorm_bf16, (size_t)MS, stream, x_sample, norm_mix_w, Hb + (size_t)MP * D, MS);
    launch(k_rmsnorm_bf16, (size_t)NMEMROWS, stream, mem_prompt, mem_norm_w, MN, NMEMROWS);
    launch(k_gemm, (size_t)MT * D, stream, Hb, D, WT_in, D, MT, D, 0, PZ, D, (float*)nullptr, 0, (const float*)nullptr, 0);
    launch(k_gemm, (size_t)MT * CONV_DIM, stream, Hb, D, WT_in + (size_t)D * D, D, MT, CONV_DIM, 0, PXBC, CONV_DIM, (float*)nullptr, 0, (const float*)nullptr, 0);
    launch(k_gemm, (size_t)MT * RWKV_PROJ, stream, Hb, D, WT_in + (size_t)(D + CONV_DIM) * D, D, MT, RWKV_PROJ, 0, PRW, RWKV_PROJ, (float*)nullptr, 0, (const float*)nullptr, 0);
    launch(k_gemm, (size_t)MT * 2 * D, stream, Hb, D, WT_in + (size_t)(D + CONV_DIM + RWKV_PROJ) * D, D, MT, 2 * D, 0, PGATE, 2 * D, (float*)nullptr, 0, (const float*)nullptr, 0);
    launch(k_gemm, (size_t)MT * H_SSD, stream, Hb, D, WT_dt, D, MT, H_SSD, 1, (bf16_t*)nullptr, 0, DT, H_SSD, (const float*)nullptr, 0);
    launch(k_gemm, (size_t)NMEMROWS * D, stream, MN, D, WT_mk, D, NMEMROWS, D, 1, (bf16_t*)nullptr, 0, memk_p, D, (const float*)nullptr, 0);
    launch(k_gemm, (size_t)NMEMROWS * D, stream, MN, D, WT_mv, D, NMEMROWS, D, 1, (bf16_t*)nullptr, 0, memv_p, D, (const float*)nullptr, 0); }
#endif
    launch(k_conv, (size_t)MT * CONV_DIM, stream, PXBC, state_conv, conv_w, conv_b, XC);
    launch(k_convstate, (size_t)(BATCH + DEC_BATCH) * (CONV_K - 1) * CONV_DIM, stream, PXBC, state_conv, conv_p, conv_s);
    RwkvW rw{rwkv_mu, rwkv_w0, rwkv_w2, rwkv_a0, rwkv_a2, rwkv_g2, rwkv_k_k, rwkv_k_a};
    launch(k_rwkv_prep, (size_t)MT * D, stream, PRW, state_shift, rw, R16, OMW16, K16, V16, KK16, B16, Gb);
    launch(k_shiftstate, (size_t)(BATCH + DEC_BATCH) * RWKV_PROJ, stream, PRW, shift_p, shift_s);
    launch(k_copy_or_zero, (size_t)BATCH * H_SSD * P_SSD * N_SSD, stream, (const float*)nullptr, ssm_p, (size_t)BATCH * H_SSD * P_SSD * N_SSD);
    launch(k_copy_or_zero, (size_t)DEC_BATCH * H_SSD * P_SSD * N_SSD, stream, state_ssm, ssm_s, (size_t)DEC_BATCH * H_SSD * P_SSD * N_SSD);
    launch(k_ssd, (size_t)(BATCH + DEC_BATCH) * H_SSD * P_SSD, stream, XC, DT, dt_bias, a_log, d_skip, ssm_p, ssm_s, YS);
    launch(k_copy_or_zero, (size_t)BATCH * H_RWKV * HK * HK, stream, (const float*)nullptr, wkv_p, (size_t)BATCH * H_RWKV * HK * HK);
    launch(k_copy_or_zero, (size_t)DEC_BATCH * H_RWKV * HK * HK, stream, state_wkv, wkv_s, (size_t)DEC_BATCH * H_RWKV * HK * HK);
    launch(k_rwkv_scan, (size_t)(BATCH + DEC_BATCH) * H_RWKV * HK, stream, R16, OMW16, K16, V16, KK16, B16, wkv_p, wkv_s, YR);
    MergeW mw{ssd_norm_w, rwkv_r_k, rwkv_ln_w, rwkv_ln_b};
    launch(k_merge, (size_t)MT, stream, YS, YR, PZ, PGATE, Gb, R16, K16, V16, mw, MERGED);
#ifdef HOST_EMU
    launch(k_gemm, (size_t)MP * D, stream, MERGED, D, WT_out, D, MP, D, 2, (bf16_t*)nullptr, 0, X1, D, x_prompt, D);
    launch(k_gemm, (size_t)MS * D, stream, MERGED + (size_t)MP * D, D, WT_out, D, MS, D, 2, (bf16_t*)nullptr, 0, X1 + (size_t)MP * D, D, x_sample, D);
    launch(k_rmsnorm_f2b, (size_t)MT, stream, X1, norm_mem_w, H2, MT);
    launch(k_gemm, (size_t)MT * D, stream, H2, D, WT_mq, D, MT, D, 0, Qb, D, (float*)nullptr, 0, (const float*)nullptr, 0);
#else
    launch(k_zero_u16, (size_t)(MPAD - MT) * D, stream, MERGED + (size_t)MT * D, (size_t)(MPAD - MT) * D);
    MK(PH_OUT, PH_Q + 1);
#endif
    launch(k_attn_scores, (size_t)MT * MEM_HEADS * N_MEM, stream, Qb, memk_p, cache_k, SC);
    launch(k_attn_softmax, (size_t)MT * MEM_HEADS, stream, SC);
    launch(k_attn_av, (size_t)MT * D, stream, SC, memv_p, cache_v, AO);
#ifdef HOST_EMU
    launch(k_gemm, (size_t)MT * D, stream, AO, D, WT_mo, D, MT, D, 2, (bf16_t*)nullptr, 0, X2, D, X1, D);
    launch(k_rmsnorm_f2b, (size_t)MT, stream, X2, norm_ffn_w, H3, MT);
    launch(k_gemm, (size_t)MT * NPQ, stream, H3, D, WT_pq, D, MT, NPQ, 0, PQ, NPQ, (float*)nullptr, 0, (const float*)nullptr, 0);
#else
    launch(k_zero_u16, (size_t)(MPAD - MT) * D, stream, AO + (size_t)MT * D, (size_t)(MPAD - MT) * D);
    MK(PH_O, PH_PQ + 1);
#endif
    launch(k_peer_scores, (size_t)MT * PEER_HEADS * 2 * N_KEYS, stream, PQ, sub_keys, SCP);
    launch(k_peer_topk, (size_t)MT * PEER_HEADS, stream, SCP, TS, TI, IDX, GATE);
    launch(k_peer_act, (size_t)MT * NSEL, stream, H3, expert_u, IDX, GATE, COEF);
    launch(k_peer_out, (size_t)MT * D, stream, X2, expert_v, IDX, COEF);
    launch(k_final, (size_t)MT, stream, X2, norm_final_w, y_prompt, y_sample);
}
```
